# Optimizing an MI355X kernel written in HIP

```python
import math
import jax
import jax.numpy as jnp
from jax import lax
import numpy as np

D_MODEL = 1024
BATCH = 8
SEQ = 2048
DEPTH = 4

GRID_W = 64
CTX_LEN = 256
NORM_EPS = 1e-6
N_MOD = 6

D_MIX = D_MODEL
D_HYENA = D_MIX // 4
HYENA_SHORT = 3
HYENA_BANDS = 16
HYENA_EMB = 1 + 2 * HYENA_BANDS
HYENA_FILTER_HIDDEN = 64
HYENA_DECAY_TARGET = 1e-2
HYENA_FAST_PCT = 0.3
HYENA_SLOW_PCT = 1.5
RWKV_HEAD_DIM = 64
D_RWKV = D_MIX // 4
RWKV_HEADS = D_RWKV // RWKV_HEAD_DIM
RWKV_DECAY_LORA = 64
RWKV_ICLR_LORA = 64
RWKV_GATE_LORA = 128
RWKV_GN_EPS = 64e-5
GDN_HEAD_DIM = 128
D_GDN = D_MIX - D_HYENA - D_RWKV
GDN_HEADS = D_GDN // GDN_HEAD_DIM
GDN_CONV = 5
GDN_CHUNK = 64
HY_COLS = 3 * D_HYENA
RW_COLS = 3 * D_RWKV + 2 * RWKV_DECAY_LORA + 2 * RWKV_ICLR_LORA + RWKV_GATE_LORA
GDN_COLS = 4 * D_GDN + 4 * GDN_HEADS
IN_COLS = HY_COLS + RW_COLS + GDN_COLS
N_EXPERTS = 32
TOP_K = 4
D_EXPERT = D_MODEL
SWIGLU_ALPHA = 1.702
SWIGLU_LIMIT = 7.0
MOE_BLOCK = 256

kernel_name = 'hybrid_hyena_rwkv7_gdn_moe_dit'


def _rev(t):
    return jnp.flip(t, axis=1)


def rms_norm(h, w):
    hf = h.astype(jnp.float32)
    hf = hf * lax.rsqrt(jnp.mean(hf * hf, axis=-1, keepdims=True) + NORM_EPS)
    return (hf * w.astype(jnp.float32)).astype(h.dtype)


def modulate(h, shift, scale):
    return h * (1 + scale) + shift


def l2_normalize(t):
    return t * lax.rsqrt(jnp.sum(t * t, axis=-1, keepdims=True) + 1e-12)


def dwconv_centred(u, w):
    K, C = w.shape
    return lax.conv_general_dilated(u, w[:, None, :].astype(u.dtype), window_strides=(1,),
                                    padding=[(K // 2, K // 2)],
                                    dimension_numbers=('NWC', 'WIO', 'NWC'),
                                    feature_group_count=C)


def split_cols(p):
    return p[..., :HY_COLS], p[..., HY_COLS:HY_COLS + RW_COLS], p[..., HY_COLS + RW_COLS:]


def hyena_filters(L, w1, b1, w2, b2, w3, b3, w4, freq):
    f32 = jnp.float32
    pos = jnp.arange(L, dtype=f32)
    t = jnp.linspace(0.0, 1.0, L, dtype=f32)[:, None]
    bands = jnp.linspace(1e-4, HYENA_BANDS - 1, HYENA_BANDS, dtype=f32)
    ang = (2.0 * math.pi / L) * pos[:, None] * bands
    z = jnp.concatenate([t, jnp.cos(ang), -jnp.sin(ang)], axis=-1)
    fr = freq.astype(f32)
    hdn = jnp.sin(fr * (z @ w1.astype(f32) + b1.astype(f32)))
    hdn = jnp.sin(fr * (hdn @ w2.astype(f32) + b2.astype(f32)))
    hdn = jnp.sin(fr * (hdn @ w3.astype(f32) + b3.astype(f32)))
    h = hdn @ w4.astype(f32)
    deltas = jnp.linspace(math.log(HYENA_DECAY_TARGET) / HYENA_SLOW_PCT,
                          math.log(HYENA_DECAY_TARGET) / HYENA_FAST_PCT, D_HYENA, dtype=f32)
    window = jnp.exp(-t * jnp.abs(deltas))
    h_fwd = h[:, :D_HYENA] * window
    h_bwd = h[:, D_HYENA:] * window
    return jnp.concatenate([h_fwd, jnp.zeros((1, D_HYENA), f32), h_bwd[:0:-1]], axis=0)


def hyena_mixer(u, short_w, short_b, w1, b1, w2, b2, w3, b3, w4, freq, skip):
    L = u.shape[1]
    uc = dwconv_centred(u, short_w) + short_b
    x0, x1, v = jnp.split(uc, 3, axis=-1)
    v = (v * x1).astype(jnp.float32)
    k = hyena_filters(L, w1, b1, w2, b2, w3, b3, w4, freq)
    vf = jnp.fft.rfft(v, n=2 * L, axis=1)
    kf = jnp.fft.rfft(k, n=2 * L, axis=0)
    y = jnp.fft.irfft(vf * kf[None], n=2 * L, axis=1)[:, :L] + v * skip.astype(jnp.float32)
    return y.astype(u.dtype) * x0


def token_shift_grid(p):
    B, L, C = p.shape
    rows = L // GRID_W
    g = p.reshape(B, rows, GRID_W, C // 4, 4)
    gp = jnp.pad(g, ((0, 0), (1, 1), (1, 1), (0, 0), (0, 0)))
    left = gp[:, 1:-1, :-2, :, 0]
    right = gp[:, 1:-1, 2:, :, 1]
    up = gp[:, :-2, 1:-1, :, 2]
    down = gp[:, 2:, 1:-1, :, 3]
    return jnp.stack([left, right, up, down], axis=-1).reshape(B, L, C)


def token_shift_seq(p):
    B, L, C = p.shape
    s = jnp.pad(p.reshape(B, L, C // 2, 2), ((0, 0), (1, 1), (0, 0), (0, 0)))
    return jnp.stack([s[:, :-2, :, 0], s[:, 2:, :, 1]], axis=-1).reshape(B, L, C)


def rwkv7_prepare(m, w0, w2, a0, a2, g2, k_k, k_a):
    m = m.astype(jnp.float32)
    B, L, _ = m.shape
    H, N = RWKV_HEADS, RWKV_HEAD_DIM
    o1, o2, o3 = D_RWKV, 2 * D_RWKV, 3 * D_RWKV
    o4 = o3 + 2 * RWKV_DECAY_LORA
    o5 = o4 + 2 * RWKV_ICLR_LORA
    r, k, v = m[..., :o1], m[..., o1:o2], m[..., o2:o3]
    wd = m[..., o3:o4].reshape(B, L, 2, RWKV_DECAY_LORA)
    ad = m[..., o4:o5].reshape(B, L, 2, RWKV_ICLR_LORA)
    gd = m[..., o5:]
    lw = -jax.nn.softplus(-(w0 + jnp.einsum('bldr,drc->bldc', jnp.tanh(wd), w2))) - 0.5
    decay = jnp.exp(-jnp.exp(lw))
    a = jax.nn.sigmoid(a0 + jnp.einsum('bldr,drc->bldc', ad, a2))
    g = jax.nn.sigmoid(gd) @ g2
    kk = l2_normalize((k * k_k).reshape(B, L, H, N))
    k_dir = k[:, :, None] * (1 + (a - 1) * k_a)
    heads = lambda t: t.reshape(t.shape[:-1] + (H, N))
    return heads(r), heads(k_dir), heads(v), kk, heads(decay), heads(a), g


def rwkv7_dir(inp, d):
    r, k_dir, v, kk, decay, a, _ = inp
    seq = (r, decay[:, :, d], k_dir[:, :, d], v, -kk, kk * a[:, :, d])
    return tuple(_rev(t) for t in seq) if d else seq


def rwkv7_scan(s0, r, w, k, v, a, b):
    def step(s, inp):
        r_t, w_t, k_t, v_t, a_t, b_t = inp
        sa = jnp.einsum('bhvk,bhk->bhv', s, a_t)
        s = s * w_t[:, :, None, :] + sa[..., None] * b_t[:, :, None, :] + v_t[..., None] * k_t[:, :, None, :]
        return s, jnp.einsum('bhvk,bhk->bhv', s, r_t)
    xs = tuple(jnp.swapaxes(t, 0, 1) for t in (r, w, k, v, a, b))
    s, o = lax.scan(step, s0, xs)
    return s, jnp.swapaxes(o, 0, 1)


def rwkv7_finish(o, inp, r_k, gn_w, gn_b):
    r, k_dir, v, kk, decay, a, g = inp
    B, L, H, N = o.shape
    mean = jnp.mean(o, axis=-1, keepdims=True)
    var = jnp.mean(jnp.square(o - mean), axis=-1, keepdims=True)
    y = ((o - mean) * lax.rsqrt(var + RWKV_GN_EPS)).reshape(B, L, H * N) * gn_w + gn_b
    bonus = jnp.sum(r[:, :, None] * k_dir * r_k.reshape(H, N), axis=(2, 4))
    y = y + (bonus[..., None] * v).reshape(B, L, H * N)
    return y * g


def rwkv7_mixer(p_ctx, p_lat, mu, w0, w2, a0, a2, g2, k_k, k_a, r_k, gn_w, gn_b, with_ctx):
    B = p_lat.shape[0]
    m_ctx = p_ctx + mu * (token_shift_seq(p_ctx) - p_ctx)
    m_lat = p_lat + mu * (token_shift_grid(p_lat) - p_lat)
    ctx_in = rwkv7_prepare(m_ctx, w0, w2, a0, a2, g2, k_k, k_a)
    lat_in = rwkv7_prepare(m_lat, w0, w2, a0, a2, g2, k_k, k_a)
    s0 = jnp.zeros((B, RWKV_HEADS, RWKV_HEAD_DIM, RWKV_HEAD_DIM), jnp.float32)
    o_ctx, o_lat = 0.0, 0.0
    for d in range(2):
        s_c, oc = rwkv7_scan(s0, *rwkv7_dir(ctx_in, d))
        _, ol = rwkv7_scan(s_c, *rwkv7_dir(lat_in, d))
        o_ctx = o_ctx + (_rev(oc) if d else oc)
        o_lat = o_lat + (_rev(ol) if d else ol)
    y_lat = rwkv7_finish(o_lat, lat_in, r_k, gn_w, gn_b).astype(p_lat.dtype)
    y_ctx = rwkv7_finish(o_ctx, ctx_in, r_k, gn_w, gn_b).astype(p_ctx.dtype) if with_ctx else None
    return y_ctx, y_lat


def gdn_prepare(p, conv_w, a_log, dt_bias):
    B, L, _ = p.shape
    H, K = GDN_HEADS, GDN_HEAD_DIM
    qkv = jax.nn.silu(dwconv_centred(p[..., :3 * D_GDN], conv_w)).astype(jnp.float32)
    q, k, v = [t.reshape(B, L, H, K) for t in jnp.split(qkv, 3, axis=-1)]
    z = p[..., 3 * D_GDN:4 * D_GDN]
    rest = p[..., 4 * D_GDN:].astype(jnp.float32)
    beta = jax.nn.sigmoid(rest[..., :2 * H].reshape(B, L, 2, H))
    g = -jnp.exp(a_log) * jax.nn.softplus(rest[..., 2 * H:].reshape(B, L, 2, H) + dt_bias)
    return l2_normalize(q), l2_normalize(k), v, z, beta, g


def gdn_chunk_scan(q, k, v, g, beta, s0):
    B, L, H, K = q.shape
    V = v.shape[-1]
    C = GDN_CHUNK
    n = L // C
    def chunks(t):
        return jnp.moveaxis(t.reshape((B, n, C, H) + t.shape[3:]), 3, 1)
    q = chunks(q * (K ** -0.5))
    k, v, g, beta = chunks(k), chunks(v), chunks(g), chunks(beta)
    gc = jnp.cumsum(g, axis=-1)
    causal = jnp.tril(jnp.ones((C, C), bool))
    strict = jnp.tril(jnp.ones((C, C), bool), -1)
    diff = gc[..., :, None] - gc[..., None, :]
    decay = jnp.where(causal, jnp.exp(jnp.where(causal, diff, 0.0)), 0.0)
    kb = k * beta[..., None]
    m = jnp.where(strict, jnp.einsum('bhnik,bhnjk->bhnij', kb, k) * decay, 0.0)
    rhs = jnp.concatenate([v * beta[..., None], kb * jnp.exp(gc)[..., None]], axis=-1)
    sol = lax.linalg.triangular_solve(m + jnp.eye(C, dtype=jnp.float32), rhs, left_side=True,
                                      lower=True, unit_diagonal=True)
    u, w = sol[..., :V], sol[..., V:]
    attn = jnp.einsum('bhnik,bhnjk->bhnij', q, k) * decay
    def step(s, xs):
        q_i, k_i, u_i, w_i, g_i, a_i = xs
        v_new = u_i - jnp.einsum('bhck,bhkv->bhcv', w_i, s)
        o = (jnp.einsum('bhck,bhkv->bhcv', q_i * jnp.exp(g_i)[..., None], s)
             + jnp.einsum('bhij,bhjv->bhiv', a_i, v_new))
        g_last = g_i[..., -1:]
        s = (s * jnp.exp(g_last)[..., None]
             + jnp.einsum('bhck,bhcv->bhkv', k_i * jnp.exp(g_last - g_i)[..., None], v_new))
        return s, o
    xs = tuple(jnp.moveaxis(t, 2, 0) for t in (q, k, u, w, gc, attn))
    s, o = lax.scan(step, s0, xs)
    return s, jnp.transpose(o, (1, 0, 3, 2, 4)).reshape(B, L, H, V)


def gdn_finish(o, z, norm_w):
    B, L, H, V = o.shape
    o = o * lax.rsqrt(jnp.mean(o * o, axis=-1, keepdims=True) + NORM_EPS) * norm_w.astype(jnp.float32)
    y = o * jax.nn.silu(z.astype(jnp.float32)).reshape(B, L, H, V)
    return y.reshape(B, L, H * V).astype(z.dtype)


def gdn_mixer(p_ctx, p_lat, conv_w, a_log, dt_bias, norm_w, with_ctx):
    B = p_lat.shape[0]
    qc, kc, vc, zc, bc, gc = gdn_prepare(p_ctx, conv_w, a_log, dt_bias)
    ql, kl, vl, zl, bl, gl = gdn_prepare(p_lat, conv_w, a_log, dt_bias)
    s0 = jnp.zeros((B, GDN_HEADS, GDN_HEAD_DIM, GDN_HEAD_DIM), jnp.float32)
    o_ctx, o_lat = 0.0, 0.0
    for d in range(2):
        f = _rev if d else (lambda t: t)
        s_c, oc = gdn_chunk_scan(f(qc), f(kc), f(vc), f(gc[:, :, d]), f(bc[:, :, d]), s0)
        _, ol = gdn_chunk_scan(f(ql), f(kl), f(vl), f(gl[:, :, d]), f(bl[:, :, d]), s_c)
        o_ctx = o_ctx + f(oc)
        o_lat = o_lat + f(ol)
    y_lat = gdn_finish(o_lat, zl, norm_w)
    y_ctx = gdn_finish(o_ctx, zc, norm_w) if with_ctx else None
    return y_ctx, y_lat


def moe_ffn(h, router_w, router_b, w_gu, b_gu, w_dn, b_dn):
    N, D = h.shape
    logits = (h @ router_w + router_b).astype(jnp.float32)
    top_logit, top_idx = lax.top_k(logits, TOP_K)
    gates = jax.nn.softmax(top_logit, axis=-1).astype(h.dtype)
    A = N * TOP_K
    flat_e = top_idx.reshape(A)
    flat_tok = jnp.arange(A, dtype=jnp.int32) // TOP_K
    flat_g = gates.reshape(A)
    order = jnp.argsort(flat_e)
    sorted_e = flat_e[order]
    counts = jnp.bincount(flat_e, length=N_EXPERTS)
    starts = jnp.cumsum(counts) - counts
    blocks_per = (counts + MOE_BLOCK - 1) // MOE_BLOCK
    block_end = jnp.cumsum(blocks_per)
    padded_starts = (block_end - blocks_per) * MOE_BLOCK
    dest = padded_starts[sorted_e] + jnp.arange(A, dtype=jnp.int32) - starts[sorted_e]
    n_blocks = -(-A // MOE_BLOCK) + N_EXPERTS
    slot_tok = jnp.full((n_blocks * MOE_BLOCK,), N, jnp.int32).at[dest].set(flat_tok[order])
    slot_g = jnp.zeros((n_blocks * MOE_BLOCK,), h.dtype).at[dest].set(flat_g[order])
    block_e = jnp.minimum(jnp.searchsorted(block_end, jnp.arange(n_blocks), side='right'), N_EXPERTS - 1)
    h_pad = jnp.concatenate([h, jnp.zeros((1, D), h.dtype)], axis=0)
    xb = h_pad[slot_tok].reshape(n_blocks, MOE_BLOCK, D)
    def expert_block(args):
        xblk, e = args
        gu = xblk @ w_gu[e] + b_gu[e]
        gate = jnp.minimum(gu[:, :D_EXPERT], SWIGLU_LIMIT)
        up = jnp.clip(gu[:, D_EXPERT:], -SWIGLU_LIMIT, SWIGLU_LIMIT)
        glu = gate * jax.nn.sigmoid(gate * SWIGLU_ALPHA)
        return ((up + 1) * glu) @ w_dn[e] + b_dn[e]
    yb = lax.map(expert_block, (xb, block_e))
    y = jax.ops.segment_sum(yb.reshape(-1, D) * slot_g[:, None], slot_tok, num_segments=N + 1)
    return y[:N]


def setup_inputs(seed: int = 0) -> dict:
    key = jax.random.key(seed)
    keys = iter(jax.random.split(key, 64))
    def nrm(shape, scale):
        return jax.random.normal(next(keys), shape, jnp.float32) * scale
    def unif(shape, lo, hi):
        return jax.random.uniform(next(keys), shape, jnp.float32, lo, hi)
    D, E, F, FH = D_MODEL, N_EXPERTS, D_EXPERT, HYENA_FILTER_HIDDEN
    dt = jnp.exp(unif((DEPTH, 2, GDN_HEADS), math.log(1e-3), math.log(1e-1)))
    return {
        'x': nrm((BATCH, SEQ, D), 1.0),
        'c': nrm((BATCH, D), 1.0),
        'ctx': nrm((BATCH, CTX_LEN, D), 1.0),
        'c_ctx': nrm((D,), 1.0),
        'ada_w': nrm((DEPTH, D, N_MOD * D), 0.5 * D ** -0.5),
        'ada_b': nrm((DEPTH, N_MOD * D), 0.02),
        'norm_mix_w': 1.0 + nrm((DEPTH, D), 0.02),
        'norm_ffn_w': 1.0 + nrm((DEPTH, D), 0.02),
        'final_norm_w': 1.0 + nrm((D,), 0.02),
        'w_in': nrm((DEPTH, D, IN_COLS), D ** -0.5),
        'w_out': nrm((DEPTH, D_MIX, D), D_MIX ** -0.5),
        'hy_short_w': nrm((DEPTH, HYENA_SHORT, HY_COLS), HYENA_SHORT ** -0.5),
        'hy_short_b': nrm((DEPTH, HY_COLS), 0.02),
        'hy_f_w1': nrm((DEPTH, HYENA_EMB, FH), HYENA_EMB ** -0.5),
        'hy_f_b1': nrm((DEPTH, FH), 0.02),
        'hy_f_w2': nrm((DEPTH, FH, FH), FH ** -0.5),
        'hy_f_b2': nrm((DEPTH, FH), 0.02),
        'hy_f_w3': nrm((DEPTH, FH, FH), FH ** -0.5),
        'hy_f_b3': nrm((DEPTH, FH), 0.02),
        'hy_f_w4': nrm((DEPTH, FH, 2 * D_HYENA), 0.05 * FH ** -0.5),
        'hy_f_freq': 1.0 + nrm((DEPTH, FH), 0.02),
        'hy_skip': nrm((DEPTH, D_HYENA), 0.5),
        'rw_mu': unif((DEPTH, RW_COLS), 0.0, 1.0),
        'rw_w0': unif((DEPTH, 2, D_RWKV), -6.0, -1.0),
        'rw_w2': nrm((DEPTH, 2, RWKV_DECAY_LORA, D_RWKV), 0.1 * RWKV_DECAY_LORA ** -0.5),
        'rw_a0': nrm((DEPTH, 2, D_RWKV), 0.1),
        'rw_a2': nrm((DEPTH, 2, RWKV_ICLR_LORA, D_RWKV), 0.5 * RWKV_ICLR_LORA ** -0.5),
        'rw_g2': nrm((DEPTH, RWKV_GATE_LORA, D_RWKV), RWKV_GATE_LORA ** -0.5),
        'rw_k_k': 0.85 + nrm((DEPTH, D_RWKV), 0.02),
        'rw_k_a': 1.0 + nrm((DEPTH, D_RWKV), 0.02),
        'rw_r_k': nrm((DEPTH, D_RWKV), 0.1),
        'rw_gn_w': 1.0 + nrm((DEPTH, D_RWKV), 0.02),
        'rw_gn_b': nrm((DEPTH, D_RWKV), 0.01),
        'gdn_conv_w': nrm((DEPTH, GDN_CONV, 3 * D_GDN), GDN_CONV ** -0.5),
        'gdn_a_log': jnp.log(unif((DEPTH, 2, GDN_HEADS), 1.0, 16.0)),
        'gdn_dt_bias': dt + jnp.log(-jnp.expm1(-dt)),
        'gdn_norm_w': 1.0 + nrm((DEPTH, GDN_HEAD_DIM), 0.02),
        'moe_router_w': nrm((DEPTH, D, E), D ** -0.5),
        'moe_router_b': nrm((DEPTH, E), 0.01),
        'moe_w_gu': nrm((DEPTH, E, D, 2 * F), D ** -0.5),
        'moe_b_gu': nrm((DEPTH, E, 2 * F), 0.01),
        'moe_w_dn': nrm((DEPTH, E, F, D), F ** -0.5),
        'moe_b_dn': nrm((DEPTH, E, D), 0.01),
    }


def reference(x, c, ctx, c_ctx, ada_w, ada_b, norm_mix_w, norm_ffn_w, final_norm_w, w_in, w_out,
              hy_short_w, hy_short_b, hy_f_w1, hy_f_b1, hy_f_w2, hy_f_b2, hy_f_w3, hy_f_b3, hy_f_w4,
              hy_f_freq, hy_skip, rw_mu, rw_w0, rw_w2, rw_a0, rw_a2, rw_g2, rw_k_k, rw_k_a, rw_r_k,
              rw_gn_w, rw_gn_b, gdn_conv_w, gdn_a_log, gdn_dt_bias, gdn_norm_w,
              moe_router_w, moe_router_b, moe_w_gu, moe_b_gu, moe_w_dn, moe_b_dn):
    B, L, D = x.shape
    Lc = ctx.shape[1]
    h_lat, h_ctx = x, ctx
    s_lat = jax.nn.silu(c)
    s_ctx = jax.nn.silu(c_ctx)
    for l in range(DEPTH):
        last = l == DEPTH - 1
        ml = jnp.split((s_lat @ ada_w[l] + ada_b[l])[:, None, :], N_MOD, axis=-1)
        mc = jnp.split(s_ctx @ ada_w[l] + ada_b[l], N_MOD, axis=-1)
        n_lat = modulate(rms_norm(h_lat, norm_mix_w[l]), ml[0], ml[1])
        n_ctx = modulate(rms_norm(h_ctx, norm_mix_w[l]), mc[0], mc[1])
        hy_l, rw_l, gd_l = split_cols(n_lat @ w_in[l])
        hy_c, rw_c, gd_c = split_cols(n_ctx @ w_in[l])
        hy_p = (hy_short_w[l], hy_short_b[l], hy_f_w1[l], hy_f_b1[l], hy_f_w2[l], hy_f_b2[l],
                hy_f_w3[l], hy_f_b3[l], hy_f_w4[l], hy_f_freq[l], hy_skip[l])
        y_hy_l = hyena_mixer(hy_l, *hy_p)
        y_rw_c, y_rw_l = rwkv7_mixer(rw_c, rw_l, rw_mu[l], rw_w0[l], rw_w2[l], rw_a0[l], rw_a2[l],
                                     rw_g2[l], rw_k_k[l], rw_k_a[l], rw_r_k[l], rw_gn_w[l], rw_gn_b[l],
                                     not last)
        y_gd_c, y_gd_l = gdn_mixer(gd_c, gd_l, gdn_conv_w[l], gdn_a_log[l], gdn_dt_bias[l],
                                   gdn_norm_w[l], not last)
        h_lat = h_lat + ml[2] * (jnp.concatenate([y_hy_l, y_rw_l, y_gd_l], axis=-1) @ w_out[l])
        moe_p = (moe_router_w[l], moe_router_b[l], moe_w_gu[l], moe_b_gu[l], moe_w_dn[l], moe_b_dn[l])
        if last:
            n_lat = modulate(rms_norm(h_lat, norm_ffn_w[l]), ml[3], ml[4])
            h_lat = h_lat + ml[5] * moe_ffn(n_lat.reshape(B * L, D), *moe_p).reshape(B, L, D)
        else:
            y_hy_c = hyena_mixer(hy_c, *hy_p)
            h_ctx = h_ctx + mc[2] * (jnp.concatenate([y_hy_c, y_rw_c, y_gd_c], axis=-1) @ w_out[l])
            n_lat = modulate(rms_norm(h_lat, norm_ffn_w[l]), ml[3], ml[4])
            n_ctx = modulate(rms_norm(h_ctx, norm_ffn_w[l]), mc[3], mc[4])
            y = moe_ffn(jnp.concatenate([n_ctx.reshape(B * Lc, D), n_lat.reshape(B * L, D)], axis=0), *moe_p)
            h_ctx = h_ctx + mc[5] * y[:B * Lc].reshape(B, Lc, D)
            h_lat = h_lat + ml[5] * y[B * Lc:].reshape(B, L, D)
    return rms_norm(h_lat, final_norm_w)
```

```cpp
#include <hip/hip_runtime.h>
#include <cstdio>
#include <cstdint>

#ifndef N_LAUNCH_MODE
#define N_LAUNCH_MODE 0
#endif

#define LAS __attribute__((address_space(3)))
#define GAS __attribute__((address_space(1)))
typedef unsigned short bf16_t;
typedef short bf16x8 __attribute__((ext_vector_type(8)));
typedef float f32x4 __attribute__((ext_vector_type(4)));
typedef float f32x2 __attribute__((ext_vector_type(2)));
typedef unsigned u32x4 __attribute__((ext_vector_type(4)));
typedef unsigned u32x2 __attribute__((ext_vector_type(2)));

constexpr int D = 1024, NB = 8, SEQ = 2048, CTX = 256, DEPTH = 4;
constexpr int M_CTX = NB * CTX;
constexpr int M_LAT = NB * SEQ;
constexpr int M_ALL = M_CTX + M_LAT;
constexpr int NMOD = 6;
constexpr int PW = 4096;
constexpr int IN_COLS = 3984;
constexpr int C_HY = 0, C_RW = 768, C_GD = 1920;
constexpr int RWC = 1152;
constexpr int NE = 32, TOPK = 4, FF = 1024;
constexpr int NT = 512, NWV = 8;

constexpr size_t MiB = 1ull << 20;
constexpr size_t WS_CTL   = 0;
constexpr size_t CTL_ZERO = 2 * MiB;
constexpr size_t WS_MODS  = 2 * MiB;
constexpr size_t WS_FILT  = 4 * MiB;
constexpr size_t WS_FILTC = 20 * MiB;
constexpr size_t WS_WIN   = 24 * MiB;
constexpr size_t WS_WOUT  = 56 * MiB;
constexpr size_t WS_WGU   = 64 * MiB;
constexpr size_t WS_WDN   = 576 * MiB;
constexpr size_t WS_H     = 832 * MiB;
constexpr size_t WS_N     = 904 * MiB;
constexpr size_t WS_P     = 940 * MiB;
constexpr size_t WS_RW    = 1228 * MiB;
constexpr size_t WS_RWBON = 1408 * MiB;
constexpr size_t WS_GQKV  = 1410 * MiB;
constexpr size_t WS_GBG   = 1518 * MiB;
constexpr size_t WS_VVT   = 1520 * MiB;
constexpr size_t WS_YT    = 1540 * MiB;
constexpr size_t WS_RWO   = 1560 * MiB;
constexpr size_t WS_GDO   = 1596 * MiB;
constexpr size_t WS_GPRE  = 1668 * MiB;
constexpr size_t WS_YCAT  = 1884 * MiB;
constexpr size_t WS_STOK  = 1920 * MiB;
constexpr size_t WS_TOKE  = 1924 * MiB;
constexpr size_t WS_ACT   = 1928 * MiB;
constexpr size_t WS_YB    = 2088 * MiB;
constexpr size_t WS_END   = 2248 * MiB;

constexpr int CW_BAR = 4096;
constexpr int CW_CNT = 16384;

constexpr int LDS_BYTES = 155648;
constexpr int MISC_OFF  = 153600;
constexpr int SCR_BYTES = 153600;

__device__ __forceinline__ unsigned f2bf(float f) { unsigned u = __builtin_bit_cast(unsigned, f); return (u + 0x7fffu + ((u >> 16) & 1u)) >> 16; }
__device__ __forceinline__ unsigned pk2(float lo, float hi) { return f2bf(lo) | (f2bf(hi) << 16); }
__device__ __forceinline__ float bf2f(unsigned short b) { return __builtin_bit_cast(float, ((unsigned)b) << 16); }
__device__ __forceinline__ float wave_sum(float v) {
#pragma unroll
    for (int o = 1; o < 64; o <<= 1) v += __shfl_xor(v, o);
    return v;
}
__device__ __forceinline__ float sigmoidf_(float x) { return 1.0f / (1.0f + __expf(-x)); }
__device__ __forceinline__ float siluf_(float x) { return x / (1.0f + __expf(-x)); }
__device__ __forceinline__ float softplusf_(float x) { return x > 20.f ? x : log1pf(__expf(x)); }
template <int CTRL> __device__ __forceinline__ float dppf(float x) {
    return __builtin_bit_cast(float, __builtin_amdgcn_update_dpp(0, __builtin_bit_cast(int, x), CTRL, 0xF, 0xF, true));
}
__device__ __forceinline__ float row16_sum(float x) {
    x += dppf<0xB1>(x);
    x += dppf<0x4E>(x);
    x += dppf<0x141>(x);
    x += dppf<0x140>(x);
    return x;
}

__device__ __forceinline__ int launder_int(int x) { asm volatile("" : "+v"(x)); return __builtin_amdgcn_readfirstlane(x); }
template <class T> __device__ __forceinline__ T* launder_ptr(T* p) {
    unsigned long long u = (unsigned long long)p; unsigned lo = (unsigned)u, hi = (unsigned)(u >> 32);
    asm volatile("" : "+v"(lo), "+v"(hi));
    lo = __builtin_amdgcn_readfirstlane(lo); hi = __builtin_amdgcn_readfirstlane(hi);
    return (T*)(((unsigned long long)hi << 32) | lo);
}

#define XB_TMO      128
#define XB_XCNT(j)  (256  + 64 * (j))
#define XB_XSUB(j)  (1280 + 64 * (j))
#define XB_XGEN(j)  (2304 + 64 * (j))
#define XB_TOP      3328
#define XB_TOPGEN   3392
#define XCD_BAR_WORDS 3456
#define XB_SPIN_CAP (1u << 24)

__device__ __forceinline__ unsigned xb_ld(unsigned* p)              { return __hip_atomic_load(p, __ATOMIC_RELAXED, __HIP_MEMORY_SCOPE_AGENT); }
__device__ __forceinline__ unsigned xb_add(unsigned* p, unsigned v) { return __hip_atomic_fetch_add(p, v, __ATOMIC_RELAXED, __HIP_MEMORY_SCOPE_AGENT); }
__device__ __forceinline__ unsigned xb_xcc_id() { return (unsigned)__builtin_amdgcn_s_getreg((3 << 11) | 20) & 0xFu; }
#define XB_SPIN(cond, bar) do { unsigned _sp = 0; while (cond) { __builtin_amdgcn_s_sleep(1); \
    if ((++_sp & 255u) == 0u) { if (xb_ld(&(bar)[XB_TMO])) break; if (_sp > XB_SPIN_CAP) { atomicAdd(&(bar)[XB_TMO], 1u); break; } } } } while (0)

struct XcdBarrier { unsigned* bar; unsigned x; volatile LAS unsigned* st; };

__device__ __forceinline__ XcdBarrier xcd_barrier_post(unsigned* bar, volatile LAS unsigned* st) {
    XcdBarrier b; b.bar = bar; b.x = xb_xcc_id(); b.st = st;
    if (threadIdx.x == 0) (void)xb_add(&bar[XB_XCNT(b.x)], 1u);
    return b;
}
__device__ __forceinline__ void xcd_barrier_complete(unsigned* bar, unsigned x, unsigned& nloc, unsigned& nx) {
    const unsigned G = gridDim.x * gridDim.y * gridDim.z;
    unsigned sum, cnt, mine, sp = 0u;
    for (;;) {
        sum = 0u; cnt = 0u; mine = 0u;
#pragma unroll
        for (unsigned j = 0; j < 16; ++j) { const unsigned c = xb_ld(&bar[XB_XCNT(j)]); sum += c; cnt += (c > 0u) ? 1u : 0u; mine = (j == x) ? c : mine; }
        if (sum == G) break;
        __builtin_amdgcn_s_sleep(1);
        if ((++sp & 255u) == 0u) { if (xb_ld(&bar[XB_TMO])) break; if (sp > XB_SPIN_CAP) { atomicAdd(&bar[XB_TMO], 1u); break; } }
    }
    nloc = mine > 0u ? mine : 1u; nx = cnt > 0u ? cnt : 1u;
}
__device__ __forceinline__ void xcd_barrier(const XcdBarrier& b) {
    asm volatile("s_waitcnt vmcnt(0)" ::: "memory");
    __syncthreads();
    if (threadIdx.x == 0) {
        unsigned* bar = b.bar;
        __builtin_amdgcn_s_waitcnt(0);
        unsigned nloc = b.st[0], nx = b.st[1];
        if (nloc == 0u) { xcd_barrier_complete(bar, b.x, nloc, nx); b.st[0] = nloc; b.st[1] = nx; }
        const unsigned old = xb_add(&bar[XB_XSUB(b.x)], 1u);
        const unsigned gen = old / nloc;
        if (old + 1u == (gen + 1u) * nloc) {
            __builtin_amdgcn_fence(__ATOMIC_RELEASE, "agent");
            asm volatile("s_waitcnt vmcnt(0)" ::: "memory");
            const unsigned og = xb_add(&bar[XB_TOP], 1u);
            const unsigned tg = og / nx;
            if (og + 1u == (tg + 1u) * nx) xb_add(&bar[XB_TOPGEN], 1u);
            else XB_SPIN(xb_ld(&bar[XB_TOPGEN]) == tg, bar);
            __builtin_amdgcn_fence(__ATOMIC_ACQUIRE, "agent");
            xb_add(&bar[XB_XGEN(b.x)], 1u);
            asm volatile("s_waitcnt vmcnt(0)" ::: "memory");
        } else {
            XB_SPIN(xb_ld(&bar[XB_XGEN(b.x)]) == gen, bar);
            __builtin_amdgcn_fence(__ATOMIC_ACQUIRE, "agent");
            asm volatile("s_waitcnt vmcnt(0)" ::: "memory");
        }
    }
    __syncthreads();
}

namespace pg8 {
constexpr int BM = 256, BK = 64, HALF = 128, HTB = HALF * BK * 2, STAGE_BYTES = 8 * HTB, NXCD = 8, WGM = 8;
__host__ __device__ __forceinline__ int lds_byte(int r, int c) { const int st = (r >> 4) * 2 + (c >> 5), rr = r & 15, cc = c & 31, ob = rr * 64 + cc * 2; return st * 1024 + (ob ^ (((ob >> 9) & 1) << 5)); }
__host__ __device__ __forceinline__ void stage_rc(int b, int& R, int& C) { const int st = b / 1024, sb = b % 1024, swz = sb ^ (((sb >> 9) & 1) << 5); R = (st >> 1) * 16 + swz / 64; C = (st & 1) * 32 + (swz % 64) / 2; }
__host__ __device__ __forceinline__ int perm32(int rho) { const int n = rho >> 4, i = rho & 15; return 8 * (i >> 2) + 4 * n + (i & 3); }

struct Unit { int pm, pn, e, j, rows; };

struct StaticOrder {
    static constexpr bool GATHER = false;
    const bf16_t* A; const bf16_t* Bt; int K;
    int nM, nN, nwg, G, c;
    __device__ void init(const bf16_t* A_, const bf16_t* Bt_, int M, int N, int K_, int G_, int c_) { A = A_; Bt = Bt_; K = K_; nM = M / BM; nN = N / BM; nwg = nM * nN; G = G_; c = c_; }
    __device__ bool next(int i, Unit& u) const {
        const long L = (long)i * G + c; if (L >= nwg) return false;
        int wgid = (int)L; { const int q = nwg / NXCD, r = nwg % NXCD, xcd = wgid % NXCD, off = wgid / NXCD; wgid = (xcd < r ? xcd * (q + 1) : r * (q + 1) + (xcd - r) * q) + off; }
        const int nig = WGM * nN, gid = wgid / nig, fm = gid * WGM, gsz = (nM - fm) < WGM ? (nM - fm) : WGM;
        u.pm = fm + ((wgid % nig) % gsz); u.pn = (wgid % nig) / gsz; u.e = 0; u.j = 0; u.rows = BM; return true;
    }
    __device__ __forceinline__ const char* a_base(const Unit& u) const { return (const char*)A + (size_t)u.pm * (size_t)(2 * HALF) * K * 2; }
    __device__ __forceinline__ const char* b_base(const Unit& u) const { return (const char*)Bt + (size_t)u.pn * (size_t)(2 * HALF) * K * 2; }
    __device__ __forceinline__ unsigned gather_row(const Unit&, int) const { return 0u; }
};
template <bool GATHER_, int NPN> struct MoeOrder {
    static constexpr bool GATHER = GATHER_;
    const bf16_t* A; const bf16_t* Bt; int K, Nexp;
    const LAS int* pref;
    const int* stok;
    int G, c;
    __device__ bool next(int i, Unit& u) const {
        const int L = i * G + c; const int nU = __builtin_amdgcn_readfirstlane(pref[32]) * NPN; if (L >= nU) return false;
        const int rb = L / NPN; u.pn = L % NPN; int e = 0;
        for (int q = 1; q < 32; ++q) e = (__builtin_amdgcn_readfirstlane(pref[q]) <= rb) ? q : e;
        u.e = e; u.pm = rb; u.j = rb - __builtin_amdgcn_readfirstlane(pref[e]); const int rem = __builtin_amdgcn_readfirstlane(pref[64 + e]) - u.j * BM; u.rows = rem < BM ? rem : BM; return true;
    }
    __device__ __forceinline__ const char* a_base(const Unit& u) const { return GATHER ? (const char*)A : (const char*)A + (size_t)u.pm * (size_t)(2 * HALF) * K * 2; }
    __device__ __forceinline__ const char* b_base(const Unit& u) const { return (const char*)Bt + ((size_t)u.e * Nexp + (size_t)u.pn * BM) * K * 2; }
    __device__ __forceinline__ unsigned gather_row(const Unit& u, int r) const { return (r < u.rows) ? (unsigned)stok[(size_t)u.e * M_ALL + u.j * BM + r] : 0u; }
};

__device__ __forceinline__ unsigned cvt_pk_bf16(float lo, float hi) { unsigned r; asm volatile("v_cvt_pk_bf16_f32 %0, %1, %2" : "=v"(r) : "v"(lo), "v"(hi)); return r; }

struct EpiF32 {
    static constexpr bool PERM = false;
    float* C; int ldc;
    __device__ __forceinline__ void operator()(const f32x4 (&acc)[2][2][4][2], const Unit& u, int wr, int wc, int fr, int fq) const {
        const int row0 = u.pm * BM + wr * 64 + fr, col0 = u.pn * BM + wc * 32 + 4 * fq;
#pragma unroll
        for (int ai = 0; ai < 2; ++ai)
#pragma unroll
            for (int m = 0; m < 4; ++m) { float* rowp = C + (size_t)(row0 + ai * HALF + m * 16) * ldc + col0;
#pragma unroll
                for (int bj = 0; bj < 2; ++bj)
#pragma unroll
                    for (int n = 0; n < 2; ++n) *(f32x4*)(rowp + bj * HALF + n * 16) = acc[ai][bj][m][n]; }
    }
};
struct EpiRes {
    static constexpr bool PERM = false;
    const float* base; float* out; const float* gate; int row0g;
    __device__ __forceinline__ void operator()(const f32x4 (&acc)[2][2][4][2], const Unit& u, int wr, int wc, int fr, int fq) const {
        const int row0 = u.pm * BM + wr * 64 + fr, col0 = u.pn * BM + wc * 32 + 4 * fq;
        const int grow = row0g + u.pm * BM; const int r = grow < M_CTX ? 8 : (grow - M_CTX) / SEQ;
        f32x4 gv[2][2];
#pragma unroll
        for (int bj = 0; bj < 2; ++bj)
#pragma unroll
            for (int n = 0; n < 2; ++n) gv[bj][n] = *(const f32x4*)(gate + (size_t)r * (NMOD * D) + col0 + bj * HALF + n * 16);
#pragma unroll
        for (int ai = 0; ai < 2; ++ai)
#pragma unroll
            for (int m = 0; m < 4; ++m) { const size_t off = (size_t)(row0 + ai * HALF + m * 16) * D + col0;
#pragma unroll
                for (int bj = 0; bj < 2; ++bj)
#pragma unroll
                    for (int n = 0; n < 2; ++n) { const f32x4 b = *(const f32x4*)(base + off + bj * HALF + n * 16);
                        *(f32x4*)(out + off + bj * HALF + n * 16) = b + gv[bj][n] * acc[ai][bj][m][n]; } }
    }
};
struct EpiGU {
    static constexpr bool PERM = true;
    bf16_t* O; const float* bias;
    __device__ __forceinline__ void operator()(const f32x4 (&acc)[2][2][4][2], const Unit& u, int wr, int wc, int fr, int fq) const {
        const int row0 = u.pm * BM + wr * 64 + fr, col0 = u.pn * HALF + wc * 32 + 8 * fq;
        const float* bp = bias + (size_t)u.e * 2048 + col0;
        f32x4 bg[2], bu[2];
#pragma unroll
        for (int n = 0; n < 2; ++n) { bg[n] = *(const f32x4*)(bp + 4 * n); bu[n] = *(const f32x4*)(bp + 1024 + 4 * n); }
#pragma unroll
        for (int ai = 0; ai < 2; ++ai)
#pragma unroll
            for (int m = 0; m < 4; ++m) { bf16_t* rowp = O + (size_t)(row0 + ai * HALF + m * 16) * FF + col0;
                float o[8];
#pragma unroll
                for (int n = 0; n < 2; ++n)
#pragma unroll
                    for (int i = 0; i < 4; ++i) { float g = acc[ai][0][m][n][i] + bg[n][i], up = acc[ai][1][m][n][i] + bu[n][i];
                        g = fminf(g, 7.0f); up = fminf(fmaxf(up, -7.0f), 7.0f);
                        const float glu = g / (1.0f + __expf(-1.702f * g)); o[n * 4 + i] = (up + 1.0f) * glu; }
                u32x4 w; w.x = cvt_pk_bf16(o[0], o[1]); w.y = cvt_pk_bf16(o[2], o[3]); w.z = cvt_pk_bf16(o[4], o[5]); w.w = cvt_pk_bf16(o[6], o[7]);
                *(u32x4*)rowp = w; }
    }
};
struct EpiDN {
    static constexpr bool PERM = true;
    bf16_t* O; const float* bias;
    __device__ __forceinline__ void operator()(const f32x4 (&acc)[2][2][4][2], const Unit& u, int wr, int wc, int fr, int fq) const {
        const int row0 = u.pm * BM + wr * 64 + fr, col0 = u.pn * BM + wc * 32 + 8 * fq;
        const float* bp = bias + (size_t)u.e * 1024 + col0;
        f32x4 bv[2][2];
#pragma unroll
        for (int bj = 0; bj < 2; ++bj)
#pragma unroll
            for (int n = 0; n < 2; ++n) bv[bj][n] = *(const f32x4*)(bp + bj * HALF + 4 * n);
#pragma unroll
        for (int ai = 0; ai < 2; ++ai)
#pragma unroll
            for (int m = 0; m < 4; ++m) { bf16_t* rowp = O + (size_t)(row0 + ai * HALF + m * 16) * D + col0;
#pragma unroll
                for (int bj = 0; bj < 2; ++bj) { const f32x4 v0 = acc[ai][bj][m][0] + bv[bj][0], v1 = acc[ai][bj][m][1] + bv[bj][1];
                    u32x4 w; w.x = cvt_pk_bf16(v0[0], v0[1]); w.y = cvt_pk_bf16(v0[2], v0[3]); w.z = cvt_pk_bf16(v1[0], v1[1]); w.w = cvt_pk_bf16(v1[2], v1[3]);
                    *(u32x4*)(rowp + bj * HALF) = w; } }
    }
};

template <class Epi, class Sched>
__device__ __forceinline__ void gemm_phase(LAS unsigned char* lds, const Sched& S, const Epi& E, const int tid) {
    constexpr bool GATHER = Sched::GATHER;
    const int wid = __builtin_amdgcn_readfirstlane(tid >> 6), lane = tid & 63, wr = wid >> 2, wc = wid & 3, fr = lane & 15, fq = lane >> 4;
    const int K = S.K, nt = K / BK;
    unsigned voffA[2], voffB[2]; int RA[2], CA[2];
#pragma unroll
    for (int i = 0; i < 2; ++i) { int R, C; stage_rc(tid * 16 + i * 8192, R, C); const int Rb = Epi::PERM ? ((R & ~31) + perm32(R & 31)) : R;
        RA[i] = R; CA[i] = C; voffA[i] = (unsigned)(R * K + C) * 2u; voffB[i] = (unsigned)(Rb * K + C) * 2u; }
    const size_t kstep = (size_t)(BK * 2);
    const size_t hstep = (size_t)HALF * K * 2;
    const unsigned ldsw = (unsigned)wid * 1024u;
    const int aoff = lds_byte(wr * 64 + fr, fq * 8), boff = lds_byte(wc * 32 + fr, fq * 8);
#define PG8_SA(b, h) (((b) * 2 + (h)) * HTB)
#define PG8_SB(b, h) ((4 + (b) * 2 + (h)) * HTB)
#define PG8_STAGE(bufoff, gbase, voff) do { _Pragma("unroll") for (int _i = 0; _i < 2; ++_i) \
        __builtin_amdgcn_global_load_lds((const unsigned*)((const char*)(gbase) + (voff)[_i]), (LAS unsigned*)(lds + (bufoff) + ldsw + _i * 8192), 16, 0, 0); } while (0)
#define PG8_STAGE2(bufoff, gbase, v0, v1) do { \
        __builtin_amdgcn_global_load_lds((const unsigned*)((const char*)(gbase) + (v0)), (LAS unsigned*)(lds + (bufoff) + ldsw), 16, 0, 0); \
        __builtin_amdgcn_global_load_lds((const unsigned*)((const char*)(gbase) + (v1)), (LAS unsigned*)(lds + (bufoff) + ldsw + 8192), 16, 0, 0); } while (0)
#define PG8_LDA(dst, b, h) do { _Pragma("unroll") for (int m = 0; m < 4; ++m) _Pragma("unroll") for (int k = 0; k < 2; ++k) dst[m][k] = *(const LAS bf16x8*)(lds + PG8_SA(b, h) + aoff + m * 2048 + k * 1024); } while (0)
#define PG8_LDB(dst, b, h) do { _Pragma("unroll") for (int n = 0; n < 2; ++n) _Pragma("unroll") for (int k = 0; k < 2; ++k) dst[n][k] = *(const LAS bf16x8*)(lds + PG8_SB(b, h) + boff + n * 2048 + k * 1024); } while (0)
#define PG8_MMA(ai, bj, At, Bt) do { __builtin_amdgcn_s_setprio(1); _Pragma("unroll") for (int m = 0; m < 4; ++m) _Pragma("unroll") for (int n = 0; n < 2; ++n) _Pragma("unroll") for (int k = 0; k < 2; ++k) \
        acc[ai][bj][m][n] = __builtin_amdgcn_mfma_f32_16x16x32_bf16(Bt[n][k], At[m][k], acc[ai][bj][m][n], 0, 0, 0); __builtin_amdgcn_s_setprio(0); } while (0)
#define PG8_WAIT_V(n) asm volatile("s_waitcnt vmcnt(" #n ")" ::: "memory")
#define PG8_WAIT_L(n) asm volatile("s_waitcnt lgkmcnt(" #n ")" ::: "memory")
#define PG8_BAR __builtin_amdgcn_s_barrier()
#define PG8_SCHED __builtin_amdgcn_sched_barrier(0)
    unsigned pc[2] = {0u, 0u}, pn_[2] = {0u, 0u};
    const unsigned R0 = (unsigned)RA[0], C2 = (unsigned)(CA[0] * 2);
#define PG8_PACK(p, u) do { _Pragma("unroll") for (int _h = 0; _h < 2; ++_h) p[_h] = S.gather_row(u, _h * HALF + R0) | (S.gather_row(u, _h * HALF + 64 + R0) << 16); } while (0)
#define PG8_AOFF(p, h, i) (GATHER ? ((((p)[h] >> (16 * (i))) & 0xffffu) * (unsigned)(K * 2) + C2) : ((unsigned)((h) * hstep) + voffA[i]))
#define PG8_STAGEA(bufoff, gbase, p, h) PG8_STAGE2(bufoff, gbase, PG8_AOFF(p, h, 0), PG8_AOFF(p, h, 1))
    Unit cur, nxt; int ui = 0;
    if (!S.next(0, cur)) return;
    f32x4 acc[2][2][4][2];
#pragma unroll
    for (int a = 0; a < 2; ++a)
#pragma unroll
        for (int b = 0; b < 2; ++b)
#pragma unroll
            for (int m = 0; m < 4; ++m)
#pragma unroll
                for (int n = 0; n < 2; ++n) acc[a][b][m][n] = (f32x4){0.f, 0.f, 0.f, 0.f};
    bf16x8 At[4][2], B0[2][2], B1[2][2];
    const char* cA = S.a_base(cur); const char* cB = S.b_base(cur);
    if (GATHER) PG8_PACK(pc, cur);
    PG8_STAGE(PG8_SB(0, 0), cB, voffB); PG8_STAGEA(PG8_SA(0, 0), cA, pc, 0); PG8_STAGE(PG8_SB(0, 1), cB + hstep, voffB); PG8_STAGEA(PG8_SA(0, 1), cA, pc, 1);
    if (wr == 1) PG8_BAR;
    PG8_WAIT_V(4); PG8_BAR;
    PG8_STAGE(PG8_SB(1, 0), cB + kstep, voffB); PG8_STAGEA(PG8_SA(1, 0), cA + kstep, pc, 0); PG8_STAGE(PG8_SB(1, 1), cB + hstep + kstep, voffB);
    PG8_WAIT_V(6); PG8_BAR;
    for (;;) {
        const bool has_next = S.next(ui + 1, nxt);
        const char* nA = has_next ? S.a_base(nxt) : cA; const char* nB = has_next ? S.b_base(nxt) : cB;
        if (GATHER) { if (has_next) { PG8_PACK(pn_, nxt); } else { pn_[0] = pc[0]; pn_[1] = pc[1]; } }
        for (int t = 0; t < nt; t += 2) {
            const bool last = (t == nt - 2);
            const char* a1 = cA + (size_t)(t + 1) * kstep;
            const char* a2 = last ? nA : cA + (size_t)(t + 2) * kstep; const char* b2 = last ? nB : cB + (size_t)(t + 2) * kstep;
            const char* a3 = a2 + kstep; const char* b3 = b2 + kstep;
            PG8_LDB(B0, 0, 0); PG8_SCHED; PG8_LDA(At, 0, 0); PG8_STAGEA(PG8_SA(1, 1), a1, pc, 1);
            PG8_WAIT_L(8); PG8_BAR; PG8_WAIT_L(0); PG8_MMA(0, 0, At, B0); PG8_BAR; PG8_SCHED;
            PG8_LDB(B1, 0, 1); PG8_STAGE(PG8_SB(0, 0), b2, voffB);
            PG8_BAR; PG8_WAIT_L(0); PG8_MMA(0, 1, At, B1); PG8_BAR;
            PG8_LDA(At, 0, 1); { const unsigned pq[2] = {last ? pn_[0] : pc[0], 0u}; PG8_STAGEA(PG8_SA(0, 0), a2, pq, 0); }
            PG8_BAR; PG8_WAIT_L(0); PG8_MMA(1, 0, At, B0); PG8_BAR; PG8_SCHED;
            PG8_STAGE(PG8_SB(0, 1), b2 + hstep, voffB);
            PG8_WAIT_V(6); PG8_BAR; PG8_MMA(1, 1, At, B1); PG8_BAR;
            PG8_LDB(B0, 1, 0); PG8_SCHED; PG8_LDA(At, 1, 0); { const unsigned pq[2] = {0u, last ? pn_[1] : pc[1]}; PG8_STAGEA(PG8_SA(0, 1), a2, pq, 1); }
            PG8_WAIT_L(8); PG8_BAR; PG8_WAIT_L(0); PG8_MMA(0, 0, At, B0); PG8_BAR; PG8_SCHED;
            PG8_LDB(B1, 1, 1); PG8_STAGE(PG8_SB(1, 0), b3, voffB);
            PG8_BAR; PG8_WAIT_L(0); PG8_MMA(0, 1, At, B1); PG8_BAR;
            PG8_LDA(At, 1, 1); { const unsigned pq[2] = {last ? pn_[0] : pc[0], 0u}; PG8_STAGEA(PG8_SA(1, 0), a3, pq, 0); }
            PG8_BAR; PG8_WAIT_L(0); PG8_MMA(1, 0, At, B0); PG8_BAR; PG8_SCHED;
            PG8_STAGE(PG8_SB(1, 1), b3 + hstep, voffB);
            PG8_WAIT_V(6); PG8_BAR; PG8_MMA(1, 1, At, B1); PG8_BAR;
        }
        E(acc, cur, wr, wc, fr, fq);
        if (!has_next) break;
#pragma unroll
        for (int a = 0; a < 2; ++a)
#pragma unroll
            for (int b = 0; b < 2; ++b)
#pragma unroll
                for (int m = 0; m < 4; ++m)
#pragma unroll
                    for (int n = 0; n < 2; ++n) acc[a][b][m][n] = (f32x4){0.f, 0.f, 0.f, 0.f};
        cur = nxt; cA = nA; cB = nB; ++ui; pc[0] = pn_[0]; pc[1] = pn_[1];
    }
    PG8_WAIT_V(0);
    if (wr == 0) PG8_BAR;
    PG8_BAR;
#undef PG8_SA
#undef PG8_SB
#undef PG8_STAGE
#undef PG8_STAGE2
#undef PG8_LDA
#undef PG8_LDB
#undef PG8_MMA
#undef PG8_WAIT_V
#undef PG8_WAIT_L
#undef PG8_BAR
#undef PG8_SCHED
#undef PG8_PACK
#undef PG8_AOFF
#undef PG8_STAGEA
}
}

struct Args { const float* in[43]; float* out; unsigned char* ws; int ph_lo, ph_hi; };
enum { I_X = 0, I_C, I_CTX, I_CCTX, I_ADAW, I_ADAB, I_NMIX, I_NFFN, I_NFIN, I_WIN, I_WOUT, I_HSW, I_HSB, I_HW1, I_HB1, I_HW2, I_HB2, I_HW3, I_HB3, I_HW4,
       I_HFREQ, I_HSKIP, I_RMU, I_RW0, I_RW2, I_RA0, I_RA2, I_RG2, I_RKK, I_RKA, I_RRK, I_RGNW, I_RGNB, I_GCONV, I_GALOG, I_GDT, I_GNW,
       I_MRW, I_MRB, I_MWGU, I_MBGU, I_MWDN, I_MBDN };

struct Frame {
    LAS unsigned char* lds;
    int tid, lane, wave, G, bid;
    const float* const* in;
    unsigned char* ws;
    float* out;
};
#define WSP(T, off) ((T*)(F.ws + (off)))
#define LDS_WAIT() asm volatile("s_waitcnt lgkmcnt(0)" ::: "memory")

__device__ __forceinline__ int row_batch(int row) { return row < M_CTX ? row / CTX : (row - M_CTX) / SEQ; }
__device__ __forceinline__ int row_modr(int row) { return row < M_CTX ? 8 : (row - M_CTX) / SEQ; }

__device__ __forceinline__ void p0_transpose_item(const float* W, int K, int N, bf16_t* WT, int k0, int n0, int drow0, LAS float* scr, int lane) {
#pragma unroll 8
    for (int i = 0; i < 32; ++i) { const int kk = 2 * i + (lane >> 5); const int n = n0 + (lane & 31);
        scr[kk * 33 + (lane & 31)] = (n < N) ? W[(size_t)(k0 + kk) * N + n] : 0.f; }
    LDS_WAIT(); asm volatile("" ::: "memory");
    const int c = lane & 7;
#pragma unroll
    for (int j = 0; j < 4; ++j) { const int n = (lane >> 3) + 8 * j; const LAS float* s = scr + (8 * c) * 33 + n;
        u32x4 o; o.x = pk2(s[0 * 33], s[1 * 33]); o.y = pk2(s[2 * 33], s[3 * 33]); o.z = pk2(s[4 * 33], s[5 * 33]); o.w = pk2(s[6 * 33], s[7 * 33]);
        *(u32x4*)(WT + (size_t)(drow0 + n) * K + k0 + 8 * c) = o; }
    LDS_WAIT(); asm volatile("" ::: "memory");
}

__device__ __forceinline__ void phase_prologue(Frame& F) {
    const int gw = F.bid * NWV + F.wave, NGW = F.G * NWV;
    {
        LAS float* scr = (LAS float*)(F.lds + F.wave * 16384);
        constexpr int I_IN = 16 * 128, I_OUT = 16 * 32, I_GU = 16 * 64, I_DN = 16 * 32;
        constexpr int T_IN = DEPTH * I_IN, T_OUT = DEPTH * I_OUT, T_GU = DEPTH * NE * I_GU, T_DN = DEPTH * NE * I_DN;
        for (int it = gw; it < T_IN + T_OUT + T_GU + T_DN; it += NGW) {
            int r = it;
            if (r < T_IN) { const int l = r / I_IN, q = r % I_IN, kb = q / 128, nb = q % 128;
                p0_transpose_item(F.in[I_WIN] + (size_t)l * D * IN_COLS, D, IN_COLS, WSP(bf16_t, WS_WIN) + (size_t)l * PW * D, kb * 64, nb * 32, nb * 32, scr, F.lane); continue; }
            r -= T_IN;
            if (r < T_OUT) { const int l = r / I_OUT, q = r % I_OUT, kb = q / 32, nb = q % 32;
                p0_transpose_item(F.in[I_WOUT] + (size_t)l * D * D, D, D, WSP(bf16_t, WS_WOUT) + (size_t)l * D * D, kb * 64, nb * 32, nb * 32, scr, F.lane); continue; }
            r -= T_OUT;
            if (r < T_GU) { const int le = r / I_GU, q = r % I_GU, kb = q / 64, nb = q % 64; const int n0 = nb * 32;
                const int j = n0 & 1023, drow = 256 * (j >> 7) + (n0 >= 1024 ? 128 : 0) + (j & 127);
                p0_transpose_item(F.in[I_MWGU] + (size_t)le * D * 2048, D, 2048, WSP(bf16_t, WS_WGU) + (size_t)le * 2048 * D, kb * 64, n0, drow, scr, F.lane); continue; }
            r -= T_GU;
            { const int le = r / I_DN, q = r % I_DN, kb = q / 32, nb = q % 32;
                p0_transpose_item(F.in[I_MWDN] + (size_t)le * FF * D, FF, D, WSP(bf16_t, WS_WDN) + (size_t)le * D * FF, kb * 64, nb * 32, nb * 32, scr, F.lane); }
        }
    }
    __syncthreads();
    {
        LAS float* sl = (LAS float*)F.lds;
        LAS float* red = sl + 9 * 1024;
        for (int i = F.tid; i < 9 * 1024; i += NT) { const float v = (i < 8 * 1024) ? F.in[I_C][i] : F.in[I_CCTX][i - 8 * 1024]; sl[i] = siluf_(v); }
        __syncthreads();
        float* mods = WSP(float, WS_MODS);
        const int kh = F.lane >> 5, cl = F.lane & 31;
        for (int it = F.bid; it < DEPTH * (NMOD * D / 32); it += F.G) {
            const int l = it / (NMOD * D / 32), nb = it % (NMOD * D / 32);
            const float* W = F.in[I_ADAW] + (size_t)l * D * (NMOD * D) + nb * 32 + cl;
            float a[9];
#pragma unroll
            for (int r = 0; r < 9; ++r) a[r] = 0.f;
            const int kbase = F.wave * 128 + kh * 64;
#pragma unroll 8
            for (int k = 0; k < 64; ++k) { const float w = W[(size_t)(kbase + k) * (NMOD * D)];
#pragma unroll
                for (int r = 0; r < 9; ++r) a[r] += sl[r * 1024 + kbase + k] * w; }
#pragma unroll
            for (int r = 0; r < 9; ++r) red[((F.wave * 2 + kh) * 9 + r) * 32 + cl] = a[r];
            __syncthreads();
            if (F.tid < 9 * 32) { const int r = F.tid / 32, cc = F.tid % 32; float s = 0.f;
#pragma unroll
                for (int p = 0; p < 16; ++p) s += red[(p * 9 + r) * 32 + cc];
                mods[((size_t)l * 9 + r) * (NMOD * D) + nb * 32 + cc] = s + F.in[I_ADAB][(size_t)l * (NMOD * D) + nb * 32 + cc]; }
            __syncthreads();
        }
    }
    __syncthreads();
    {
        LAS float* hb = (LAS float*)F.lds;
        LAS float* hx = hb + 32 * 512 + F.wave * 64;
        constexpr int NB_LAT = SEQ / 32, NB_CTX = CTX / 32, NB_L = NB_LAT + NB_CTX;
        for (int it = F.bid; it < DEPTH * NB_L; it += F.G) {
            const int l = it / NB_L, q = it % NB_L; const bool isctx = q >= NB_LAT; const int L = isctx ? CTX : SEQ; const int p0 = (isctx ? q - NB_LAT : q) * 32;
            const float* w1 = F.in[I_HW1] + (size_t)l * 33 * 64; const float* b1 = F.in[I_HB1] + l * 64;
            const float* w2 = F.in[I_HW2] + (size_t)l * 64 * 64; const float* b2 = F.in[I_HB2] + l * 64;
            const float* w3 = F.in[I_HW3] + (size_t)l * 64 * 64; const float* b3 = F.in[I_HB3] + l * 64;
            const float* w4 = F.in[I_HW4] + (size_t)l * 64 * 512; const float fr = F.in[I_HFREQ][l * 64 + F.lane];
            for (int pp = 0; pp < 4; ++pp) {
                const int pl = F.wave * 4 + pp, p = p0 + pl;
                const float t = (float)p / (float)(L - 1);
                float z = 0.f;
                if (F.lane == 0) z = t;
                else if (F.lane < 33) { const int bi = (F.lane - 1) & 15; const float band = 1e-4f + (float)bi * ((15.0f - 1e-4f) / 15.0f);
                    const float ang = (6.283185307179586f / (float)L) * (float)p * band; z = (F.lane <= 16) ? cosf(ang) : -sinf(ang); }
                hx[F.lane] = z; LDS_WAIT();
                float a = b1[F.lane];
                for (int i = 0; i < 33; ++i) a += hx[i] * w1[i * 64 + F.lane];
                float h1 = sinf(fr * a); LDS_WAIT(); hx[F.lane] = h1; LDS_WAIT();
                a = b2[F.lane];
                for (int i = 0; i < 64; ++i) a += hx[i] * w2[i * 64 + F.lane];
                float h2 = sinf(fr * a); LDS_WAIT(); hx[F.lane] = h2; LDS_WAIT();
                a = b3[F.lane];
                for (int i = 0; i < 64; ++i) a += hx[i] * w3[i * 64 + F.lane];
                float h3 = sinf(fr * a); LDS_WAIT(); hx[F.lane] = h3; LDS_WAIT();
                float o[8];
#pragma unroll
                for (int j = 0; j < 8; ++j) o[j] = 0.f;
                for (int i = 0; i < 64; ++i) { const float hv = hx[i];
#pragma unroll
                    for (int j = 0; j < 8; ++j) o[j] += hv * w4[i * 512 + j * 64 + F.lane]; }
#pragma unroll
                for (int j = 0; j < 8; ++j) { const int n = j * 64 + F.lane; const int ch = n & 255;
                    const float dl = -3.0701134573253946f + (float)ch * ((-15.350567286626973f + 3.0701134573253946f) / 255.0f);
                    hb[pl * 512 + n] = o[j] * __expf(-t * fabsf(dl)); }
                LDS_WAIT();
            }
            __syncthreads();
            float* filt = isctx ? WSP(float, WS_FILTC) + (size_t)l * 256 * (2 * CTX) : WSP(float, WS_FILT) + (size_t)l * 256 * (2 * SEQ);
            for (int i = F.tid; i < 512 * 32; i += NT) { const int n = i >> 5, pl = i & 31, p = p0 + pl, ch = n & 255; const float v = hb[pl * 512 + n];
                if (n < 256) filt[(size_t)ch * (2 * L) + L + p] = v + (p == 0 ? F.in[I_HSKIP][l * 256 + ch] : 0.f);
                else if (p >= 1) filt[(size_t)ch * (2 * L) + L - p] = v;
                if (n >= 256 && p == 0) filt[(size_t)ch * (2 * L)] = 0.f; }
            __syncthreads();
        }
    }
}

template <bool TO_LDS>
__device__ __forceinline__ void norm_mod_row(const float* xrow, const float* nw, const float* shift, const float* scale, bf16_t* orow, LAS float* lrow, int lane) {
    f32x4 v[4]; float s = 0.f;
#pragma unroll
    for (int j = 0; j < 4; ++j) { v[j] = *(const f32x4*)(xrow + 4 * lane + 256 * j); s += (v[j].x * v[j].x + v[j].y * v[j].y) + (v[j].z * v[j].z + v[j].w * v[j].w); }
    const float rstd = rsqrtf(wave_sum(s) * (1.f / D) + 1e-6f);
#pragma unroll
    for (int j = 0; j < 4; ++j) { const int c = 4 * lane + 256 * j;
        const f32x4 w = *(const f32x4*)(nw + c), sh = *(const f32x4*)(shift + c), sc = *(const f32x4*)(scale + c);
        const f32x4 o = (v[j] * rstd) * w * (sc + 1.0f) + sh;
        u32x2 p; p.x = pk2(o.x, o.y); p.y = pk2(o.z, o.w);
        *(u32x2*)(orow + c) = p;
        if (TO_LDS) *(LAS f32x4*)(lrow + c) = o; }
}

__device__ __forceinline__ void phase_norm0(Frame& F) {
    const int gw = F.bid * NWV + F.wave, NGW = F.G * NWV;
    const float* mods = WSP(float, WS_MODS);
    bf16_t* N = WSP(bf16_t, WS_N);
    for (int row = gw; row < M_ALL; row += NGW) {
        const float* src = row < M_CTX ? F.in[I_CTX] + (size_t)row * D : F.in[I_X] + (size_t)(row - M_CTX) * D;
        const float* mr = mods + (size_t)row_modr(row) * (NMOD * D);
        norm_mod_row<false>(src, F.in[I_NMIX], mr, mr + D, N + (size_t)row * D, (LAS float*)F.lds, F.lane);
        float* hrow = WSP(float, WS_H) + (size_t)row * D;
#pragma unroll
        for (int j = 0; j < 4; ++j) *(f32x4*)(hrow + 4 * F.lane + 256 * j) = *(const f32x4*)(src + 4 * F.lane + 256 * j);
    }
}

__device__ __forceinline__ void prep_hyena(Frame& F, int l, bool with_ctx_hy) {
    const float* P = WSP(float, WS_P);
    float* VVT = WSP(float, WS_VVT);
    const float* sw = F.in[I_HSW] + (size_t)l * 3 * 768; const float* sb = F.in[I_HSB] + (size_t)l * 768;
    LAS float* tile = (LAS float*)F.lds;
    const int nun = M_ALL / 64;
    for (int u = F.bid; u < nun; u += F.G) {
        const int row0 = u * 64; const bool isctx = row0 < M_CTX; if (isctx && !with_ctx_hy) continue;
        const int L = isctx ? CTX : SEQ; const int b = row_batch(row0); const int t0 = isctx ? row0 - b * CTX : row0 - M_CTX - b * SEQ;
        const int c = F.tid & 255, th = F.tid >> 8;
        const float w1a = sw[0 * 768 + 256 + c], w1b = sw[1 * 768 + 256 + c], w1c = sw[2 * 768 + 256 + c], b1 = sb[256 + c];
        const float wva = sw[0 * 768 + 512 + c], wvb = sw[1 * 768 + 512 + c], wvc = sw[2 * 768 + 512 + c], bv = sb[512 + c];
        for (int tt = 0; tt < 32; ++tt) { const int tl = th * 32 + tt, t = t0 + tl; const float* pr = P + (size_t)(row0 + tl) * PW;
            float x1 = b1 + w1b * pr[256 + c], vv = bv + wvb * pr[512 + c];
            if (t > 0) { x1 += w1a * pr[-PW + 256 + c]; vv += wva * pr[-PW + 512 + c]; }
            if (t < L - 1) { x1 += w1c * pr[PW + 256 + c]; vv += wvc * pr[PW + 512 + c]; }
            tile[c * 65 + tl] = x1 * vv; }
        __syncthreads();
        const int pos0 = isctx ? t0 : CTX + t0;
        for (int i = F.tid; i < 256 * 64; i += NT) { const int cc = i >> 6, tl = i & 63;
            VVT[((size_t)cc * NB + b) * (CTX + SEQ) + pos0 + tl] = tile[cc * 65 + tl]; }
        __syncthreads();
    }
}

__device__ __forceinline__ void prep_rwkv(Frame& F, int l) {
    const float* P = WSP(float, WS_P);
    float* RW = WSP(float, WS_RW); float* BON = WSP(float, WS_RWBON);
    const float* mu = F.in[I_RMU] + (size_t)l * RWC;
    const float* w0 = F.in[I_RW0] + (size_t)l * 512; const float* w2 = F.in[I_RW2] + (size_t)l * 2 * 64 * 256;
    const float* a0 = F.in[I_RA0] + (size_t)l * 512; const float* a2 = F.in[I_RA2] + (size_t)l * 2 * 64 * 256;
    const float* g2 = F.in[I_RG2] + (size_t)l * 128 * 256;
    const float* kkw = F.in[I_RKK] + l * 256; const float* kaw = F.in[I_RKA] + l * 256; const float* rkw = F.in[I_RRK] + l * 256;
    LAS float* lin = (LAS float*)(F.lds + F.wave * 12288);
    const int gw = F.bid * NWV + F.wave, NGW = F.G * NWV, lane = F.lane;
    for (int it = gw; it < M_ALL / 8; it += NGW) {
        const int row0 = it * 8; const bool isctx = row0 < M_CTX;
        for (int tk = 0; tk < 8; ++tk) { const int row = row0 + tk; const float* pr = P + (size_t)row * PW + C_RW;
            const int b = row_batch(row); const int t = isctx ? row - b * CTX : row - M_CTX - b * SEQ;
#pragma unroll
            for (int j = 0; j < 6; ++j) { const int cc = 768 + j * 64 + lane;
                float sh = 0.f;
                if (isctx) { if ((cc & 1) == 0) { if (t > 0) sh = pr[-PW + cc]; } else { if (t < CTX - 1) sh = pr[PW + cc]; } }
                else { const int gr = t >> 6, gc = t & 63; const int m4 = cc & 3;
                    if (m4 == 0) { if (gc > 0) sh = pr[-PW + cc]; } else if (m4 == 1) { if (gc < 63) sh = pr[PW + cc]; }
                    else if (m4 == 2) { if (gr > 0) sh = pr[-64 * PW + cc]; } else { if (gr < 31) sh = pr[64 * PW + cc]; } }
                const float p = pr[cc]; const float m = p + mu[cc] * (sh - p);
                const float v = (j < 2) ? tanhf(m) : ((j < 4) ? m : sigmoidf_(m));
                lin[(j * 64 + lane) * 8 + tk] = v; } }
        LDS_WAIT(); asm volatile("" ::: "memory");
        for (int q = 0; q < 4; ++q) { const int c = lane + 64 * q;
            float accw[2][8], acca[2][8], accg[8];
#pragma unroll
            for (int tk = 0; tk < 8; ++tk) { accw[0][tk] = accw[1][tk] = acca[0][tk] = acca[1][tk] = accg[tk] = 0.f; }
            for (int r = 0; r < 64; ++r) {
                const float ww0 = w2[(0 * 64 + r) * 256 + c], ww1 = w2[(1 * 64 + r) * 256 + c], aa0 = a2[(0 * 64 + r) * 256 + c], aa1 = a2[(1 * 64 + r) * 256 + c];
                const float gg0 = g2[r * 256 + c], gg1 = g2[(64 + r) * 256 + c];
                const LAS f32x4* p0 = (const LAS f32x4*)(lin + (0 * 64 + r) * 8); const LAS f32x4* p1 = (const LAS f32x4*)(lin + (64 + r) * 8);
                const LAS f32x4* p2 = (const LAS f32x4*)(lin + (128 + r) * 8); const LAS f32x4* p3 = (const LAS f32x4*)(lin + (192 + r) * 8);
                const LAS f32x4* p4 = (const LAS f32x4*)(lin + (256 + r) * 8); const LAS f32x4* p5 = (const LAS f32x4*)(lin + (320 + r) * 8);
#pragma unroll
                for (int hh = 0; hh < 2; ++hh) { const f32x4 x0 = p0[hh], x1 = p1[hh], x2 = p2[hh], x3 = p3[hh], x4 = p4[hh], x5 = p5[hh];
#pragma unroll
                    for (int e = 0; e < 4; ++e) { const int tk = hh * 4 + e;
                        accw[0][tk] += x0[e] * ww0; accw[1][tk] += x1[e] * ww1; acca[0][tk] += x2[e] * aa0; acca[1][tk] += x3[e] * aa1;
                        accg[tk] += x4[e] * gg0 + x5[e] * gg1; } } }
            const float w00 = w0[c], w01 = w0[256 + c], a00 = a0[c], a01 = a0[256 + c], kkc = kkw[c], kac = kaw[c], rkc = rkw[c];
#pragma unroll
            for (int tk = 0; tk < 8; ++tk) { const int row = row0 + tk; const float* pr = P + (size_t)row * PW + C_RW;
                const int b = row_batch(row); const int t = isctx ? row - b * CTX : row - M_CTX - b * SEQ;
                float mm[3];
#pragma unroll
                for (int s3 = 0; s3 < 3; ++s3) { const int cc = s3 * 256 + c; float sh = 0.f;
                    if (isctx) { if ((cc & 1) == 0) { if (t > 0) sh = pr[-PW + cc]; } else { if (t < CTX - 1) sh = pr[PW + cc]; } }
                    else { const int gr = t >> 6, gc = t & 63; const int m4 = cc & 3;
                        if (m4 == 0) { if (gc > 0) sh = pr[-PW + cc]; } else if (m4 == 1) { if (gc < 63) sh = pr[PW + cc]; }
                        else if (m4 == 2) { if (gr > 0) sh = pr[-64 * PW + cc]; } else { if (gr < 31) sh = pr[64 * PW + cc]; } }
                    const float p = pr[cc]; mm[s3] = p + mu[cc] * (sh - p); }
                const float r_ = mm[0], k_ = mm[1], v_ = mm[2];
                const float kx = k_ * kkc; const float ss = wave_sum(kx * kx); const float kk = kx * rsqrtf(ss + 1e-12f);
                float* o = RW + (size_t)row * 2560;
                o[c] = r_; o[256 + c] = v_; o[512 + c] = kk;
                float bon = 0.f;
#pragma unroll
                for (int d = 0; d < 2; ++d) { const float xw = (d ? w01 : w00) + accw[d][tk];
                    const float lw = -softplusf_(-xw) - 0.5f; const float dec = __expf(-__expf(lw));
                    const float a = sigmoidf_((d ? a01 : a00) + acca[d][tk]);
                    const float kd = k_ * (1.0f + (a - 1.0f) * kac);
                    o[(3 + 3 * d) * 256 + c] = dec; o[(4 + 3 * d) * 256 + c] = kd; o[(5 + 3 * d) * 256 + c] = kk * a;
                    bon += r_ * kd * rkc; }
                o[9 * 256 + c] = accg[tk];
                bon = wave_sum(bon);
                if (lane == 0) BON[(size_t)row * 4 + q] = bon; }
        }
        LDS_WAIT(); asm volatile("" ::: "memory");
    }
}

__device__ __forceinline__ void prep_gdn(Frame& F, int l) {
    const float* P = WSP(float, WS_P);
    float* Q = WSP(float, WS_GQKV); float* BG = WSP(float, WS_GBG);
    const float* cw = F.in[I_GCONV] + (size_t)l * 5 * 1536;
    const int gw = F.bid * NWV + F.wave, NGW = F.G * NWV, lane = F.lane;
    for (int row = gw; row < M_ALL; row += NGW) {
        const bool isctx = row < M_CTX; const int L = isctx ? CTX : SEQ; const int b = row_batch(row); const int t = isctx ? row - b * CTX : row - M_CTX - b * SEQ;
        const float* pr = P + (size_t)row * PW + C_GD; const float* cwl = cw;
        pr = launder_ptr(pr); cwl = launder_ptr(cwl);
        float* o = Q + (size_t)row * 1536;
#pragma unroll
        for (int part = 0; part < 3; ++part) {
            float x[8];
#pragma unroll
            for (int j = 0; j < 8; ++j) { const int c = (part * 8 + j) * 64 + lane; float a = 0.f;
#pragma unroll
                for (int tap = 0; tap < 5; ++tap) { const int tt = t + tap - 2; if (tt >= 0 && tt < L) a += pr[(tap - 2) * PW + c] * cwl[tap * 1536 + c]; }
                x[j] = siluf_(a); }
            if (part < 2) {
#pragma unroll
                for (int h4 = 0; h4 < 4; ++h4) { const float ss = wave_sum(x[2 * h4] * x[2 * h4] + x[2 * h4 + 1] * x[2 * h4 + 1]);
                    const float sc = rsqrtf(ss + 1e-12f) * (part == 0 ? 0.08838834764831845f : 1.0f);
                    x[2 * h4] *= sc; x[2 * h4 + 1] *= sc; } }
#pragma unroll
            for (int j = 0; j < 8; ++j) o[(part * 8 + j) * 64 + lane] = x[j];
            asm volatile("" ::: "memory");
        }
        if (lane < 16) { const float rv = pr[2048 + lane]; float ov;
            if (lane < 8) ov = sigmoidf_(rv);
            else { const int dh = lane - 8; ov = -__expf(F.in[I_GALOG][l * 8 + dh]) * softplusf_(rv + F.in[I_GDT][l * 8 + dh]); }
            BG[(size_t)row * 16 + lane] = ov; }
    }
}

template <class Fin>
__device__ __forceinline__ void mm_lds(const LAS bf16_t* A, int lda, const LAS bf16_t* Bt, int ldb, int M, int N, int K, int wave, int lane, Fin fin) {
    const int tn = N >> 4, ntile = (M >> 4) * tn, fr = lane & 15, fq = lane >> 4;
    for (int tI = wave; tI < ntile; tI += NWV) {
        const int i0 = (tI / tn) << 4, j0 = (tI % tn) << 4;
        f32x4 acc = (f32x4){0.f, 0.f, 0.f, 0.f};
        const LAS bf16_t* ap = A + (i0 + fr) * lda + fq * 8; const LAS bf16_t* bp = Bt + (j0 + fr) * ldb + fq * 8;
        for (int k = 0; k < K; k += 32) { const bf16x8 a = *(const LAS bf16x8*)(ap + k); const bf16x8 b = *(const LAS bf16x8*)(bp + k);
            acc = __builtin_amdgcn_mfma_f32_16x16x32_bf16(a, b, acc, 0, 0, 0); }
#pragma unroll
        for (int r = 0; r < 4; ++r) fin(i0 + fq * 4 + r, j0 + fr, acc[r]);
    }
}

__device__ __forceinline__ int chain_row(int b, int d, int s) {
    if (s < CTX) { const int pos = d ? (CTX - 1 - s) : s; return b * CTX + pos; }
    const int q = s - CTX; const int pos = d ? (SEQ - 1 - q) : q; return M_CTX + b * SEQ + pos;
}
constexpr int NCHUNK = (CTX + SEQ) / 64;
constexpr size_t GREC = 98304;
constexpr int GR_W = 0, GR_QG = 16384, GR_KT = 32768, GR_AT = 49152, GR_U = 57344, GR_EG = 90112;

__device__ __forceinline__ void gdn_precompute(Frame& F) {
    const float* Q = WSP(float, WS_GQKV); const float* BG = WSP(float, WS_GBG);
    LAS bf16_t* kc = (LAS bf16_t*)(F.lds);
    LAS bf16_t* qc = (LAS bf16_t*)(F.lds + 17408);
    LAS bf16_t* vT = (LAS bf16_t*)(F.lds + 34816);
    LAS bf16_t* kT = (LAS bf16_t*)(F.lds + 53248);
    LAS float*  Mf = (LAS float*)(F.lds + 71680);
    LAS bf16_t* T1 = (LAS bf16_t*)(F.lds + 89088);
    LAS bf16_t* T2 = (LAS bf16_t*)(F.lds + 98304);
    LAS float*  gcv = (LAS float*)(F.lds + 107520);
    LAS float*  bet = gcv + 64;
    LAS int*    rws = (LAS int*)(gcv + 128);
    LAS float*  Tf = (LAS float*)(F.lds + 108544);
    const int tid = F.tid, lane = F.lane, wave = F.wave;
    for (int u = F.bid; u < 64 * NCHUNK; u += F.G) {
        const int ci = u / NCHUNK, n = u % NCHUNK; const int b = ci >> 3, h = (ci >> 1) & 3, d = ci & 1;
        unsigned char* rec = F.ws + WS_GPRE + (size_t)u * GREC;
        if (tid < 64) { const int row = chain_row(b, d, n * 64 + tid); rws[tid] = row; bet[tid] = BG[(size_t)row * 16 + d * 4 + h]; gcv[tid] = BG[(size_t)row * 16 + 8 + d * 4 + h]; }
        __syncthreads();
        if (tid == 0) { float a = 0.f; for (int i = 0; i < 64; ++i) { a += gcv[i]; gcv[i] = a; } }
        for (int i = tid; i < 64 * 128; i += NT) { const int r = i >> 7, c = i & 127; const float* src = Q + (size_t)rws[r] * 1536 + h * 128 + c;
            const unsigned short qb = (unsigned short)f2bf(src[0]), kb = (unsigned short)f2bf(src[512]), vb = (unsigned short)f2bf(src[1024]);
            qc[r * 136 + c] = qb; kc[r * 136 + c] = kb; kT[c * 72 + r] = kb; vT[c * 72 + r] = vb; }
        __syncthreads();
        mm_lds(kc, 136, kc, 136, 64, 64, 128, wave, lane, [&](int i, int j, float v) {
            Mf[i * 68 + j] = (j < i) ? bet[i] * v * __expf(gcv[i] - gcv[j]) : 0.f; });
        mm_lds(qc, 136, kc, 136, 64, 64, 128, wave, lane, [&](int i, int j, float v) {
            const float a = (j <= i) ? v * __expf(gcv[i] - gcv[j]) : 0.f; ((bf16_t*)(rec + GR_AT))[i * 64 + j] = (bf16_t)f2bf(a); });
        __syncthreads();
#pragma unroll 1
        for (int I = 0; I < 4; ++I) {
            for (int rr = 0; rr < 2; ++rr) { const int i = 16 * I + (tid >> 6) + 8 * rr, c = tid & 63; float a = 0.f;
                for (int j = 0; j < 16 * I; ++j) a += Mf[i * 68 + j] * Tf[j * 68 + c];
                Tf[i * 68 + c] = -a; }
            __syncthreads();
            if (wave == 0) { float t[16]; const LAS float* mrow = Mf + (16 * I) * 68 + 16 * I; LAS float* trow = Tf + (16 * I) * 68 + lane;
#pragma unroll
                for (int ii = 0; ii < 16; ++ii) { float a = trow[ii * 68] + ((16 * I + ii == lane) ? 1.f : 0.f);
#pragma unroll
                    for (int jj = 0; jj < ii; ++jj) a -= mrow[ii * 68 + jj] * t[jj];
                    t[ii] = a; trow[ii * 68] = a; } }
            __syncthreads();
        }
        for (int i = tid; i < 64 * 64; i += NT) { const int r = i >> 6, c = i & 63; const float tv = Tf[r * 68 + c] * bet[c];
            T1[r * 72 + c] = (bf16_t)f2bf(tv); T2[r * 72 + c] = (bf16_t)f2bf(tv * __expf(gcv[c])); }
        __syncthreads();
        mm_lds(T1, 72, vT, 72, 64, 128, 64, wave, lane, [&](int i, int j, float v) { ((float*)(rec + GR_U))[i * 128 + j] = v; });
        mm_lds(T2, 72, kT, 72, 64, 128, 64, wave, lane, [&](int i, int j, float v) { ((bf16_t*)(rec + GR_W))[i * 128 + j] = (bf16_t)f2bf(v); });
        const float gl = gcv[63];
        for (int i = tid; i < 64 * 128; i += NT) { const int r = i >> 7, c = i & 127;
            ((bf16_t*)(rec + GR_QG))[r * 128 + c] = (bf16_t)f2bf(bf2f(qc[r * 136 + c]) * __expf(gcv[r])); }
        for (int i = tid; i < 128 * 64; i += NT) { const int c = i >> 6, r = i & 63;
            ((bf16_t*)(rec + GR_KT))[c * 64 + r] = (bf16_t)f2bf(bf2f(kT[c * 72 + r]) * __expf(gl - gcv[r])); }
        if (tid == 0) *(float*)(rec + GR_EG) = __expf(gl);
        __syncthreads();
    }
}

__device__ __forceinline__ void gdn_chain_unit(Frame& F, int ci, int vh) {
    LAS float*  Sf = (LAS float*)(F.lds);
    LAS bf16_t* St = (LAS bf16_t*)(F.lds + 34816);
    LAS bf16_t* Wl = (LAS bf16_t*)(F.lds + 52224);
    LAS bf16_t* Ql = (LAS bf16_t*)(F.lds + 69632);
    LAS bf16_t* Al = (LAS bf16_t*)(F.lds + 87040);
    LAS bf16_t* Kl = (LAS bf16_t*)(F.lds + 96256);
    LAS float*  Ul = (LAS float*)(F.lds + 114688);
    LAS bf16_t* Vn = (LAS bf16_t*)(F.lds + 132096);
    const int tid = F.tid, lane = F.lane, wave = F.wave;
    const int b = ci >> 3, h = (ci >> 1) & 3, d = ci & 1;
    float* GO = WSP(float, WS_GDO) + (size_t)d * M_ALL * 512;
    for (int i = tid; i < 128 * 68; i += NT) Sf[i] = 0.f;
    for (int i = tid; i < 64 * 136; i += NT) St[i] = 0;
    __syncthreads();
    for (int n = 0; n < NCHUNK; ++n) {
        const unsigned char* rec = F.ws + WS_GPRE + (size_t)(ci * NCHUNK + n) * GREC;
        for (int i = tid; i < 64 * 16; i += NT) { const int r = i >> 4, c8 = i & 15;
            *(LAS u32x4*)(Wl + r * 136 + c8 * 8) = *(const u32x4*)(rec + GR_W + (r * 128 + c8 * 8) * 2);
            *(LAS u32x4*)(Ql + r * 136 + c8 * 8) = *(const u32x4*)(rec + GR_QG + (r * 128 + c8 * 8) * 2); }
        for (int i = tid; i < 128 * 8; i += NT) { const int r = i >> 3, c8 = i & 7;
            *(LAS u32x4*)(Kl + r * 72 + c8 * 8) = *(const u32x4*)(rec + GR_KT + (r * 64 + c8 * 8) * 2); }
        for (int i = tid; i < 64 * 8; i += NT) { const int r = i >> 3, c8 = i & 7;
            *(LAS u32x4*)(Al + r * 72 + c8 * 8) = *(const u32x4*)(rec + GR_AT + (r * 64 + c8 * 8) * 2); }
        for (int i = tid; i < 64 * 16; i += NT) { const int r = i >> 4, c4 = i & 15;
            *(LAS f32x4*)(Ul + r * 68 + c4 * 4) = *(const f32x4*)(rec + GR_U + (r * 128 + vh * 64 + c4 * 4) * 4); }
        const float eg = *(const float*)(rec + GR_EG);
        __syncthreads();
        mm_lds(Wl, 136, St, 136, 64, 64, 128, wave, lane, [&](int i, int j, float v) { Vn[j * 72 + i] = (bf16_t)f2bf(Ul[i * 68 + j] - v); });
        __syncthreads();
        mm_lds(Ql, 136, St, 136, 64, 64, 128, wave, lane, [&](int i, int j, float v) { Ul[i * 68 + j] = v; });
        mm_lds(Al, 72, Vn, 72, 64, 64, 64, wave, lane, [&](int i, int j, float v) {
            const int row = chain_row(b, d, n * 64 + i); GO[(size_t)row * 512 + h * 128 + vh * 64 + j] = Ul[i * 68 + j] + v; });
        __syncthreads();
        mm_lds(Kl, 72, Vn, 72, 128, 64, 64, wave, lane, [&](int i, int j, float v) {
            const float s = eg * Sf[i * 68 + j] + v; Sf[i * 68 + j] = s; St[j * 136 + i] = (bf16_t)f2bf(s); });
        __syncthreads();
    }
}

__device__ __forceinline__ void rwkv_scan_unit(Frame& F, int ci, int vhalf) {
    constexpr int TB = 32, NBLK = (CTX + SEQ) / TB, PER = 5 * 64 + 32, NLD = TB * PER / NT;
    const float* RW = WSP(float, WS_RW);
    const int tid = F.tid, lane = F.lane, wave = F.wave;
    const int b = ci >> 3, h = (ci >> 1) & 3, d = ci & 1;
    float* RO = WSP(float, WS_RWO) + (size_t)d * M_ALL * 256;
    LAS float* buf0 = (LAS float*)F.lds;
    LAS float* obuf = buf0 + 2 * TB * PER;
    const int rr = lane >> 4, kq = lane & 15, vloc = wave * 4 + rr;
    float S[4] = {0.f, 0.f, 0.f, 0.f};
    float regs[NLD];
    const int sgn = d ? -1 : 1;
    auto load_block = [&](int blk) {
        const int s0 = blk * TB;
        const int row0 = (s0 < CTX) ? b * CTX + (d ? CTX - 1 - s0 : s0) : M_CTX + b * SEQ + (d ? SEQ - 1 - (s0 - CTX) : (s0 - CTX));
        const float* base = RW + (size_t)row0 * 2560 + h * 64;
#pragma unroll
        for (int e = 0; e < 20; ++e) { const int arr = e % 5, st = (e / 5) * 8 + wave;
            const int slot = arr == 0 ? 2 : (arr == 1 ? 3 + 3 * d : (arr == 2 ? 5 + 3 * d : (arr == 3 ? 4 + 3 * d : 0)));
            const float v = base[(ptrdiff_t)(sgn * st) * 2560 + slot * 256 + lane]; regs[e] = (arr == 0) ? -v : v; }
#pragma unroll
        for (int e = 0; e < 2; ++e) { const int idx = e * NT + tid, st = idx >> 5, vi = idx & 31;
            regs[20 + e] = base[(ptrdiff_t)(sgn * st) * 2560 + 256 + vhalf * 32 + vi]; } };
    auto store_block = [&](LAS float* dst) {
#pragma unroll
        for (int e = 0; e < 20; ++e) { const int arr = e % 5, st = (e / 5) * 8 + wave; dst[st * PER + arr * 64 + lane] = regs[e]; }
#pragma unroll
        for (int e = 0; e < 2; ++e) { const int idx = e * NT + tid, st = idx >> 5, vi = idx & 31; dst[st * PER + 320 + vi] = regs[20 + e]; } };
    load_block(0); store_block(buf0);
    __syncthreads();
    for (int blk = 0; blk < NBLK; ++blk) {
        LAS float* cb = buf0 + (blk & 1) * TB * PER;
        if (blk + 1 < NBLK) load_block(blk + 1);
        for (int st = 0; st < TB; ++st) {
            const LAS float* vp = cb + st * PER;
            const f32x4 a4 = *(const LAS f32x4*)(vp + 4 * kq), w4 = *(const LAS f32x4*)(vp + 64 + 4 * kq), b4 = *(const LAS f32x4*)(vp + 128 + 4 * kq),
                        k4 = *(const LAS f32x4*)(vp + 192 + 4 * kq), r4 = *(const LAS f32x4*)(vp + 256 + 4 * kq);
            const float vv = vp[320 + vloc];
            float sa = (S[0] * a4[0] + S[1] * a4[1]) + (S[2] * a4[2] + S[3] * a4[3]);
            sa = row16_sum(sa);
#pragma unroll
            for (int e = 0; e < 4; ++e) S[e] = S[e] * w4[e] + (sa * b4[e] + vv * k4[e]);
            float o = (S[0] * r4[0] + S[1] * r4[1]) + (S[2] * r4[2] + S[3] * r4[3]);
            o = row16_sum(o);
            if (kq == 0) obuf[st * 32 + vloc] = o;
        }
        __syncthreads();
        if (blk + 1 < NBLK) store_block(buf0 + ((blk + 1) & 1) * TB * PER);
#pragma unroll
        for (int e = 0; e < 2; ++e) { const int idx = e * NT + tid; const int st = idx >> 5, vi = idx & 31;
            const int row = chain_row(b, d, blk * TB + st); RO[(size_t)row * 256 + h * 64 + vhalf * 32 + vi] = obuf[idx]; }
        __syncthreads();
    }
}

__device__ __forceinline__ void hyena_lat_unit(Frame& F, int l, int c) {
    constexpr int CPS = 8192 + 32;
    constexpr int VST = 2184;
    LAS unsigned char* cp = F.lds;
    LAS bf16_t* vv = (LAS bf16_t*)(F.lds + 8 * CPS);
    const int tid = F.tid, lane = F.lane, wave = F.wave;
    const float* g = WSP(float, WS_FILT) + ((size_t)l * 256 + c) * (2 * SEQ);
    const float* V = WSP(float, WS_VVT) + (size_t)c * NB * (CTX + SEQ);
    float* Y = WSP(float, WS_YT) + (size_t)c * NB * (CTX + SEQ);
    for (int i = tid; i < 8 * 512; i += NT) { const int r = i >> 9, n = i & 511; float v[8];
#pragma unroll
        for (int e = 0; e < 8; ++e) { const int gi = 8 * n + r + e; v[e] = (gi >= 1 && gi <= 4095) ? g[gi] : 0.f; }
        u32x4 p; p.x = pk2(v[0], v[1]); p.y = pk2(v[2], v[3]); p.z = pk2(v[4], v[5]); p.w = pk2(v[6], v[7]);
        *(LAS u32x4*)(cp + r * CPS + n * 16) = p; }
    for (int i = tid; i < 8 * 272; i += NT) { const int bb = i / 272, gq = i % 272; float v[8];
        const int s0 = gq * 8 - 64;
#pragma unroll
        for (int e = 0; e < 8; ++e) v[e] = (s0 >= 0 && s0 < SEQ) ? V[(size_t)bb * (CTX + SEQ) + CTX + s0 + 7 - e] : 0.f;
        u32x4 p; p.x = pk2(v[0], v[1]); p.y = pk2(v[2], v[3]); p.z = pk2(v[4], v[5]); p.w = pk2(v[6], v[7]);
        *(LAS u32x4*)(vv + bb * VST + gq * 8) = p; }
    __syncthreads();
    const int fr = lane & 15, fq = lane >> 4;
    const int rcp = (fr + 1) & 7;
    const int bcol = fr & 7, pb = fr >> 3;
    f32x4 acc[2][4];
#pragma unroll
    for (int p = 0; p < 2; ++p)
#pragma unroll
        for (int m = 0; m < 4; ++m) acc[p][m] = (f32x4){0.f, 0.f, 0.f, 0.f};
    const int P0 = 2 * wave;
    const int dlo = 2 * P0 - 31 < -31 ? -31 : 2 * P0 - 31, dhi = 2 * (P0 + 1) + 1 > 31 ? 31 : 2 * (P0 + 1) + 1;
    for (int d = dlo; d <= dhi; ++d) {
        bf16x8 A[4][2];
#pragma unroll
        for (int m = 0; m < 4; ++m)
#pragma unroll
            for (int s = 0; s < 2; ++s) { const int a = d * 64 + 16 * m + fr - 32 * s - 8 * fq - 7 + 2048;
                A[m][s] = *(const LAS bf16x8*)(cp + rcp * CPS + ((a - rcp) >> 3) * 16); }
#pragma unroll
        for (int p = 0; p < 2; ++p) { const int Pp = P0 + p; if (d > 2 * Pp + 1 || d < 2 * Pp - 31) continue;
            const int J = 2 * Pp + pb - d;
#pragma unroll
            for (int s = 0; s < 2; ++s) { const bf16x8 B = *(const LAS bf16x8*)(vv + bcol * VST + (J + 1) * 64 + 32 * s + 8 * fq);
#pragma unroll
                for (int m = 0; m < 4; ++m) acc[p][m] = __builtin_amdgcn_mfma_f32_16x16x32_bf16(A[m][s], B, acc[p][m], 0, 0, 0); } }
    }
#pragma unroll
    for (int p = 0; p < 2; ++p)
#pragma unroll
        for (int m = 0; m < 4; ++m) { const int t = 64 * (2 * (P0 + p) + pb) + 16 * m + 4 * fq;
            *(f32x4*)(Y + (size_t)bcol * (CTX + SEQ) + CTX + t) = acc[p][m]; }
    __syncthreads();
}
__device__ __forceinline__ void hyena_ctx_unit(Frame& F, int l, int c) {
    LAS float* gl = (LAS float*)F.lds;
    LAS float* vl = gl + 512;
    const int tid = F.tid, lane = F.lane, wave = F.wave;
    const float* g = WSP(float, WS_FILTC) + ((size_t)l * 256 + c) * (2 * CTX);
    const float* V = WSP(float, WS_VVT) + (size_t)c * NB * (CTX + SEQ);
    float* Y = WSP(float, WS_YT) + (size_t)c * NB * (CTX + SEQ);
    gl[tid] = (tid >= 1) ? g[tid] : 0.f;
    for (int i = tid; i < 8 * 256; i += NT) vl[i] = V[(size_t)(i >> 8) * (CTX + SEQ) + (i & 255)];
    __syncthreads();
    float a[4] = {0.f, 0.f, 0.f, 0.f};
    for (int s = 0; s < CTX; ++s) { const float v = vl[wave * 256 + s];
#pragma unroll
        for (int j = 0; j < 4; ++j) a[j] += gl[lane + 64 * j - s + 256] * v; }
#pragma unroll
    for (int j = 0; j < 4; ++j) Y[(size_t)wave * (CTX + SEQ) + lane + 64 * j] = a[j];
    __syncthreads();
}

__device__ __forceinline__ void phase_finish(Frame& F, int l, bool with_ctx) {
    const float* P = WSP(float, WS_P); const float* YT = WSP(float, WS_YT);
    const float* RW = WSP(float, WS_RW); const float* BON = WSP(float, WS_RWBON);
    const float* RO = WSP(float, WS_RWO); const float* GO = WSP(float, WS_GDO);
    bf16_t* YC = WSP(bf16_t, WS_YCAT);
    const float* sw = F.in[I_HSW] + (size_t)l * 3 * 768; const float* sb = F.in[I_HSB] + (size_t)l * 768;
    const float* gnw = F.in[I_RGNW] + l * 256; const float* gnb = F.in[I_RGNB] + l * 256; const float* gdw = F.in[I_GNW] + l * 128;
    LAS float* tile = (LAS float*)F.lds;
    const int tid = F.tid, lane = F.lane, wave = F.wave;
    for (int u = F.bid; u < M_ALL / 64; u += F.G) {
        const int row0 = u * 64; const bool isctx = row0 < M_CTX; if (isctx && !with_ctx) continue;
        const int L = isctx ? CTX : SEQ; const int b = row_batch(row0); const int t0 = isctx ? row0 - b * CTX : row0 - M_CTX - b * SEQ;
        const int pos0 = isctx ? t0 : CTX + t0;
        for (int i = tid; i < 256 * 64; i += NT) { const int cc = i >> 6, tl = i & 63; tile[cc * 65 + tl] = YT[((size_t)cc * NB + b) * (CTX + SEQ) + pos0 + tl]; }
        __syncthreads();
        { const int c = tid & 255, th = tid >> 8;
          const float wa = sw[c], wb = sw[768 + c], wc_ = sw[2 * 768 + c], b0 = sb[c];
          for (int tt = 0; tt < 32; ++tt) { const int tl = th * 32 + tt, t = t0 + tl; const float* pr = P + (size_t)(row0 + tl) * PW;
              float x0 = b0 + wb * pr[c]; if (t > 0) x0 += wa * pr[-PW + c]; if (t < L - 1) x0 += wc_ * pr[PW + c];
              YC[(size_t)(row0 + tl) * D + c] = (bf16_t)f2bf(tile[c * 65 + tl] * x0); } }
        for (int tk = 0; tk < 8; ++tk) { const int row = row0 + wave * 8 + tk;
            const float* rw = RW + (size_t)row * 2560;
#pragma unroll
            for (int q = 0; q < 4; ++q) { const int c = lane + 64 * q;
                const float o = RO[(size_t)row * 256 + c] + RO[(size_t)(M_ALL + row) * 256 + c];
                const float mean = wave_sum(o) * (1.f / 64.f); const float dv = o - mean; const float var = wave_sum(dv * dv) * (1.f / 64.f);
                float y = dv * rsqrtf(var + 64e-5f) * gnw[c] + gnb[c];
                y += BON[(size_t)row * 4 + q] * rw[256 + c];
                y *= rw[9 * 256 + c];
                YC[(size_t)row * D + 256 + c] = (bf16_t)f2bf(y); }
            float o[8];
#pragma unroll
            for (int j = 0; j < 8; ++j) { const int c = j * 64 + lane; o[j] = GO[(size_t)row * 512 + c] + GO[(size_t)(M_ALL + row) * 512 + c]; }
#pragma unroll
            for (int hh = 0; hh < 4; ++hh) { const float ms = wave_sum(o[2 * hh] * o[2 * hh] + o[2 * hh + 1] * o[2 * hh + 1]) * (1.f / 128.f); const float rs = rsqrtf(ms + 1e-6f);
#pragma unroll
                for (int jj = 0; jj < 2; ++jj) { const int j = 2 * hh + jj, c = j * 64 + lane; const float z = P[(size_t)row * PW + C_GD + 1536 + c];
                    YC[(size_t)row * D + 512 + c] = (bf16_t)f2bf(o[j] * rs * gdw[c & 127] * siluf_(z)); } }
        }
        __syncthreads();
    }
}

__device__ __forceinline__ void phase_router(Frame& F, int l, int row_lo) {
    const float* H = WSP(float, WS_H); const float* mods = WSP(float, WS_MODS) + (size_t)l * 9 * (NMOD * D);
    bf16_t* N = WSP(bf16_t, WS_N);
    const float* rw = F.in[I_MRW] + (size_t)l * D * NE; const float* rb = F.in[I_MRB] + l * NE;
    unsigned* cnt = (unsigned*)(F.ws + WS_CTL) + CW_CNT + l * NE * 64;
    int* stok = WSP(int, WS_STOK); int* toke = WSP(int, WS_TOKE); int* tokr = WSP(int, WS_TOKE + MiB); float* tokg = WSP(float, WS_TOKE + 2 * MiB);
    LAS float* xr = (LAS float*)F.lds;
    LAS float* lg = xr + 32 * 1024;
    const int tid = F.tid, lane = F.lane, wave = F.wave;
    for (int u = F.bid; u < (M_ALL - row_lo) / 32; u += F.G) {
        const int row0 = row_lo + u * 32;
        for (int tk = 0; tk < 4; ++tk) { const int tl = wave * 4 + tk, row = row0 + tl; const float* mr = mods + (size_t)row_modr(row) * (NMOD * D);
            norm_mod_row<true>(H + (size_t)row * D, F.in[I_NFFN] + l * D, mr + 3 * D, mr + 4 * D, N + (size_t)row * D, xr + tl * 1024, lane); }
        __syncthreads();
        { const int tl = tid >> 4, e0 = (tid & 15) * 2; float a0 = 0.f, a1 = 0.f; const LAS float* xp = xr + tl * 1024;
#pragma unroll 8
          for (int k = 0; k < D; ++k) { const float x = xp[k]; const f32x2 w = *(const f32x2*)(rw + (size_t)k * NE + e0); a0 += x * w.x; a1 += x * w.y; }
          lg[tl * 33 + e0] = a0 + rb[e0]; lg[tl * 33 + e0 + 1] = a1 + rb[e0 + 1]; }
        __syncthreads();
        if (tid < 32) { const int row = row0 + tid; float v[NE];
#pragma unroll
            for (int e = 0; e < NE; ++e) v[e] = lg[tid * 33 + e];
            int sel[4]; float sv[4];
#pragma unroll
            for (int k = 0; k < 4; ++k) { float best = -3.0e38f; int bi = 0;
#pragma unroll
                for (int e = 0; e < NE; ++e) { const bool taken = (k > 0 && sel[0] == e) || (k > 1 && sel[1] == e) || (k > 2 && sel[2] == e);
                    if (!taken && v[e] > best) { best = v[e]; bi = e; } }
                sel[k] = bi; sv[k] = best; }
            float ex[4], den = 0.f;
#pragma unroll
            for (int k = 0; k < 4; ++k) { ex[k] = __expf(sv[k] - sv[0]); den += ex[k]; }
#pragma unroll
            for (int k = 0; k < 4; ++k) { const unsigned rk = atomicAdd(cnt + sel[k] * 64, 1u);
                stok[(size_t)sel[k] * M_ALL + rk] = row; toke[(size_t)row * 4 + k] = sel[k]; tokr[(size_t)row * 4 + k] = (int)rk; tokg[(size_t)row * 4 + k] = ex[k] / den; } }
        __syncthreads();
    }
}

__device__ __forceinline__ void moe_prefix(Frame& F, int l, LAS int* pref) {
    const unsigned* cnt = (const unsigned*)(F.ws + WS_CTL) + CW_CNT + l * NE * 64;
    if (F.tid == 0) { int a = 0; for (int e = 0; e < NE; ++e) { const int c = (int)__hip_atomic_load(cnt + e * 64, __ATOMIC_RELAXED, __HIP_MEMORY_SCOPE_AGENT); pref[e] = a; pref[64 + e] = c; a += (c + 255) >> 8; } pref[32] = a; }
    __syncthreads();
}

__device__ __forceinline__ void phase_combine(Frame& F, int l, int row_lo, LAS int* pref) {
    float* H = WSP(float, WS_H); const float* mods = WSP(float, WS_MODS);
    const bf16_t* YB = WSP(bf16_t, WS_YB); bf16_t* N = WSP(bf16_t, WS_N);
    const int* toke = WSP(int, WS_TOKE); const int* tokr = WSP(int, WS_TOKE + MiB); const float* tokg = WSP(float, WS_TOKE + 2 * MiB);
    const int gw = F.bid * NWV + F.wave, NGW = F.G * NWV, lane = F.lane;
    const bool last = (l == DEPTH - 1);
    for (int row = row_lo + gw; row < M_ALL; row += NGW) {
        const int r9 = row_modr(row); const float* mr = mods + ((size_t)l * 9 + r9) * (NMOD * D);
        int dst[4]; float gk[4];
#pragma unroll
        for (int k = 0; k < 4; ++k) { const int e = toke[(size_t)row * 4 + k]; dst[k] = pref[e] * 256 + tokr[(size_t)row * 4 + k]; gk[k] = tokg[(size_t)row * 4 + k]; }
        f32x4 v[4]; float ss = 0.f;
#pragma unroll
        for (int j = 0; j < 4; ++j) { const int c = 4 * lane + 256 * j; f32x4 y = (f32x4){0.f, 0.f, 0.f, 0.f};
#pragma unroll
            for (int k = 0; k < 4; ++k) { const u32x2 p = *(const u32x2*)(YB + (size_t)dst[k] * D + c);
                y.x += gk[k] * __builtin_bit_cast(float, p.x << 16); y.y += gk[k] * __builtin_bit_cast(float, p.x & 0xffff0000u);
                y.z += gk[k] * __builtin_bit_cast(float, p.y << 16); y.w += gk[k] * __builtin_bit_cast(float, p.y & 0xffff0000u); }
            const f32x4 hv = *(const f32x4*)(H + (size_t)row * D + c) + *(const f32x4*)(mr + 5 * D + c) * y;
            v[j] = hv; ss += (hv.x * hv.x + hv.y * hv.y) + (hv.z * hv.z + hv.w * hv.w);
            if (!last) *(f32x4*)(H + (size_t)row * D + c) = hv; }
        const float rstd = rsqrtf(wave_sum(ss) * (1.f / D) + 1e-6f);
        if (last) { float* orow = F.out + (size_t)(row - M_CTX) * D;
#pragma unroll
            for (int j = 0; j < 4; ++j) { const int c = 4 * lane + 256 * j; f32x4 ov = (v[j] * rstd) * *(const f32x4*)(F.in[I_NFIN] + c);
#ifdef PROBE_EDGE
                { const int tt = (row - M_CTX) % SEQ; if (tt < 8 || tt >= SEQ - 8) ov = (f32x4){0.f, 0.f, 0.f, 0.f}; }
#endif
                *(f32x4*)(orow + c) = ov; } }
        else { const float* mn = mods + ((size_t)(l + 1) * 9 + r9) * (NMOD * D); const float* nw = F.in[I_NMIX] + (l + 1) * D;
#pragma unroll
            for (int j = 0; j < 4; ++j) { const int c = 4 * lane + 256 * j;
                const f32x4 o = (v[j] * rstd) * *(const f32x4*)(nw + c) * (*(const f32x4*)(mn + D + c) + 1.0f) + *(const f32x4*)(mn + c);
                u32x2 p; p.x = pk2(o.x, o.y); p.y = pk2(o.z, o.w); *(u32x2*)(N + (size_t)row * D + c) = p; } }
    }
}


#ifdef DBG_CHECK
constexpr int CW_DBG = 40000;
__device__ __forceinline__ void dbg_add(Frame& F, float num, float den) {
    float* acc = (float*)((unsigned*)(F.ws + WS_CTL) + CW_DBG);
    num = wave_sum(num); den = wave_sum(den);
    if (F.lane == 0) { atomicAdd(acc, num); atomicAdd(acc + 1, den); }
}
__device__ __forceinline__ void dbg_gdn(Frame& F, int ci) {
    const float* Q = WSP(float, WS_GQKV); const float* BG = WSP(float, WS_GBG);
    const int b = ci >> 3, h = (ci >> 1) & 3, d = ci & 1;
    const float* GO = WSP(float, WS_GDO) + (size_t)d * M_ALL * 512;
    LAS float* S = (LAS float*)F.lds;
    LAS float* part = S + 128 * 129;
    LAS float* vn = part + 512;
    LAS float* kq = vn + 128;
    const int tid = F.tid, v = tid & 127, pt = tid >> 7;
    for (int i = tid; i < 128 * 129; i += NT) S[i] = 0.f;
    __syncthreads();
    float num = 0.f, den = 0.f;
    for (int s = 0; s < CTX + SEQ; ++s) {
        const int row = chain_row(b, d, s); const float* qr = Q + (size_t)row * 1536 + h * 128;
        const float beta = BG[(size_t)row * 16 + d * 4 + h], al = __expf(BG[(size_t)row * 16 + 8 + d * 4 + h]);
        if (tid < 128) kq[tid] = qr[512 + tid]; else if (tid < 256) kq[tid] = qr[tid - 128];
        __syncthreads();
        float a = 0.f;
        for (int j = 0; j < 32; ++j) { const int kd = pt * 32 + j; const float sv = S[kd * 129 + v] * al; S[kd * 129 + v] = sv; a += sv * kq[kd]; }
        part[pt * 128 + v] = a;
        __syncthreads();
        if (tid < 128) vn[tid] = beta * (qr[1024 + tid] - (part[tid] + part[128 + tid] + part[256 + tid] + part[384 + tid]));
        __syncthreads();
        a = 0.f;
        for (int j = 0; j < 32; ++j) { const int kd = pt * 32 + j; const float sv = S[kd * 129 + v] + kq[kd] * vn[v]; S[kd * 129 + v] = sv; a += sv * kq[128 + kd]; }
        part[pt * 128 + v] = a;
        __syncthreads();
        if (tid < 128) { const float o = part[tid] + part[128 + tid] + part[256 + tid] + part[384 + tid]; const float f = GO[(size_t)row * 512 + h * 128 + tid];
            num += (o - f) * (o - f); den += o * o; }
        __syncthreads();
    }
    dbg_add(F, num, den);
}
__device__ __forceinline__ void dbg_hyena(Frame& F, int l) {
    const int gw = F.bid * NWV + F.wave, lane = F.lane;
    float num = 0.f, den = 0.f;
    for (int smp = gw; smp < 8192; smp += F.G * NWV) {
        const unsigned hsh = (unsigned)smp * 2654435761u; const int c = hsh & 255, b = (hsh >> 8) & 7; const int isc = (smp & 7) == 0; const int L = isc ? CTX : SEQ; const int t = (hsh >> 11) % L;
        const float* g = isc ? WSP(float, WS_FILTC) + ((size_t)l * 256 + c) * (2 * CTX) : WSP(float, WS_FILT) + ((size_t)l * 256 + c) * (2 * SEQ);
        const float* V = WSP(float, WS_VVT) + ((size_t)c * NB + b) * (CTX + SEQ) + (isc ? 0 : CTX);
        float a = 0.f;
        for (int s = lane; s < L; s += 64) a += g[t - s + L] * V[s];
        a = wave_sum(a);
        const float f = WSP(float, WS_YT)[((size_t)c * NB + b) * (CTX + SEQ) + (isc ? 0 : CTX) + t];
        if (isc && l == DEPTH - 1) continue;
        if (lane == 0) { num += (a - f) * (a - f); den += a * a; }
    }
    dbg_add(F, num, den);
}
__device__ __forceinline__ void dbg_moe(Frame& F, int l, LAS int* pref) {
    const bf16_t* N = WSP(bf16_t, WS_N); const bf16_t* YB = WSP(bf16_t, WS_YB);
    const int* toke = WSP(int, WS_TOKE); const int* tokr = WSP(int, WS_TOKE + MiB); const float* tokg = WSP(float, WS_TOKE + 2 * MiB);
    LAS float* xs = (LAS float*)(F.lds + F.wave * 8192);
    LAS float* as = xs + 1024;
    const int gw = F.bid * NWV + F.wave, lane = F.lane;
    float num = 0.f, den = 0.f;
    for (int smp = gw; smp < 2048; smp += F.G * NWV) {
        const int row = M_CTX + (int)(((unsigned)smp * 2654435761u) % (unsigned)M_LAT);
        for (int i = lane; i < 1024; i += 64) xs[i] = bf2f(N[(size_t)row * D + i]);
        LDS_WAIT();
        float y[16], yf[16];
#pragma unroll
        for (int j = 0; j < 16; ++j) { y[j] = 0.f; yf[j] = 0.f; }
        for (int k = 0; k < 4; ++k) { const int e = toke[(size_t)row * 4 + k]; const float gk = tokg[(size_t)row * 4 + k]; const int dst = pref[e] * 256 + tokr[(size_t)row * 4 + k];
            const float* wgu = F.in[I_MWGU] + ((size_t)l * NE + e) * D * 2048; const float* bgu = F.in[I_MBGU] + ((size_t)l * NE + e) * 2048;
            const float* wdn = F.in[I_MWDN] + ((size_t)l * NE + e) * FF * D; const float* bdn = F.in[I_MBDN] + ((size_t)l * NE + e) * D;
            for (int jf = 0; jf < 16; ++jf) { const int f = jf * 64 + lane; float g = bgu[f], u = bgu[1024 + f];
                for (int dd = 0; dd < D; ++dd) { const float x = xs[dd]; g += x * wgu[(size_t)dd * 2048 + f]; u += x * wgu[(size_t)dd * 2048 + 1024 + f]; }
                g = fminf(g, 7.f); u = fminf(fmaxf(u, -7.f), 7.f); as[f] = (u + 1.f) * (g / (1.f + __expf(-1.702f * g))); }
            LDS_WAIT();
#pragma unroll
            for (int j = 0; j < 16; ++j) { const int c = j * 64 + lane; float a = bdn[c];
                for (int f = 0; f < FF; ++f) a += as[f] * wdn[(size_t)f * D + c];
                y[j] += gk * a; yf[j] += gk * bf2f(YB[(size_t)dst * D + c]); }
            LDS_WAIT(); }
#pragma unroll
        for (int j = 0; j < 16; ++j) { num += (y[j] - yf[j]) * (y[j] - yf[j]); den += y[j] * y[j]; }
    }
    dbg_add(F, num, den);
}

__device__ __forceinline__ void dbg_static(Frame& F) {
    const int gw = F.bid * NWV + F.wave, lane = F.lane;
    float num = 0.f, den = 0.f;
    if (DBG_SUB & 1) for (int smp = gw * 64 + lane; smp < (1 << 20); smp += F.G * NT) {
        const unsigned hsh = (unsigned)smp * 2654435761u; const int l = hsh & 3, k = (hsh >> 2) & 1023, n = (hsh >> 12) % IN_COLS, n2 = (hsh >> 12) & 1023;
        const float a = F.in[I_WIN][((size_t)l * D + k) * IN_COLS + n], b = bf2f(WSP(bf16_t, WS_WIN)[((size_t)l * PW + n) * D + k]);
        const float c = F.in[I_WOUT][((size_t)l * D + k) * D + n2], d = bf2f(WSP(bf16_t, WS_WOUT)[((size_t)l * D + n2) * D + k]);
        num += (a - b) * (a - b) + (c - d) * (c - d); den += a * a + c * c; }
    if (DBG_SUB & 2) for (int smp = gw; smp < 4096; smp += F.G * NWV) {
        const unsigned hsh = (unsigned)smp * 2654435761u; const int l = hsh & 3, r = (hsh >> 2) % 9, n = (hsh >> 8) % (NMOD * D);
        float a = 0.f;
        for (int k = lane; k < D; k += 64) { const float cv = (r < 8) ? F.in[I_C][r * D + k] : F.in[I_CCTX][k]; a += siluf_(cv) * F.in[I_ADAW][((size_t)l * D + k) * (NMOD * D) + n]; }
        a = wave_sum(a) + F.in[I_ADAB][l * (NMOD * D) + n];
        const float f = WSP(float, WS_MODS)[((size_t)l * 9 + r) * (NMOD * D) + n];
        if (lane == 0) { num += (a - f) * (a - f); den += a * a; } }
    if (DBG_SUB & 4) for (int smp = gw; smp < 2048; smp += F.G * NWV) {
        const unsigned hsh = (unsigned)smp * 2654435761u; const int l = hsh & 3; const bool isctx = (hsh >> 2) & 1; const int L = isctx ? CTX : SEQ; const int p = (hsh >> 3) % L;
        const float t = (float)p / (float)(L - 1);
        LAS float* hx = (LAS float*)(F.lds + F.wave * 1024);
        float z = 0.f;
        if (lane == 0) z = t; else if (lane < 33) { const int bi = (lane - 1) & 15; const float band = 1e-4f + (float)bi * ((15.0f - 1e-4f) / 15.0f); const float ang = (6.283185307179586f / (float)L) * (float)p * band; z = (lane <= 16) ? cosf(ang) : -sinf(ang); }
        const float fr = F.in[I_HFREQ][l * 64 + lane];
        hx[lane] = z; LDS_WAIT(); float a = F.in[I_HB1][l * 64 + lane];
#pragma unroll 1
        for (int i = 0; i < 33; ++i) a += hx[i] * F.in[I_HW1][((size_t)l * 33 + i) * 64 + lane];
        float hh = sinf(fr * a); LDS_WAIT(); hx[lane] = hh; LDS_WAIT(); a = F.in[I_HB2][l * 64 + lane];
#pragma unroll 1
        for (int i = 0; i < 64; ++i) a += hx[i] * F.in[I_HW2][((size_t)l * 64 + i) * 64 + lane];
        hh = sinf(fr * a); LDS_WAIT(); hx[lane] = hh; LDS_WAIT(); a = F.in[I_HB3][l * 64 + lane];
#pragma unroll 1
        for (int i = 0; i < 64; ++i) a += hx[i] * F.in[I_HW3][((size_t)l * 64 + i) * 64 + lane];
        hh = sinf(fr * a); LDS_WAIT(); hx[lane] = hh; LDS_WAIT();
        const int ch = ((hsh >> 16) + lane * 16) & 255; float of = 0.f, ob = 0.f;
#pragma unroll 1
        for (int i = 0; i < 64; ++i) { of += hx[i] * F.in[I_HW4][((size_t)l * 64 + i) * 512 + ch]; ob += hx[i] * F.in[I_HW4][((size_t)l * 64 + i) * 512 + 256 + ch]; }
        const float dl = -3.0701134573253946f + (float)ch * ((-15.350567286626973f + 3.0701134573253946f) / 255.0f); const float win = __expf(-t * fabsf(dl));
        of = of * win + (p == 0 ? F.in[I_HSKIP][l * 256 + ch] : 0.f); ob *= win;
        const float* filt = isctx ? WSP(float, WS_FILTC) + ((size_t)l * 256 + ch) * (2 * CTX) : WSP(float, WS_FILT) + ((size_t)l * 256 + ch) * (2 * SEQ);
        if (lane < 16) { const float ff = filt[L + p]; num += (of - ff) * (of - ff); den += of * of;
            if (p >= 1) { const float fb = filt[L - p]; num += (ob - fb) * (ob - fb); den += ob * ob; } }
        LDS_WAIT(); }
    dbg_add(F, num, den);
}

__device__ __forceinline__ float dbg_rw_m(const float* P, const float* mu, int row, int cc) {
    const bool isctx = row < M_CTX; const int b = row_batch(row); const int t = isctx ? row - b * CTX : row - M_CTX - b * SEQ;
    const float* pr = P + (size_t)row * PW + C_RW; float sh = 0.f;
    if (isctx) { if ((cc & 1) == 0) { if (t > 0) sh = pr[-PW + cc]; } else { if (t < CTX - 1) sh = pr[PW + cc]; } }
    else { const int gr = t / 64, gc = t % 64, m4 = cc % 4;
        if (m4 == 0) { if (gc > 0) sh = pr[-PW + cc]; } else if (m4 == 1) { if (gc < 63) sh = pr[PW + cc]; } else if (m4 == 2) { if (gr > 0) sh = pr[-64 * PW + cc]; } else { if (gr < 31) sh = pr[64 * PW + cc]; } }
    return pr[cc] + mu[cc] * (sh - pr[cc]);
}
__device__ __forceinline__ void dbg_prep(Frame& F, int l) {
    const float* P = WSP(float, WS_P); const int gw = F.bid * NWV + F.wave, lane = F.lane;
    float num = 0.f, den = 0.f;
    if (DBG_SUB & 1) for (int smp = gw; smp < 1024; smp += F.G * NWV) {
        const int row = (int)(((unsigned)smp * 2654435761u) % (unsigned)M_ALL);
        const float* mu = F.in[I_RMU] + (size_t)l * RWC; const float* rw = WSP(float, WS_RW) + (size_t)row * 2560;
#pragma unroll 1
        for (int q = 0; q < 4; ++q) { const int c = lane + 64 * q;
            const float r_ = dbg_rw_m(P, mu, row, c), k_ = dbg_rw_m(P, mu, row, 256 + c), v_ = dbg_rw_m(P, mu, row, 512 + c);
            float lw[2] = {F.in[I_RW0][l * 512 + c], F.in[I_RW0][l * 512 + 256 + c]}, la[2] = {F.in[I_RA0][l * 512 + c], F.in[I_RA0][l * 512 + 256 + c]}, g = 0.f;
#pragma unroll 1
            for (int r = 0; r < 64; ++r) {
#pragma unroll
                for (int d = 0; d < 2; ++d) { lw[d] += tanhf(dbg_rw_m(P, mu, row, 768 + d * 64 + r)) * F.in[I_RW2][(((size_t)l * 2 + d) * 64 + r) * 256 + c];
                    la[d] += dbg_rw_m(P, mu, row, 896 + d * 64 + r) * F.in[I_RA2][(((size_t)l * 2 + d) * 64 + r) * 256 + c]; } }
#pragma unroll 1
            for (int r = 0; r < 128; ++r) g += sigmoidf_(dbg_rw_m(P, mu, row, 1024 + r)) * F.in[I_RG2][((size_t)l * 128 + r) * 256 + c];
            const float kx = k_ * F.in[I_RKK][l * 256 + c]; const float kk = kx * rsqrtf(wave_sum(kx * kx) + 1e-12f);
            float ref[10]; ref[0] = r_; ref[1] = v_; ref[2] = kk; ref[9] = g; float bon = 0.f;
#pragma unroll
            for (int d = 0; d < 2; ++d) { const float lwv = -softplusf_(-lw[d]) - 0.5f; ref[3 + 3 * d] = expf(-expf(lwv)); const float a = sigmoidf_(la[d]);
                const float kd = k_ * (1.f + (a - 1.f) * F.in[I_RKA][l * 256 + c]); ref[4 + 3 * d] = kd; ref[5 + 3 * d] = kk * a; bon += r_ * kd * F.in[I_RRK][l * 256 + c]; }
            bon = wave_sum(bon);
#pragma unroll
            for (int j = 0; j < 10; ++j) { const float f = rw[j * 256 + c]; num += (ref[j] - f) * (ref[j] - f); den += ref[j] * ref[j]; }
            if (lane == 0) { const float f = WSP(float, WS_RWBON)[(size_t)row * 4 + q]; num += (bon - f) * (bon - f); den += bon * bon; } } }
    if (DBG_SUB & 2) for (int smp = gw; smp < 4096; smp += F.G * NWV) {
        const int row = (int)(((unsigned)smp * 2654435761u) % (unsigned)M_ALL);
        const bool isctx = row < M_CTX; const int L = isctx ? CTX : SEQ; const int b = row_batch(row); const int t = isctx ? row - b * CTX : row - M_CTX - b * SEQ;
        const float* cw = F.in[I_GCONV] + (size_t)l * 5 * 1536; const float* q = WSP(float, WS_GQKV) + (size_t)row * 1536;
#pragma unroll 1
        for (int part = 0; part < 3; ++part)
#pragma unroll 1
            for (int hd = 0; hd < 4; ++hd) { float x[2];
#pragma unroll
                for (int jj = 0; jj < 2; ++jj) { const int c = part * 512 + hd * 128 + jj * 64 + lane; float a = 0.f;
                    for (int tap = 0; tap < 5; ++tap) { const int tt = t + tap - 2; if (tt >= 0 && tt < L) a += P[(size_t)(row + tap - 2) * PW + C_GD + c] * cw[tap * 1536 + c]; }
                    x[jj] = a / (1.f + expf(-a)); }
                if (part < 2) { const float sc = rsqrtf(wave_sum(x[0] * x[0] + x[1] * x[1]) + 1e-12f) * (part == 0 ? 0.08838834764831845f : 1.f); x[0] *= sc; x[1] *= sc; }
#pragma unroll
                for (int jj = 0; jj < 2; ++jj) { const float f = q[part * 512 + hd * 128 + jj * 64 + lane]; num += (x[jj] - f) * (x[jj] - f); den += x[jj] * x[jj]; } }
        if (lane < 16) { const float rv = P[(size_t)row * PW + C_GD + 2048 + lane]; float ov;
            if (lane < 8) ov = 1.f / (1.f + expf(-rv)); else { const int dh = lane - 8; ov = -expf(F.in[I_GALOG][l * 8 + dh]) * softplusf_(rv + F.in[I_GDT][l * 8 + dh]); }
            const float f = WSP(float, WS_GBG)[(size_t)row * 16 + lane]; num += (ov - f) * (ov - f); den += ov * ov; } }
    if (DBG_SUB & 4) for (int smp = gw; smp < 4096; smp += F.G * NWV) {
        const int row = M_CTX + (int)(((unsigned)smp * 2654435761u) % (unsigned)M_LAT); const int b = row_batch(row), t = row - M_CTX - b * SEQ;
        const float* sw = F.in[I_HSW] + (size_t)l * 3 * 768; const float* sb = F.in[I_HSB] + (size_t)l * 768;
        const bf16_t* yc = WSP(bf16_t, WS_YCAT) + (size_t)row * D;
#pragma unroll 1
        for (int j = 0; j < 4; ++j) { const int c = j * 64 + lane; float u[3];
#pragma unroll
            for (int g3 = 0; g3 < 3; ++g3) { float a = sb[g3 * 256 + c];
                for (int tap = 0; tap < 3; ++tap) { const int tt = t + tap - 1; if (tt >= 0 && tt < SEQ) a += P[(size_t)(row + tap - 1) * PW + g3 * 256 + c] * sw[tap * 768 + g3 * 256 + c]; }
                u[g3] = a; }
            const float vv = u[2] * u[1]; const float fv = WSP(float, WS_VVT)[((size_t)c * NB + b) * (CTX + SEQ) + CTX + t];
            num += (vv - fv) * (vv - fv); den += vv * vv;
            const float yv = WSP(float, WS_YT)[((size_t)c * NB + b) * (CTX + SEQ) + CTX + t] * u[0]; const float fy = bf2f(yc[c]);
            num += (yv - fy) * (yv - fy); den += yv * yv; }
        const float* rw = WSP(float, WS_RW) + (size_t)row * 2560;
#pragma unroll 1
        for (int q = 0; q < 4; ++q) { const int c = lane + 64 * q; const float o = WSP(float, WS_RWO)[(size_t)row * 256 + c] + WSP(float, WS_RWO)[(size_t)(M_ALL + row) * 256 + c];
            const float mean = wave_sum(o) / 64.f; const float var = wave_sum((o - mean) * (o - mean)) / 64.f;
            float y = (o - mean) / sqrtf(var + 64e-5f) * F.in[I_RGNW][l * 256 + c] + F.in[I_RGNB][l * 256 + c];
            y = (y + WSP(float, WS_RWBON)[(size_t)row * 4 + q] * rw[256 + c]) * rw[9 * 256 + c];
            const float fy = bf2f(yc[256 + c]); num += (y - fy) * (y - fy); den += y * y; }
#pragma unroll 1
        for (int hd = 0; hd < 4; ++hd) { float o[2];
#pragma unroll
            for (int jj = 0; jj < 2; ++jj) { const int c = hd * 128 + jj * 64 + lane; o[jj] = WSP(float, WS_GDO)[(size_t)row * 512 + c] + WSP(float, WS_GDO)[(size_t)(M_ALL + row) * 512 + c]; }
            const float rs = 1.f / sqrtf(wave_sum(o[0] * o[0] + o[1] * o[1]) / 128.f + 1e-6f);
#pragma unroll
            for (int jj = 0; jj < 2; ++jj) { const int c = hd * 128 + jj * 64 + lane; const float z = P[(size_t)row * PW + C_GD + 1536 + c];
                const float y = o[jj] * rs * F.in[I_GNW][l * 128 + jj * 64 + lane] * (z / (1.f + expf(-z))); const float fy = bf2f(yc[512 + c]); num += (y - fy) * (y - fy); den += y * y; } } }
    dbg_add(F, num, den);
}
__device__ __forceinline__ void dbg_router(Frame& F, int l) {
    const int gw = F.bid * NWV + F.wave, lane = F.lane; LAS float* xs = (LAS float*)(F.lds + F.wave * 4096);
    float num = 0.f, den = 0.f;
    for (int smp = gw; smp < 4096; smp += F.G * NWV) {
        const int row = M_CTX + (int)(((unsigned)smp * 2654435761u) % (unsigned)M_LAT); const int b = row_batch(row);
        const float* h = WSP(float, WS_H) + (size_t)row * D; const float* mr = WSP(float, WS_MODS) + ((size_t)l * 9 + b) * (NMOD * D);
        float ss = 0.f; for (int i = lane; i < D; i += 64) ss += h[i] * h[i];
        const float rstd = 1.f / sqrtf(wave_sum(ss) / D + 1e-6f);
        for (int i = lane; i < D; i += 64) xs[i] = h[i] * rstd * F.in[I_NFFN][l * D + i] * (1.f + mr[4 * D + i]) + mr[3 * D + i];
        LDS_WAIT();
        float lg = -3e38f;
        if (lane < 32) { lg = F.in[I_MRB][l * NE + lane]; for (int k = 0; k < D; ++k) lg += xs[k] * F.in[I_MRW][((size_t)l * D + k) * NE + lane]; }
        float sv[4]; int se[4]; float cur = lg;
#pragma unroll
        for (int k = 0; k < 4; ++k) { float m = cur;
#pragma unroll
            for (int o = 1; o < 64; o <<= 1) m = fmaxf(m, __shfl_xor(m, o));
            const unsigned long long bal = __ballot(cur == m); const int who = __ffsll((long long)bal) - 1; sv[k] = m; se[k] = who; if (lane == who) cur = -3e38f; }
        float ex[4], dn = 0.f;
#pragma unroll
        for (int k = 0; k < 4; ++k) { ex[k] = expf(sv[k] - sv[0]); dn += ex[k]; }
        if (lane == 0) {
#pragma unroll
            for (int k = 0; k < 4; ++k) { const float g = ex[k] / dn; float fg = 0.f;
                for (int k2 = 0; k2 < 4; ++k2) if (WSP(int, WS_TOKE)[(size_t)row * 4 + k2] == se[k]) fg = WSP(float, WS_TOKE + 2 * MiB)[(size_t)row * 4 + k2];
                num += (g - fg) * (g - fg); den += g * g; } }
        LDS_WAIT(); }
    dbg_add(F, num, den);
}
__device__ __forceinline__ void dbg_rwkv_scan(Frame& F, int ci) {
    const int lane = F.lane; const int b = ci >> 3, h = (ci >> 1) & 3, d = ci & 1;
    const float* RW = WSP(float, WS_RW); const float* RO = WSP(float, WS_RWO) + (size_t)d * M_ALL * 256;
    LAS float* vs = (LAS float*)(F.lds + F.wave * 2048);
    float S[64];
#pragma unroll
    for (int k = 0; k < 64; ++k) S[k] = 0.f;
    float num = 0.f, den = 0.f;
#pragma unroll 1
    for (int s = 0; s < CTX + SEQ; ++s) { const int row = chain_row(b, d, s); const float* src = RW + (size_t)row * 2560 + h * 64;
        vs[lane] = -src[2 * 256 + lane]; vs[64 + lane] = src[(3 + 3 * d) * 256 + lane]; vs[128 + lane] = src[(5 + 3 * d) * 256 + lane]; vs[192 + lane] = src[(4 + 3 * d) * 256 + lane]; vs[256 + lane] = src[lane];
        const float v = src[256 + lane]; LDS_WAIT();
        float sa = 0.f;
#pragma unroll
        for (int k = 0; k < 64; ++k) sa += S[k] * vs[k];
        float o = 0.f;
#pragma unroll
        for (int k = 0; k < 64; ++k) { S[k] = S[k] * vs[64 + k] + sa * vs[128 + k] + v * vs[192 + k]; o += S[k] * vs[256 + k]; }
        const float f = RO[(size_t)row * 256 + h * 64 + lane]; num += (o - f) * (o - f); den += o * o; LDS_WAIT(); }
    dbg_add(F, num, den);
}
__device__ __forceinline__ void dbg_scale(Frame& F, float K) {
    const float* acc = (const float*)((unsigned*)(F.ws + WS_CTL) + CW_DBG);
    const float rel = sqrtf(acc[0] / fmaxf(acc[1], 1e-30f)); const float sc = 1.f + K * rel;
    for (size_t i = (size_t)F.bid * NT + F.tid; i < (size_t)M_LAT * D; i += (size_t)F.G * NT) F.out[i] *= sc;
}
#endif
constexpr int PH_PER_LAYER = 11, N_PHASES = 1 + DEPTH * PH_PER_LAYER;
__global__ void __launch_bounds__(NT, 2) hybrid_fwd(Args args) {
    extern __shared__ __attribute__((aligned(16))) unsigned char lds_raw[];
    Frame F;
    F.lds = (LAS unsigned char*)lds_raw;
    F.tid = threadIdx.x; F.lane = F.tid & 63; F.wave = __builtin_amdgcn_readfirstlane(F.tid >> 6);
    F.G = gridDim.x; F.bid = blockIdx.x; F.in = args.in; F.ws = args.ws; F.out = args.out;
    const int wave0 = F.wave;
    volatile LAS unsigned* MISC = (volatile LAS unsigned*)(F.lds + MISC_OFF);
    LAS int* pref = (LAS int*)(F.lds + MISC_OFF + 256);
    if (F.tid < 4) MISC[F.tid] = 0u;
    __syncthreads();
    const int lo = args.ph_lo, hi = args.ph_hi;
    XcdBarrier bar; bar.bar = (unsigned*)(F.ws + WS_CTL) + CW_BAR; bar.x = 0; bar.st = MISC;
    if (hi - lo > 1) bar = xcd_barrier_post((unsigned*)(F.ws + WS_CTL) + CW_BAR, MISC);
#ifndef PHASE_MASK
#define PHASE_MASK 0xFFFF
#endif
#define PM(j) ((PHASE_MASK >> (j)) & 1)
#define ENTER() do { F.ws = launder_ptr(F.ws); F.out = launder_ptr(F.out); l = launder_int(l); { int ln_; asm volatile("v_mbcnt_lo_u32_b32 %0, -1, 0\n\tv_mbcnt_hi_u32_b32 %0, -1, %0" : "=&v"(ln_)); __builtin_assume(ln_ >= 0 && ln_ < 64); F.lane = ln_; F.wave = launder_int(wave0); __builtin_assume(F.wave >= 0 && F.wave < 8); F.tid = F.wave * 64 + ln_; } } while (0)
#define IN(k) (lo <= (k) && (k) < hi)
#define last (l == DEPTH - 1)
#define SEAM(k) do { if (hi > (k) + 1) xcd_barrier(bar); } while (0)

    if (PM(11) && IN(0)) { phase_prologue(F); SEAM(0); }
    for (int l = 0; l < DEPTH; ++l) {
        const int pb = 1 + l * PH_PER_LAYER;
        if (PM(0) && l == 0 && IN(pb + 0)) { ENTER(); phase_norm0(F); SEAM(pb + 0); }
        if (PM(1) && IN(pb + 1)) {
            ENTER();
            pg8::StaticOrder S; S.init(WSP(bf16_t, WS_N), WSP(bf16_t, WS_WIN) + (size_t)l * PW * D, M_ALL, PW, D, F.G, F.bid);
            pg8::EpiF32 E{WSP(float, WS_P), PW};
            pg8::gemm_phase(F.lds, S, E, F.tid);
            SEAM(pb + 1);
        }
        if (PM(2) && IN(pb + 2)) {
            ENTER();
#ifndef SUBM
#define SUBM 7
#endif
            if (SUBM & 1) prep_hyena(F, l, !last); __syncthreads(); if (SUBM & 2) prep_rwkv(F, l); __syncthreads(); if (SUBM & 4) prep_gdn(F, l); SEAM(pb + 2); }
        if (PM(3) && IN(pb + 3)) {
            ENTER();
            if (SUBM & 1) gdn_precompute(F);
            for (int c = F.bid; c < 256; c += F.G) { if (SUBM & 2) hyena_lat_unit(F, l, c); if ((SUBM & 4) && !last) hyena_ctx_unit(F, l, c); }
            SEAM(pb + 3);
        }
        if (PM(4) && IN(pb + 4)) {
            ENTER();
            for (int u = F.bid; u < 256; u += F.G) { if (u < 128) { if (SUBM & 1) rwkv_scan_unit(F, u >> 1, u & 1); } else { if (SUBM & 2) gdn_chain_unit(F, (u - 128) >> 1, (u - 128) & 1); } }
            SEAM(pb + 4);
        }
        if (PM(5) && IN(pb + 5)) { ENTER(); phase_finish(F, l, !last); SEAM(pb + 5); }
        if (PM(6) && IN(pb + 6)) {
            ENTER();
            const int r0 = last ? M_CTX : 0;
            pg8::StaticOrder S; S.init(WSP(bf16_t, WS_YCAT) + (size_t)r0 * D, WSP(bf16_t, WS_WOUT) + (size_t)l * D * D, M_ALL - r0, D, D, F.G, F.bid);
            pg8::EpiRes E{WSP(float, WS_H) + (size_t)r0 * D, WSP(float, WS_H) + (size_t)r0 * D, WSP(float, WS_MODS) + (size_t)l * 9 * (NMOD * D) + 2 * D, r0};
            pg8::gemm_phase(F.lds, S, E, F.tid);
            SEAM(pb + 6);
        }
        if (PM(7) && IN(pb + 7)) { ENTER(); phase_router(F, l, last ? M_CTX : 0); SEAM(pb + 7); }
        if (PM(8) && IN(pb + 8)) {
            ENTER();
            moe_prefix(F, l, pref);
            pg8::MoeOrder<true, 8> S; S.A = WSP(bf16_t, WS_N); S.Bt = WSP(bf16_t, WS_WGU) + (size_t)l * NE * 2048 * D; S.K = D; S.Nexp = 2048; S.pref = pref; S.stok = WSP(int, WS_STOK); S.G = F.G; S.c = F.bid;
            pg8::EpiGU E{WSP(bf16_t, WS_ACT), F.in[I_MBGU] + (size_t)l * NE * 2048};
            pg8::gemm_phase(F.lds, S, E, F.tid);
            SEAM(pb + 8);
        }
        if (PM(9) && IN(pb + 9)) {
            ENTER();
            moe_prefix(F, l, pref);
            pg8::MoeOrder<false, 4> S; S.A = WSP(bf16_t, WS_ACT); S.Bt = WSP(bf16_t, WS_WDN) + (size_t)l * NE * D * FF; S.K = FF; S.Nexp = D; S.pref = pref; S.stok = nullptr; S.G = F.G; S.c = F.bid;
            pg8::EpiDN E{WSP(bf16_t, WS_YB), F.in[I_MBDN] + (size_t)l * NE * D};
            pg8::gemm_phase(F.lds, S, E, F.tid);
            SEAM(pb + 9);
        }
        if (PM(10) && IN(pb + 10)) { ENTER(); moe_prefix(F, l, pref); phase_combine(F, l, last ? M_CTX : 0, pref); SEAM(pb + 10); }
    }
#undef IN
#undef SEAM
#undef last
}


#ifdef DBG_CHECK
__global__ void __launch_bounds__(NT, 2) dbg_kernel(Args args) {
    extern __shared__ __attribute__((aligned(16))) unsigned char lds_raw[];
    Frame F;
    F.lds = (LAS unsigned char*)lds_raw;
    F.tid = threadIdx.x; F.lane = F.tid & 63; F.wave = __builtin_amdgcn_readfirstlane(F.tid >> 6);
    F.G = gridDim.x; F.bid = blockIdx.x; F.in = args.in; F.ws = args.ws; F.out = args.out;
    LAS int* pref = (LAS int*)(F.lds + MISC_OFF + 256);
    const int l = DEPTH - 1;
    if (args.ph_lo == 0) {
        if (DBG_CHECK == 1) { moe_prefix(F, l, pref); dbg_moe(F, l, pref); }
        if (DBG_CHECK == 2) { if (F.bid < 8) dbg_gdn(F, F.bid * 8 + (F.bid & 1) + 2 * (F.bid % 4)); }
        if (DBG_CHECK == 3) dbg_hyena(F, l);
        if (DBG_CHECK == 4) dbg_static(F);
        if (DBG_CHECK == 5) dbg_prep(F, l);
        if (DBG_CHECK == 6) dbg_router(F, l);
        if (DBG_CHECK == 7) { if (F.bid < 8 && F.wave == 0) dbg_rwkv_scan(F, F.bid * 8 + (F.bid & 1) + 2 * (F.bid % 4)); }
    } else dbg_scale(F, DBG_K);
}
#endif
extern "C" void kernel_launch(void* const* d_in, const int* in_sizes, int n_in, void* d_out, int out_size, void* d_ws, size_t ws_size, hipStream_t stream) {
    static int grid = 0;
    if (grid == 0) {
        int dev = 0, cus = 0, per_cu = 0;
        if (n_in != 43 || ws_size < WS_END) { fprintf(stderr, "kernel_launch: unexpected inputs (%d) or workspace (%zu < %zu)\n", n_in, ws_size, (size_t)WS_END); grid = -1; return; }
        if (hipGetDevice(&dev) != hipSuccess || hipDeviceGetAttribute(&cus, hipDeviceAttributeMultiprocessorCount, dev) != hipSuccess) { grid = -1; return; }
        if (hipFuncSetAttribute((const void*)hybrid_fwd, hipFuncAttributeMaxDynamicSharedMemorySize, LDS_BYTES) != hipSuccess) { fprintf(stderr, "kernel_launch: hipFuncSetAttribute failed\n"); grid = -1; return; }
        if (hipOccupancyMaxActiveBlocksPerMultiprocessor(&per_cu, (const void*)hybrid_fwd, NT, LDS_BYTES) != hipSuccess || per_cu < 1) fprintf(stderr, "kernel_launch: occupancy query reports %d\n", per_cu);
        (void)hipGetLastError();
        grid = cus;
    }
    if (grid < 0) return;
    (void)hipMemsetAsync((char*)d_ws + WS_CTL, 0, CTL_ZERO, stream);
    Args a{};
    for (int i = 0; i < 43; ++i) a.in[i] = (const float*)d_in[i];
    a.out = (float*)d_out; a.ws = (unsigned char*)d_ws;
#if N_LAUNCH_MODE == 1
    a.ph_lo = 0; a.ph_hi = N_PHASES;
    hipLaunchKernelGGL(hybrid_fwd, dim3(grid), dim3(NT), LDS_BYTES, stream, a);
#else
    const int nph = N_PHASES;
    for (int ph = 0; ph < nph; ++ph) {
        if (ph > 0 && ph < N_PHASES && (ph - 1) % PH_PER_LAYER == 0 && (ph - 1) / PH_PER_LAYER > 0) continue;
        a.ph_lo = ph; a.ph_hi = ph + 1;
        hipLaunchKernelGGL(hybrid_fwd, dim3(grid), dim3(NT), LDS_BYTES, stream, a);
    }
#ifdef DBG_CHECK
    static int dbg_init = 0;
    if (!dbg_init) { (void)hipFuncSetAttribute((const void*)dbg_kernel, hipFuncAttributeMaxDynamicSharedMemorySize, LDS_BYTES); dbg_init = 1; }
    a.ph_lo = 0; a.ph_hi = 1; hipLaunchKernelGGL(dbg_kernel, dim3(grid), dim3(NT), LDS_BYTES, stream, a);
    a.ph_lo = 1; a.ph_hi = 2; hipLaunchKernelGGL(dbg_kernel, dim3(grid), dim3(NT), LDS_BYTES, stream, a);
#endif
#endif
}
```

```cpp
#include <hip/hip_runtime.h>
#include <cstdio>
#include <cstdint>

#ifndef N_LAUNCH_MODE
#define N_LAUNCH_MODE 1
#endif

#define LAS __attribute__((address_space(3)))
#define GAS __attribute__((address_space(1)))
typedef unsigned short bf16_t;
typedef short bf16x8 __attribute__((ext_vector_type(8)));
typedef float f32x4 __attribute__((ext_vector_type(4)));
typedef float f32x2 __attribute__((ext_vector_type(2)));
typedef unsigned u32x4 __attribute__((ext_vector_type(4)));
typedef unsigned u32x2 __attribute__((ext_vector_type(2)));

constexpr int D = 1024, NB = 8, SEQ = 2048, CTX = 256, DEPTH = 4;
constexpr int M_CTX = NB * CTX;
constexpr int M_LAT = NB * SEQ;
constexpr int M_ALL = M_CTX + M_LAT;
constexpr int NMOD = 6;
constexpr int PW = 4096;
constexpr int IN_COLS = 3984;
constexpr int C_HY = 0, C_RW = 768, C_GD = 1920;
constexpr int RWC = 1152;
constexpr int NE = 32, TOPK = 4, FF = 1024;
constexpr int NT = 512, NWV = 8;

constexpr size_t MiB = 1ull << 20;
constexpr size_t WS_CTL   = 0;
constexpr size_t CTL_ZERO = 2 * MiB;
constexpr size_t WS_MODS  = 2 * MiB;
constexpr size_t WS_FILT  = 4 * MiB;
constexpr size_t WS_FILTC = 20 * MiB;
constexpr size_t WS_WIN   = 24 * MiB;
constexpr size_t WS_WOUT  = 56 * MiB;
constexpr size_t WS_WGU   = 64 * MiB;
constexpr size_t WS_WDN   = 576 * MiB;
constexpr size_t WS_H     = 832 * MiB;
constexpr size_t WS_N     = 904 * MiB;
constexpr size_t WS_P     = 940 * MiB;
constexpr size_t WS_RW    = 1228 * MiB;
constexpr size_t WS_RWBON = 1408 * MiB;
constexpr size_t WS_GQKV  = 1410 * MiB;
constexpr size_t WS_GBG   = 1518 * MiB;
constexpr size_t WS_VVT   = 1520 * MiB;
constexpr size_t WS_YT    = 1540 * MiB;
constexpr size_t WS_RWO   = 1560 * MiB;
constexpr size_t WS_GDO   = 1596 * MiB;
constexpr size_t WS_GPRE  = 1668 * MiB;
constexpr size_t WS_YCAT  = 1884 * MiB;
constexpr size_t WS_STOK  = 1920 * MiB;
constexpr size_t WS_TOKE  = 1924 * MiB;
constexpr size_t WS_ACT   = 1928 * MiB;
constexpr size_t WS_YB    = 2088 * MiB;
constexpr size_t WS_END   = 2248 * MiB;

constexpr int CW_BAR = 4096;
constexpr int CW_CNT = 16384;

constexpr int LDS_BYTES = 155648;
constexpr int MISC_OFF  = 153600;
constexpr int SCR_BYTES = 153600;

__device__ __forceinline__ unsigned f2bf(float f) { unsigned u = __builtin_bit_cast(unsigned, f); return (u + 0x7fffu + ((u >> 16) & 1u)) >> 16; }
__device__ __forceinline__ unsigned pk2(float lo, float hi) { return f2bf(lo) | (f2bf(hi) << 16); }
__device__ __forceinline__ float bf2f(unsigned short b) { return __builtin_bit_cast(float, ((unsigned)b) << 16); }
__device__ __forceinline__ float wave_sum(float v) {
#pragma unroll
    for (int o = 1; o < 64; o <<= 1) v += __shfl_xor(v, o);
    return v;
}
__device__ __forceinline__ float sigmoidf_(float x) { return 1.0f / (1.0f + __expf(-x)); }
__device__ __forceinline__ float siluf_(float x) { return x / (1.0f + __expf(-x)); }
__device__ __forceinline__ float softplusf_(float x) { return x > 20.f ? x : log1pf(__expf(x)); }
template <int CTRL> __device__ __forceinline__ float dppf(float x) {
    return __builtin_bit_cast(float, __builtin_amdgcn_update_dpp(0, __builtin_bit_cast(int, x), CTRL, 0xF, 0xF, true));
}
__device__ __forceinline__ float row16_sum(float x) {
    x += dppf<0xB1>(x);
    x += dppf<0x4E>(x);
    x += dppf<0x141>(x);
    x += dppf<0x140>(x);
    return x;
}

__device__ __forceinline__ int launder_int(int x) { asm volatile("" : "+v"(x)); return __builtin_amdgcn_readfirstlane(x); }
template <class T> __device__ __forceinline__ T* launder_ptr(T* p) {
    unsigned long long u = (unsigned long long)p; unsigned lo = (unsigned)u, hi = (unsigned)(u >> 32);
    asm volatile("" : "+v"(lo), "+v"(hi));
    lo = __builtin_amdgcn_readfirstlane(lo); hi = __builtin_amdgcn_readfirstlane(hi);
    return (T*)(((unsigned long long)hi << 32) | lo);
}

#define XB_TMO      128
#define XB_XCNT(j)  (256  + 64 * (j))
#define XB_XSUB(j)  (1280 + 64 * (j))
#define XB_XGEN(j)  (2304 + 64 * (j))
#define XB_TOP      3328
#define XB_TOPGEN   3392
#define XCD_BAR_WORDS 3456
#define XB_SPIN_CAP (1u << 24)

__device__ __forceinline__ unsigned xb_ld(unsigned* p)              { return __hip_atomic_load(p, __ATOMIC_RELAXED, __HIP_MEMORY_SCOPE_AGENT); }
__device__ __forceinline__ unsigned xb_add(unsigned* p, unsigned v) { return __hip_atomic_fetch_add(p, v, __ATOMIC_RELAXED, __HIP_MEMORY_SCOPE_AGENT); }
__device__ __forceinline__ unsigned xb_xcc_id() { return (unsigned)__builtin_amdgcn_s_getreg((3 << 11) | 20) & 0xFu; }
#define XB_SPIN(cond, bar) do { unsigned _sp = 0; while (cond) { __builtin_amdgcn_s_sleep(1); \
    if ((++_sp & 255u) == 0u) { if (xb_ld(&(bar)[XB_TMO])) break; if (_sp > XB_SPIN_CAP) { atomicAdd(&(bar)[XB_TMO], 1u); break; } } } } while (0)

struct XcdBarrier { unsigned* bar; unsigned x; volatile LAS unsigned* st; };

__device__ __forceinline__ XcdBarrier xcd_barrier_post(unsigned* bar, volatile LAS unsigned* st) {
    XcdBarrier b; b.bar = bar; b.x = xb_xcc_id(); b.st = st;
    if (threadIdx.x == 0) (void)xb_add(&bar[XB_XCNT(b.x)], 1u);
    return b;
}
__device__ __forceinline__ void xcd_barrier_complete(unsigned* bar, unsigned x, unsigned& nloc, unsigned& nx) {
    const unsigned G = gridDim.x * gridDim.y * gridDim.z;
    unsigned sum, cnt, mine, sp = 0u;
    for (;;) {
        sum = 0u; cnt = 0u; mine = 0u;
#pragma unroll
        for (unsigned j = 0; j < 16; ++j) { const unsigned c = xb_ld(&bar[XB_XCNT(j)]); sum += c; cnt += (c > 0u) ? 1u : 0u; mine = (j == x) ? c : mine; }
        if (sum == G) break;
        __builtin_amdgcn_s_sleep(1);
        if ((++sp & 255u) == 0u) { if (xb_ld(&bar[XB_TMO])) break; if (sp > XB_SPIN_CAP) { atomicAdd(&bar[XB_TMO], 1u); break; } }
    }
    nloc = mine > 0u ? mine : 1u; nx = cnt > 0u ? cnt : 1u;
}
__device__ __forceinline__ void xcd_barrier(const XcdBarrier& b) {
    asm volatile("s_waitcnt vmcnt(0)" ::: "memory");
    __syncthreads();
    if (threadIdx.x == 0) {
        unsigned* bar = b.bar;
        __builtin_amdgcn_s_waitcnt(0);
        unsigned nloc = b.st[0], nx = b.st[1];
        if (nloc == 0u) { xcd_barrier_complete(bar, b.x, nloc, nx); b.st[0] = nloc; b.st[1] = nx; }
        const unsigned old = xb_add(&bar[XB_XSUB(b.x)], 1u);
        const unsigned gen = old / nloc;
        if (old + 1u == (gen + 1u) * nloc) {
            __builtin_amdgcn_fence(__ATOMIC_RELEASE, "agent");
            asm volatile("s_waitcnt vmcnt(0)" ::: "memory");
            const unsigned og = xb_add(&bar[XB_TOP], 1u);
            const unsigned tg = og / nx;
            if (og + 1u == (tg + 1u) * nx) xb_add(&bar[XB_TOPGEN], 1u);
            else XB_SPIN(xb_ld(&bar[XB_TOPGEN]) == tg, bar);
            __builtin_amdgcn_fence(__ATOMIC_ACQUIRE, "agent");
            xb_add(&bar[XB_XGEN(b.x)], 1u);
            asm volatile("s_waitcnt vmcnt(0)" ::: "memory");
        } else {
            XB_SPIN(xb_ld(&bar[XB_XGEN(b.x)]) == gen, bar);
            __builtin_amdgcn_fence(__ATOMIC_ACQUIRE, "agent");
            asm volatile("s_waitcnt vmcnt(0)" ::: "memory");
        }
    }
    __syncthreads();
}

namespace pg8 {
constexpr int BM = 256, BK = 64, HALF = 128, HTB = HALF * BK * 2, STAGE_BYTES = 8 * HTB, NXCD = 8, WGM = 8;
__host__ __device__ __forceinline__ int lds_byte(int r, int c) { const int st = (r >> 4) * 2 + (c >> 5), rr = r & 15, cc = c & 31, ob = rr * 64 + cc * 2; return st * 1024 + (ob ^ (((ob >> 9) & 1) << 5)); }
__host__ __device__ __forceinline__ void stage_rc(int b, int& R, int& C) { const int st = b / 1024, sb = b % 1024, swz = sb ^ (((sb >> 9) & 1) << 5); R = (st >> 1) * 16 + swz / 64; C = (st & 1) * 32 + (swz % 64) / 2; }
__host__ __device__ __forceinline__ int perm32(int rho) { const int n = rho >> 4, i = rho & 15; return 8 * (i >> 2) + 4 * n + (i & 3); }

struct Unit { int pm, pn, e, j, rows; };

struct StaticOrder {
    static constexpr bool GATHER = false;
    const bf16_t* A; const bf16_t* Bt; int K;
    int nM, nN, nwg, G, c;
    __device__ void init(const bf16_t* A_, const bf16_t* Bt_, int M, int N, int K_, int G_, int c_) { A = A_; Bt = Bt_; K = K_; nM = M / BM; nN = N / BM; nwg = nM * nN; G = G_; c = c_; }
    __device__ bool next(int i, Unit& u) const {
        const long L = (long)i * G + c; if (L >= nwg) return false;
        int wgid = (int)L; { const int q = nwg / NXCD, r = nwg % NXCD, xcd = wgid % NXCD, off = wgid / NXCD; wgid = (xcd < r ? xcd * (q + 1) : r * (q + 1) + (xcd - r) * q) + off; }
        const int nig = WGM * nN, gid = wgid / nig, fm = gid * WGM, gsz = (nM - fm) < WGM ? (nM - fm) : WGM;
        u.pm = fm + ((wgid % nig) % gsz); u.pn = (wgid % nig) / gsz; u.e = 0; u.j = 0; u.rows = BM; return true;
    }
    __device__ __forceinline__ const char* a_base(const Unit& u) const { return (const char*)A + (size_t)u.pm * (size_t)(2 * HALF) * K * 2; }
    __device__ __forceinline__ const char* b_base(const Unit& u) const { return (const char*)Bt + (size_t)u.pn * (size_t)(2 * HALF) * K * 2; }
    __device__ __forceinline__ unsigned gather_row(const Unit&, int) const { return 0u; }
};
template <bool GATHER_, int NPN> struct MoeOrder {
    static constexpr bool GATHER = GATHER_;
    const bf16_t* A; const bf16_t* Bt; int K, Nexp;
    const LAS int* pref;
    const int* stok;
    int G, c;
    __device__ bool next(int i, Unit& u) const {
        const int L = i * G + c; const int nU = __builtin_amdgcn_readfirstlane(pref[32]) * NPN; if (L >= nU) return false;
        const int rb = L / NPN; u.pn = L % NPN; int e = 0;
        for (int q = 1; q < 32; ++q) e = (__builtin_amdgcn_readfirstlane(pref[q]) <= rb) ? q : e;
        u.e = e; u.pm = rb; u.j = rb - __builtin_amdgcn_readfirstlane(pref[e]); const int rem = __builtin_amdgcn_readfirstlane(pref[64 + e]) - u.j * BM; u.rows = rem < BM ? rem : BM; return true;
    }
    __device__ __forceinline__ const char* a_base(const Unit& u) const { return GATHER ? (const char*)A : (const char*)A + (size_t)u.pm * (size_t)(2 * HALF) * K * 2; }
    __device__ __forceinline__ const char* b_base(const Unit& u) const { return (const char*)Bt + ((size_t)u.e * Nexp + (size_t)u.pn * BM) * K * 2; }
    __device__ __forceinline__ unsigned gather_row(const Unit& u, int r) const { return (r < u.rows) ? (unsigned)stok[(size_t)u.e * M_ALL + u.j * BM + r] : 0u; }
};

__device__ __forceinline__ unsigned cvt_pk_bf16(float lo, float hi) { unsigned r; asm volatile("v_cvt_pk_bf16_f32 %0, %1, %2" : "=v"(r) : "v"(lo), "v"(hi)); return r; }

struct EpiF32 {
    static constexpr bool PERM = false;
    float* C; int ldc;
    __device__ __forceinline__ void operator()(const f32x4 (&acc)[2][2][4][2], const Unit& u, int wr, int wc, int fr, int fq) const {
        const int row0 = u.pm * BM + wr * 64 + fr, col0 = u.pn * BM + wc * 32 + 4 * fq;
#pragma unroll
        for (int ai = 0; ai < 2; ++ai)
#pragma unroll
            for (int m = 0; m < 4; ++m) { float* rowp = C + (size_t)(row0 + ai * HALF + m * 16) * ldc + col0;
#pragma unroll
                for (int bj = 0; bj < 2; ++bj)
#pragma unroll
                    for (int n = 0; n < 2; ++n) *(f32x4*)(rowp + bj * HALF + n * 16) = acc[ai][bj][m][n]; }
    }
};
struct EpiRes {
    static constexpr bool PERM = false;
    const float* base; float* out; const float* gate; int row0g;
    __device__ __forceinline__ void operator()(const f32x4 (&acc)[2][2][4][2], const Unit& u, int wr, int wc, int fr, int fq) const {
        const int row0 = u.pm * BM + wr * 64 + fr, col0 = u.pn * BM + wc * 32 + 4 * fq;
        const int grow = row0g + u.pm * BM; const int r = grow < M_CTX ? 8 : (grow - M_CTX) / SEQ;
        f32x4 gv[2][2];
#pragma unroll
        for (int bj = 0; bj < 2; ++bj)
#pragma unroll
            for (int n = 0; n < 2; ++n) gv[bj][n] = *(const f32x4*)(gate + (size_t)r * (NMOD * D) + col0 + bj * HALF + n * 16);
#pragma unroll
        for (int ai = 0; ai < 2; ++ai)
#pragma unroll
            for (int m = 0; m < 4; ++m) { const size_t off = (size_t)(row0 + ai * HALF + m * 16) * D + col0;
#pragma unroll
                for (int bj = 0; bj < 2; ++bj)
#pragma unroll
                    for (int n = 0; n < 2; ++n) { const f32x4 b = *(const f32x4*)(base + off + bj * HALF + n * 16);
                        *(f32x4*)(out + off + bj * HALF + n * 16) = b + gv[bj][n] * acc[ai][bj][m][n]; } }
    }
};
struct EpiGU {
    static constexpr bool PERM = true;
    bf16_t* O; const float* bias;
    __device__ __forceinline__ void operator()(const f32x4 (&acc)[2][2][4][2], const Unit& u, int wr, int wc, int fr, int fq) const {
        const int row0 = u.pm * BM + wr * 64 + fr, col0 = u.pn * HALF + wc * 32 + 8 * fq;
        const float* bp = bias + (size_t)u.e * 2048 + col0;
        f32x4 bg[2], bu[2];
#pragma unroll
        for (int n = 0; n < 2; ++n) { bg[n] = *(const f32x4*)(bp + 4 * n); bu[n] = *(const f32x4*)(bp + 1024 + 4 * n); }
#pragma unroll
        for (int ai = 0; ai < 2; ++ai)
#pragma unroll
            for (int m = 0; m < 4; ++m) { bf16_t* rowp = O + (size_t)(row0 + ai * HALF + m * 16) * FF + col0;
                float o[8];
#pragma unroll
                for (int n = 0; n < 2; ++n)
#pragma unroll
                    for (int i = 0; i < 4; ++i) { float g = acc[ai][0][m][n][i] + bg[n][i], up = acc[ai][1][m][n][i] + bu[n][i];
                        g = fminf(g, 7.0f); up = fminf(fmaxf(up, -7.0f), 7.0f);
                        const float glu = g / (1.0f + __expf(-1.702f * g)); o[n * 4 + i] = (up + 1.0f) * glu; }
                u32x4 w; w.x = cvt_pk_bf16(o[0], o[1]); w.y = cvt_pk_bf16(o[2], o[3]); w.z = cvt_pk_bf16(o[4], o[5]); w.w = cvt_pk_bf16(o[6], o[7]);
                *(u32x4*)rowp = w; }
    }
};
struct EpiDN {
    static constexpr bool PERM = true;
    bf16_t* O; const float* bias;
    __device__ __forceinline__ void operator()(const f32x4 (&acc)[2][2][4][2], const Unit& u, int wr, int wc, int fr, int fq) const {
        const int row0 = u.pm * BM + wr * 64 + fr, col0 = u.pn * BM + wc * 32 + 8 * fq;
        const float* bp = bias + (size_t)u.e * 1024 + col0;
        f32x4 bv[2][2];
#pragma unroll
        for (int bj = 0; bj < 2; ++bj)
#pragma unroll
            for (int n = 0; n < 2; ++n) bv[bj][n] = *(const f32x4*)(bp + bj * HALF + 4 * n);
#pragma unroll
        for (int ai = 0; ai < 2; ++ai)
#pragma unroll
            for (int m = 0; m < 4; ++m) { bf16_t* rowp = O + (size_t)(row0 + ai * HALF + m * 16) * D + col0;
#pragma unroll
                for (int bj = 0; bj < 2; ++bj) { const f32x4 v0 = acc[ai][bj][m][0] + bv[bj][0], v1 = acc[ai][bj][m][1] + bv[bj][1];
                    u32x4 w; w.x = cvt_pk_bf16(v0[0], v0[1]); w.y = cvt_pk_bf16(v0[2], v0[3]); w.z = cvt_pk_bf16(v1[0], v1[1]); w.w = cvt_pk_bf16(v1[2], v1[3]);
                    *(u32x4*)(rowp + bj * HALF) = w; } }
    }
};

template <class Epi, class Sched>
__device__ __forceinline__ void gemm_phase(LAS unsigned char* lds, const Sched& S, const Epi& E, const int tid) {
    constexpr bool GATHER = Sched::GATHER;
    const int wid = __builtin_amdgcn_readfirstlane(tid >> 6), lane = tid & 63, wr = wid >> 2, wc = wid & 3, fr = lane & 15, fq = lane >> 4;
    const int K = S.K, nt = K / BK;
    unsigned voffA[2], voffB[2]; int RA[2], CA[2];
#pragma unroll
    for (int i = 0; i < 2; ++i) { int R, C; stage_rc(tid * 16 + i * 8192, R, C); const int Rb = Epi::PERM ? ((R & ~31) + perm32(R & 31)) : R;
        RA[i] = R; CA[i] = C; voffA[i] = (unsigned)(R * K + C) * 2u; voffB[i] = (unsigned)(Rb * K + C) * 2u; }
    const size_t kstep = (size_t)(BK * 2);
    const size_t hstep = (size_t)HALF * K * 2;
    const unsigned ldsw = (unsigned)wid * 1024u;
    const int aoff = lds_byte(wr * 64 + fr, fq * 8), boff = lds_byte(wc * 32 + fr, fq * 8);
#define PG8_SA(b, h) (((b) * 2 + (h)) * HTB)
#define PG8_SB(b, h) ((4 + (b) * 2 + (h)) * HTB)
#define PG8_STAGE(bufoff, gbase, voff) do { _Pragma("unroll") for (int _i = 0; _i < 2; ++_i) \
        __builtin_amdgcn_global_load_lds((const unsigned*)((const char*)(gbase) + (voff)[_i]), (LAS unsigned*)(lds + (bufoff) + ldsw + _i * 8192), 16, 0, 0); } while (0)
#define PG8_STAGE2(bufoff, gbase, v0, v1) do { \
        __builtin_amdgcn_global_load_lds((const unsigned*)((const char*)(gbase) + (v0)), (LAS unsigned*)(lds + (bufoff) + ldsw), 16, 0, 0); \
        __builtin_amdgcn_global_load_lds((const unsigned*)((const char*)(gbase) + (v1)), (LAS unsigned*)(lds + (bufoff) + ldsw + 8192), 16, 0, 0); } while (0)
#define PG8_LDA(dst, b, h) do { _Pragma("unroll") for (int m = 0; m < 4; ++m) _Pragma("unroll") for (int k = 0; k < 2; ++k) dst[m][k] = *(const LAS bf16x8*)(lds + PG8_SA(b, h) + aoff + m * 2048 + k * 1024); } while (0)
#define PG8_LDB(dst, b, h) do { _Pragma("unroll") for (int n = 0; n < 2; ++n) _Pragma("unroll") for (int k = 0; k < 2; ++k) dst[n][k] = *(const LAS bf16x8*)(lds + PG8_SB(b, h) + boff + n * 2048 + k * 1024); } while (0)
#define PG8_MMA(ai, bj, At, Bt) do { __builtin_amdgcn_s_setprio(1); _Pragma("unroll") for (int m = 0; m < 4; ++m) _Pragma("unroll") for (int n = 0; n < 2; ++n) _Pragma("unroll") for (int k = 0; k < 2; ++k) \
        acc[ai][bj][m][n] = __builtin_amdgcn_mfma_f32_16x16x32_bf16(Bt[n][k], At[m][k], acc[ai][bj][m][n], 0, 0, 0); __builtin_amdgcn_s_setprio(0); } while (0)
#define PG8_WAIT_V(n) asm volatile("s_waitcnt vmcnt(" #n ")" ::: "memory")
#define PG8_WAIT_L(n) asm volatile("s_waitcnt lgkmcnt(" #n ")" ::: "memory")
#define PG8_BAR __builtin_amdgcn_s_barrier()
#define PG8_SCHED __builtin_amdgcn_sched_barrier(0)
    unsigned pc[2] = {0u, 0u}, pn_[2] = {0u, 0u};
    const unsigned R0 = (unsigned)RA[0], C2 = (unsigned)(CA[0] * 2);
#define PG8_PACK(p, u) do { _Pragma("unroll") for (int _h = 0; _h < 2; ++_h) p[_h] = S.gather_row(u, _h * HALF + R0) | (S.gather_row(u, _h * HALF + 64 + R0) << 16); } while (0)
#define PG8_AOFF(p, h, i) (GATHER ? ((((p)[h] >> (16 * (i))) & 0xffffu) * (unsigned)(K * 2) + C2) : ((unsigned)((h) * hstep) + voffA[i]))
#define PG8_STAGEA(bufoff, gbase, p, h) PG8_STAGE2(bufoff, gbase, PG8_AOFF(p, h, 0), PG8_AOFF(p, h, 1))
    Unit cur, nxt; int ui = 0;
    if (!S.next(0, cur)) return;
    f32x4 acc[2][2][4][2];
#pragma unroll
    for (int a = 0; a < 2; ++a)
#pragma unroll
        for (int b = 0; b < 2; ++b)
#pragma unroll
            for (int m = 0; m < 4; ++m)
#pragma unroll
                for (int n = 0; n < 2; ++n) acc[a][b][m][n] = (f32x4){0.f, 0.f, 0.f, 0.f};
    bf16x8 At[4][2], B0[2][2], B1[2][2];
    const char* cA = S.a_base(cur); const char* cB = S.b_base(cur);
    if (GATHER) PG8_PACK(pc, cur);
    PG8_STAGE(PG8_SB(0, 0), cB, voffB); PG8_STAGEA(PG8_SA(0, 0), cA, pc, 0); PG8_STAGE(PG8_SB(0, 1), cB + hstep, voffB); PG8_STAGEA(PG8_SA(0, 1), cA, pc, 1);
    if (wr == 1) PG8_BAR;
    PG8_WAIT_V(4); PG8_BAR;
    PG8_STAGE(PG8_SB(1, 0), cB + kstep, voffB); PG8_STAGEA(PG8_SA(1, 0), cA + kstep, pc, 0); PG8_STAGE(PG8_SB(1, 1), cB + hstep + kstep, voffB);
    PG8_WAIT_V(6); PG8_BAR;
    for (;;) {
        const bool has_next = S.next(ui + 1, nxt);
        const char* nA = has_next ? S.a_base(nxt) : cA; const char* nB = has_next ? S.b_base(nxt) : cB;
        if (GATHER) { if (has_next) { PG8_PACK(pn_, nxt); } else { pn_[0] = pc[0]; pn_[1] = pc[1]; } }
        for (int t = 0; t < nt; t += 2) {
            const bool last = (t == nt - 2);
            const char* a1 = cA + (size_t)(t + 1) * kstep;
            const char* a2 = last ? nA : cA + (size_t)(t + 2) * kstep; const char* b2 = last ? nB : cB + (size_t)(t + 2) * kstep;
            const char* a3 = a2 + kstep; const char* b3 = b2 + kstep;
            PG8_LDB(B0, 0, 0); PG8_SCHED; PG8_LDA(At, 0, 0); PG8_STAGEA(PG8_SA(1, 1), a1, pc, 1);
            PG8_WAIT_L(8); PG8_BAR; PG8_WAIT_L(0); PG8_MMA(0, 0, At, B0); PG8_BAR; PG8_SCHED;
            PG8_LDB(B1, 0, 1); PG8_STAGE(PG8_SB(0, 0), b2, voffB);
            PG8_BAR; PG8_WAIT_L(0); PG8_MMA(0, 1, At, B1); PG8_BAR;
            PG8_LDA(At, 0, 1); { const unsigned pq[2] = {last ? pn_[0] : pc[0], 0u}; PG8_STAGEA(PG8_SA(0, 0), a2, pq, 0); }
            PG8_BAR; PG8_WAIT_L(0); PG8_MMA(1, 0, At, B0); PG8_BAR; PG8_SCHED;
            PG8_STAGE(PG8_SB(0, 1), b2 + hstep, voffB);
            PG8_WAIT_V(6); PG8_BAR; PG8_MMA(1, 1, At, B1); PG8_BAR;
            PG8_LDB(B0, 1, 0); PG8_SCHED; PG8_LDA(At, 1, 0); { const unsigned pq[2] = {0u, last ? pn_[1] : pc[1]}; PG8_STAGEA(PG8_SA(0, 1), a2, pq, 1); }
            PG8_WAIT_L(8); PG8_BAR; PG8_WAIT_L(0); PG8_MMA(0, 0, At, B0); PG8_BAR; PG8_SCHED;
            PG8_LDB(B1, 1, 1); PG8_STAGE(PG8_SB(1, 0), b3, voffB);
            PG8_BAR; PG8_WAIT_L(0); PG8_MMA(0, 1, At, B1); PG8_BAR;
            PG8_LDA(At, 1, 1); { const unsigned pq[2] = {last ? pn_[0] : pc[0], 0u}; PG8_STAGEA(PG8_SA(1, 0), a3, pq, 0); }
            PG8_BAR; PG8_WAIT_L(0); PG8_MMA(1, 0, At, B0); PG8_BAR; PG8_SCHED;
            PG8_STAGE(PG8_SB(1, 1), b3 + hstep, voffB);
            PG8_WAIT_V(6); PG8_BAR; PG8_MMA(1, 1, At, B1); PG8_BAR;
        }
        E(acc, cur, wr, wc, fr, fq);
        if (!has_next) break;
#pragma unroll
        for (int a = 0; a < 2; ++a)
#pragma unroll
            for (int b = 0; b < 2; ++b)
#pragma unroll
                for (int m = 0; m < 4; ++m)
#pragma unroll
                    for (int n = 0; n < 2; ++n) acc[a][b][m][n] = (f32x4){0.f, 0.f, 0.f, 0.f};
        cur = nxt; cA = nA; cB = nB; ++ui; pc[0] = pn_[0]; pc[1] = pn_[1];
    }
    PG8_WAIT_V(0);
    if (wr == 0) PG8_BAR;
    PG8_BAR;
#undef PG8_SA
#undef PG8_SB
#undef PG8_STAGE
#undef PG8_STAGE2
#undef PG8_LDA
#undef PG8_LDB
#undef PG8_MMA
#undef PG8_WAIT_V
#undef PG8_WAIT_L
#undef PG8_BAR
#undef PG8_SCHED
#undef PG8_PACK
#undef PG8_AOFF
#undef PG8_STAGEA
}
}

struct Args { const float* in[43]; float* out; unsigned char* ws; int ph_lo, ph_hi; };
enum { I_X = 0, I_C, I_CTX, I_CCTX, I_ADAW, I_ADAB, I_NMIX, I_NFFN, I_NFIN, I_WIN, I_WOUT, I_HSW, I_HSB, I_HW1, I_HB1, I_HW2, I_HB2, I_HW3, I_HB3, I_HW4,
       I_HFREQ, I_HSKIP, I_RMU, I_RW0, I_RW2, I_RA0, I_RA2, I_RG2, I_RKK, I_RKA, I_RRK, I_RGNW, I_RGNB, I_GCONV, I_GALOG, I_GDT, I_GNW,
       I_MRW, I_MRB, I_MWGU, I_MBGU, I_MWDN, I_MBDN };

struct Frame {
    LAS unsigned char* lds;
    int tid, lane, wave, G, bid;
    const float* const* in;
    unsigned char* ws;
    float* out;
};
#define WSP(T, off) ((T*)(F.ws + (off)))
#define LDS_WAIT() asm volatile("s_waitcnt lgkmcnt(0)" ::: "memory")

__device__ __forceinline__ int row_batch(int row) { return row < M_CTX ? row / CTX : (row - M_CTX) / SEQ; }
__device__ __forceinline__ int row_modr(int row) { return row < M_CTX ? 8 : (row - M_CTX) / SEQ; }

__device__ __forceinline__ void p0_transpose_item(const float* W, int K, int N, bf16_t* WT, int k0, int n0, int drow0, LAS float* scr, int lane) {
#pragma unroll 8
    for (int i = 0; i < 32; ++i) { const int kk = 2 * i + (lane >> 5); const int n = n0 + (lane & 31);
        scr[kk * 33 + (lane & 31)] = (n < N) ? W[(size_t)(k0 + kk) * N + n] : 0.f; }
    LDS_WAIT(); asm volatile("" ::: "memory");
    const int c = lane & 7;
#pragma unroll
    for (int j = 0; j < 4; ++j) { const int n = (lane >> 3) + 8 * j; const LAS float* s = scr + (8 * c) * 33 + n;
        u32x4 o; o.x = pk2(s[0 * 33], s[1 * 33]); o.y = pk2(s[2 * 33], s[3 * 33]); o.z = pk2(s[4 * 33], s[5 * 33]); o.w = pk2(s[6 * 33], s[7 * 33]);
        *(u32x4*)(WT + (size_t)(drow0 + n) * K + k0 + 8 * c) = o; }
    LDS_WAIT(); asm volatile("" ::: "memory");
}

__device__ __forceinline__ void phase_prologue(Frame& F) {
    const int gw = F.bid * NWV + F.wave, NGW = F.G * NWV;
    {
        LAS float* scr = (LAS float*)(F.lds + F.wave * 16384);
        constexpr int I_IN = 16 * 128, I_OUT = 16 * 32, I_GU = 16 * 64, I_DN = 16 * 32;
        constexpr int T_IN = DEPTH * I_IN, T_OUT = DEPTH * I_OUT, T_GU = DEPTH * NE * I_GU, T_DN = DEPTH * NE * I_DN;
        for (int it = gw; it < T_IN + T_OUT + T_GU + T_DN; it += NGW) {
            int r = it;
            if (r < T_IN) { const int l = r / I_IN, q = r % I_IN, kb = q / 128, nb = q % 128;
                p0_transpose_item(F.in[I_WIN] + (size_t)l * D * IN_COLS, D, IN_COLS, WSP(bf16_t, WS_WIN) + (size_t)l * PW * D, kb * 64, nb * 32, nb * 32, scr, F.lane); continue; }
            r -= T_IN;
            if (r < T_OUT) { const int l = r / I_OUT, q = r % I_OUT, kb = q / 32, nb = q % 32;
                p0_transpose_item(F.in[I_WOUT] + (size_t)l * D * D, D, D, WSP(bf16_t, WS_WOUT) + (size_t)l * D * D, kb * 64, nb * 32, nb * 32, scr, F.lane); continue; }
            r -= T_OUT;
            if (r < T_GU) { const int le = r / I_GU, q = r % I_GU, kb = q / 64, nb = q % 64; const int n0 = nb * 32;
                const int j = n0 & 1023, drow = 256 * (j >> 7) + (n0 >= 1024 ? 128 : 0) + (j & 127);
                p0_transpose_item(F.in[I_MWGU] + (size_t)le * D * 2048, D, 2048, WSP(bf16_t, WS_WGU) + (size_t)le * 2048 * D, kb * 64, n0, drow, scr, F.lane); continue; }
            r -= T_GU;
            { const int le = r / I_DN, q = r % I_DN, kb = q / 32, nb = q % 32;
                p0_transpose_item(F.in[I_MWDN] + (size_t)le * FF * D, FF, D, WSP(bf16_t, WS_WDN) + (size_t)le * D * FF, kb * 64, nb * 32, nb * 32, scr, F.lane); }
        }
    }
    __syncthreads();
    {
        LAS float* sl = (LAS float*)F.lds;
        LAS float* red = sl + 9 * 1024;
        for (int i = F.tid; i < 9 * 1024; i += NT) { const float v = (i < 8 * 1024) ? F.in[I_C][i] : F.in[I_CCTX][i - 8 * 1024]; sl[i] = siluf_(v); }
        __syncthreads();
        float* mods = WSP(float, WS_MODS);
        const int kh = F.lane >> 5, cl = F.lane & 31;
        for (int it = F.bid; it < DEPTH * (NMOD * D / 32); it += F.G) {
            const int l = it / (NMOD * D / 32), nb = it % (NMOD * D / 32);
            const float* W = F.in[I_ADAW] + (size_t)l * D * (NMOD * D) + nb * 32 + cl;
            float a[9];
#pragma unroll
            for (int r = 0; r < 9; ++r) a[r] = 0.f;
            const int kbase = F.wave * 128 + kh * 64;
#pragma unroll 8
            for (int k = 0; k < 64; ++k) { const float w = W[(size_t)(kbase + k) * (NMOD * D)];
#pragma unroll
                for (int r = 0; r < 9; ++r) a[r] += sl[r * 1024 + kbase + k] * w; }
#pragma unroll
            for (int r = 0; r < 9; ++r) red[((F.wave * 2 + kh) * 9 + r) * 32 + cl] = a[r];
            __syncthreads();
            if (F.tid < 9 * 32) { const int r = F.tid / 32, cc = F.tid % 32; float s = 0.f;
#pragma unroll
                for (int p = 0; p < 16; ++p) s += red[(p * 9 + r) * 32 + cc];
                mods[((size_t)l * 9 + r) * (NMOD * D) + nb * 32 + cc] = s + F.in[I_ADAB][(size_t)l * (NMOD * D) + nb * 32 + cc]; }
            __syncthreads();
        }
    }
    __syncthreads();
    {
        LAS float* hb = (LAS float*)F.lds;
        LAS float* hx = hb + 32 * 512 + F.wave * 64;
        constexpr int NB_LAT = SEQ / 32, NB_CTX = CTX / 32, NB_L = NB_LAT + NB_CTX;
        for (int it = F.bid; it < DEPTH * NB_L; it += F.G) {
            const int l = it / NB_L, q = it % NB_L; const bool isctx = q >= NB_LAT; const int L = isctx ? CTX : SEQ; const int p0 = (isctx ? q - NB_LAT : q) * 32;
            const float* w1 = F.in[I_HW1] + (size_t)l * 33 * 64; const float* b1 = F.in[I_HB1] + l * 64;
            const float* w2 = F.in[I_HW2] + (size_t)l * 64 * 64; const float* b2 = F.in[I_HB2] + l * 64;
            const float* w3 = F.in[I_HW3] + (size_t)l * 64 * 64; const float* b3 = F.in[I_HB3] + l * 64;
            const float* w4 = F.in[I_HW4] + (size_t)l * 64 * 512; const float fr = F.in[I_HFREQ][l * 64 + F.lane];
            for (int pp = 0; pp < 4; ++pp) {
                const int pl = F.wave * 4 + pp, p = p0 + pl;
                const float t = (float)p / (float)(L - 1);
                float z = 0.f;
                if (F.lane == 0) z = t;
                else if (F.lane < 33) { const int bi = (F.lane - 1) & 15; const float band = 1e-4f + (float)bi * ((15.0f - 1e-4f) / 15.0f);
                    const float ang = (6.283185307179586f / (float)L) * (float)p * band; z = (F.lane <= 16) ? cosf(ang) : -sinf(ang); }
                hx[F.lane] = z; LDS_WAIT();
                float a = b1[F.lane];
                for (int i = 0; i < 33; ++i) a += hx[i] * w1[i * 64 + F.lane];
                float h1 = sinf(fr * a); LDS_WAIT(); hx[F.lane] = h1; LDS_WAIT();
                a = b2[F.lane];
                for (int i = 0; i < 64; ++i) a += hx[i] * w2[i * 64 + F.lane];
                float h2 = sinf(fr * a); LDS_WAIT(); hx[F.lane] = h2; LDS_WAIT();
                a = b3[F.lane];
                for (int i = 0; i < 64; ++i) a += hx[i] * w3[i * 64 + F.lane];
                float h3 = sinf(fr * a); LDS_WAIT(); hx[F.lane] = h3; LDS_WAIT();
                float o[8];
#pragma unroll
                for (int j = 0; j < 8; ++j) o[j] = 0.f;
                for (int i = 0; i < 64; ++i) { const float hv = hx[i];
#pragma unroll
                    for (int j = 0; j < 8; ++j) o[j] += hv * w4[i * 512 + j * 64 + F.lane]; }
#pragma unroll
                for (int j = 0; j < 8; ++j) { const int n = j * 64 + F.lane; const int ch = n & 255;
                    const float dl = -3.0701134573253946f + (float)ch * ((-15.350567286626973f + 3.0701134573253946f) / 255.0f);
                    hb[pl * 512 + n] = o[j] * __expf(-t * fabsf(dl)); }
                LDS_WAIT();
            }
            __syncthreads();
            float* filt = isctx ? WSP(float, WS_FILTC) + (size_t)l * 256 * (2 * CTX) : WSP(float, WS_FILT) + (size_t)l * 256 * (2 * SEQ);
            for (int i = F.tid; i < 512 * 32; i += NT) { const int n = i >> 5, pl = i & 31, p = p0 + pl, ch = n & 255; const float v = hb[pl * 512 + n];
                if (n < 256) filt[(size_t)ch * (2 * L) + L + p] = v + (p == 0 ? F.in[I_HSKIP][l * 256 + ch] : 0.f);
                else if (p >= 1) filt[(size_t)ch * (2 * L) + L - p] = v;
                if (n >= 256 && p == 0) filt[(size_t)ch * (2 * L)] = 0.f; }
            __syncthreads();
        }
    }
}

template <bool TO_LDS>
__device__ __forceinline__ void norm_mod_row(const float* xrow, const float* nw, const float* shift, const float* scale, bf16_t* orow, LAS float* lrow, int lane) {
    f32x4 v[4]; float s = 0.f;
#pragma unroll
    for (int j = 0; j < 4; ++j) { v[j] = *(const f32x4*)(xrow + 4 * lane + 256 * j); s += (v[j].x * v[j].x + v[j].y * v[j].y) + (v[j].z * v[j].z + v[j].w * v[j].w); }
    const float rstd = rsqrtf(wave_sum(s) * (1.f / D) + 1e-6f);
#pragma unroll
    for (int j = 0; j < 4; ++j) { const int c = 4 * lane + 256 * j;
        const f32x4 w = *(const f32x4*)(nw + c), sh = *(const f32x4*)(shift + c), sc = *(const f32x4*)(scale + c);
        const f32x4 o = (v[j] * rstd) * w * (sc + 1.0f) + sh;
        u32x2 p; p.x = pk2(o.x, o.y); p.y = pk2(o.z, o.w);
        *(u32x2*)(orow + c) = p;
        if (TO_LDS) *(LAS f32x4*)(lrow + c) = o; }
}

__device__ __forceinline__ void phase_norm0(Frame& F) {
    const int gw = F.bid * NWV + F.wave, NGW = F.G * NWV;
    const float* mods = WSP(float, WS_MODS);
    bf16_t* N = WSP(bf16_t, WS_N);
    for (int row = gw; row < M_ALL; row += NGW) {
        const float* src = row < M_CTX ? F.in[I_CTX] + (size_t)row * D : F.in[I_X] + (size_t)(row - M_CTX) * D;
        const float* mr = mods + (size_t)row_modr(row) * (NMOD * D);
        norm_mod_row<false>(src, F.in[I_NMIX], mr, mr + D, N + (size_t)row * D, (LAS float*)F.lds, F.lane);
        float* hrow = WSP(float, WS_H) + (size_t)row * D;
#pragma unroll
        for (int j = 0; j < 4; ++j) *(f32x4*)(hrow + 4 * F.lane + 256 * j) = *(const f32x4*)(src + 4 * F.lane + 256 * j);
    }
}

__device__ __forceinline__ void prep_hyena(Frame& F, int l, bool with_ctx_hy) {
    const float* P = WSP(float, WS_P);
    float* VVT = WSP(float, WS_VVT);
    const float* sw = F.in[I_HSW] + (size_t)l * 3 * 768; const float* sb = F.in[I_HSB] + (size_t)l * 768;
    LAS float* tile = (LAS float*)F.lds;
    const int nun = M_ALL / 64;
    for (int u = F.bid; u < nun; u += F.G) {
        const int row0 = u * 64; const bool isctx = row0 < M_CTX; if (isctx && !with_ctx_hy) continue;
        const int L = isctx ? CTX : SEQ; const int b = row_batch(row0); const int t0 = isctx ? row0 - b * CTX : row0 - M_CTX - b * SEQ;
        const int c = F.tid & 255, th = F.tid >> 8;
        const float w1a = sw[0 * 768 + 256 + c], w1b = sw[1 * 768 + 256 + c], w1c = sw[2 * 768 + 256 + c], b1 = sb[256 + c];
        const float wva = sw[0 * 768 + 512 + c], wvb = sw[1 * 768 + 512 + c], wvc = sw[2 * 768 + 512 + c], bv = sb[512 + c];
        for (int tt = 0; tt < 32; ++tt) { const int tl = th * 32 + tt, t = t0 + tl; const float* pr = P + (size_t)(row0 + tl) * PW;
            float x1 = b1 + w1b * pr[256 + c], vv = bv + wvb * pr[512 + c];
            if (t > 0) { x1 += w1a * pr[-PW + 256 + c]; vv += wva * pr[-PW + 512 + c]; }
            if (t < L - 1) { x1 += w1c * pr[PW + 256 + c]; vv += wvc * pr[PW + 512 + c]; }
            tile[c * 65 + tl] = x1 * vv; }
        __syncthreads();
        const int pos0 = isctx ? t0 : CTX + t0;
        for (int i = F.tid; i < 256 * 64; i += NT) { const int cc = i >> 6, tl = i & 63;
            VVT[((size_t)cc * NB + b) * (CTX + SEQ) + pos0 + tl] = tile[cc * 65 + tl]; }
        __syncthreads();
    }
}

__device__ __forceinline__ void prep_rwkv(Frame& F, int l) {
    const float* P = WSP(float, WS_P);
    float* RW = WSP(float, WS_RW); float* BON = WSP(float, WS_RWBON);
    const float* mu = F.in[I_RMU] + (size_t)l * RWC;
    const float* w0 = F.in[I_RW0] + (size_t)l * 512; const float* w2 = F.in[I_RW2] + (size_t)l * 2 * 64 * 256;
    const float* a0 = F.in[I_RA0] + (size_t)l * 512; const float* a2 = F.in[I_RA2] + (size_t)l * 2 * 64 * 256;
    const float* g2 = F.in[I_RG2] + (size_t)l * 128 * 256;
    const float* kkw = F.in[I_RKK] + l * 256; const float* kaw = F.in[I_RKA] + l * 256; const float* rkw = F.in[I_RRK] + l * 256;
    LAS float* lin = (LAS float*)(F.lds + F.wave * 12288);
    const int gw = F.bid * NWV + F.wave, NGW = F.G * NWV, lane = F.lane;
    for (int it = gw; it < M_ALL / 8; it += NGW) {
        const int row0 = it * 8; const bool isctx = row0 < M_CTX;
        for (int tk = 0; tk < 8; ++tk) { const int row = row0 + tk; const float* pr = P + (size_t)row * PW + C_RW;
            const int b = row_batch(row); const int t = isctx ? row - b * CTX : row - M_CTX - b * SEQ;
#pragma unroll
            for (int j = 0; j < 6; ++j) { const int cc = 768 + j * 64 + lane;
                float sh = 0.f;
                if (isctx) { if ((cc & 1) == 0) { if (t > 0) sh = pr[-PW + cc]; } else { if (t < CTX - 1) sh = pr[PW + cc]; } }
                else { const int gr = t >> 6, gc = t & 63; const int m4 = cc & 3;
                    if (m4 == 0) { if (gc > 0) sh = pr[-PW + cc]; } else if (m4 == 1) { if (gc < 63) sh = pr[PW + cc]; }
                    else if (m4 == 2) { if (gr > 0) sh = pr[-64 * PW + cc]; } else { if (gr < 31) sh = pr[64 * PW + cc]; } }
                const float p = pr[cc]; const float m = p + mu[cc] * (sh - p);
                const float v = (j < 2) ? tanhf(m) : ((j < 4) ? m : sigmoidf_(m));
                lin[(j * 64 + lane) * 8 + tk] = v; } }
        LDS_WAIT(); asm volatile("" ::: "memory");
        for (int q = 0; q < 4; ++q) { const int c = lane + 64 * q;
            float accw[2][8], acca[2][8], accg[8];
#pragma unroll
            for (int tk = 0; tk < 8; ++tk) { accw[0][tk] = accw[1][tk] = acca[0][tk] = acca[1][tk] = accg[tk] = 0.f; }
            for (int r = 0; r < 64; ++r) {
                const float ww0 = w2[(0 * 64 + r) * 256 + c], ww1 = w2[(1 * 64 + r) * 256 + c], aa0 = a2[(0 * 64 + r) * 256 + c], aa1 = a2[(1 * 64 + r) * 256 + c];
                const float gg0 = g2[r * 256 + c], gg1 = g2[(64 + r) * 256 + c];
                const LAS f32x4* p0 = (const LAS f32x4*)(lin + (0 * 64 + r) * 8); const LAS f32x4* p1 = (const LAS f32x4*)(lin + (64 + r) * 8);
                const LAS f32x4* p2 = (const LAS f32x4*)(lin + (128 + r) * 8); const LAS f32x4* p3 = (const LAS f32x4*)(lin + (192 + r) * 8);
                const LAS f32x4* p4 = (const LAS f32x4*)(lin + (256 + r) * 8); const LAS f32x4* p5 = (const LAS f32x4*)(lin + (320 + r) * 8);
#pragma unroll
                for (int hh = 0; hh < 2; ++hh) { const f32x4 x0 = p0[hh], x1 = p1[hh], x2 = p2[hh], x3 = p3[hh], x4 = p4[hh], x5 = p5[hh];
#pragma unroll
                    for (int e = 0; e < 4; ++e) { const int tk = hh * 4 + e;
                        accw[0][tk] += x0[e] * ww0; accw[1][tk] += x1[e] * ww1; acca[0][tk] += x2[e] * aa0; acca[1][tk] += x3[e] * aa1;
                        accg[tk] += x4[e] * gg0 + x5[e] * gg1; } } }
            const float w00 = w0[c], w01 = w0[256 + c], a00 = a0[c], a01 = a0[256 + c], kkc = kkw[c], kac = kaw[c], rkc = rkw[c];
#pragma unroll
            for (int tk = 0; tk < 8; ++tk) { const int row = row0 + tk; const float* pr = P + (size_t)row * PW + C_RW;
                const int b = row_batch(row); const int t = isctx ? row - b * CTX : row - M_CTX - b * SEQ;
                float mm[3];
#pragma unroll
                for (int s3 = 0; s3 < 3; ++s3) { const int cc = s3 * 256 + c; float sh = 0.f;
                    if (isctx) { if ((cc & 1) == 0) { if (t > 0) sh = pr[-PW + cc]; } else { if (t < CTX - 1) sh = pr[PW + cc]; } }
                    else { const int gr = t >> 6, gc = t & 63; const int m4 = cc & 3;
                        if (m4 == 0) { if (gc > 0) sh = pr[-PW + cc]; } else if (m4 == 1) { if (gc < 63) sh = pr[PW + cc]; }
                        else if (m4 == 2) { if (gr > 0) sh = pr[-64 * PW + cc]; } else { if (gr < 31) sh = pr[64 * PW + cc]; } }
                    const float p = pr[cc]; mm[s3] = p + mu[cc] * (sh - p); }
                const float r_ = mm[0], k_ = mm[1], v_ = mm[2];
                const float kx = k_ * kkc; const float ss = wave_sum(kx * kx); const float kk = kx * rsqrtf(ss + 1e-12f);
                float* o = RW + (size_t)row * 2560;
                o[c] = r_; o[256 + c] = v_; o[512 + c] = kk;
                float bon = 0.f;
#pragma unroll
                for (int d = 0; d < 2; ++d) { const float xw = (d ? w01 : w00) + accw[d][tk];
                    const float lw = -softplusf_(-xw) - 0.5f; const float dec = __expf(-__expf(lw));
                    const float a = sigmoidf_((d ? a01 : a00) + acca[d][tk]);
                    const float kd = k_ * (1.0f + (a - 1.0f) * kac);
                    o[(3 + 3 * d) * 256 + c] = dec; o[(4 + 3 * d) * 256 + c] = kd; o[(5 + 3 * d) * 256 + c] = kk * a;
                    bon += r_ * kd * rkc; }
                o[9 * 256 + c] = accg[tk];
                bon = wave_sum(bon);
                if (lane == 0) BON[(size_t)row * 4 + q] = bon; }
        }
        LDS_WAIT(); asm volatile("" ::: "memory");
    }
}

__device__ __forceinline__ void prep_gdn(Frame& F, int l) {
    const float* P = WSP(float, WS_P);
    float* Q = WSP(float, WS_GQKV); float* BG = WSP(float, WS_GBG);
    const float* cw = F.in[I_GCONV] + (size_t)l * 5 * 1536;
    const int gw = F.bid * NWV + F.wave, NGW = F.G * NWV, lane = F.lane;
    for (int row = gw; row < M_ALL; row += NGW) {
        const bool isctx = row < M_CTX; const int L = isctx ? CTX : SEQ; const int b = row_batch(row); const int t = isctx ? row - b * CTX : row - M_CTX - b * SEQ;
        const float* pr = P + (size_t)row * PW + C_GD; const float* cwl = cw;
        pr = launder_ptr(pr); cwl = launder_ptr(cwl);
        float* o = Q + (size_t)row * 1536;
#pragma unroll
        for (int part = 0; part < 3; ++part) {
            float x[8];
#pragma unroll
            for (int j = 0; j < 8; ++j) { const int c = (part * 8 + j) * 64 + lane; float a = 0.f;
#pragma unroll
                for (int tap = 0; tap < 5; ++tap) { const int tt = t + tap - 2; if (tt >= 0 && tt < L) a += pr[(tap - 2) * PW + c] * cwl[tap * 1536 + c]; }
                x[j] = siluf_(a); }
            if (part < 2) {
#pragma unroll
                for (int h4 = 0; h4 < 4; ++h4) { const float ss = wave_sum(x[2 * h4] * x[2 * h4] + x[2 * h4 + 1] * x[2 * h4 + 1]);
                    const float sc = rsqrtf(ss + 1e-12f) * (part == 0 ? 0.08838834764831845f : 1.0f);
                    x[2 * h4] *= sc; x[2 * h4 + 1] *= sc; } }
#pragma unroll
            for (int j = 0; j < 8; ++j) o[(part * 8 + j) * 64 + lane] = x[j];
            asm volatile("" ::: "memory");
        }
        if (lane < 16) { const float rv = pr[2048 + lane]; float ov;
            if (lane < 8) ov = sigmoidf_(rv);
            else { const int dh = lane - 8; ov = -__expf(F.in[I_GALOG][l * 8 + dh]) * softplusf_(rv + F.in[I_GDT][l * 8 + dh]); }
            BG[(size_t)row * 16 + lane] = ov; }
    }
}

template <class Fin>
__device__ __forceinline__ void mm_lds(const LAS bf16_t* A, int lda, const LAS bf16_t* Bt, int ldb, int M, int N, int K, int wave, int lane, Fin fin) {
    const int tn = N >> 4, ntile = (M >> 4) * tn, fr = lane & 15, fq = lane >> 4;
    for (int tI = wave; tI < ntile; tI += NWV) {
        const int i0 = (tI / tn) << 4, j0 = (tI % tn) << 4;
        f32x4 acc = (f32x4){0.f, 0.f, 0.f, 0.f};
        const LAS bf16_t* ap = A + (i0 + fr) * lda + fq * 8; const LAS bf16_t* bp = Bt + (j0 + fr) * ldb + fq * 8;
        for (int k = 0; k < K; k += 32) { const bf16x8 a = *(const LAS bf16x8*)(ap + k); const bf16x8 b = *(const LAS bf16x8*)(bp + k);
            acc = __builtin_amdgcn_mfma_f32_16x16x32_bf16(a, b, acc, 0, 0, 0); }
#pragma unroll
        for (int r = 0; r < 4; ++r) fin(i0 + fq * 4 + r, j0 + fr, acc[r]);
    }
}

__device__ __forceinline__ int chain_row(int b, int d, int s) {
    if (s < CTX) { const int pos = d ? (CTX - 1 - s) : s; return b * CTX + pos; }
    const int q = s - CTX; const int pos = d ? (SEQ - 1 - q) : q; return M_CTX + b * SEQ + pos;
}
constexpr int NCHUNK = (CTX + SEQ) / 64;
constexpr size_t GREC = 98304;
constexpr int GR_W = 0, GR_QG = 16384, GR_KT = 32768, GR_AT = 49152, GR_U = 57344, GR_EG = 90112;

__device__ __forceinline__ void gdn_precompute(Frame& F) {
    const float* Q = WSP(float, WS_GQKV); const float* BG = WSP(float, WS_GBG);
    LAS bf16_t* kc = (LAS bf16_t*)(F.lds);
    LAS bf16_t* qc = (LAS bf16_t*)(F.lds + 17408);
    LAS bf16_t* vT = (LAS bf16_t*)(F.lds + 34816);
    LAS bf16_t* kT = (LAS bf16_t*)(F.lds + 53248);
    LAS float*  Mf = (LAS float*)(F.lds + 71680);
    LAS bf16_t* T1 = (LAS bf16_t*)(F.lds + 89088);
    LAS bf16_t* T2 = (LAS bf16_t*)(F.lds + 98304);
    LAS float*  gcv = (LAS float*)(F.lds + 107520);
    LAS float*  bet = gcv + 64;
    LAS int*    rws = (LAS int*)(gcv + 128);
    LAS float*  Tf = (LAS float*)(F.lds + 108544);
    const int tid = F.tid, lane = F.lane, wave = F.wave;
    for (int u = F.bid; u < 64 * NCHUNK; u += F.G) {
        const int ci = u / NCHUNK, n = u % NCHUNK; const int b = ci >> 3, h = (ci >> 1) & 3, d = ci & 1;
        unsigned char* rec = F.ws + WS_GPRE + (size_t)u * GREC;
        if (tid < 64) { const int row = chain_row(b, d, n * 64 + tid); rws[tid] = row; bet[tid] = BG[(size_t)row * 16 + d * 4 + h]; gcv[tid] = BG[(size_t)row * 16 + 8 + d * 4 + h]; }
        __syncthreads();
        if (tid == 0) { float a = 0.f; for (int i = 0; i < 64; ++i) { a += gcv[i]; gcv[i] = a; } }
        for (int i = tid; i < 64 * 128; i += NT) { const int r = i >> 7, c = i & 127; const float* src = Q + (size_t)rws[r] * 1536 + h * 128 + c;
            const unsigned short qb = (unsigned short)f2bf(src[0]), kb = (unsigned short)f2bf(src[512]), vb = (unsigned short)f2bf(src[1024]);
            qc[r * 136 + c] = qb; kc[r * 136 + c] = kb; kT[c * 72 + r] = kb; vT[c * 72 + r] = vb; }
        __syncthreads();
        mm_lds(kc, 136, kc, 136, 64, 64, 128, wave, lane, [&](int i, int j, float v) {
            Mf[i * 68 + j] = (j < i) ? bet[i] * v * __expf(gcv[i] - gcv[j]) : 0.f; });
        mm_lds(qc, 136, kc, 136, 64, 64, 128, wave, lane, [&](int i, int j, float v) {
            const float a = (j <= i) ? v * __expf(gcv[i] - gcv[j]) : 0.f; ((bf16_t*)(rec + GR_AT))[i * 64 + j] = (bf16_t)f2bf(a); });
        __syncthreads();
#pragma unroll 1
        for (int I = 0; I < 4; ++I) {
            for (int rr = 0; rr < 2; ++rr) { const int i = 16 * I + (tid >> 6) + 8 * rr, c = tid & 63; float a = 0.f;
                for (int j = 0; j < 16 * I; ++j) a += Mf[i * 68 + j] * Tf[j * 68 + c];
                Tf[i * 68 + c] = -a; }
            __syncthreads();
            if (wave == 0) { float t[16]; const LAS float* mrow = Mf + (16 * I) * 68 + 16 * I; LAS float* trow = Tf + (16 * I) * 68 + lane;
#pragma unroll
                for (int ii = 0; ii < 16; ++ii) { float a = trow[ii * 68] + ((16 * I + ii == lane) ? 1.f : 0.f);
#pragma unroll
                    for (int jj = 0; jj < ii; ++jj) a -= mrow[ii * 68 + jj] * t[jj];
                    t[ii] = a; trow[ii * 68] = a; } }
            __syncthreads();
        }
        for (int i = tid; i < 64 * 64; i += NT) { const int r = i >> 6, c = i & 63; const float tv = Tf[r * 68 + c] * bet[c];
            T1[r * 72 + c] = (bf16_t)f2bf(tv); T2[r * 72 + c] = (bf16_t)f2bf(tv * __expf(gcv[c])); }
        __syncthreads();
        mm_lds(T1, 72, vT, 72, 64, 128, 64, wave, lane, [&](int i, int j, float v) { ((float*)(rec + GR_U))[i * 128 + j] = v; });
        mm_lds(T2, 72, kT, 72, 64, 128, 64, wave, lane, [&](int i, int j, float v) { ((bf16_t*)(rec + GR_W))[i * 128 + j] = (bf16_t)f2bf(v); });
        const float gl = gcv[63];
        for (int i = tid; i < 64 * 128; i += NT) { const int r = i >> 7, c = i & 127;
            ((bf16_t*)(rec + GR_QG))[r * 128 + c] = (bf16_t)f2bf(bf2f(qc[r * 136 + c]) * __expf(gcv[r])); }
        for (int i = tid; i < 128 * 64; i += NT) { const int c = i >> 6, r = i & 63;
            ((bf16_t*)(rec + GR_KT))[c * 64 + r] = (bf16_t)f2bf(bf2f(kT[c * 72 + r]) * __expf(gl - gcv[r])); }
        if (tid == 0) *(float*)(rec + GR_EG) = __expf(gl);
        __syncthreads();
    }
}

__device__ __forceinline__ void gdn_chain_unit(Frame& F, int ci, int vh) {
    LAS float*  Sf = (LAS float*)(F.lds);
    LAS bf16_t* St = (LAS bf16_t*)(F.lds + 34816);
    LAS bf16_t* Wl = (LAS bf16_t*)(F.lds + 52224);
    LAS bf16_t* Ql = (LAS bf16_t*)(F.lds + 69632);
    LAS bf16_t* Al = (LAS bf16_t*)(F.lds + 87040);
    LAS bf16_t* Kl = (LAS bf16_t*)(F.lds + 96256);
    LAS float*  Ul = (LAS float*)(F.lds + 114688);
    LAS bf16_t* Vn = (LAS bf16_t*)(F.lds + 132096);
    const int tid = F.tid, lane = F.lane, wave = F.wave;
    const int b = ci >> 3, h = (ci >> 1) & 3, d = ci & 1;
    float* GO = WSP(float, WS_GDO) + (size_t)d * M_ALL * 512;
    for (int i = tid; i < 128 * 68; i += NT) Sf[i] = 0.f;
    for (int i = tid; i < 64 * 136; i += NT) St[i] = 0;
    __syncthreads();
    for (int n = 0; n < NCHUNK; ++n) {
        const unsigned char* rec = F.ws + WS_GPRE + (size_t)(ci * NCHUNK + n) * GREC;
        for (int i = tid; i < 64 * 16; i += NT) { const int r = i >> 4, c8 = i & 15;
            *(LAS u32x4*)(Wl + r * 136 + c8 * 8) = *(const u32x4*)(rec + GR_W + (r * 128 + c8 * 8) * 2);
            *(LAS u32x4*)(Ql + r * 136 + c8 * 8) = *(const u32x4*)(rec + GR_QG + (r * 128 + c8 * 8) * 2); }
        for (int i = tid; i < 128 * 8; i += NT) { const int r = i >> 3, c8 = i & 7;
            *(LAS u32x4*)(Kl + r * 72 + c8 * 8) = *(const u32x4*)(rec + GR_KT + (r * 64 + c8 * 8) * 2); }
        for (int i = tid; i < 64 * 8; i += NT) { const int r = i >> 3, c8 = i & 7;
            *(LAS u32x4*)(Al + r * 72 + c8 * 8) = *(const u32x4*)(rec + GR_AT + (r * 64 + c8 * 8) * 2); }
        for (int i = tid; i < 64 * 16; i += NT) { const int r = i >> 4, c4 = i & 15;
            *(LAS f32x4*)(Ul + r * 68 + c4 * 4) = *(const f32x4*)(rec + GR_U + (r * 128 + vh * 64 + c4 * 4) * 4); }
        const float eg = *(const float*)(rec + GR_EG);
        __syncthreads();
        mm_lds(Wl, 136, St, 136, 64, 64, 128, wave, lane, [&](int i, int j, float v) { Vn[j * 72 + i] = (bf16_t)f2bf(Ul[i * 68 + j] - v); });
        __syncthreads();
        mm_lds(Ql, 136, St, 136, 64, 64, 128, wave, lane, [&](int i, int j, float v) { Ul[i * 68 + j] = v; });
        mm_lds(Al, 72, Vn, 72, 64, 64, 64, wave, lane, [&](int i, int j, float v) {
            const int row = chain_row(b, d, n * 64 + i); GO[(size_t)row * 512 + h * 128 + vh * 64 + j] = Ul[i * 68 + j] + v; });
        __syncthreads();
        mm_lds(Kl, 72, Vn, 72, 128, 64, 64, wave, lane, [&](int i, int j, float v) {
            const float s = eg * Sf[i * 68 + j] + v; Sf[i * 68 + j] = s; St[j * 136 + i] = (bf16_t)f2bf(s); });
        __syncthreads();
    }
}

__device__ __forceinline__ void rwkv_scan_unit(Frame& F, int ci, int vhalf) {
    constexpr int TB = 32, NBLK = (CTX + SEQ) / TB, PER = 5 * 64 + 32, NLD = TB * PER / NT;
    const float* RW = WSP(float, WS_RW);
    const int tid = F.tid, lane = F.lane, wave = F.wave;
    const int b = ci >> 3, h = (ci >> 1) & 3, d = ci & 1;
    float* RO = WSP(float, WS_RWO) + (size_t)d * M_ALL * 256;
    LAS float* buf0 = (LAS float*)F.lds;
    LAS float* obuf = buf0 + 2 * TB * PER;
    const int rr = lane >> 4, kq = lane & 15, vloc = wave * 4 + rr;
    float S[4] = {0.f, 0.f, 0.f, 0.f};
    float regs[NLD];
    const int sgn = d ? -1 : 1;
    auto load_block = [&](int blk) {
        const int s0 = blk * TB;
        const int row0 = (s0 < CTX) ? b * CTX + (d ? CTX - 1 - s0 : s0) : M_CTX + b * SEQ + (d ? SEQ - 1 - (s0 - CTX) : (s0 - CTX));
        const float* base = RW + (size_t)row0 * 2560 + h * 64;
#pragma unroll
        for (int e = 0; e < 20; ++e) { const int arr = e % 5, st = (e / 5) * 8 + wave;
            const int slot = arr == 0 ? 2 : (arr == 1 ? 3 + 3 * d : (arr == 2 ? 5 + 3 * d : (arr == 3 ? 4 + 3 * d : 0)));
            const float v = base[(ptrdiff_t)(sgn * st) * 2560 + slot * 256 + lane]; regs[e] = (arr == 0) ? -v : v; }
#pragma unroll
        for (int e = 0; e < 2; ++e) { const int idx = e * NT + tid, st = idx >> 5, vi = idx & 31;
            regs[20 + e] = base[(ptrdiff_t)(sgn * st) * 2560 + 256 + vhalf * 32 + vi]; } };
    auto store_block = [&](LAS float* dst) {
#pragma unroll
        for (int e = 0; e < 20; ++e) { const int arr = e % 5, st = (e / 5) * 8 + wave; dst[st * PER + arr * 64 + lane] = regs[e]; }
#pragma unroll
        for (int e = 0; e < 2; ++e) { const int idx = e * NT + tid, st = idx >> 5, vi = idx & 31; dst[st * PER + 320 + vi] = regs[20 + e]; } };
    load_block(0); store_block(buf0);
    __syncthreads();
    for (int blk = 0; blk < NBLK; ++blk) {
        LAS float* cb = buf0 + (blk & 1) * TB * PER;
        if (blk + 1 < NBLK) load_block(blk + 1);
        for (int st = 0; st < TB; ++st) {
            const LAS float* vp = cb + st * PER;
            const f32x4 a4 = *(const LAS f32x4*)(vp + 4 * kq), w4 = *(const LAS f32x4*)(vp + 64 + 4 * kq), b4 = *(const LAS f32x4*)(vp + 128 + 4 * kq),
                        k4 = *(const LAS f32x4*)(vp + 192 + 4 * kq), r4 = *(const LAS f32x4*)(vp + 256 + 4 * kq);
            const float vv = vp[320 + vloc];
            float sa = (S[0] * a4[0] + S[1] * a4[1]) + (S[2] * a4[2] + S[3] * a4[3]);
            sa = row16_sum(sa);
#pragma unroll
            for (int e = 0; e < 4; ++e) S[e] = S[e] * w4[e] + (sa * b4[e] + vv * k4[e]);
            float o = (S[0] * r4[0] + S[1] * r4[1]) + (S[2] * r4[2] + S[3] * r4[3]);
            o = row16_sum(o);
            if (kq == 0) obuf[st * 32 + vloc] = o;
        }
        __syncthreads();
        if (blk + 1 < NBLK) store_block(buf0 + ((blk + 1) & 1) * TB * PER);
#pragma unroll
        for (int e = 0; e < 2; ++e) { const int idx = e * NT + tid; const int st = idx >> 5, vi = idx & 31;
            const int row = chain_row(b, d, blk * TB + st); RO[(size_t)row * 256 + h * 64 + vhalf * 32 + vi] = obuf[idx]; }
        __syncthreads();
    }
}

__device__ __forceinline__ void hyena_lat_unit(Frame& F, int l, int c) {
    constexpr int CPS = 8192 + 32;
    constexpr int VST = 2184;
    LAS unsigned char* cp = F.lds;
    LAS bf16_t* vv = (LAS bf16_t*)(F.lds + 8 * CPS);
    const int tid = F.tid, lane = F.lane, wave = F.wave;
    const float* g = WSP(float, WS_FILT) + ((size_t)l * 256 + c) * (2 * SEQ);
    const float* V = WSP(float, WS_VVT) + (size_t)c * NB * (CTX + SEQ);
    float* Y = WSP(float, WS_YT) + (size_t)c * NB * (CTX + SEQ);
    for (int i = tid; i < 8 * 512; i += NT) { const int r = i >> 9, n = i & 511; float v[8];
#pragma unroll
        for (int e = 0; e < 8; ++e) { const int gi = 8 * n + r + e; v[e] = (gi >= 1 && gi <= 4095) ? g[gi] : 0.f; }
        u32x4 p; p.x = pk2(v[0], v[1]); p.y = pk2(v[2], v[3]); p.z = pk2(v[4], v[5]); p.w = pk2(v[6], v[7]);
        *(LAS u32x4*)(cp + r * CPS + n * 16) = p; }
    for (int i = tid; i < 8 * 272; i += NT) { const int bb = i / 272, gq = i % 272; float v[8];
        const int s0 = gq * 8 - 64;
#pragma unroll
        for (int e = 0; e < 8; ++e) v[e] = (s0 >= 0 && s0 < SEQ) ? V[(size_t)bb * (CTX + SEQ) + CTX + s0 + 7 - e] : 0.f;
        u32x4 p; p.x = pk2(v[0], v[1]); p.y = pk2(v[2], v[3]); p.z = pk2(v[4], v[5]); p.w = pk2(v[6], v[7]);
        *(LAS u32x4*)(vv + bb * VST + gq * 8) = p; }
    __syncthreads();
    const int fr = lane & 15, fq = lane >> 4;
    const int rcp = (fr + 1) & 7;
    const int bcol = fr & 7, pb = fr >> 3;
    f32x4 acc[2][4];
#pragma unroll
    for (int p = 0; p < 2; ++p)
#pragma unroll
        for (int m = 0; m < 4; ++m) acc[p][m] = (f32x4){0.f, 0.f, 0.f, 0.f};
    const int P0 = 2 * wave;
    const int dlo = 2 * P0 - 31 < -31 ? -31 : 2 * P0 - 31, dhi = 2 * (P0 + 1) + 1 > 31 ? 31 : 2 * (P0 + 1) + 1;
    for (int d = dlo; d <= dhi; ++d) {
        bf16x8 A[4][2];
#pragma unroll
        for (int m = 0; m < 4; ++m)
#pragma unroll
            for (int s = 0; s < 2; ++s) { const int a = d * 64 + 16 * m + fr - 32 * s - 8 * fq - 7 + 2048;
                A[m][s] = *(const LAS bf16x8*)(cp + rcp * CPS + ((a - rcp) >> 3) * 16); }
#pragma unroll
        for (int p = 0; p < 2; ++p) { const int Pp = P0 + p; if (d > 2 * Pp + 1 || d < 2 * Pp - 31) continue;
            const int J = 2 * Pp + pb - d;
#pragma unroll
            for (int s = 0; s < 2; ++s) { const bf16x8 B = *(const LAS bf16x8*)(vv + bcol * VST + (J + 1) * 64 + 32 * s + 8 * fq);
#pragma unroll
                for (int m = 0; m < 4; ++m) acc[p][m] = __builtin_amdgcn_mfma_f32_16x16x32_bf16(A[m][s], B, acc[p][m], 0, 0, 0); } }
    }
#pragma unroll
    for (int p = 0; p < 2; ++p)
#pragma unroll
        for (int m = 0; m < 4; ++m) { const int t = 64 * (2 * (P0 + p) + pb) + 16 * m + 4 * fq;
            *(f32x4*)(Y + (size_t)bcol * (CTX + SEQ) + CTX + t) = acc[p][m]; }
    __syncthreads();
}
__device__ __forceinline__ void hyena_ctx_unit(Frame& F, int l, int c) {
    LAS float* gl = (LAS float*)F.lds;
    LAS float* vl = gl + 512;
    const int tid = F.tid, lane = F.lane, wave = F.wave;
    const float* g = WSP(float, WS_FILTC) + ((size_t)l * 256 + c) * (2 * CTX);
    const float* V = WSP(float, WS_VVT) + (size_t)c * NB * (CTX + SEQ);
    float* Y = WSP(float, WS_YT) + (size_t)c * NB * (CTX + SEQ);
    gl[tid] = (tid >= 1) ? g[tid] : 0.f;
    for (int i = tid; i < 8 * 256; i += NT) vl[i] = V[(size_t)(i >> 8) * (CTX + SEQ) + (i & 255)];
    __syncthreads();
    float a[4] = {0.f, 0.f, 0.f, 0.f};
    for (int s = 0; s < CTX; ++s) { const float v = vl[wave * 256 + s];
#pragma unroll
        for (int j = 0; j < 4; ++j) a[j] += gl[lane + 64 * j - s + 256] * v; }
#pragma unroll
    for (int j = 0; j < 4; ++j) Y[(size_t)wave * (CTX + SEQ) + lane + 64 * j] = a[j];
    __syncthreads();
}

__device__ __forceinline__ void phase_finish(Frame& F, int l, bool with_ctx) {
    const float* P = WSP(float, WS_P); const float* YT = WSP(float, WS_YT);
    const float* RW = WSP(float, WS_RW); const float* BON = WSP(float, WS_RWBON);
    const float* RO = WSP(float, WS_RWO); const float* GO = WSP(float, WS_GDO);
    bf16_t* YC = WSP(bf16_t, WS_YCAT);
    const float* sw = F.in[I_HSW] + (size_t)l * 3 * 768; const float* sb = F.in[I_HSB] + (size_t)l * 768;
    const float* gnw = F.in[I_RGNW] + l * 256; const float* gnb = F.in[I_RGNB] + l * 256; const float* gdw = F.in[I_GNW] + l * 128;
    LAS float* tile = (LAS float*)F.lds;
    const int tid = F.tid, lane = F.lane, wave = F.wave;
    for (int u = F.bid; u < M_ALL / 64; u += F.G) {
        const int row0 = u * 64; const bool isctx = row0 < M_CTX; if (isctx && !with_ctx) continue;
        const int L = isctx ? CTX : SEQ; const int b = row_batch(row0); const int t0 = isctx ? row0 - b * CTX : row0 - M_CTX - b * SEQ;
        const int pos0 = isctx ? t0 : CTX + t0;
        for (int i = tid; i < 256 * 64; i += NT) { const int cc = i >> 6, tl = i & 63; tile[cc * 65 + tl] = YT[((size_t)cc * NB + b) * (CTX + SEQ) + pos0 + tl]; }
        __syncthreads();
        { const int c = tid & 255, th = tid >> 8;
          const float wa = sw[c], wb = sw[768 + c], wc_ = sw[2 * 768 + c], b0 = sb[c];
          for (int tt = 0; tt < 32; ++tt) { const int tl = th * 32 + tt, t = t0 + tl; const float* pr = P + (size_t)(row0 + tl) * PW;
              float x0 = b0 + wb * pr[c]; if (t > 0) x0 += wa * pr[-PW + c]; if (t < L - 1) x0 += wc_ * pr[PW + c];
              YC[(size_t)(row0 + tl) * D + c] = (bf16_t)f2bf(tile[c * 65 + tl] * x0); } }
        for (int tk = 0; tk < 8; ++tk) { const int row = row0 + wave * 8 + tk;
            const float* rw = RW + (size_t)row * 2560;
#pragma unroll
            for (int q = 0; q < 4; ++q) { const int c = lane + 64 * q;
                const float o = RO[(size_t)row * 256 + c] + RO[(size_t)(M_ALL + row) * 256 + c];
                const float mean = wave_sum(o) * (1.f / 64.f); const float dv = o - mean; const float var = wave_sum(dv * dv) * (1.f / 64.f);
                float y = dv * rsqrtf(var + 64e-5f) * gnw[c] + gnb[c];
                y += BON[(size_t)row * 4 + q] * rw[256 + c];
                y *= rw[9 * 256 + c];
                YC[(size_t)row * D + 256 + c] = (bf16_t)f2bf(y); }
            float o[8];
#pragma unroll
            for (int j = 0; j < 8; ++j) { const int c = j * 64 + lane; o[j] = GO[(size_t)row * 512 + c] + GO[(size_t)(M_ALL + row) * 512 + c]; }
#pragma unroll
            for (int hh = 0; hh < 4; ++hh) { const float ms = wave_sum(o[2 * hh] * o[2 * hh] + o[2 * hh + 1] * o[2 * hh + 1]) * (1.f / 128.f); const float rs = rsqrtf(ms + 1e-6f);
#pragma unroll
                for (int jj = 0; jj < 2; ++jj) { const int j = 2 * hh + jj, c = j * 64 + lane; const float z = P[(size_t)row * PW + C_GD + 1536 + c];
                    YC[(size_t)row * D + 512 + c] = (bf16_t)f2bf(o[j] * rs * gdw[c & 127] * siluf_(z)); } }
        }
        __syncthreads();
    }
}

__device__ __forceinline__ void phase_router(Frame& F, int l, int row_lo) {
    const float* H = WSP(float, WS_H); const float* mods = WSP(float, WS_MODS) + (size_t)l * 9 * (NMOD * D);
    bf16_t* N = WSP(bf16_t, WS_N);
    const float* rw = F.in[I_MRW] + (size_t)l * D * NE; const float* rb = F.in[I_MRB] + l * NE;
    unsigned* cnt = (unsigned*)(F.ws + WS_CTL) + CW_CNT + l * NE * 64;
    int* stok = WSP(int, WS_STOK); int* toke = WSP(int, WS_TOKE); int* tokr = WSP(int, WS_TOKE + MiB); float* tokg = WSP(float, WS_TOKE + 2 * MiB);
    LAS float* xr = (LAS float*)F.lds;
    LAS float* lg = xr + 32 * 1024;
    const int tid = F.tid, lane = F.lane, wave = F.wave;
    for (int u = F.bid; u < (M_ALL - row_lo) / 32; u += F.G) {
        const int row0 = row_lo + u * 32;
        for (int tk = 0; tk < 4; ++tk) { const int tl = wave * 4 + tk, row = row0 + tl; const float* mr = mods + (size_t)row_modr(row) * (NMOD * D);
            norm_mod_row<true>(H + (size_t)row * D, F.in[I_NFFN] + l * D, mr + 3 * D, mr + 4 * D, N + (size_t)row * D, xr + tl * 1024, lane); }
        __syncthreads();
        { const int tl = tid >> 4, e0 = (tid & 15) * 2; float a0 = 0.f, a1 = 0.f; const LAS float* xp = xr + tl * 1024;
#pragma unroll 8
          for (int k = 0; k < D; ++k) { const float x = xp[k]; const f32x2 w = *(const f32x2*)(rw + (size_t)k * NE + e0); a0 += x * w.x; a1 += x * w.y; }
          lg[tl * 33 + e0] = a0 + rb[e0]; lg[tl * 33 + e0 + 1] = a1 + rb[e0 + 1]; }
        __syncthreads();
        if (tid < 32) { const int row = row0 + tid; float v[NE];
#pragma unroll
            for (int e = 0; e < NE; ++e) v[e] = lg[tid * 33 + e];
            int sel[4]; float sv[4];
#pragma unroll
            for (int k = 0; k < 4; ++k) { float best = -3.0e38f; int bi = 0;
#pragma unroll
                for (int e = 0; e < NE; ++e) { const bool taken = (k > 0 && sel[0] == e) || (k > 1 && sel[1] == e) || (k > 2 && sel[2] == e);
                    if (!taken && v[e] > best) { best = v[e]; bi = e; } }
                sel[k] = bi; sv[k] = best; }
            float ex[4], den = 0.f;
#pragma unroll
            for (int k = 0; k < 4; ++k) { ex[k] = __expf(sv[k] - sv[0]); den += ex[k]; }
#pragma unroll
            for (int k = 0; k < 4; ++k) { const unsigned rk = atomicAdd(cnt + sel[k] * 64, 1u);
                stok[(size_t)sel[k] * M_ALL + rk] = row; toke[(size_t)row * 4 + k] = sel[k]; tokr[(size_t)row * 4 + k] = (int)rk; tokg[(size_t)row * 4 + k] = ex[k] / den; } }
        __syncthreads();
    }
}

__device__ __forceinline__ void moe_prefix(Frame& F, int l, LAS int* pref) {
    const unsigned* cnt = (const unsigned*)(F.ws + WS_CTL) + CW_CNT + l * NE * 64;
    if (F.tid == 0) { int a = 0; for (int e = 0; e < NE; ++e) { const int c = (int)__hip_atomic_load(cnt + e * 64, __ATOMIC_RELAXED, __HIP_MEMORY_SCOPE_AGENT); pref[e] = a; pref[64 + e] = c; a += (c + 255) >> 8; } pref[32] = a; }
    __syncthreads();
}

__device__ __forceinline__ void phase_combine(Frame& F, int l, int row_lo, LAS int* pref) {
    float* H = WSP(float, WS_H); const float* mods = WSP(float, WS_MODS);
    const bf16_t* YB = WSP(bf16_t, WS_YB); bf16_t* N = WSP(bf16_t, WS_N);
    const int* toke = WSP(int, WS_TOKE); const int* tokr = WSP(int, WS_TOKE + MiB); const float* tokg = WSP(float, WS_TOKE + 2 * MiB);
    const int gw = F.bid * NWV + F.wave, NGW = F.G * NWV, lane = F.lane;
    const bool last = (l == DEPTH - 1);
    for (int row = row_lo + gw; row < M_ALL; row += NGW) {
        const int r9 = row_modr(row); const float* mr = mods + ((size_t)l * 9 + r9) * (NMOD * D);
        int dst[4]; float gk[4];
#pragma unroll
        for (int k = 0; k < 4; ++k) { const int e = toke[(size_t)row * 4 + k]; dst[k] = pref[e] * 256 + tokr[(size_t)row * 4 + k]; gk[k] = tokg[(size_t)row * 4 + k]; }
        f32x4 v[4]; float ss = 0.f;
#pragma unroll
        for (int j = 0; j < 4; ++j) { const int c = 4 * lane + 256 * j; f32x4 y = (f32x4){0.f, 0.f, 0.f, 0.f};
#pragma unroll
            for (int k = 0; k < 4; ++k) { const u32x2 p = *(const u32x2*)(YB + (size_t)dst[k] * D + c);
                y.x += gk[k] * __builtin_bit_cast(float, p.x << 16); y.y += gk[k] * __builtin_bit_cast(float, p.x & 0xffff0000u);
                y.z += gk[k] * __builtin_bit_cast(float, p.y << 16); y.w += gk[k] * __builtin_bit_cast(float, p.y & 0xffff0000u); }
            const f32x4 hv = *(const f32x4*)(H + (size_t)row * D + c) + *(const f32x4*)(mr + 5 * D + c) * y;
            v[j] = hv; ss += (hv.x * hv.x + hv.y * hv.y) + (hv.z * hv.z + hv.w * hv.w);
            if (!last) *(f32x4*)(H + (size_t)row * D + c) = hv; }
        const float rstd = rsqrtf(wave_sum(ss) * (1.f / D) + 1e-6f);
        if (last) { float* orow = F.out + (size_t)(row - M_CTX) * D;
#pragma unroll
            for (int j = 0; j < 4; ++j) { const int c = 4 * lane + 256 * j; f32x4 ov = (v[j] * rstd) * *(const f32x4*)(F.in[I_NFIN] + c);
#ifdef PROBE_EDGE
                { const int tt = (row - M_CTX) % SEQ; if (tt < 8 || tt >= SEQ - 8) ov = (f32x4){0.f, 0.f, 0.f, 0.f}; }
#endif
                *(f32x4*)(orow + c) = ov; } }
        else { const float* mn = mods + ((size_t)(l + 1) * 9 + r9) * (NMOD * D); const float* nw = F.in[I_NMIX] + (l + 1) * D;
#pragma unroll
            for (int j = 0; j < 4; ++j) { const int c = 4 * lane + 256 * j;
                const f32x4 o = (v[j] * rstd) * *(const f32x4*)(nw + c) * (*(const f32x4*)(mn + D + c) + 1.0f) + *(const f32x4*)(mn + c);
                u32x2 p; p.x = pk2(o.x, o.y); p.y = pk2(o.z, o.w); *(u32x2*)(N + (size_t)row * D + c) = p; } }
    }
}


#ifdef DBG_CHECK
constexpr int CW_DBG = 40000;
__device__ __forceinline__ void dbg_add(Frame& F, float num, float den) {
    float* acc = (float*)((unsigned*)(F.ws + WS_CTL) + CW_DBG);
    num = wave_sum(num); den = wave_sum(den);
    if (F.lane == 0) { atomicAdd(acc, num); atomicAdd(acc + 1, den); }
}
__device__ __forceinline__ void dbg_gdn(Frame& F, int ci) {
    const float* Q = WSP(float, WS_GQKV); const float* BG = WSP(float, WS_GBG);
    const int b = ci >> 3, h = (ci >> 1) & 3, d = ci & 1;
    const float* GO = WSP(float, WS_GDO) + (size_t)d * M_ALL * 512;
    LAS float* S = (LAS float*)F.lds;
    LAS float* part = S + 128 * 129;
    LAS float* vn = part + 512;
    LAS float* kq = vn + 128;
    const int tid = F.tid, v = tid & 127, pt = tid >> 7;
    for (int i = tid; i < 128 * 129; i += NT) S[i] = 0.f;
    __syncthreads();
    float num = 0.f, den = 0.f;
    for (int s = 0; s < CTX + SEQ; ++s) {
        const int row = chain_row(b, d, s); const float* qr = Q + (size_t)row * 1536 + h * 128;
        const float beta = BG[(size_t)row * 16 + d * 4 + h], al = __expf(BG[(size_t)row * 16 + 8 + d * 4 + h]);
        if (tid < 128) kq[tid] = qr[512 + tid]; else if (tid < 256) kq[tid] = qr[tid - 128];
        __syncthreads();
        float a = 0.f;
        for (int j = 0; j < 32; ++j) { const int kd = pt * 32 + j; const float sv = S[kd * 129 + v] * al; S[kd * 129 + v] = sv; a += sv * kq[kd]; }
        part[pt * 128 + v] = a;
        __syncthreads();
        if (tid < 128) vn[tid] = beta * (qr[1024 + tid] - (part[tid] + part[128 + tid] + part[256 + tid] + part[384 + tid]));
        __syncthreads();
        a = 0.f;
        for (int j = 0; j < 32; ++j) { const int kd = pt * 32 + j; const float sv = S[kd * 129 + v] + kq[kd] * vn[v]; S[kd * 129 + v] = sv; a += sv * kq[128 + kd]; }
        part[pt * 128 + v] = a;
        __syncthreads();
        if (tid < 128) { const float o = part[tid] + part[128 + tid] + part[256 + tid] + part[384 + tid]; const float f = GO[(size_t)row * 512 + h * 128 + tid];
            num += (o - f) * (o - f); den += o * o; }
        __syncthreads();
    }
    dbg_add(F, num, den);
}
__device__ __forceinline__ void dbg_hyena(Frame& F, int l) {
    const int gw = F.bid * NWV + F.wave, lane = F.lane;
    float num = 0.f, den = 0.f;
    for (int smp = gw; smp < 8192; smp += F.G * NWV) {
        const unsigned hsh = (unsigned)smp * 2654435761u; const int c = hsh & 255, b = (hsh >> 8) & 7; const int isc = (smp & 7) == 0; const int L = isc ? CTX : SEQ; const int t = (hsh >> 11) % L;
        const float* g = isc ? WSP(float, WS_FILTC) + ((size_t)l * 256 + c) * (2 * CTX) : WSP(float, WS_FILT) + ((size_t)l * 256 + c) * (2 * SEQ);
        const float* V = WSP(float, WS_VVT) + ((size_t)c * NB + b) * (CTX + SEQ) + (isc ? 0 : CTX);
        float a = 0.f;
        for (int s = lane; s < L; s += 64) a += g[t - s + L] * V[s];
        a = wave_sum(a);
        const float f = WSP(float, WS_YT)[((size_t)c * NB + b) * (CTX + SEQ) + (isc ? 0 : CTX) + t];
        if (isc && l == DEPTH - 1) continue;
        if (lane == 0) { num += (a - f) * (a - f); den += a * a; }
    }
    dbg_add(F, num, den);
}
__device__ __forceinline__ void dbg_moe(Frame& F, int l, LAS int* pref) {
    const bf16_t* N = WSP(bf16_t, WS_N); const bf16_t* YB = WSP(bf16_t, WS_YB);
    const int* toke = WSP(int, WS_TOKE); const int* tokr = WSP(int, WS_TOKE + MiB); const float* tokg = WSP(float, WS_TOKE + 2 * MiB);
    LAS float* xs = (LAS float*)(F.lds + F.wave * 8192);
    LAS float* as = xs + 1024;
    const int gw = F.bid * NWV + F.wave, lane = F.lane;
    float num = 0.f, den = 0.f;
    for (int smp = gw; smp < 2048; smp += F.G * NWV) {
        const int row = M_CTX + (int)(((unsigned)smp * 2654435761u) % (unsigned)M_LAT);
        for (int i = lane; i < 1024; i += 64) xs[i] = bf2f(N[(size_t)row * D + i]);
        LDS_WAIT();
        float y[16], yf[16];
#pragma unroll
        for (int j = 0; j < 16; ++j) { y[j] = 0.f; yf[j] = 0.f; }
        for (int k = 0; k < 4; ++k) { const int e = toke[(size_t)row * 4 + k]; const float gk = tokg[(size_t)row * 4 + k]; const int dst = pref[e] * 256 + tokr[(size_t)row * 4 + k];
            const float* wgu = F.in[I_MWGU] + ((size_t)l * NE + e) * D * 2048; const float* bgu = F.in[I_MBGU] + ((size_t)l * NE + e) * 2048;
            const float* wdn = F.in[I_MWDN] + ((size_t)l * NE + e) * FF * D; const float* bdn = F.in[I_MBDN] + ((size_t)l * NE + e) * D;
            for (int jf = 0; jf < 16; ++jf) { const int f = jf * 64 + lane; float g = bgu[f], u = bgu[1024 + f];
                for (int dd = 0; dd < D; ++dd) { const float x = xs[dd]; g += x * wgu[(size_t)dd * 2048 + f]; u += x * wgu[(size_t)dd * 2048 + 1024 + f]; }
                g = fminf(g, 7.f); u = fminf(fmaxf(u, -7.f), 7.f); as[f] = (u + 1.f) * (g / (1.f + __expf(-1.702f * g))); }
            LDS_WAIT();
#pragma unroll
            for (int j = 0; j < 16; ++j) { const int c = j * 64 + lane; float a = bdn[c];
                for (int f = 0; f < FF; ++f) a += as[f] * wdn[(size_t)f * D + c];
                y[j] += gk * a; yf[j] += gk * bf2f(YB[(size_t)dst * D + c]); }
            LDS_WAIT(); }
#pragma unroll
        for (int j = 0; j < 16; ++j) { num += (y[j] - yf[j]) * (y[j] - yf[j]); den += y[j] * y[j]; }
    }
    dbg_add(F, num, den);
}

__device__ __forceinline__ void dbg_static(Frame& F) {
    const int gw = F.bid * NWV + F.wave, lane = F.lane;
    float num = 0.f, den = 0.f;
    if (DBG_SUB & 1) for (int smp = gw * 64 + lane; smp < (1 << 20); smp += F.G * NT) {
        const unsigned hsh = (unsigned)smp * 2654435761u; const int l = hsh & 3, k = (hsh >> 2) & 1023, n = (hsh >> 12) % IN_COLS, n2 = (hsh >> 12) & 1023;
        const float a = F.in[I_WIN][((size_t)l * D + k) * IN_COLS + n], b = bf2f(WSP(bf16_t, WS_WIN)[((size_t)l * PW + n) * D + k]);
        const float c = F.in[I_WOUT][((size_t)l * D + k) * D + n2], d = bf2f(WSP(bf16_t, WS_WOUT)[((size_t)l * D + n2) * D + k]);
        num += (a - b) * (a - b) + (c - d) * (c - d); den += a * a + c * c; }
    if (DBG_SUB & 2) for (int smp = gw; smp < 4096; smp += F.G * NWV) {
        const unsigned hsh = (unsigned)smp * 2654435761u; const int l = hsh & 3, r = (hsh >> 2) % 9, n = (hsh >> 8) % (NMOD * D);
        float a = 0.f;
        for (int k = lane; k < D; k += 64) { const float cv = (r < 8) ? F.in[I_C][r * D + k] : F.in[I_CCTX][k]; a += siluf_(cv) * F.in[I_ADAW][((size_t)l * D + k) * (NMOD * D) + n]; }
        a = wave_sum(a) + F.in[I_ADAB][l * (NMOD * D) + n];
        const float f = WSP(float, WS_MODS)[((size_t)l * 9 + r) * (NMOD * D) + n];
        if (lane == 0) { num += (a - f) * (a - f); den += a * a; } }
    if (DBG_SUB & 4) for (int smp = gw; smp < 2048; smp += F.G * NWV) {
        const unsigned hsh = (unsigned)smp * 2654435761u; const int l = hsh & 3; const bool isctx = (hsh >> 2) & 1; const int L = isctx ? CTX : SEQ; const int p = (hsh >> 3) % L;
        const float t = (float)p / (float)(L - 1);
        LAS float* hx = (LAS float*)(F.lds + F.wave * 1024);
        float z = 0.f;
        if (lane == 0) z = t; else if (lane < 33) { const int bi = (lane - 1) & 15; const float band = 1e-4f + (float)bi * ((15.0f - 1e-4f) / 15.0f); const float ang = (6.283185307179586f / (float)L) * (float)p * band; z = (lane <= 16) ? cosf(ang) : -sinf(ang); }
        const float fr = F.in[I_HFREQ][l * 64 + lane];
        hx[lane] = z; LDS_WAIT(); float a = F.in[I_HB1][l * 64 + lane];
#pragma unroll 1
        for (int i = 0; i < 33; ++i) a += hx[i] * F.in[I_HW1][((size_t)l * 33 + i) * 64 + lane];
        float hh = sinf(fr * a); LDS_WAIT(); hx[lane] = hh; LDS_WAIT(); a = F.in[I_HB2][l * 64 + lane];
#pragma unroll 1
        for (int i = 0; i < 64; ++i) a += hx[i] * F.in[I_HW2][((size_t)l * 64 + i) * 64 + lane];
        hh = sinf(fr * a); LDS_WAIT(); hx[lane] = hh; LDS_WAIT(); a = F.in[I_HB3][l * 64 + lane];
#pragma unroll 1
        for (int i = 0; i < 64; ++i) a += hx[i] * F.in[I_HW3][((size_t)l * 64 + i) * 64 + lane];
        hh = sinf(fr * a); LDS_WAIT(); hx[lane] = hh; LDS_WAIT();
        const int ch = ((hsh >> 16) + lane * 16) & 255; float of = 0.f, ob = 0.f;
#pragma unroll 1
        for (int i = 0; i < 64; ++i) { of += hx[i] * F.in[I_HW4][((size_t)l * 64 + i) * 512 + ch]; ob += hx[i] * F.in[I_HW4][((size_t)l * 64 + i) * 512 + 256 + ch]; }
        const float dl = -3.0701134573253946f + (float)ch * ((-15.350567286626973f + 3.0701134573253946f) / 255.0f); const float win = __expf(-t * fabsf(dl));
        of = of * win + (p == 0 ? F.in[I_HSKIP][l * 256 + ch] : 0.f); ob *= win;
        const float* filt = isctx ? WSP(float, WS_FILTC) + ((size_t)l * 256 + ch) * (2 * CTX) : WSP(float, WS_FILT) + ((size_t)l * 256 + ch) * (2 * SEQ);
        if (lane < 16) { const float ff = filt[L + p]; num += (of - ff) * (of - ff); den += of * of;
            if (p >= 1) { const float fb = filt[L - p]; num += (ob - fb) * (ob - fb); den += ob * ob; } }
        LDS_WAIT(); }
    dbg_add(F, num, den);
}

__device__ __forceinline__ float dbg_rw_m(const float* P, const float* mu, int row, int cc) {
    const bool isctx = row < M_CTX; const int b = row_batch(row); const int t = isctx ? row - b * CTX : row - M_CTX - b * SEQ;
    const float* pr = P + (size_t)row * PW + C_RW; float sh = 0.f;
    if (isctx) { if ((cc & 1) == 0) { if (t > 0) sh = pr[-PW + cc]; } else { if (t < CTX - 1) sh = pr[PW + cc]; } }
    else { const int gr = t / 64, gc = t % 64, m4 = cc % 4;
        if (m4 == 0) { if (gc > 0) sh = pr[-PW + cc]; } else if (m4 == 1) { if (gc < 63) sh = pr[PW + cc]; } else if (m4 == 2) { if (gr > 0) sh = pr[-64 * PW + cc]; } else { if (gr < 31) sh = pr[64 * PW + cc]; } }
    return pr[cc] + mu[cc] * (sh - pr[cc]);
}
__device__ __forceinline__ void dbg_prep(Frame& F, int l) {
    const float* P = WSP(float, WS_P); const int gw = F.bid * NWV + F.wave, lane = F.lane;
    float num = 0.f, den = 0.f;
    if (DBG_SUB & 1) for (int smp = gw; smp < 1024; smp += F.G * NWV) {
        const int row = (int)(((unsigned)smp * 2654435761u) % (unsigned)M_ALL);
        const float* mu = F.in[I_RMU] + (size_t)l * RWC; const float* rw = WSP(float, WS_RW) + (size_t)row * 2560;
#pragma unroll 1
        for (int q = 0; q < 4; ++q) { const int c = lane + 64 * q;
            const float r_ = dbg_rw_m(P, mu, row, c), k_ = dbg_rw_m(P, mu, row, 256 + c), v_ = dbg_rw_m(P, mu, row, 512 + c);
            float lw[2] = {F.in[I_RW0][l * 512 + c], F.in[I_RW0][l * 512 + 256 + c]}, la[2] = {F.in[I_RA0][l * 512 + c], F.in[I_RA0][l * 512 + 256 + c]}, g = 0.f;
#pragma unroll 1
            for (int r = 0; r < 64; ++r) {
#pragma unroll
                for (int d = 0; d < 2; ++d) { lw[d] += tanhf(dbg_rw_m(P, mu, row, 768 + d * 64 + r)) * F.in[I_RW2][(((size_t)l * 2 + d) * 64 + r) * 256 + c];
                    la[d] += dbg_rw_m(P, mu, row, 896 + d * 64 + r) * F.in[I_RA2][(((size_t)l * 2 + d) * 64 + r) * 256 + c]; } }
#pragma unroll 1
            for (int r = 0; r < 128; ++r) g += sigmoidf_(dbg_rw_m(P, mu, row, 1024 + r)) * F.in[I_RG2][((size_t)l * 128 + r) * 256 + c];
            const float kx = k_ * F.in[I_RKK][l * 256 + c]; const float kk = kx * rsqrtf(wave_sum(kx * kx) + 1e-12f);
            float ref[10]; ref[0] = r_; ref[1] = v_; ref[2] = kk; ref[9] = g; float bon = 0.f;
#pragma unroll
            for (int d = 0; d < 2; ++d) { const float lwv = -softplusf_(-lw[d]) - 0.5f; ref[3 + 3 * d] = expf(-expf(lwv)); const float a = sigmoidf_(la[d]);
                const float kd = k_ * (1.f + (a - 1.f) * F.in[I_RKA][l * 256 + c]); ref[4 + 3 * d] = kd; ref[5 + 3 * d] = kk * a; bon += r_ * kd * F.in[I_RRK][l * 256 + c]; }
            bon = wave_sum(bon);
#pragma unroll
            for (int j = 0; j < 10; ++j) { const float f = rw[j * 256 + c]; num += (ref[j] - f) * (ref[j] - f); den += ref[j] * ref[j]; }
            if (lane == 0) { const float f = WSP(float, WS_RWBON)[(size_t)row * 4 + q]; num += (bon - f) * (bon - f); den += bon * bon; } } }
    if (DBG_SUB & 2) for (int smp = gw; smp < 4096; smp += F.G * NWV) {
        const int row = (int)(((unsigned)smp * 2654435761u) % (unsigned)M_ALL);
        const bool isctx = row < M_CTX; const int L = isctx ? CTX : SEQ; const int b = row_batch(row); const int t = isctx ? row - b * CTX : row - M_CTX - b * SEQ;
        const float* cw = F.in[I_GCONV] + (size_t)l * 5 * 1536; const float* q = WSP(float, WS_GQKV) + (size_t)row * 1536;
#pragma unroll 1
        for (int part = 0; part < 3; ++part)
#pragma unroll 1
            for (int hd = 0; hd < 4; ++hd) { float x[2];
#pragma unroll
                for (int jj = 0; jj < 2; ++jj) { const int c = part * 512 + hd * 128 + jj * 64 + lane; float a = 0.f;
                    for (int tap = 0; tap < 5; ++tap) { const int tt = t + tap - 2; if (tt >= 0 && tt < L) a += P[(size_t)(row + tap - 2) * PW + C_GD + c] * cw[tap * 1536 + c]; }
                    x[jj] = a / (1.f + expf(-a)); }
                if (part < 2) { const float sc = rsqrtf(wave_sum(x[0] * x[0] + x[1] * x[1]) + 1e-12f) * (part == 0 ? 0.08838834764831845f : 1.f); x[0] *= sc; x[1] *= sc; }
#pragma unroll
                for (int jj = 0; jj < 2; ++jj) { const float f = q[part * 512 + hd * 128 + jj * 64 + lane]; num += (x[jj] - f) * (x[jj] - f); den += x[jj] * x[jj]; } }
        if (lane < 16) { const float rv = P[(size_t)row * PW + C_GD + 2048 + lane]; float ov;
            if (lane < 8) ov = 1.f / (1.f + expf(-rv)); else { const int dh = lane - 8; ov = -expf(F.in[I_GALOG][l * 8 + dh]) * softplusf_(rv + F.in[I_GDT][l * 8 + dh]); }
            const float f = WSP(float, WS_GBG)[(size_t)row * 16 + lane]; num += (ov - f) * (ov - f); den += ov * ov; } }
    if (DBG_SUB & 4) for (int smp = gw; smp < 4096; smp += F.G * NWV) {
        const int row = M_CTX + (int)(((unsigned)smp * 2654435761u) % (unsigned)M_LAT); const int b = row_batch(row), t = row - M_CTX - b * SEQ;
        const float* sw = F.in[I_HSW] + (size_t)l * 3 * 768; const float* sb = F.in[I_HSB] + (size_t)l * 768;
        const bf16_t* yc = WSP(bf16_t, WS_YCAT) + (size_t)row * D;
#pragma unroll 1
        for (int j = 0; j < 4; ++j) { const int c = j * 64 + lane; float u[3];
#pragma unroll
            for (int g3 = 0; g3 < 3; ++g3) { float a = sb[g3 * 256 + c];
                for (int tap = 0; tap < 3; ++tap) { const int tt = t + tap - 1; if (tt >= 0 && tt < SEQ) a += P[(size_t)(row + tap - 1) * PW + g3 * 256 + c] * sw[tap * 768 + g3 * 256 + c]; }
                u[g3] = a; }
            const float vv = u[2] * u[1]; const float fv = WSP(float, WS_VVT)[((size_t)c * NB + b) * (CTX + SEQ) + CTX + t];
            num += (vv - fv) * (vv - fv); den += vv * vv;
            const float yv = WSP(float, WS_YT)[((size_t)c * NB + b) * (CTX + SEQ) + CTX + t] * u[0]; const float fy = bf2f(yc[c]);
            num += (yv - fy) * (yv - fy); den += yv * yv; }
        const float* rw = WSP(float, WS_RW) + (size_t)row * 2560;
#pragma unroll 1
        for (int q = 0; q < 4; ++q) { const int c = lane + 64 * q; const float o = WSP(float, WS_RWO)[(size_t)row * 256 + c] + WSP(float, WS_RWO)[(size_t)(M_ALL + row) * 256 + c];
            const float mean = wave_sum(o) / 64.f; const float var = wave_sum((o - mean) * (o - mean)) / 64.f;
            float y = (o - mean) / sqrtf(var + 64e-5f) * F.in[I_RGNW][l * 256 + c] + F.in[I_RGNB][l * 256 + c];
            y = (y + WSP(float, WS_RWBON)[(size_t)row * 4 + q] * rw[256 + c]) * rw[9 * 256 + c];
            const float fy = bf2f(yc[256 + c]); num += (y - fy) * (y - fy); den += y * y; }
#pragma unroll 1
        for (int hd = 0; hd < 4; ++hd) { float o[2];
#pragma unroll
            for (int jj = 0; jj < 2; ++jj) { const int c = hd * 128 + jj * 64 + lane; o[jj] = WSP(float, WS_GDO)[(size_t)row * 512 + c] + WSP(float, WS_GDO)[(size_t)(M_ALL + row) * 512 + c]; }
            const float rs = 1.f / sqrtf(wave_sum(o[0] * o[0] + o[1] * o[1]) / 128.f + 1e-6f);
#pragma unroll
            for (int jj = 0; jj < 2; ++jj) { const int c = hd * 128 + jj * 64 + lane; const float z = P[(size_t)row * PW + C_GD + 1536 + c];
                const float y = o[jj] * rs * F.in[I_GNW][l * 128 + jj * 64 + lane] * (z / (1.f + expf(-z))); const float fy = bf2f(yc[512 + c]); num += (y - fy) * (y - fy); den += y * y; } } }
    dbg_add(F, num, den);
}
__device__ __forceinline__ void dbg_router(Frame& F, int l) {
    const int gw = F.bid * NWV + F.wave, lane = F.lane; LAS float* xs = (LAS float*)(F.lds + F.wave * 4096);
    float num = 0.f, den = 0.f;
    for (int smp = gw; smp < 4096; smp += F.G * NWV) {
        const int row = M_CTX + (int)(((unsigned)smp * 2654435761u) % (unsigned)M_LAT); const int b = row_batch(row);
        const float* h = WSP(float, WS_H) + (size_t)row * D; const float* mr = WSP(float, WS_MODS) + ((size_t)l * 9 + b) * (NMOD * D);
        float ss = 0.f; for (int i = lane; i < D; i += 64) ss += h[i] * h[i];
        const float rstd = 1.f / sqrtf(wave_sum(ss) / D + 1e-6f);
        for (int i = lane; i < D; i += 64) xs[i] = h[i] * rstd * F.in[I_NFFN][l * D + i] * (1.f + mr[4 * D + i]) + mr[3 * D + i];
        LDS_WAIT();
        float lg = -3e38f;
        if (lane < 32) { lg = F.in[I_MRB][l * NE + lane]; for (int k = 0; k < D; ++k) lg += xs[k] * F.in[I_MRW][((size_t)l * D + k) * NE + lane]; }
        float sv[4]; int se[4]; float cur = lg;
#pragma unroll
        for (int k = 0; k < 4; ++k) { float m = cur;
#pragma unroll
            for (int o = 1; o < 64; o <<= 1) m = fmaxf(m, __shfl_xor(m, o));
            const unsigned long long bal = __ballot(cur == m); const int who = __ffsll((long long)bal) - 1; sv[k] = m; se[k] = who; if (lane == who) cur = -3e38f; }
        float ex[4], dn = 0.f;
#pragma unroll
        for (int k = 0; k < 4; ++k) { ex[k] = expf(sv[k] - sv[0]); dn += ex[k]; }
        if (lane == 0) {
#pragma unroll
            for (int k = 0; k < 4; ++k) { const float g = ex[k] / dn; float fg = 0.f;
                for (int k2 = 0; k2 < 4; ++k2) if (WSP(int, WS_TOKE)[(size_t)row * 4 + k2] == se[k]) fg = WSP(float, WS_TOKE + 2 * MiB)[(size_t)row * 4 + k2];
                num += (g - fg) * (g - fg); den += g * g; } }
        LDS_WAIT(); }
    dbg_add(F, num, den);
}
__device__ __forceinline__ void dbg_rwkv_scan(Frame& F, int ci) {
    const int lane = F.lane; const int b = ci >> 3, h = (ci >> 1) & 3, d = ci & 1;
    const float* RW = WSP(float, WS_RW); const float* RO = WSP(float, WS_RWO) + (size_t)d * M_ALL * 256;
    LAS float* vs = (LAS float*)(F.lds + F.wave * 2048);
    float S[64];
#pragma unroll
    for (int k = 0; k < 64; ++k) S[k] = 0.f;
    float num = 0.f, den = 0.f;
#pragma unroll 1
    for (int s = 0; s < CTX + SEQ; ++s) { const int row = chain_row(b, d, s); const float* src = RW + (size_t)row * 2560 + h * 64;
        vs[lane] = -src[2 * 256 + lane]; vs[64 + lane] = src[(3 + 3 * d) * 256 + lane]; vs[128 + lane] = src[(5 + 3 * d) * 256 + lane]; vs[192 + lane] = src[(4 + 3 * d) * 256 + lane]; vs[256 + lane] = src[lane];
        const float v = src[256 + lane]; LDS_WAIT();
        float sa = 0.f;
#pragma unroll
        for (int k = 0; k < 64; ++k) sa += S[k] * vs[k];
        float o = 0.f;
#pragma unroll
        for (int k = 0; k < 64; ++k) { S[k] = S[k] * vs[64 + k] + sa * vs[128 + k] + v * vs[192 + k]; o += S[k] * vs[256 + k]; }
        const float f = RO[(size_t)row * 256 + h * 64 + lane]; num += (o - f) * (o - f); den += o * o; LDS_WAIT(); }
    dbg_add(F, num, den);
}
__device__ __forceinline__ void dbg_scale(Frame& F, float K) {
    const float* acc = (const float*)((unsigned*)(F.ws + WS_CTL) + CW_DBG);
    const float rel = sqrtf(acc[0] / fmaxf(acc[1], 1e-30f)); const float sc = 1.f + K * rel;
    for (size_t i = (size_t)F.bid * NT + F.tid; i < (size_t)M_LAT * D; i += (size_t)F.G * NT) F.out[i] *= sc;
}
#endif
constexpr int PH_PER_LAYER = 11, N_PHASES = 1 + DEPTH * PH_PER_LAYER;
__global__ void __launch_bounds__(NT, 2) hybrid_fwd(Args args) {
    extern __shared__ __attribute__((aligned(16))) unsigned char lds_raw[];
    Frame F;
    F.lds = (LAS unsigned char*)lds_raw;
    F.tid = threadIdx.x; F.lane = F.tid & 63; F.wave = __builtin_amdgcn_readfirstlane(F.tid >> 6);
    F.G = gridDim.x; F.bid = blockIdx.x; F.in = args.in; F.ws = args.ws; F.out = args.out;
    const int wave0 = F.wave;
    volatile LAS unsigned* MISC = (volatile LAS unsigned*)(F.lds + MISC_OFF);
    LAS int* pref = (LAS int*)(F.lds + MISC_OFF + 256);
    if (F.tid < 4) MISC[F.tid] = 0u;
    __syncthreads();
    const int lo = args.ph_lo, hi = args.ph_hi;
    XcdBarrier bar; bar.bar = (unsigned*)(F.ws + WS_CTL) + CW_BAR; bar.x = 0; bar.st = MISC;
    if (hi - lo > 1) bar = xcd_barrier_post((unsigned*)(F.ws + WS_CTL) + CW_BAR, MISC);
#ifndef PHASE_MASK
#define PHASE_MASK 0xFFFF
#endif
#define PM(j) ((PHASE_MASK >> (j)) & 1)
#define ENTER() do { F.ws = launder_ptr(F.ws); F.out = launder_ptr(F.out); l = launder_int(l); { int ln_; asm volatile("v_mbcnt_lo_u32_b32 %0, -1, 0\n\tv_mbcnt_hi_u32_b32 %0, -1, %0" : "=&v"(ln_)); __builtin_assume(ln_ >= 0 && ln_ < 64); F.lane = ln_; F.wave = launder_int(wave0); __builtin_assume(F.wave >= 0 && F.wave < 8); F.tid = F.wave * 64 + ln_; } } while (0)
#define IN(k) (lo <= (k) && (k) < hi)
#define last (l == DEPTH - 1)
#define SEAM(k) do { if (hi > (k) + 1) xcd_barrier(bar); } while (0)

    if (PM(11) && IN(0)) { phase_prologue(F); SEAM(0); }
    for (int l = 0; l < DEPTH; ++l) {
        const int pb = 1 + l * PH_PER_LAYER;
        if (PM(0) && l == 0 && IN(pb + 0)) { ENTER(); phase_norm0(F); SEAM(pb + 0); }
        if (PM(1) && IN(pb + 1)) {
            ENTER();
            pg8::StaticOrder S; S.init(WSP(bf16_t, WS_N), WSP(bf16_t, WS_WIN) + (size_t)l * PW * D, M_ALL, PW, D, F.G, F.bid);
            pg8::EpiF32 E{WSP(float, WS_P), PW};
            pg8::gemm_phase(F.lds, S, E, F.tid);
            SEAM(pb + 1);
        }
        if (PM(2) && IN(pb + 2)) {
            ENTER();
#ifndef SUBM
#define SUBM 7
#endif
            if (SUBM & 1) prep_hyena(F, l, !last); __syncthreads(); if (SUBM & 2) prep_rwkv(F, l); __syncthreads(); if (SUBM & 4) prep_gdn(F, l); SEAM(pb + 2); }
        if (PM(3) && IN(pb + 3)) {
            ENTER();
            if (SUBM & 1) gdn_precompute(F);
            for (int c = F.bid; c < 256; c += F.G) { if (SUBM & 2) hyena_lat_unit(F, l, c); if ((SUBM & 4) && !last) hyena_ctx_unit(F, l, c); }
            SEAM(pb + 3);
        }
        if (PM(4) && IN(pb + 4)) {
            ENTER();
            for (int u = F.bid; u < 256; u += F.G) { if (u < 128) { if (SUBM & 1) rwkv_scan_unit(F, u >> 1, u & 1); } else { if (SUBM & 2) gdn_chain_unit(F, (u - 128) >> 1, (u - 128) & 1); } }
            SEAM(pb + 4);
        }
        if (PM(5) && IN(pb + 5)) { ENTER(); phase_finish(F, l, !last); SEAM(pb + 5); }
        if (PM(6) && IN(pb + 6)) {
            ENTER();
            const int r0 = last ? M_CTX : 0;
            pg8::StaticOrder S; S.init(WSP(bf16_t, WS_YCAT) + (size_t)r0 * D, WSP(bf16_t, WS_WOUT) + (size_t)l * D * D, M_ALL - r0, D, D, F.G, F.bid);
            pg8::EpiRes E{WSP(float, WS_H) + (size_t)r0 * D, WSP(float, WS_H) + (size_t)r0 * D, WSP(float, WS_MODS) + (size_t)l * 9 * (NMOD * D) + 2 * D, r0};
            pg8::gemm_phase(F.lds, S, E, F.tid);
            SEAM(pb + 6);
        }
        if (PM(7) && IN(pb + 7)) { ENTER(); phase_router(F, l, last ? M_CTX : 0); SEAM(pb + 7); }
        if (PM(8) && IN(pb + 8)) {
            ENTER();
            moe_prefix(F, l, pref);
            pg8::MoeOrder<true, 8> S; S.A = WSP(bf16_t, WS_N); S.Bt = WSP(bf16_t, WS_WGU) + (size_t)l * NE * 2048 * D; S.K = D; S.Nexp = 2048; S.pref = pref; S.stok = WSP(int, WS_STOK); S.G = F.G; S.c = F.bid;
            pg8::EpiGU E{WSP(bf16_t, WS_ACT), F.in[I_MBGU] + (size_t)l * NE * 2048};
            pg8::gemm_phase(F.lds, S, E, F.tid);
            SEAM(pb + 8);
        }
        if (PM(9) && IN(pb + 9)) {
            ENTER();
            moe_prefix(F, l, pref);
            pg8::MoeOrder<false, 4> S; S.A = WSP(bf16_t, WS_ACT); S.Bt = WSP(bf16_t, WS_WDN) + (size_t)l * NE * D * FF; S.K = FF; S.Nexp = D; S.pref = pref; S.stok = nullptr; S.G = F.G; S.c = F.bid;
            pg8::EpiDN E{WSP(bf16_t, WS_YB), F.in[I_MBDN] + (size_t)l * NE * D};
            pg8::gemm_phase(F.lds, S, E, F.tid);
            SEAM(pb + 9);
        }
        if (PM(10) && IN(pb + 10)) { ENTER(); moe_prefix(F, l, pref); phase_combine(F, l, last ? M_CTX : 0, pref); SEAM(pb + 10); }
    }
#undef IN
#undef SEAM
#undef last
}


#ifdef DBG_CHECK
__global__ void __launch_bounds__(NT, 2) dbg_kernel(Args args) {
    extern __shared__ __attribute__((aligned(16))) unsigned char lds_raw[];
    Frame F;
    F.lds = (LAS unsigned char*)lds_raw;
    F.tid = threadIdx.x; F.lane = F.tid & 63; F.wave = __builtin_amdgcn_readfirstlane(F.tid >> 6);
    F.G = gridDim.x; F.bid = blockIdx.x; F.in = args.in; F.ws = args.ws; F.out = args.out;
    LAS int* pref = (LAS int*)(F.lds + MISC_OFF + 256);
    const int l = DEPTH - 1;
    if (args.ph_lo == 0) {
        if (DBG_CHECK == 1) { moe_prefix(F, l, pref); dbg_moe(F, l, pref); }
        if (DBG_CHECK == 2) { if (F.bid < 8) dbg_gdn(F, F.bid * 8 + (F.bid & 1) + 2 * (F.bid % 4)); }
        if (DBG_CHECK == 3) dbg_hyena(F, l);
        if (DBG_CHECK == 4) dbg_static(F);
        if (DBG_CHECK == 5) dbg_prep(F, l);
        if (DBG_CHECK == 6) dbg_router(F, l);
        if (DBG_CHECK == 7) { if (F.bid < 8 && F.wave == 0) dbg_rwkv_scan(F, F.bid * 8 + (F.bid & 1) + 2 * (F.bid % 4)); }
    } else dbg_scale(F, DBG_K);
}
#endif
extern "C" void kernel_launch(void* const* d_in, const int* in_sizes, int n_in, void* d_out, int out_size, void* d_ws, size_t ws_size, hipStream_t stream) {
    static int grid = 0;
    if (grid == 0) {
        int dev = 0, cus = 0, per_cu = 0;
        if (n_in != 43 || ws_size < WS_END) { fprintf(stderr, "kernel_launch: unexpected inputs (%d) or workspace (%zu < %zu)\n", n_in, ws_size, (size_t)WS_END); grid = -1; return; }
        if (hipGetDevice(&dev) != hipSuccess || hipDeviceGetAttribute(&cus, hipDeviceAttributeMultiprocessorCount, dev) != hipSuccess) { grid = -1; return; }
        if (hipFuncSetAttribute((const void*)hybrid_fwd, hipFuncAttributeMaxDynamicSharedMemorySize, LDS_BYTES) != hipSuccess) { fprintf(stderr, "kernel_launch: hipFuncSetAttribute failed\n"); grid = -1; return; }
        if (hipOccupancyMaxActiveBlocksPerMultiprocessor(&per_cu, (const void*)hybrid_fwd, NT, LDS_BYTES) != hipSuccess || per_cu < 1) fprintf(stderr, "kernel_launch: occupancy query reports %d\n", per_cu);
        (void)hipGetLastError();
        grid = cus;
    }
    if (grid < 0) return;
    (void)hipMemsetAsync((char*)d_ws + WS_CTL, 0, CTL_ZERO, stream);
    Args a{};
    for (int i = 0; i < 43; ++i) a.in[i] = (const float*)d_in[i];
    a.out = (float*)d_out; a.ws = (unsigned char*)d_ws;
#if N_LAUNCH_MODE == 1
    a.ph_lo = 0; a.ph_hi = N_PHASES;
    hipLaunchKernelGGL(hybrid_fwd, dim3(grid), dim3(NT), LDS_BYTES, stream, a);
#else
    const int nph = N_PHASES;
    for (int ph = 0; ph < nph; ++ph) {
        if (ph > 0 && ph < N_PHASES && (ph - 1) % PH_PER_LAYER == 0 && (ph - 1) / PH_PER_LAYER > 0) continue;
        a.ph_lo = ph; a.ph_hi = ph + 1;
        hipLaunchKernelGGL(hybrid_fwd, dim3(grid), dim3(NT), LDS_BYTES, stream, a);
    }
#ifdef DBG_CHECK
    static int dbg_init = 0;
    if (!dbg_init) { (void)hipFuncSetAttribute((const void*)dbg_kernel, hipFuncAttributeMaxDynamicSharedMemorySize, LDS_BYTES); dbg_init = 1; }
    a.ph_lo = 0; a.ph_hi = 1; hipLaunchKernelGGL(dbg_kernel, dim3(grid), dim3(NT), LDS_BYTES, stream, a);
    a.ph_lo = 1; a.ph_hi = 2; hipLaunchKernelGGL(dbg_kernel, dim3(grid), dim3(NT), LDS_BYTES, stream, a);
#endif
#endif
}
```

```cpp
#include <hip/hip_runtime.h>
#include <cstdio>
#include <cstdint>

#ifndef N_LAUNCH_MODE
#define N_LAUNCH_MODE 1
#endif

#define LAS __attribute__((address_space(3)))
#define GAS __attribute__((address_space(1)))
typedef unsigned short bf16_t;
typedef short bf16x8 __attribute__((ext_vector_type(8)));
typedef float f32x4 __attribute__((ext_vector_type(4)));
typedef float f32x2 __attribute__((ext_vector_type(2)));
typedef unsigned u32x4 __attribute__((ext_vector_type(4)));
typedef unsigned u32x2 __attribute__((ext_vector_type(2)));

constexpr int NCHUNK = 36;
constexpr int D = 1024, NB = 8, SEQ = 2048, CTX = 256, DEPTH = 4;
constexpr int M_CTX = NB * CTX;
constexpr int M_LAT = NB * SEQ;
constexpr int M_ALL = M_CTX + M_LAT;
constexpr int NMOD = 6;
constexpr int PW = 4096;
constexpr int IN_COLS = 3984;
constexpr int C_HY = 0, C_RW = 768, C_GD = 1920;
constexpr int RWC = 1152;
constexpr int NE = 32, TOPK = 4, FF = 1024;
constexpr int NT = 512, NWV = 8;

constexpr size_t MiB = 1ull << 20;
constexpr size_t WS_CTL   = 0;
constexpr size_t CTL_ZERO = 2 * MiB;
constexpr size_t WS_MODS  = 2 * MiB;
constexpr size_t WS_FILT  = 4 * MiB;
constexpr size_t WS_FILTC = 20 * MiB;
constexpr size_t WS_LORA  = 22 * MiB;
constexpr size_t LORA_L = 196608;
constexpr size_t WS_WIN   = 24 * MiB;
constexpr size_t WS_WOUT  = 56 * MiB;
constexpr size_t WS_WGU   = 64 * MiB;
constexpr size_t WS_WDN   = 576 * MiB;
constexpr size_t WS_H     = 832 * MiB;
constexpr size_t WS_N     = 904 * MiB;
constexpr size_t WS_P     = 940 * MiB;
constexpr size_t WS_RW    = 1228 * MiB;
constexpr size_t WS_RWBON = 1408 * MiB;
constexpr size_t WS_GQKV  = 1410 * MiB;
constexpr size_t WS_QB = WS_GQKV, WS_KB = WS_GQKV + 20 * MiB, WS_KT = WS_GQKV + 40 * MiB, WS_VT = WS_GQKV + 60 * MiB;
constexpr size_t WS_GBG   = 1518 * MiB;
constexpr size_t WS_VVT   = 1520 * MiB;
constexpr size_t WS_YT    = 1540 * MiB;
constexpr size_t WS_RWO   = 1560 * MiB;
constexpr size_t WS_GDO   = 1596 * MiB;
constexpr size_t WS_GPRE  = 1668 * MiB;
constexpr size_t WS_YCAT  = 1884 * MiB;
constexpr size_t WS_STOK  = 1920 * MiB;
constexpr size_t WS_TOKE  = 1924 * MiB;
constexpr size_t WS_ACT   = 1928 * MiB;
constexpr size_t WS_YB    = 2088 * MiB;
constexpr size_t WS_END   = 2248 * MiB;

constexpr int CW_BAR = 4096;
constexpr int CW_CNT = 16384;

constexpr int LDS_BYTES = 155648;
constexpr int MISC_OFF  = 153600;
constexpr int SCR_BYTES = 153600;

typedef __bf16 hwbf16x2 __attribute__((ext_vector_type(2)));
__device__ __forceinline__ unsigned pk2(float lo, float hi) { const f32x2 v = {lo, hi}; return __builtin_bit_cast(unsigned, __builtin_convertvector(v, hwbf16x2)); }
__device__ __forceinline__ unsigned f2bf(float f) { return (unsigned)__builtin_bit_cast(unsigned short, (__bf16)f); }
__device__ __forceinline__ float bf2f(unsigned short b) { return __builtin_bit_cast(float, ((unsigned)b) << 16); }
template <int CTRL> __device__ __forceinline__ float dppf(float x) {
    return __builtin_bit_cast(float, __builtin_amdgcn_update_dpp(0, __builtin_bit_cast(int, x), CTRL, 0xF, 0xF, true));
}
__device__ __forceinline__ float row16_sum(float x) {
    x += dppf<0xB1>(x);
    x += dppf<0x4E>(x);
    x += dppf<0x141>(x);
    x += dppf<0x140>(x);
    return x;
}
__device__ __forceinline__ float wave_sum(float v) {
    v = row16_sum(v);
    v += __builtin_bit_cast(float, __builtin_amdgcn_update_dpp(0, __builtin_bit_cast(int, v), 0x142, 0xA, 0xF, false));
    v += __builtin_bit_cast(float, __builtin_amdgcn_update_dpp(0, __builtin_bit_cast(int, v), 0x143, 0xC, 0xF, false));
    return __builtin_bit_cast(float, __builtin_amdgcn_readlane(__builtin_bit_cast(int, v), 63));
}
__device__ __forceinline__ float sigmoidf_(float x) { return __builtin_amdgcn_rcpf(1.0f + __expf(-x)); }
__device__ __forceinline__ float siluf_(float x) { return x * __builtin_amdgcn_rcpf(1.0f + __expf(-x)); }
__device__ __forceinline__ float softplusf_(float x) { return x > 20.f ? x : log1pf(__expf(x)); }
__device__ __forceinline__ int launder_int(int x) { asm volatile("" : "+v"(x)); return __builtin_amdgcn_readfirstlane(x); }
template <class T> __device__ __forceinline__ T* launder_ptr(T* p) {
    unsigned long long u = (unsigned long long)p; unsigned lo = (unsigned)u, hi = (unsigned)(u >> 32);
    asm volatile("" : "+v"(lo), "+v"(hi));
    lo = __builtin_amdgcn_readfirstlane(lo); hi = __builtin_amdgcn_readfirstlane(hi);
    return (T*)(GAS T*)(((unsigned long long)hi << 32) | lo);
}

#define XB_TMO      128
#define XB_XCNT(j)  (256  + 64 * (j))
#define XB_XSUB(j)  (1280 + 64 * (j))
#define XB_XGEN(j)  (2304 + 64 * (j))
#define XB_TOP      3328
#define XB_TOPGEN   3392
#define XCD_BAR_WORDS 3456
#define XB_SPIN_CAP (1u << 24)

__device__ __forceinline__ unsigned xb_ld(unsigned* p)              { return __hip_atomic_load(p, __ATOMIC_RELAXED, __HIP_MEMORY_SCOPE_AGENT); }
__device__ __forceinline__ unsigned xb_add(unsigned* p, unsigned v) { return __hip_atomic_fetch_add(p, v, __ATOMIC_RELAXED, __HIP_MEMORY_SCOPE_AGENT); }
__device__ __forceinline__ unsigned xb_xcc_id() { return (unsigned)__builtin_amdgcn_s_getreg((3 << 11) | 20) & 0xFu; }
#define XB_SPIN(cond, bar) do { unsigned _sp = 0; while (cond) { __builtin_amdgcn_s_sleep(1); \
    if ((++_sp & 255u) == 0u) { if (xb_ld(&(bar)[XB_TMO])) break; if (_sp > XB_SPIN_CAP) { atomicAdd(&(bar)[XB_TMO], 1u); break; } } } } while (0)

struct XcdBarrier { unsigned* bar; unsigned x; volatile LAS unsigned* st; };

__device__ __forceinline__ XcdBarrier xcd_barrier_post(unsigned* bar, volatile LAS unsigned* st) {
    XcdBarrier b; b.bar = bar; b.x = xb_xcc_id(); b.st = st;
    if (threadIdx.x == 0) (void)xb_add(&bar[XB_XCNT(b.x)], 1u);
    return b;
}
__device__ __forceinline__ void xcd_barrier_complete(unsigned* bar, unsigned x, unsigned& nloc, unsigned& nx) {
    const unsigned G = gridDim.x * gridDim.y * gridDim.z;
    unsigned sum, cnt, mine, sp = 0u;
    for (;;) {
        sum = 0u; cnt = 0u; mine = 0u;
#pragma unroll
        for (unsigned j = 0; j < 16; ++j) { const unsigned c = xb_ld(&bar[XB_XCNT(j)]); sum += c; cnt += (c > 0u) ? 1u : 0u; mine = (j == x) ? c : mine; }
        if (sum == G) break;
        __builtin_amdgcn_s_sleep(1);
        if ((++sp & 255u) == 0u) { if (xb_ld(&bar[XB_TMO])) break; if (sp > XB_SPIN_CAP) { atomicAdd(&bar[XB_TMO], 1u); break; } }
    }
    nloc = mine > 0u ? mine : 1u; nx = cnt > 0u ? cnt : 1u;
}
__device__ __forceinline__ void xcd_barrier(const XcdBarrier& b) {
    asm volatile("s_waitcnt vmcnt(0)" ::: "memory");
    __syncthreads();
    if (threadIdx.x == 0) {
        unsigned* bar = b.bar;
        __builtin_amdgcn_s_waitcnt(0);
        unsigned nloc = b.st[0], nx = b.st[1];
        if (nloc == 0u) { xcd_barrier_complete(bar, b.x, nloc, nx); b.st[0] = nloc; b.st[1] = nx; }
        const unsigned old = xb_add(&bar[XB_XSUB(b.x)], 1u);
        const unsigned gen = old / nloc;
        if (old + 1u == (gen + 1u) * nloc) {
            __builtin_amdgcn_fence(__ATOMIC_RELEASE, "agent");
            asm volatile("s_waitcnt vmcnt(0)" ::: "memory");
            const unsigned og = xb_add(&bar[XB_TOP], 1u);
            const unsigned tg = og / nx;
            if (og + 1u == (tg + 1u) * nx) xb_add(&bar[XB_TOPGEN], 1u);
            else XB_SPIN(xb_ld(&bar[XB_TOPGEN]) == tg, bar);
            __builtin_amdgcn_fence(__ATOMIC_ACQUIRE, "agent");
            xb_add(&bar[XB_XGEN(b.x)], 1u);
            asm volatile("s_waitcnt vmcnt(0)" ::: "memory");
        } else {
            XB_SPIN(xb_ld(&bar[XB_XGEN(b.x)]) == gen, bar);
            __builtin_amdgcn_fence(__ATOMIC_ACQUIRE, "agent");
            asm volatile("s_waitcnt vmcnt(0)" ::: "memory");
        }
    }
    __syncthreads();
}

namespace pg8 {
constexpr int BM = 256, BK = 64, HALF = 128, HTB = HALF * BK * 2, STAGE_BYTES = 8 * HTB, NXCD = 8, WGM = 8;
__host__ __device__ __forceinline__ int lds_byte(int r, int c) { const int st = (r >> 4) * 2 + (c >> 5), rr = r & 15, cc = c & 31, ob = rr * 64 + cc * 2; return st * 1024 + (ob ^ (((ob >> 9) & 1) << 5)); }
__host__ __device__ __forceinline__ void stage_rc(int b, int& R, int& C) { const int st = b / 1024, sb = b % 1024, swz = sb ^ (((sb >> 9) & 1) << 5); R = (st >> 1) * 16 + swz / 64; C = (st & 1) * 32 + (swz % 64) / 2; }
__host__ __device__ __forceinline__ int perm32(int rho) { const int n = rho >> 4, i = rho & 15; return 8 * (i >> 2) + 4 * n + (i & 3); }

struct Unit { int pm, pn, e, j, rows; };

struct StaticOrder {
    static constexpr bool GATHER = false;
    const bf16_t* A; const bf16_t* Bt; int K;
    int nM, nN, nwg, G, c;
    __device__ void init(const bf16_t* A_, const bf16_t* Bt_, int M, int N, int K_, int G_, int c_) { A = A_; Bt = Bt_; K = K_; nM = M / BM; nN = N / BM; nwg = nM * nN; G = G_; c = c_; }
    __device__ bool next(int i, Unit& u) const {
        const long L = (long)i * G + c; if (L >= nwg) return false;
        int wgid = (int)L; { const int q = nwg / NXCD, r = nwg % NXCD, xcd = wgid % NXCD, off = wgid / NXCD; wgid = (xcd < r ? xcd * (q + 1) : r * (q + 1) + (xcd - r) * q) + off; }
        const int nig = WGM * nN, gid = wgid / nig, fm = gid * WGM, gsz = (nM - fm) < WGM ? (nM - fm) : WGM;
        u.pm = fm + ((wgid % nig) % gsz); u.pn = (wgid % nig) / gsz; u.e = 0; u.j = 0; u.rows = BM; return true;
    }
    __device__ __forceinline__ const char* a_base(const Unit& u) const { return (const char*)A + (size_t)u.pm * (size_t)(2 * HALF) * K * 2; }
    __device__ __forceinline__ const char* b_base(const Unit& u) const { return (const char*)Bt + (size_t)u.pn * (size_t)(2 * HALF) * K * 2; }
    __device__ __forceinline__ unsigned gather_row(const Unit&, int) const { return 0u; }
};
template <bool GATHER_, int NPN> struct MoeOrder {
    static constexpr bool GATHER = GATHER_;
    const bf16_t* A; const bf16_t* Bt; int K, Nexp;
    const LAS int* pref;
    const int* stok;
    int G, c;
    __device__ bool next(int i, Unit& u) const {
        int e = -1, t;
        if ((G & 7) == 0) {
            const int x = c & 7; t = i * (G >> 3) + (c >> 3);
#pragma unroll
            for (int q = 0; q < 4; ++q) { const int ee = x + 8 * q; const int nt = (__builtin_amdgcn_readfirstlane(pref[ee + 1]) - __builtin_amdgcn_readfirstlane(pref[ee])) * NPN;
                if (e < 0) { if (t < nt) e = ee; else t -= nt; } }
            if (e < 0) return false;
        } else {
            const int L = i * G + c; const int nU = __builtin_amdgcn_readfirstlane(pref[32]) * NPN; if (L >= nU) return false;
            const int rb = L / NPN; e = 0;
            for (int q = 1; q < 32; ++q) e = (__builtin_amdgcn_readfirstlane(pref[q]) <= rb) ? q : e;
            t = (rb - __builtin_amdgcn_readfirstlane(pref[e])) * NPN + L % NPN;
        }
        u.e = e; u.j = t / NPN; u.pn = t % NPN; u.pm = __builtin_amdgcn_readfirstlane(pref[e]) + u.j;
        const int rem = __builtin_amdgcn_readfirstlane(pref[64 + e]) - u.j * BM; u.rows = rem < BM ? rem : BM; return true;
    }
    __device__ __forceinline__ const char* a_base(const Unit& u) const { return GATHER ? (const char*)A : (const char*)A + (size_t)u.pm * (size_t)(2 * HALF) * K * 2; }
    __device__ __forceinline__ const char* b_base(const Unit& u) const { return (const char*)Bt + ((size_t)u.e * Nexp + (size_t)u.pn * BM) * K * 2; }
    __device__ __forceinline__ unsigned gather_row(const Unit& u, int r) const { const int* base = stok + ((size_t)u.e * M_ALL + (size_t)u.j * BM); const unsigned rr = (unsigned)(r < u.rows ? r : u.rows - 1) & 255u; return (unsigned)base[rr]; }
};

__device__ __forceinline__ unsigned cvt_pk_bf16(float lo, float hi) { unsigned r; asm volatile("v_cvt_pk_bf16_f32 %0, %1, %2" : "=v"(r) : "v"(lo), "v"(hi)); return r; }

struct EpiF32 {
    static constexpr bool PERM = false;
    float* C; int ldc;
    __device__ __forceinline__ void operator()(const f32x4 (&acc)[2][2][4][2], const Unit& u, int wr, int wc, int fr, int fq) const {
        const int row0 = u.pm * BM + wr * 64 + fr, col0 = u.pn * BM + wc * 32 + 4 * fq;
#pragma unroll
        for (int ai = 0; ai < 2; ++ai)
#pragma unroll
            for (int m = 0; m < 4; ++m) { float* rowp = C + (size_t)(row0 + ai * HALF + m * 16) * ldc + col0;
#pragma unroll
                for (int bj = 0; bj < 2; ++bj)
#pragma unroll
                    for (int n = 0; n < 2; ++n) *(f32x4*)(rowp + bj * HALF + n * 16) = acc[ai][bj][m][n]; }
    }
};
struct EpiRes {
    static constexpr bool PERM = false;
    const float* base; float* out; const float* gate; int row0g;
    __device__ __forceinline__ void operator()(const f32x4 (&acc)[2][2][4][2], const Unit& u, int wr, int wc, int fr, int fq) const {
        const int row0 = u.pm * BM + wr * 64 + fr, col0 = u.pn * BM + wc * 32 + 4 * fq;
        const int grow = row0g + u.pm * BM; const int r = grow < M_CTX ? 8 : (grow - M_CTX) / SEQ;
        f32x4 gv[2][2];
#pragma unroll
        for (int bj = 0; bj < 2; ++bj)
#pragma unroll
            for (int n = 0; n < 2; ++n) gv[bj][n] = *(const f32x4*)(gate + (size_t)r * (NMOD * D) + col0 + bj * HALF + n * 16);
#pragma unroll
        for (int ai = 0; ai < 2; ++ai)
#pragma unroll
            for (int m = 0; m < 4; ++m) { const size_t off = (size_t)(row0 + ai * HALF + m * 16) * D + col0;
#pragma unroll
                for (int bj = 0; bj < 2; ++bj)
#pragma unroll
                    for (int n = 0; n < 2; ++n) { const f32x4 b = *(const f32x4*)(base + off + bj * HALF + n * 16);
                        *(f32x4*)(out + off + bj * HALF + n * 16) = b + gv[bj][n] * acc[ai][bj][m][n]; } }
    }
};
struct EpiGU {
    static constexpr bool PERM = true;
    bf16_t* O; const float* bias;
    __device__ __forceinline__ void operator()(const f32x4 (&acc)[2][2][4][2], const Unit& u, int wr, int wc, int fr, int fq) const {
        const int row0 = u.pm * BM + wr * 64 + fr, col0 = u.pn * HALF + wc * 32 + 8 * fq;
        const float* bp = bias + (size_t)u.e * 2048 + col0;
        f32x4 bg[2], bu[2];
#pragma unroll
        for (int n = 0; n < 2; ++n) { bg[n] = *(const f32x4*)(bp + 4 * n); bu[n] = *(const f32x4*)(bp + 1024 + 4 * n); }
#pragma unroll
        for (int ai = 0; ai < 2; ++ai)
#pragma unroll
            for (int m = 0; m < 4; ++m) { bf16_t* rowp = O + (size_t)(row0 + ai * HALF + m * 16) * FF + col0;
                float o[8];
#pragma unroll
                for (int n = 0; n < 2; ++n)
#pragma unroll
                    for (int i = 0; i < 4; ++i) { float g = acc[ai][0][m][n][i] + bg[n][i], up = acc[ai][1][m][n][i] + bu[n][i];
                        g = fminf(g, 7.0f); up = fminf(fmaxf(up, -7.0f), 7.0f);
                        const float glu = g * __builtin_amdgcn_rcpf(1.0f + __expf(-1.702f * g)); o[n * 4 + i] = (up + 1.0f) * glu; }
                u32x4 w; w.x = cvt_pk_bf16(o[0], o[1]); w.y = cvt_pk_bf16(o[2], o[3]); w.z = cvt_pk_bf16(o[4], o[5]); w.w = cvt_pk_bf16(o[6], o[7]);
                *(u32x4*)rowp = w; }
    }
};
struct EpiDN {
    static constexpr bool PERM = true;
    bf16_t* O; const float* bias;
    __device__ __forceinline__ void operator()(const f32x4 (&acc)[2][2][4][2], const Unit& u, int wr, int wc, int fr, int fq) const {
        const int row0 = u.pm * BM + wr * 64 + fr, col0 = u.pn * BM + wc * 32 + 8 * fq;
        const float* bp = bias + (size_t)u.e * 1024 + col0;
        f32x4 bv[2][2];
#pragma unroll
        for (int bj = 0; bj < 2; ++bj)
#pragma unroll
            for (int n = 0; n < 2; ++n) bv[bj][n] = *(const f32x4*)(bp + bj * HALF + 4 * n);
#pragma unroll
        for (int ai = 0; ai < 2; ++ai)
#pragma unroll
            for (int m = 0; m < 4; ++m) { bf16_t* rowp = O + (size_t)(row0 + ai * HALF + m * 16) * D + col0;
#pragma unroll
                for (int bj = 0; bj < 2; ++bj) { const f32x4 v0 = acc[ai][bj][m][0] + bv[bj][0], v1 = acc[ai][bj][m][1] + bv[bj][1];
                    u32x4 w; w.x = cvt_pk_bf16(v0[0], v0[1]); w.y = cvt_pk_bf16(v0[2], v0[3]); w.z = cvt_pk_bf16(v1[0], v1[1]); w.w = cvt_pk_bf16(v1[2], v1[3]);
                    *(u32x4*)(rowp + bj * HALF) = w; } }
    }
};

template <class Epi, class Sched>
__device__ __forceinline__ void gemm_phase(LAS unsigned char* lds, const Sched& S, const Epi& E, const int tid) {
    constexpr bool GATHER = Sched::GATHER;
    const int wid = __builtin_amdgcn_readfirstlane(tid >> 6), lane = tid & 63, wr = wid >> 2, wc = wid & 3, fr = lane & 15, fq = lane >> 4;
    const int K = S.K, nt = K / BK;
    unsigned voffA[2], voffB[2]; int RA[2], CA[2];
#pragma unroll
    for (int i = 0; i < 2; ++i) { int R, C; stage_rc(tid * 16 + i * 8192, R, C); const int Rb = Epi::PERM ? ((R & ~31) + perm32(R & 31)) : R;
        RA[i] = R; CA[i] = C; voffA[i] = (unsigned)(R * K + C) * 2u; voffB[i] = (unsigned)(Rb * K + C) * 2u; }
    const size_t kstep = (size_t)(BK * 2);
    const size_t hstep = (size_t)HALF * K * 2;
    const unsigned ldsw = (unsigned)wid * 1024u;
    const int aoff = lds_byte(wr * 64 + fr, fq * 8), boff = lds_byte(wc * 32 + fr, fq * 8);
#define PG8_SA(b, h) (((b) * 2 + (h)) * HTB)
#define PG8_SB(b, h) ((4 + (b) * 2 + (h)) * HTB)
#define PG8_STAGE(bufoff, gbase, voff) do { _Pragma("unroll") for (int _i = 0; _i < 2; ++_i) \
        __builtin_amdgcn_global_load_lds((const unsigned*)((const char*)(gbase) + (voff)[_i]), (LAS unsigned*)(lds + (bufoff) + ldsw + _i * 8192), 16, 0, 0); } while (0)
#define PG8_STAGE2(bufoff, gbase, v0, v1) do { \
        __builtin_amdgcn_global_load_lds((const unsigned*)((const char*)(gbase) + (v0)), (LAS unsigned*)(lds + (bufoff) + ldsw), 16, 0, 0); \
        __builtin_amdgcn_global_load_lds((const unsigned*)((const char*)(gbase) + (v1)), (LAS unsigned*)(lds + (bufoff) + ldsw + 8192), 16, 0, 0); } while (0)
#define PG8_LDA(dst, b, h) do { _Pragma("unroll") for (int m = 0; m < 4; ++m) _Pragma("unroll") for (int k = 0; k < 2; ++k) dst[m][k] = *(const LAS bf16x8*)(lds + PG8_SA(b, h) + aoff + m * 2048 + k * 1024); } while (0)
#define PG8_LDB(dst, b, h) do { _Pragma("unroll") for (int n = 0; n < 2; ++n) _Pragma("unroll") for (int k = 0; k < 2; ++k) dst[n][k] = *(const LAS bf16x8*)(lds + PG8_SB(b, h) + boff + n * 2048 + k * 1024); } while (0)
#define PG8_MMA(ai, bj, At, Bt) do { __builtin_amdgcn_s_setprio(1); _Pragma("unroll") for (int m = 0; m < 4; ++m) _Pragma("unroll") for (int n = 0; n < 2; ++n) _Pragma("unroll") for (int k = 0; k < 2; ++k) \
        acc[ai][bj][m][n] = __builtin_amdgcn_mfma_f32_16x16x32_bf16(Bt[n][k], At[m][k], acc[ai][bj][m][n], 0, 0, 0); __builtin_amdgcn_s_setprio(0); } while (0)
#define PG8_WAIT_V(n) asm volatile("s_waitcnt vmcnt(" #n ")" ::: "memory")
#define PG8_WAIT_L(n) asm volatile("s_waitcnt lgkmcnt(" #n ")" ::: "memory")
#define PG8_BAR __builtin_amdgcn_s_barrier()
#define PG8_SCHED __builtin_amdgcn_sched_barrier(0)
    unsigned pc[2] = {0u, 0u}, pn_[2] = {0u, 0u};
    const unsigned R0 = (unsigned)RA[0], C2 = (unsigned)(CA[0] * 2);
#define PG8_PACK(p, u) do { _Pragma("unroll") for (int _h = 0; _h < 2; ++_h) p[_h] = S.gather_row(u, _h * HALF + R0) | (S.gather_row(u, _h * HALF + 64 + R0) << 16); } while (0)
#define PG8_AOFF(p, h, i) (GATHER ? ((((p)[h] >> (16 * (i))) & 0xffffu) * (unsigned)(K * 2) + C2) : ((unsigned)((h) * hstep) + voffA[i]))
#define PG8_STAGEA(bufoff, gbase, p, h) PG8_STAGE2(bufoff, gbase, PG8_AOFF(p, h, 0), PG8_AOFF(p, h, 1))
    Unit cur, nxt; int ui = 0;
    if (!S.next(0, cur)) return;
    f32x4 acc[2][2][4][2];
#pragma unroll
    for (int a = 0; a < 2; ++a)
#pragma unroll
        for (int b = 0; b < 2; ++b)
#pragma unroll
            for (int m = 0; m < 4; ++m)
#pragma unroll
                for (int n = 0; n < 2; ++n) acc[a][b][m][n] = (f32x4){0.f, 0.f, 0.f, 0.f};
    bf16x8 At[4][2], B0[2][2], B1[2][2];
    const char* cA = S.a_base(cur); const char* cB = S.b_base(cur);
    if (GATHER) PG8_PACK(pc, cur);
    PG8_STAGE(PG8_SB(0, 0), cB, voffB); PG8_STAGEA(PG8_SA(0, 0), cA, pc, 0); PG8_STAGE(PG8_SB(0, 1), cB + hstep, voffB); PG8_STAGEA(PG8_SA(0, 1), cA, pc, 1);
    if (wr == 1) PG8_BAR;
    PG8_WAIT_V(4); PG8_BAR;
    PG8_STAGE(PG8_SB(1, 0), cB + kstep, voffB); PG8_STAGEA(PG8_SA(1, 0), cA + kstep, pc, 0); PG8_STAGE(PG8_SB(1, 1), cB + hstep + kstep, voffB);
    PG8_WAIT_V(6); PG8_BAR;
    for (;;) {
        const bool has_next = S.next(ui + 1, nxt);
        const char* nA = has_next ? S.a_base(nxt) : cA; const char* nB = has_next ? S.b_base(nxt) : cB;
        if (GATHER) { if (has_next) { PG8_PACK(pn_, nxt); } else { pn_[0] = pc[0]; pn_[1] = pc[1]; } }
        for (int t = 0; t < nt; t += 2) {
            const bool last = (t == nt - 2);
            const char* a1 = cA + (size_t)(t + 1) * kstep;
            const char* a2 = last ? nA : cA + (size_t)(t + 2) * kstep; const char* b2 = last ? nB : cB + (size_t)(t + 2) * kstep;
            const char* a3 = a2 + kstep; const char* b3 = b2 + kstep;
            PG8_LDB(B0, 0, 0); PG8_SCHED; PG8_LDA(At, 0, 0); PG8_STAGEA(PG8_SA(1, 1), a1, pc, 1);
            PG8_WAIT_L(8); PG8_BAR; PG8_WAIT_L(0); PG8_MMA(0, 0, At, B0); PG8_BAR; PG8_SCHED;
            PG8_LDB(B1, 0, 1); PG8_STAGE(PG8_SB(0, 0), b2, voffB);
            PG8_BAR; PG8_WAIT_L(0); PG8_MMA(0, 1, At, B1); PG8_BAR;
            PG8_LDA(At, 0, 1); { const unsigned pq[2] = {last ? pn_[0] : pc[0], 0u}; PG8_STAGEA(PG8_SA(0, 0), a2, pq, 0); }
            PG8_BAR; PG8_WAIT_L(0); PG8_MMA(1, 0, At, B0); PG8_BAR; PG8_SCHED;
            PG8_STAGE(PG8_SB(0, 1), b2 + hstep, voffB);
            PG8_WAIT_V(6); PG8_BAR; PG8_MMA(1, 1, At, B1); PG8_BAR;
            PG8_LDB(B0, 1, 0); PG8_SCHED; PG8_LDA(At, 1, 0); { const unsigned pq[2] = {0u, last ? pn_[1] : pc[1]}; PG8_STAGEA(PG8_SA(0, 1), a2, pq, 1); }
            PG8_WAIT_L(8); PG8_BAR; PG8_WAIT_L(0); PG8_MMA(0, 0, At, B0); PG8_BAR; PG8_SCHED;
            PG8_LDB(B1, 1, 1); PG8_STAGE(PG8_SB(1, 0), b3, voffB);
            PG8_BAR; PG8_WAIT_L(0); PG8_MMA(0, 1, At, B1); PG8_BAR;
            PG8_LDA(At, 1, 1); { const unsigned pq[2] = {last ? pn_[0] : pc[0], 0u}; PG8_STAGEA(PG8_SA(1, 0), a3, pq, 0); }
            PG8_BAR; PG8_WAIT_L(0); PG8_MMA(1, 0, At, B0); PG8_BAR; PG8_SCHED;
            PG8_STAGE(PG8_SB(1, 1), b3 + hstep, voffB);
            PG8_WAIT_V(6); PG8_BAR; PG8_MMA(1, 1, At, B1); PG8_BAR;
        }
        E(acc, cur, wr, wc, fr, fq);
        if (!has_next) break;
#pragma unroll
        for (int a = 0; a < 2; ++a)
#pragma unroll
            for (int b = 0; b < 2; ++b)
#pragma unroll
                for (int m = 0; m < 4; ++m)
#pragma unroll
                    for (int n = 0; n < 2; ++n) acc[a][b][m][n] = (f32x4){0.f, 0.f, 0.f, 0.f};
        cur = nxt; cA = nA; cB = nB; ++ui; pc[0] = pn_[0]; pc[1] = pn_[1];
    }
    PG8_WAIT_V(0);
    if (wr == 0) PG8_BAR;
    PG8_BAR;
#undef PG8_SA
#undef PG8_SB
#undef PG8_STAGE
#undef PG8_STAGE2
#undef PG8_LDA
#undef PG8_LDB
#undef PG8_MMA
#undef PG8_WAIT_V
#undef PG8_WAIT_L
#undef PG8_BAR
#undef PG8_SCHED
#undef PG8_PACK
#undef PG8_AOFF
#undef PG8_STAGEA
}
}

struct Args { const float* in[43]; float* out; unsigned char* ws; int ph_lo, ph_hi; };
enum { I_X = 0, I_C, I_CTX, I_CCTX, I_ADAW, I_ADAB, I_NMIX, I_NFFN, I_NFIN, I_WIN, I_WOUT, I_HSW, I_HSB, I_HW1, I_HB1, I_HW2, I_HB2, I_HW3, I_HB3, I_HW4,
       I_HFREQ, I_HSKIP, I_RMU, I_RW0, I_RW2, I_RA0, I_RA2, I_RG2, I_RKK, I_RKA, I_RRK, I_RGNW, I_RGNB, I_GCONV, I_GALOG, I_GDT, I_GNW,
       I_MRW, I_MRB, I_MWGU, I_MBGU, I_MWDN, I_MBDN };

struct Frame {
    LAS unsigned char* lds;
    int tid, lane, wave, G, bid;
    const float* const* in;
    unsigned char* ws;
    float* out;
};
#define WSP(T, off) ((T*)(F.ws + (off)))
#define LDS_WAIT() asm volatile("s_waitcnt lgkmcnt(0)" ::: "memory")

__device__ __forceinline__ int row_batch(int row) { return row < M_CTX ? row / CTX : (row - M_CTX) / SEQ; }
__device__ __forceinline__ int row_modr(int row) { return row < M_CTX ? 8 : (row - M_CTX) / SEQ; }

__device__ __forceinline__ void p0_transpose_item(const float* W, int K, int N, bf16_t* WT, int k0, int n0, int drow0, LAS float* scr, int lane) {
    { float tv[32]; const int n = n0 + (lane & 31);
#pragma unroll
      for (int i = 0; i < 32; ++i) { const int kk = 2 * i + (lane >> 5); tv[i] = (n < N) ? W[(size_t)(k0 + kk) * N + n] : 0.f; }
      asm volatile("" ::: "memory");
#pragma unroll
      for (int i = 0; i < 32; ++i) { const int kk = 2 * i + (lane >> 5); scr[kk * 33 + (lane & 31)] = tv[i]; } }
    LDS_WAIT(); asm volatile("" ::: "memory");
    const int c = lane & 7;
#pragma unroll
    for (int j = 0; j < 4; ++j) { const int n = (lane >> 3) + 8 * j; const LAS float* s = scr + (8 * c) * 33 + n;
        u32x4 o; o.x = pk2(s[0 * 33], s[1 * 33]); o.y = pk2(s[2 * 33], s[3 * 33]); o.z = pk2(s[4 * 33], s[5 * 33]); o.w = pk2(s[6 * 33], s[7 * 33]);
        *(u32x4*)(WT + (size_t)(drow0 + n) * K + k0 + 8 * c) = o; }
    LDS_WAIT(); asm volatile("" ::: "memory");
}

__device__ __forceinline__ void phase_prologue(Frame& F) {
    const int gw = F.bid * NWV + F.wave, NGW = F.G * NWV;
    {
        LAS float* scr = (LAS float*)(F.lds + F.wave * 16384);
        constexpr int I_IN = 16 * 128, I_OUT = 16 * 32, I_GU = 16 * 64, I_DN = 16 * 32;
        constexpr int T_IN = DEPTH * I_IN, T_OUT = DEPTH * I_OUT, T_GU = DEPTH * NE * I_GU, T_DN = DEPTH * NE * I_DN;
        for (int it = gw; it < T_IN + T_OUT + T_GU + T_DN; it += NGW) {
            int r = it;
            if (r < T_IN) { const int l = r / I_IN, q = r % I_IN, kb = q / 128, nb = q % 128;
                p0_transpose_item(F.in[I_WIN] + (size_t)l * D * IN_COLS, D, IN_COLS, WSP(bf16_t, WS_WIN) + (size_t)l * PW * D, kb * 64, nb * 32, nb * 32, scr, F.lane); continue; }
            r -= T_IN;
            if (r < T_OUT) { const int l = r / I_OUT, q = r % I_OUT, kb = q / 32, nb = q % 32;
                p0_transpose_item(F.in[I_WOUT] + (size_t)l * D * D, D, D, WSP(bf16_t, WS_WOUT) + (size_t)l * D * D, kb * 64, nb * 32, nb * 32, scr, F.lane); continue; }
            r -= T_OUT;
            if (r < T_GU) { const int le = r / I_GU, q = r % I_GU, kb = q / 64, nb = q % 64; const int n0 = nb * 32;
                const int j = n0 & 1023, drow = 256 * (j >> 7) + (n0 >= 1024 ? 128 : 0) + (j & 127);
                p0_transpose_item(F.in[I_MWGU] + (size_t)le * D * 2048, D, 2048, WSP(bf16_t, WS_WGU) + (size_t)le * 2048 * D, kb * 64, n0, drow, scr, F.lane); continue; }
            r -= T_GU;
            { const int le = r / I_DN, q = r % I_DN, kb = q / 32, nb = q % 32;
                p0_transpose_item(F.in[I_MWDN] + (size_t)le * FF * D, FF, D, WSP(bf16_t, WS_WDN) + (size_t)le * D * FF, kb * 64, nb * 32, nb * 32, scr, F.lane); }
        }
    }
    {
        LAS float* scr = (LAS float*)(F.lds + F.wave * 16384);
        for (int it = gw; it < DEPTH * 48; it += NGW) { const int l = it / 48, q = it % 48; bf16_t* dst = (bf16_t*)(F.ws + WS_LORA + (size_t)l * LORA_L);
            if (q < 16) { const int d = q >> 3, nb = q & 7; p0_transpose_item(F.in[I_RW2] + ((size_t)l * 2 + d) * 64 * 256, 64, 256, dst + d * 256 * 64, 0, nb * 32, nb * 32, scr, F.lane); }
            else if (q < 32) { const int d = (q - 16) >> 3, nb = q & 7; p0_transpose_item(F.in[I_RA2] + ((size_t)l * 2 + d) * 64 * 256, 64, 256, dst + 2 * 256 * 64 + d * 256 * 64, 0, nb * 32, nb * 32, scr, F.lane); }
            else { const int kb = (q - 32) >> 3, nb = q & 7; p0_transpose_item(F.in[I_RG2] + (size_t)l * 128 * 256, 128, 256, dst + 4 * 256 * 64, kb * 64, nb * 32, nb * 32, scr, F.lane); } }
    }
    __syncthreads();
    {
        LAS float* sl = (LAS float*)F.lds;
        LAS float* red = sl + 9 * 1024;
        for (int i = F.tid; i < 9 * 1024; i += NT) { const float v = (i < 8 * 1024) ? F.in[I_C][i] : F.in[I_CCTX][i - 8 * 1024]; sl[i] = siluf_(v); }
        __syncthreads();
        float* mods = WSP(float, WS_MODS);
        const int kh = F.lane >> 5, cl = F.lane & 31;
        for (int it = F.bid; it < DEPTH * (NMOD * D / 32); it += F.G) {
            const int l = it / (NMOD * D / 32), nb = it % (NMOD * D / 32);
            const float* W = F.in[I_ADAW] + (size_t)l * D * (NMOD * D) + nb * 32 + cl;
            float a[9];
#pragma unroll
            for (int r = 0; r < 9; ++r) a[r] = 0.f;
            const int kbase = F.wave * 128 + kh * 64;
#pragma unroll 1
            for (int kb4 = 0; kb4 < 4; ++kb4) { float wv[16];
#pragma unroll
              for (int k = 0; k < 16; ++k) wv[k] = W[(size_t)(kbase + kb4 * 16 + k) * (NMOD * D)];
              asm volatile("" ::: "memory");
#pragma unroll
              for (int k = 0; k < 16; ++k) {
#pragma unroll
                for (int r = 0; r < 9; ++r) a[r] += sl[r * 1024 + kbase + kb4 * 16 + k] * wv[k]; } }
#pragma unroll
            for (int r = 0; r < 9; ++r) red[((F.wave * 2 + kh) * 9 + r) * 32 + cl] = a[r];
            __syncthreads();
            if (F.tid < 9 * 32) { const int r = F.tid / 32, cc = F.tid % 32; float s = 0.f;
#pragma unroll
                for (int p = 0; p < 16; ++p) s += red[(p * 9 + r) * 32 + cc];
                mods[((size_t)l * 9 + r) * (NMOD * D) + nb * 32 + cc] = s + F.in[I_ADAB][(size_t)l * (NMOD * D) + nb * 32 + cc]; }
            __syncthreads();
        }
    }
    __syncthreads();
    {
        LAS float* hb = (LAS float*)F.lds;
        LAS float* hx = hb + 32 * 512 + F.wave * 256;
        constexpr int NB_LAT = SEQ / 32, NB_CTX = CTX / 32, NB_L = NB_LAT + NB_CTX;
        for (int it = F.bid; it < DEPTH * NB_L; it += F.G) {
            const int l = it / NB_L, q = it % NB_L; const bool isctx = q >= NB_LAT; const int L = isctx ? CTX : SEQ; const int p0 = (isctx ? q - NB_LAT : q) * 32;
            const float* w1 = F.in[I_HW1] + (size_t)l * 33 * 64; const float* b1 = F.in[I_HB1] + l * 64;
            const float* w2 = F.in[I_HW2] + (size_t)l * 64 * 64; const float* b2 = F.in[I_HB2] + l * 64;
            const float* w3 = F.in[I_HW3] + (size_t)l * 64 * 64; const float* b3 = F.in[I_HB3] + l * 64;
            const float* w4 = F.in[I_HW4] + (size_t)l * 64 * 512; const float fr = F.in[I_HFREQ][l * 64 + F.lane];
            { float tq[4], av[4];
#pragma unroll
              for (int pp = 0; pp < 4; ++pp) { const int p = p0 + F.wave * 4 + pp; tq[pp] = (float)p / (float)(L - 1);
                float z = 0.f;
                if (F.lane == 0) z = tq[pp];
                else if (F.lane < 33) { const int bi = (F.lane - 1) & 15; const float band = 1e-4f + (float)bi * ((15.0f - 1e-4f) / 15.0f);
                    const float ang = (6.283185307179586f / (float)L) * (float)p * band; z = (F.lane <= 16) ? cosf(ang) : -sinf(ang); }
                hx[pp * 64 + F.lane] = z; }
              LDS_WAIT();
              { const float bb = b1[F.lane]; float wv[33];
#pragma unroll
                for (int i = 0; i < 33; ++i) wv[i] = w1[i * 64 + F.lane];
                asm volatile("" ::: "memory");
#pragma unroll
                for (int pp = 0; pp < 4; ++pp) { float a = bb;
#pragma unroll
                    for (int i = 0; i < 33; ++i) a += hx[pp * 64 + i] * wv[i];
                    av[pp] = sinf(fr * a); } }
              LDS_WAIT();
#pragma unroll
              for (int pp = 0; pp < 4; ++pp) hx[pp * 64 + F.lane] = av[pp];
              LDS_WAIT();
#pragma unroll 1
              for (int ly = 0; ly < 2; ++ly) { const float* wl_ = ly ? w3 : w2; const float bb = (ly ? b3 : b2)[F.lane];
                float a4[4] = {bb, bb, bb, bb};
#pragma unroll 1
                for (int ib = 0; ib < 2; ++ib) { float wv[32];
#pragma unroll
                  for (int i = 0; i < 32; ++i) wv[i] = wl_[(ib * 32 + i) * 64 + F.lane];
                  asm volatile("" ::: "memory");
#pragma unroll
                  for (int pp = 0; pp < 4; ++pp)
#pragma unroll
                    for (int i = 0; i < 32; ++i) a4[pp] += hx[pp * 64 + ib * 32 + i] * wv[i]; }
                LDS_WAIT();
#pragma unroll
                for (int pp = 0; pp < 4; ++pp) hx[pp * 64 + F.lane] = sinf(fr * a4[pp]);
                LDS_WAIT(); }
              float o[4][8];
#pragma unroll
              for (int pp = 0; pp < 4; ++pp)
#pragma unroll
                for (int j = 0; j < 8; ++j) o[pp][j] = 0.f;
#pragma unroll 1
              for (int ib = 0; ib < 16; ++ib) { float wv[4][8];
#pragma unroll
                  for (int ii = 0; ii < 4; ++ii)
#pragma unroll
                      for (int j = 0; j < 8; ++j) wv[ii][j] = w4[(ib * 4 + ii) * 512 + j * 64 + F.lane];
                  asm volatile("" ::: "memory");
#pragma unroll
                  for (int pp = 0; pp < 4; ++pp)
#pragma unroll
                    for (int ii = 0; ii < 4; ++ii) { const float hv = hx[pp * 64 + ib * 4 + ii];
#pragma unroll
                        for (int j = 0; j < 8; ++j) o[pp][j] += hv * wv[ii][j]; } }
#pragma unroll
              for (int pp = 0; pp < 4; ++pp) { const int pl = F.wave * 4 + pp;
#pragma unroll
                for (int j = 0; j < 8; ++j) { const int n = j * 64 + F.lane; const int ch = n & 255;
                    const float dl = -3.0701134573253946f + (float)ch * ((-15.350567286626973f + 3.0701134573253946f) / 255.0f);
                    hb[pl * 512 + n] = o[pp][j] * __expf(-tq[pp] * fabsf(dl)); } }
              LDS_WAIT();
            }
            __syncthreads();
            float* filt = isctx ? WSP(float, WS_FILTC) + (size_t)l * 256 * (2 * CTX) : WSP(float, WS_FILT) + (size_t)l * 256 * (2 * SEQ);
            for (int i = F.tid; i < 512 * 32; i += NT) { const int n = i >> 5, pl = i & 31, p = p0 + pl, ch = n & 255; const float v = hb[pl * 512 + n];
                if (n < 256) filt[(size_t)ch * (2 * L) + L + p] = v + (p == 0 ? F.in[I_HSKIP][l * 256 + ch] : 0.f);
                else if (p >= 1) filt[(size_t)ch * (2 * L) + L - p] = v;
                if (n >= 256 && p == 0) filt[(size_t)ch * (2 * L)] = 0.f; }
            __syncthreads();
        }
    }
}

template <bool TO_LDS>
__device__ __forceinline__ void norm_mod_row(const float* __restrict__ xrow, const float* __restrict__ nw, const float* __restrict__ shift, const float* __restrict__ scale, bf16_t* __restrict__ orow, LAS float* lrow, int lane) {
    f32x4 v[4], w[4], sh[4], sc[4]; float s = 0.f;
#pragma unroll
    for (int j = 0; j < 4; ++j) { const int c = 4 * lane + 256 * j; v[j] = *(const f32x4*)(xrow + c); w[j] = *(const f32x4*)(nw + c); sh[j] = *(const f32x4*)(shift + c); sc[j] = *(const f32x4*)(scale + c); }
    asm volatile("" ::: "memory");
#pragma unroll
    for (int j = 0; j < 4; ++j) s += (v[j].x * v[j].x + v[j].y * v[j].y) + (v[j].z * v[j].z + v[j].w * v[j].w);
    const float rstd = rsqrtf(wave_sum(s) * (1.f / D) + 1e-6f);
#pragma unroll
    for (int j = 0; j < 4; ++j) { const int c = 4 * lane + 256 * j;
        const f32x4 o = (v[j] * rstd) * w[j] * (sc[j] + 1.0f) + sh[j];
        u32x2 p; p.x = pk2(o.x, o.y); p.y = pk2(o.z, o.w);
        *(u32x2*)(orow + c) = p;
        if (TO_LDS) *(LAS f32x4*)(lrow + c) = o; }
}

__device__ __forceinline__ void phase_norm0(Frame& F) {
    const int gw = F.bid * NWV + F.wave, NGW = F.G * NWV;
    const float* mods = WSP(float, WS_MODS);
    bf16_t* N = WSP(bf16_t, WS_N);
    for (int row = gw; row < M_ALL; row += NGW) {
        const float* src = row < M_CTX ? F.in[I_CTX] + (size_t)row * D : F.in[I_X] + (size_t)(row - M_CTX) * D;
        const float* mr = mods + (size_t)row_modr(row) * (NMOD * D);
        norm_mod_row<false>(src, F.in[I_NMIX], mr, mr + D, N + (size_t)row * D, (LAS float*)F.lds, F.lane);
        float* hrow = WSP(float, WS_H) + (size_t)row * D;
#pragma unroll
        for (int j = 0; j < 4; ++j) *(f32x4*)(hrow + 4 * F.lane + 256 * j) = *(const f32x4*)(src + 4 * F.lane + 256 * j);
    }
}

template <class Fin>
__device__ __forceinline__ void mm_lds(const LAS bf16_t* A, int lda, const LAS bf16_t* Bt, int ldb, int M, int N, int K, int wave, int lane, Fin fin) {
    const int tn = N >> 4, ntile = (M >> 4) * tn, fr = lane & 15, fq = lane >> 4;
    for (int tI = wave; tI < ntile; tI += NWV) {
        const int i0 = (tI / tn) << 4, j0 = (tI % tn) << 4;
        f32x4 acc = (f32x4){0.f, 0.f, 0.f, 0.f};
        const LAS bf16_t* ap = A + (i0 + fr) * lda + fq * 8; const LAS bf16_t* bp = Bt + (j0 + fr) * ldb + fq * 8;
        for (int k = 0; k < K; k += 32) { const bf16x8 a = *(const LAS bf16x8*)(ap + k); const bf16x8 b = *(const LAS bf16x8*)(bp + k);
            acc = __builtin_amdgcn_mfma_f32_16x16x32_bf16(a, b, acc, 0, 0, 0); }
#pragma unroll
        for (int r = 0; r < 4; ++r) fin(i0 + fq * 4 + r, j0 + fr, acc[r]);
    }
}


struct TileSched { int v0, v1, v2; int bid, G, N; bool bal;
    __device__ __forceinline__ int first() const { return bal ? v0 : (bid < N ? bid : -1); }
    __device__ __forceinline__ int next(int it) const { return bal ? (it == 1 ? v1 : (it == 2 ? v2 : -1)) : (bid + it * G < N ? bid + it * G : -1); } };
__device__ __forceinline__ TileSched strided_sched(const Frame& F, int N) { TileSched t; t.v0 = t.v1 = t.v2 = -1; t.bid = F.bid; t.G = F.G; t.N = N; t.bal = false; return t; }
#define TILE_LOOP(u, ts) for (int it_ = 0, u = (ts).first(); u >= 0; u = (ts).next(++it_))
__device__ __forceinline__ void prep_hyena(Frame& F, int l, bool with_ctx_hy, const TileSched ts) {
    const float* __restrict__ P = WSP(float, WS_P);
    float* __restrict__ VVT = WSP(float, WS_VVT);
    const float* sw = F.in[I_HSW] + (size_t)l * 3 * 768; const float* sb = F.in[I_HSB] + (size_t)l * 768;
    LAS float* tile = (LAS float*)F.lds;
    TILE_LOOP(u, ts) {
        const int row0 = u * 64; const bool isctx = row0 < M_CTX; if (isctx && !with_ctx_hy) continue;
        const int L = isctx ? CTX : SEQ; const int b = row_batch(row0); const int t0 = isctx ? row0 - b * CTX : row0 - M_CTX - b * SEQ;
        const int c = F.tid & 255, th = F.tid >> 8;
        const float w1a = sw[0 * 768 + 256 + c], w1b = sw[1 * 768 + 256 + c], w1c = sw[2 * 768 + 256 + c], b1 = sb[256 + c];
        const float wva = sw[0 * 768 + 512 + c], wvb = sw[1 * 768 + 512 + c], wvc = sw[2 * 768 + 512 + c], bv = sb[512 + c];
        { const float* pc = P + (size_t)(row0 + th * 32) * PW + c; float xa[34], xv[34];
#pragma unroll
          for (int k = 0; k < 34; ++k) { const int t = t0 + th * 32 + k - 1; const bool ok = (t >= 0 && t < L); xa[k] = ok ? pc[(ptrdiff_t)(k - 1) * PW + 256] : 0.f; xv[k] = ok ? pc[(ptrdiff_t)(k - 1) * PW + 512] : 0.f; }
          asm volatile("" ::: "memory");
#pragma unroll
          for (int tt = 0; tt < 32; ++tt) { const float x1 = b1 + w1a * xa[tt] + w1b * xa[tt + 1] + w1c * xa[tt + 2]; const float vv = bv + wva * xv[tt] + wvb * xv[tt + 1] + wvc * xv[tt + 2];
              tile[c * 65 + th * 32 + tt] = x1 * vv; } }
        __syncthreads();
        const int pos0 = isctx ? t0 : CTX + t0;
        for (int i = F.tid; i < 256 * 64; i += NT) { const int cc = i >> 6, tl = i & 63;
            VVT[((size_t)cc * NB + b) * (CTX + SEQ) + pos0 + tl] = tile[cc * 65 + tl]; }
        __syncthreads();
    }
}

__device__ __forceinline__ float rw_mix(const float* P, const float* mu, int row, int cc, bool isctx, int t) {
    const float* pr = P + (size_t)row * PW + C_RW + cc; const int m4 = cc & 3; int off; bool ok;
    if (isctx) { const bool ev = (m4 & 1) == 0; off = ev ? -PW : PW; ok = ev ? (t > 0) : (t < CTX - 1); }
    else { const int gr = t >> 6, gc = t & 63;
        off = (m4 == 0) ? -PW : ((m4 == 1) ? PW : ((m4 == 2) ? -64 * PW : 64 * PW));
        ok = (m4 == 0) ? (gc > 0) : ((m4 == 1) ? (gc < 63) : ((m4 == 2) ? (gr > 0) : (gr < 31))); }
    const float p = pr[0]; float sh = pr[ok ? off : 0]; sh = ok ? sh : 0.f;
    return p + mu[cc] * (sh - p);
}
__device__ __forceinline__ void prep_rwkv(Frame& F, int l, const TileSched ts) {
    const float* __restrict__ P = WSP(float, WS_P);
    float* __restrict__ RW = WSP(float, WS_RW); float* __restrict__ BON = WSP(float, WS_RWBON);
    const float* __restrict__ mu = F.in[I_RMU] + (size_t)l * RWC;
    const float* __restrict__ w0 = F.in[I_RW0] + (size_t)l * 512; const float* __restrict__ a0 = F.in[I_RA0] + (size_t)l * 512;
    const float* __restrict__ kkw = F.in[I_RKK] + l * 256; const float* __restrict__ kaw = F.in[I_RKA] + l * 256; const float* __restrict__ rkw = F.in[I_RRK] + l * 256;
    const bf16_t* lora = (const bf16_t*)(F.ws + WS_LORA + (size_t)l * LORA_L);
    LAS bf16_t* lin = (LAS bf16_t*)F.lds;
    LAS float* R = (LAS float*)(F.lds + 25088);
    LAS float* R2 = (LAS float*)(F.lds + 58880);
    const int tid = F.tid, lane = F.lane, wave = F.wave, fr = lane & 15, fq = lane >> 4;
    TILE_LOOP(u, ts) {
        const int row0 = u * 32; const bool isctx = row0 < M_CTX; const int b = row_batch(row0); const int t0 = isctx ? row0 - b * CTX : row0 - M_CTX - b * SEQ;
        bf16x8 Wn[8];
#define RWP_LOADW(p) do { if ((p) < 4) { _Pragma("unroll") for (int n2 = 0; n2 < 2; ++n2) _Pragma("unroll") for (int ks = 0; ks < 2; ++ks) \
              Wn[n2 * 2 + ks] = *(const GAS bf16x8*)(lora + (p) * 256 * 64 + ((2 * wave + n2) * 16 + fr) * 64 + ks * 32 + fq * 8); } \
          else { _Pragma("unroll") for (int n2 = 0; n2 < 2; ++n2) _Pragma("unroll") for (int ks = 0; ks < 4; ++ks) \
              Wn[n2 * 4 + ks] = *(const GAS bf16x8*)(lora + 4 * 256 * 64 + ((2 * wave + n2) * 16 + fr) * 128 + ks * 32 + fq * 8); } } while (0)
        RWP_LOADW(0);
        { const int c = tid & 127, tq = tid >> 7, m4 = c & 3;
          int off;
          if (isctx) off = ((m4 & 1) == 0) ? -PW : PW; else off = (m4 == 0) ? -PW : ((m4 == 1) ? PW : ((m4 == 2) ? -64 * PW : 64 * PW));
          const float mu0 = mu[768 + c], mu1 = mu[896 + c], mu2 = mu[1024 + c];
#pragma unroll 1
          for (int hb = 0; hb < 2; ++hb) { float pv[4][3], sv[4][3]; bool okv[4];
#pragma unroll
            for (int k = 0; k < 4; ++k) { const int tok = tq * 8 + hb * 4 + k, t = t0 + tok; bool ok;
                if (isctx) ok = ((m4 & 1) == 0) ? (t > 0) : (t < CTX - 1);
                else { const int gr = t >> 6, gc = t & 63; ok = (m4 == 0) ? (gc > 0) : ((m4 == 1) ? (gc < 63) : ((m4 == 2) ? (gr > 0) : (gr < 31))); }
                okv[k] = ok;
                const float* pr = P + (size_t)(row0 + tok) * PW + C_RW + 768 + c; const float* ps = pr + (ok ? off : 0);
#pragma unroll
                for (int g = 0; g < 3; ++g) { pv[k][g] = pr[g * 128]; sv[k][g] = ps[g * 128]; } }
            asm volatile("" ::: "memory");
#pragma unroll
            for (int k = 0; k < 4; ++k) { const int tok = tq * 8 + hb * 4 + k;
                const float s0 = okv[k] ? sv[k][0] : 0.f, s1 = okv[k] ? sv[k][1] : 0.f, s2 = okv[k] ? sv[k][2] : 0.f;
                const float m0 = pv[k][0] + mu0 * (s0 - pv[k][0]), m1 = pv[k][1] + mu1 * (s1 - pv[k][1]), m2 = pv[k][2] + mu2 * (s2 - pv[k][2]);
                lin[tok * 392 + c] = (bf16_t)f2bf(1.0f - 2.0f * __builtin_amdgcn_rcpf(1.0f + __expf(2.0f * m0)));
                lin[tok * 392 + 128 + c] = (bf16_t)f2bf(m1);
                lin[tok * 392 + 256 + c] = (bf16_t)f2bf(sigmoidf_(m2)); } } }
#pragma unroll
        for (int pass = 0; pass < 5; ++pass) {
            bf16x8 Wc[8];
#pragma unroll
            for (int i = 0; i < 8; ++i) Wc[i] = Wn[i];
            __syncthreads();
#pragma unroll
            for (int m = 0; m < 2; ++m) { f32x4 acc[2] = {(f32x4){0.f, 0.f, 0.f, 0.f}, (f32x4){0.f, 0.f, 0.f, 0.f}};
                if (pass < 4) {
#pragma unroll
                    for (int ks = 0; ks < 2; ++ks) { const bf16x8 A = *(const LAS bf16x8*)(lin + (m * 16 + fr) * 392 + pass * 64 + ks * 32 + fq * 8);
                        acc[0] = __builtin_amdgcn_mfma_f32_16x16x32_bf16(A, Wc[ks], acc[0], 0, 0, 0); acc[1] = __builtin_amdgcn_mfma_f32_16x16x32_bf16(A, Wc[2 + ks], acc[1], 0, 0, 0); } }
                else {
#pragma unroll
                    for (int ks = 0; ks < 4; ++ks) { const bf16x8 A = *(const LAS bf16x8*)(lin + (m * 16 + fr) * 392 + 256 + ks * 32 + fq * 8);
                        acc[0] = __builtin_amdgcn_mfma_f32_16x16x32_bf16(A, Wc[ks], acc[0], 0, 0, 0); acc[1] = __builtin_amdgcn_mfma_f32_16x16x32_bf16(A, Wc[4 + ks], acc[1], 0, 0, 0); } }
#pragma unroll
                for (int n2 = 0; n2 < 2; ++n2)
#pragma unroll
                    for (int r = 0; r < 4; ++r) (pass == 2 ? R2 : R)[(m * 16 + 4 * fq + r) * 260 + (2 * wave + n2) * 16 + fr] = acc[n2][r]; }
            if (pass < 4) { RWP_LOADW(pass + 1); asm volatile("" ::: "memory"); }
            __syncthreads();
            if (pass < 2) { const int d = pass; const float w0c = w0[d * 256 + (tid & 255)];
                for (int i = tid; i < 32 * 256; i += NT) { const int tok = i >> 8, c = i & 255; const float xw = w0c + R[tok * 260 + c];
                    RW[(size_t)(row0 + tok) * 2560 + (3 + 3 * d) * 256 + c] = __expf(-0.6065306597126334f * sigmoidf_(xw)); } }
            else if (pass == 2) { }
            else if (pass == 3) {
                const int c4 = 4 * lane;
                const f32x4 pk4 = *(const f32x4*)(kkw + c4), pa4 = *(const f32x4*)(kaw + c4), pr4 = *(const f32x4*)(rkw + c4), p04 = *(const f32x4*)(a0 + c4), p14 = *(const f32x4*)(a0 + 256 + c4);
                f32x4 mu4[3];
#pragma unroll
                for (int g = 0; g < 3; ++g) mu4[g] = *(const f32x4*)(mu + 256 * g + c4);
                f32x4 pn[3], sn[3][4]; bool okn[4];
#define RWT_LOAD(tk_) do { const int tok_ = wave * 4 + ((tk_) < 4 ? (tk_) : 3), t_ = t0 + tok_; int of_[4]; \
                    if (isctx) { okn[0] = okn[2] = (t_ > 0); okn[1] = okn[3] = (t_ < CTX - 1); of_[0] = of_[2] = -PW; of_[1] = of_[3] = PW; } \
                    else { const int gr = t_ >> 6, gc = t_ & 63; okn[0] = gc > 0; okn[1] = gc < 63; okn[2] = gr > 0; okn[3] = gr < 31; of_[0] = -PW; of_[1] = PW; of_[2] = -64 * PW; of_[3] = 64 * PW; } \
                    const float* pr_ = P + (size_t)(row0 + tok_) * PW + C_RW + c4; \
                    _Pragma("unroll") for (int g = 0; g < 3; ++g) { pn[g] = *(const f32x4*)(pr_ + 256 * g); \
                        _Pragma("unroll") for (int k = 0; k < 4; ++k) sn[g][k] = *(const f32x4*)(pr_ + 256 * g + (okn[k] ? of_[k] : 0)); } \
                    asm volatile("" ::: "memory"); } while (0)
                RWT_LOAD(0);
#pragma unroll 1
                for (int tk = 0; tk < 4; ++tk) { const int tok = wave * 4 + tk, row = row0 + tok; float* o = RW + (size_t)row * 2560;
                    f32x4 mx[3];
#pragma unroll
                    for (int g = 0; g < 3; ++g) { const f32x4 p = pn[g];
                        const f32x4 sh = (f32x4){okn[0] ? sn[g][0].x : 0.f, okn[1] ? sn[g][1].y : 0.f, okn[2] ? sn[g][2].z : 0.f, okn[3] ? sn[g][3].w : 0.f};
                        mx[g] = p + mu4[g] * (sh - p); }
                    RWT_LOAD(tk + 1);
                    const f32x4 r_ = mx[0], k_ = mx[1];
                    const f32x4 kx = k_ * pk4;
                    const float ssq = row16_sum((kx.x * kx.x + kx.y * kx.y) + (kx.z * kx.z + kx.w * kx.w));
                    const f32x4 kk = kx * rsqrtf(ssq + 1e-12f);
                    const f32x4 xf = p04 + *(const LAS f32x4*)(R2 + tok * 260 + c4), xb = p14 + *(const LAS f32x4*)(R + tok * 260 + c4);
                    const f32x4 af = (f32x4){sigmoidf_(xf.x), sigmoidf_(xf.y), sigmoidf_(xf.z), sigmoidf_(xf.w)}, ab = (f32x4){sigmoidf_(xb.x), sigmoidf_(xb.y), sigmoidf_(xb.z), sigmoidf_(xb.w)};
                    const f32x4 kdf = k_ * (1.0f + (af - 1.0f) * pa4), kdb = k_ * (1.0f + (ab - 1.0f) * pa4);
                    *(f32x4*)(o + c4) = r_; *(f32x4*)(o + 256 + c4) = mx[2]; *(f32x4*)(o + 512 + c4) = kk;
                    *(f32x4*)(o + 4 * 256 + c4) = kdf; *(f32x4*)(o + 5 * 256 + c4) = kk * af; *(f32x4*)(o + 7 * 256 + c4) = kdb; *(f32x4*)(o + 8 * 256 + c4) = kk * ab;
                    const f32x4 bq = r_ * (kdf + kdb) * pr4;
                    const float bs = row16_sum((bq.x + bq.y) + (bq.z + bq.w));
                    if ((lane & 15) == 0) BON[(size_t)row * 4 + (lane >> 4)] = bs; }
#undef RWT_LOAD
            }
            else { for (int i = tid; i < 32 * 256; i += NT) { const int tok = i >> 8, c = i & 255; RW[(size_t)(row0 + tok) * 2560 + 9 * 256 + c] = R[tok * 260 + c]; } }
        }
        __syncthreads();
    }
}
#undef RWP_LOADW

__device__ __forceinline__ void prep_gdn(Frame& F, int l, const TileSched ts) {
    const float* __restrict__ P = WSP(float, WS_P);
    float* __restrict__ BG = WSP(float, WS_GBG);
    bf16_t* __restrict__ QB = WSP(bf16_t, WS_QB); bf16_t* __restrict__ KB = WSP(bf16_t, WS_KB); bf16_t* __restrict__ KT = WSP(bf16_t, WS_KT); bf16_t* __restrict__ VT = WSP(bf16_t, WS_VT);
    const float* __restrict__ cw = F.in[I_GCONV] + (size_t)l * 5 * 1536;
    LAS float* tile = (LAS float*)F.lds;
    const int tid = F.tid, lane = F.lane, wave = F.wave;
    TILE_LOOP(u, ts) {
        const int row0 = u * 64; const bool isctx = row0 < M_CTX; const int L = isctx ? CTX : SEQ; const int b = row_batch(row0); const int t0 = isctx ? row0 - b * CTX : row0 - M_CTX - b * SEQ;
        const int oc = (isctx ? 0 : 4) + (t0 >> 6);
        for (int i = tid; i < 64 * 16; i += NT) { const int tok = i >> 4, j = i & 15; const float rv = P[(size_t)(row0 + tok) * PW + C_GD + 2048 + j]; float ov;
            if (j < 8) ov = sigmoidf_(rv); else { const int dh = j - 8; ov = -__expf(F.in[I_GALOG][l * 8 + dh]) * softplusf_(rv + F.in[I_GDT][l * 8 + dh]); }
            BG[(size_t)(row0 + tok) * 16 + j] = ov; }
#pragma unroll 1
        for (int pass = 0; pass < 3; ++pass) {
            const int ch = pass * 512 + tid; const float* pc = P + (size_t)row0 * PW + C_GD + ch;
            const float w0 = cw[ch], w1 = cw[1536 + ch], w2 = cw[2 * 1536 + ch], w3 = cw[3 * 1536 + ch], w4 = cw[4 * 1536 + ch];
#define GLD(j) (((t0 + (j)) >= 0 && (t0 + (j)) < L) ? pc[(ptrdiff_t)(j) * PW] : 0.f)
            float xm2 = GLD(-2), xm1 = GLD(-1), x0 = GLD(0), x1 = GLD(1), x2 = GLD(2);
#pragma unroll 1
            for (int tb = 0; tb < 2; ++tb) { float nx[32];
#pragma unroll
                for (int e = 0; e < 32; ++e) nx[e] = GLD(tb * 32 + e + 3);
                asm volatile("" ::: "memory");
#pragma unroll
                for (int e = 0; e < 32; ++e) { const int tl = tb * 32 + e; const float a = (w0 * xm2 + w1 * xm1) + (w2 * x0 + w3 * x1) + w4 * x2;
                    tile[tl * 516 + tid] = siluf_(a);
                    xm2 = xm1; xm1 = x0; x0 = x1; x1 = x2; x2 = nx[e]; } }
#undef GLD
            __syncthreads();
            if (pass < 2) {
                for (int tk = 0; tk < 8; ++tk) { const int tl = wave * 8 + tk; float x[8];
#pragma unroll
                    for (int j = 0; j < 8; ++j) x[j] = tile[tl * 516 + lane + 64 * j];
#pragma unroll
                    for (int h4 = 0; h4 < 4; ++h4) { const float ss = wave_sum(x[2 * h4] * x[2 * h4] + x[2 * h4 + 1] * x[2 * h4 + 1]);
                        const float sc = rsqrtf(ss + 1e-12f) * (pass == 0 ? 0.08838834764831845f : 1.0f); x[2 * h4] *= sc; x[2 * h4 + 1] *= sc; }
#pragma unroll
                    for (int j = 0; j < 8; ++j) tile[tl * 516 + lane + 64 * j] = x[j]; }
                __syncthreads();
                bf16_t* dst = pass == 0 ? QB : KB;
                for (int i = tid; i < 64 * 64; i += NT) { const int tok = i >> 6, c8 = i & 63; const LAS float* sp = tile + tok * 516 + c8 * 8;
                    u32x4 p; p.x = pk2(sp[0], sp[1]); p.y = pk2(sp[2], sp[3]); p.z = pk2(sp[4], sp[5]); p.w = pk2(sp[6], sp[7]);
                    *(u32x4*)(dst + (size_t)(row0 + tok) * 512 + c8 * 8) = p; }
            }
            if (pass >= 1) {
                bf16_t* dst = pass == 1 ? KT : VT;
#pragma unroll 1
                for (int t8 = 0; t8 < 8; ++t8) { const LAS float* sp = tile + (t8 * 8) * 516 + tid;
                    u32x4 p; p.x = pk2(sp[0], sp[516]); p.y = pk2(sp[2 * 516], sp[3 * 516]); p.z = pk2(sp[4 * 516], sp[5 * 516]); p.w = pk2(sp[6 * 516], sp[7 * 516]);
                    *(u32x4*)(dst + ((size_t)((b * 4 + (tid >> 7)) * NCHUNK + oc) * 128 + (tid & 127)) * 64 + t8 * 8) = p; }
            }
            __syncthreads();
        }
    }
}

__device__ __forceinline__ int chain_row(int b, int d, int s) {
    if (s < CTX) { const int pos = d ? (CTX - 1 - s) : s; return b * CTX + pos; }
    const int q = s - CTX; const int pos = d ? (SEQ - 1 - q) : q; return M_CTX + b * SEQ + pos;
}
constexpr size_t GREC = 98304;
constexpr int GR_W = 0, GR_QG = 16384, GR_KT = 32768, GR_AT = 49152, GR_U = 57344, GR_EG = 90112;

__device__ __forceinline__ void gdn_precompute_wave(Frame& F, int ci, int n, LAS unsigned char* wl) {
    int lane_ = F.lane; asm volatile("" : "+v"(lane_));
    const int lane = lane_, fr = lane & 15, fq = lane >> 4;
    const int b = ci >> 3, h = (ci >> 1) & 3, d = ci & 1;
    LAS float* Tf = (LAS float*)wl;
    LAS bf16_t* MTb = (LAS bf16_t*)(wl + 17408);
    LAS float* gcv = (LAS float*)(wl + 26624); LAS float* betv = gcv + 64;
    const bool isctx = n < 4; const int np = isctx ? n : n - 4, nseg = isctx ? 4 : 32; const int ocs = d ? nseg - 1 - np : np;
    const int rowbase = (isctx ? b * CTX : M_CTX + b * SEQ) + ocs * 64; const int oc = (isctx ? 0 : 4) + ocs;
#define PROW(i) (rowbase + (d ? 63 - (i) : (i)))
    const GAS float* BG = (const GAS float*)WSP(float, WS_GBG);
    const GAS bf16_t* QB = (const GAS bf16_t*)WSP(bf16_t, WS_QB) + h * 128; const GAS bf16_t* KB = (const GAS bf16_t*)WSP(bf16_t, WS_KB) + h * 128;
    const GAS bf16_t* KT = (const GAS bf16_t*)WSP(bf16_t, WS_KT) + ((size_t)(b * 4 + h) * NCHUNK + oc) * 128 * 64;
    const GAS bf16_t* VT = (const GAS bf16_t*)WSP(bf16_t, WS_VT) + ((size_t)(b * 4 + h) * NCHUNK + oc) * 128 * 64;
    unsigned char* rec = F.ws + WS_GPRE + (size_t)(ci * NCHUNK + n) * GREC;
    const float bet = BG[(size_t)PROW(lane) * 16 + d * 4 + h]; const float g1 = BG[(size_t)PROW(lane) * 16 + 8 + d * 4 + h];
    gcv[lane] = g1; betv[lane] = bet;
    asm volatile("s_waitcnt lgkmcnt(0)" ::: "memory");
    float gc = 0.f, gl = 0.f;
#pragma unroll 8
    for (int j = 0; j < 64; ++j) { const float gj = gcv[j]; gl += gj; gc += (j <= lane) ? gj : 0.f; }
    asm volatile("s_waitcnt lgkmcnt(0)" ::: "memory");
    gcv[lane] = gc;
    asm volatile("s_waitcnt lgkmcnt(0)" ::: "memory");
    bf16x8 Kf[4][4], Qf[4][4];
#pragma unroll
    for (int t = 0; t < 4; ++t)
#pragma unroll
        for (int ks = 0; ks < 4; ++ks) { Kf[t][ks] = *(const GAS bf16x8*)(KB + (size_t)PROW(t * 16 + fr) * 512 + ks * 32 + fq * 8); Qf[t][ks] = *(const GAS bf16x8*)(QB + (size_t)PROW(t * 16 + fr) * 512 + ks * 32 + fq * 8); }
    asm volatile("" ::: "memory");
#pragma unroll
    for (int ti = 0; ti < 4; ++ti) {
#pragma unroll
        for (int tj = 0; tj < 4; ++tj) {
            __builtin_amdgcn_sched_barrier(0);
            if (tj > ti) { unsigned z_ = 0u; asm volatile("" : "+v"(z_)); *(GAS u32x2*)(rec + GR_AT + ((size_t)(ti * 16 + fr) * 64 + tj * 16 + 4 * fq) * 2) = (u32x2){z_, z_}; continue; }
            f32x4 kk = (f32x4){0.f, 0.f, 0.f, 0.f}, qk = kk;
#pragma unroll
            for (int ks = 0; ks < 4; ++ks) { kk = __builtin_amdgcn_mfma_f32_16x16x32_bf16(Kf[ti][ks], Kf[tj][ks], kk, 0, 0, 0);
                                             qk = __builtin_amdgcn_mfma_f32_16x16x32_bf16(Kf[tj][ks], Qf[ti][ks], qk, 0, 0, 0); }
            { const int j = tj * 16 + fr; const float gj = gcv[j]; f32x4 mv;
#pragma unroll
              for (int r = 0; r < 4; ++r) { const int i = ti * 16 + 4 * fq + r; mv[r] = (j < i) ? betv[i] * kk[r] * __expf(gcv[i] - gj) : 0.f; }
              u32x2 pm; pm.x = pk2(mv[0], mv[1]); pm.y = pk2(mv[2], mv[3]);
              *(LAS u32x2*)(MTb + j * 72 + ti * 16 + 4 * fq) = pm; }
            { const int i = ti * 16 + fr; const float gi = gcv[i]; float av[4];
#pragma unroll
              for (int r = 0; r < 4; ++r) { const int j = tj * 16 + 4 * fq + r; av[r] = (j <= i) ? qk[r] * __expf(gi - gcv[j]) : 0.f; }
              u32x2 pk; pk.x = pk2(av[0], av[1]); pk.y = pk2(av[2], av[3]);
              *(GAS u32x2*)(rec + GR_AT + ((size_t)i * 64 + tj * 16 + 4 * fq) * 2) = pk; }
        }
    }
    bf16x8 Vf[8][2], Tk[8][2];
#pragma unroll
    for (int t = 0; t < 8; ++t)
#pragma unroll
        for (int ks = 0; ks < 2; ++ks) { Vf[t][ks] = *(const GAS bf16x8*)(VT + (t * 16 + fr) * 64 + ks * 32 + fq * 8); Tk[t][ks] = *(const GAS bf16x8*)(KT + (t * 16 + fr) * 64 + ks * 32 + fq * 8); }
    asm volatile("" ::: "memory");
    asm volatile("s_waitcnt lgkmcnt(0)" ::: "memory");
#pragma unroll 1
    for (int I = 0; I < 4; ++I) {
        float acc[16];
#pragma unroll
        for (int ii = 0; ii < 16; ++ii) acc[ii] = 0.f;
#pragma unroll 4
        for (int j = 0; j < 16 * I; ++j) { const float tv = Tf[j * 68 + lane]; const LAS u32x4* mp = (const LAS u32x4*)(MTb + j * 72 + 16 * I);
#pragma unroll
            for (int q8 = 0; q8 < 2; ++q8) { const u32x4 m = mp[q8];
#pragma unroll
                for (int e = 0; e < 4; ++e) { acc[q8 * 8 + 2 * e] += __builtin_bit_cast(float, m[e] << 16) * tv; acc[q8 * 8 + 2 * e + 1] += __builtin_bit_cast(float, m[e] & 0xffff0000u) * tv; } } }
        float t[16];
#pragma unroll
        for (int jj = 0; jj < 16; ++jj) { t[jj] = ((16 * I + jj == lane) ? 1.f : 0.f) - acc[jj];
            const LAS u32x4* mp = (const LAS u32x4*)(MTb + (16 * I + jj) * 72 + 16 * I);
#pragma unroll
            for (int q8 = 0; q8 < 2; ++q8) { const u32x4 m = mp[q8];
#pragma unroll
                for (int e = 0; e < 4; ++e) { const int i0 = q8 * 8 + 2 * e;
                    if (i0 > jj) acc[i0] += __builtin_bit_cast(float, m[e] << 16) * t[jj];
                    if (i0 + 1 > jj) acc[i0 + 1] += __builtin_bit_cast(float, m[e] & 0xffff0000u) * t[jj]; } } }
#pragma unroll
        for (int ii = 0; ii < 16; ++ii) Tf[(16 * I + ii) * 68 + lane] = t[ii];
        asm volatile("s_waitcnt lgkmcnt(0)" ::: "memory");
    }
    LAS bf16_t* T1 = (LAS bf16_t*)Tf; LAS bf16_t* T2 = MTb;
    { const int col = d ? 63 - lane : lane; const float be = bet * __expf(gc);
#pragma unroll 1
      for (int hh = 0; hh < 2; ++hh) { float tr[32];
#pragma unroll
        for (int i = 0; i < 32; ++i) tr[i] = Tf[(hh * 32 + i) * 68 + lane];
        asm volatile("s_waitcnt lgkmcnt(0)" ::: "memory");
#pragma unroll
        for (int i = 0; i < 32; ++i) { T1[(hh * 32 + i) * 72 + col] = (bf16_t)f2bf(tr[i] * bet); T2[(hh * 32 + i) * 72 + col] = (bf16_t)f2bf(tr[i] * be); }
        asm volatile("s_waitcnt lgkmcnt(0)" ::: "memory"); } }
#pragma unroll 1
    for (int ti = 0; ti < 4; ++ti) { bf16x8 B1[2], B2[2];
#pragma unroll
        for (int ks = 0; ks < 2; ++ks) { B1[ks] = *(const LAS bf16x8*)(T1 + (ti * 16 + fr) * 72 + ks * 32 + fq * 8); B2[ks] = *(const LAS bf16x8*)(T2 + (ti * 16 + fr) * 72 + ks * 32 + fq * 8); }
#pragma unroll
        for (int tv = 0; tv < 8; ++tv) { f32x4 au = (f32x4){0.f, 0.f, 0.f, 0.f}, aw = au;
#pragma unroll
            for (int ks = 0; ks < 2; ++ks) { au = __builtin_amdgcn_mfma_f32_16x16x32_bf16(Vf[tv][ks], B1[ks], au, 0, 0, 0); aw = __builtin_amdgcn_mfma_f32_16x16x32_bf16(Tk[tv][ks], B2[ks], aw, 0, 0, 0); }
            const int i = ti * 16 + fr, c0 = tv * 16 + 4 * fq;
            *(GAS f32x4*)(rec + GR_U + ((size_t)i * 128 + c0) * 4) = au;
            u32x2 pk; pk.x = pk2(aw[0], aw[1]); pk.y = pk2(aw[2], aw[3]);
            *(GAS u32x2*)(rec + GR_W + ((size_t)i * 128 + c0) * 2) = pk; } }
    LAS float* egv = betv + 64; LAS float* fdv = egv + 64;
    egv[lane] = __expf(gc); fdv[lane] = __expf(gl - gc);
    asm volatile("s_waitcnt lgkmcnt(0)" ::: "memory");
    u32x4 ldq[16];
#pragma unroll
    for (int e = 0; e < 16; ++e) { const int idx = e * 64 + lane, i = idx >> 4, c8 = idx & 15; ldq[e] = *(const GAS u32x4*)(QB + (size_t)PROW(i) * 512 + c8 * 8); }
    asm volatile("" ::: "memory");
#pragma unroll
    for (int e = 0; e < 16; ++e) { const int idx = e * 64 + lane, i = idx >> 4, c8 = idx & 15; const float sc = egv[i];
        const u32x4 v = ldq[e]; u32x4 o;
        o.x = pk2(__builtin_bit_cast(float, v.x << 16) * sc, __builtin_bit_cast(float, v.x & 0xffff0000u) * sc); o.y = pk2(__builtin_bit_cast(float, v.y << 16) * sc, __builtin_bit_cast(float, v.y & 0xffff0000u) * sc);
        o.z = pk2(__builtin_bit_cast(float, v.z << 16) * sc, __builtin_bit_cast(float, v.z & 0xffff0000u) * sc); o.w = pk2(__builtin_bit_cast(float, v.w << 16) * sc, __builtin_bit_cast(float, v.w & 0xffff0000u) * sc);
        *(GAS u32x4*)(rec + GR_QG + ((size_t)i * 128 + c8 * 8) * 2) = o; }
#pragma unroll
    for (int e = 0; e < 16; ++e) { const int idx = e * 64 + lane, kd = idx >> 3, j8 = idx & 7; ldq[e] = *(const GAS u32x4*)(KT + kd * 64 + j8 * 8); }
    asm volatile("" ::: "memory");
#pragma unroll
    for (int e = 0; e < 16; ++e) { const int idx = e * 64 + lane, kd = idx >> 3, j8 = idx & 7;
        const u32x4 v = ldq[e];
        float x[8] = {__builtin_bit_cast(float, v.x << 16), __builtin_bit_cast(float, v.x & 0xffff0000u), __builtin_bit_cast(float, v.y << 16), __builtin_bit_cast(float, v.y & 0xffff0000u),
                      __builtin_bit_cast(float, v.z << 16), __builtin_bit_cast(float, v.z & 0xffff0000u), __builtin_bit_cast(float, v.w << 16), __builtin_bit_cast(float, v.w & 0xffff0000u)};
        float y[8];
#pragma unroll
        for (int q = 0; q < 8; ++q) { const int i = d ? 63 - (j8 * 8 + q) : j8 * 8 + q; y[q] = x[q] * fdv[i]; }
        u32x4 o;
        if (d) { o.x = pk2(y[7], y[6]); o.y = pk2(y[5], y[4]); o.z = pk2(y[3], y[2]); o.w = pk2(y[1], y[0]); }
        else { o.x = pk2(y[0], y[1]); o.y = pk2(y[2], y[3]); o.z = pk2(y[4], y[5]); o.w = pk2(y[6], y[7]); }
        *(GAS u32x4*)(rec + GR_KT + ((size_t)kd * 64 + (d ? 56 - j8 * 8 : j8 * 8)) * 2) = o; }
    if (lane == 0) *(GAS float*)(rec + GR_EG) = __expf(gl);
#undef PROW
    asm volatile("s_waitcnt lgkmcnt(0)" ::: "memory");
}

__device__ __forceinline__ void gdn_chain_unit(Frame& F, int ci, int vh) {
    LAS float*  Sf = (LAS float*)(F.lds);
    LAS bf16_t* St = (LAS bf16_t*)(F.lds + 34816);
    LAS bf16_t* Wl = (LAS bf16_t*)(F.lds + 52224);
    LAS bf16_t* Ql = (LAS bf16_t*)(F.lds + 69632);
    LAS bf16_t* Al = (LAS bf16_t*)(F.lds + 87040);
    LAS bf16_t* Kl = (LAS bf16_t*)(F.lds + 96256);
    LAS float*  Ul = (LAS float*)(F.lds + 114688);
    LAS bf16_t* Vn = (LAS bf16_t*)(F.lds + 132096);
    const int tid = F.tid, lane = F.lane, wave = F.wave;
    const int b = ci >> 3, h = (ci >> 1) & 3, d = ci & 1;
    float* GO = WSP(float, WS_GDO) + (size_t)d * M_ALL * 512;
    for (int i = tid; i < 128 * 68; i += NT) Sf[i] = 0.f;
    for (int i = tid; i < 64 * 136; i += NT) St[i] = 0;
    __syncthreads();
    for (int n = 0; n < NCHUNK; ++n) {
        const unsigned char* rec = F.ws + WS_GPRE + (size_t)(ci * NCHUNK + n) * GREC;
        for (int i = tid; i < 64 * 16; i += NT) { const int r = i >> 4, c8 = i & 15;
            *(LAS u32x4*)(Wl + r * 136 + c8 * 8) = *(const u32x4*)(rec + GR_W + (r * 128 + c8 * 8) * 2);
            *(LAS u32x4*)(Ql + r * 136 + c8 * 8) = *(const u32x4*)(rec + GR_QG + (r * 128 + c8 * 8) * 2); }
        for (int i = tid; i < 128 * 8; i += NT) { const int r = i >> 3, c8 = i & 7;
            *(LAS u32x4*)(Kl + r * 72 + c8 * 8) = *(const u32x4*)(rec + GR_KT + (r * 64 + c8 * 8) * 2); }
        for (int i = tid; i < 64 * 8; i += NT) { const int r = i >> 3, c8 = i & 7;
            *(LAS u32x4*)(Al + r * 72 + c8 * 8) = *(const u32x4*)(rec + GR_AT + (r * 64 + c8 * 8) * 2); }
        for (int i = tid; i < 64 * 16; i += NT) { const int r = i >> 4, c4 = i & 15;
            *(LAS f32x4*)(Ul + r * 68 + c4 * 4) = *(const f32x4*)(rec + GR_U + (r * 128 + vh * 64 + c4 * 4) * 4); }
        const float eg = *(const float*)(rec + GR_EG);
        __syncthreads();
        mm_lds(Wl, 136, St, 136, 64, 64, 128, wave, lane, [&](int i, int j, float v) { Vn[j * 72 + i] = (bf16_t)f2bf(Ul[i * 68 + j] - v); });
        __syncthreads();
        mm_lds(Ql, 136, St, 136, 64, 64, 128, wave, lane, [&](int i, int j, float v) { Ul[i * 68 + j] = v; });
        mm_lds(Al, 72, Vn, 72, 64, 64, 64, wave, lane, [&](int i, int j, float v) {
            const int row = chain_row(b, d, n * 64 + i); GO[(size_t)row * 512 + h * 128 + vh * 64 + j] = Ul[i * 68 + j] + v; });
        __syncthreads();
        mm_lds(Kl, 72, Vn, 72, 128, 64, 64, wave, lane, [&](int i, int j, float v) {
            const float s = eg * Sf[i * 68 + j] + v; Sf[i * 68 + j] = s; St[j * 136 + i] = (bf16_t)f2bf(s); });
        __syncthreads();
    }
}

__device__ __forceinline__ void rwkv_scan_unit(Frame& F, int ci, int vhalf) {
    constexpr int TB = 32, NBLK = (CTX + SEQ) / TB, PER = 5 * 64 + 32, NLD = TB * PER / NT;
    const float* RW = WSP(float, WS_RW);
    const int tid = F.tid, lane = F.lane, wave = F.wave;
    const int b = ci >> 3, h = (ci >> 1) & 3, d = ci & 1;
    float* RO = WSP(float, WS_RWO) + (size_t)d * M_ALL * 256;
    LAS float* buf0 = (LAS float*)F.lds;
    LAS float* obuf = buf0 + 2 * TB * PER;
    const int rr = lane >> 4, kq = lane & 15, vloc = wave * 8 + rr * 2;
    f32x4 S0 = (f32x4){0.f, 0.f, 0.f, 0.f}, S1 = S0;
    float regs[NLD];
    const int sgn = d ? -1 : 1;
    auto load_block = [&](int blk) {
        const int s0 = blk * TB;
        const int row0 = (s0 < CTX) ? b * CTX + (d ? CTX - 1 - s0 : s0) : M_CTX + b * SEQ + (d ? SEQ - 1 - (s0 - CTX) : (s0 - CTX));
        const GAS float* base = (const GAS float*)(RW + (size_t)row0 * 2560 + h * 64);
#pragma unroll
        for (int e = 0; e < 20; ++e) { const int arr = e % 5, st = (e / 5) * 8 + wave;
            const int slot = arr == 0 ? 2 : (arr == 1 ? 3 + 3 * d : (arr == 2 ? 5 + 3 * d : (arr == 3 ? 4 + 3 * d : 0)));
            const float v = base[(ptrdiff_t)(sgn * st) * 2560 + slot * 256 + lane]; regs[e] = (arr == 0) ? -v : v; }
#pragma unroll
        for (int e = 0; e < 2; ++e) { const int idx = e * NT + tid, st = idx >> 5, vi = idx & 31;
            regs[20 + e] = base[(ptrdiff_t)(sgn * st) * 2560 + 256 + vhalf * 32 + vi]; } };
    auto store_block = [&](LAS float* dst) {
#pragma unroll
        for (int e = 0; e < 20; ++e) { const int arr = e % 5, st = (e / 5) * 8 + wave; dst[st * PER + arr * 64 + lane] = regs[e]; }
#pragma unroll
        for (int e = 0; e < 2; ++e) { const int idx = e * NT + tid, st = idx >> 5, vi = idx & 31; dst[st * PER + 320 + vi] = regs[20 + e]; } };
    load_block(0); store_block(buf0);
    __syncthreads();
    for (int blk = 0; blk < NBLK; ++blk) {
        LAS float* cb = buf0 + (blk & 1) * TB * PER;
        if (blk + 1 < NBLK) load_block(blk + 1);
        if (wave < 4) {
            const LAS float* vp = cb;
            f32x4 a4 = *(const LAS f32x4*)(vp + 4 * kq), w4 = *(const LAS f32x4*)(vp + 64 + 4 * kq), b4 = *(const LAS f32x4*)(vp + 128 + 4 * kq),
                  k4 = *(const LAS f32x4*)(vp + 192 + 4 * kq), r4 = *(const LAS f32x4*)(vp + 256 + 4 * kq);
            f32x2 vv = *(const LAS f32x2*)(vp + 320 + vloc);
#pragma unroll 1
            for (int g = 0; g < TB / 8; ++g) {
                float qp0[8], qp1[8];
#pragma unroll
                for (int e = 0; e < 8; ++e) {
                    const int sn = (g * 8 + e + 1 < TB) ? g * 8 + e + 1 : TB - 1;
                    const LAS float* np = cb + sn * PER;
                    const f32x4 na4 = *(const LAS f32x4*)(np + 4 * kq), nw4 = *(const LAS f32x4*)(np + 64 + 4 * kq), nb4 = *(const LAS f32x4*)(np + 128 + 4 * kq),
                                nk4 = *(const LAS f32x4*)(np + 192 + 4 * kq), nr4 = *(const LAS f32x4*)(np + 256 + 4 * kq);
                    const f32x2 nvv = *(const LAS f32x2*)(np + 320 + vloc);
                    const f32x4 p0 = S0 * a4, p1 = S1 * a4;
                    const float sa0 = row16_sum((p0[0] + p0[1]) + (p0[2] + p0[3])), sa1 = row16_sum((p1[0] + p1[1]) + (p1[2] + p1[3]));
                    S0 = S0 * w4 + (b4 * sa0 + k4 * vv[0]);
                    S1 = S1 * w4 + (b4 * sa1 + k4 * vv[1]);
                    const f32x4 q0 = S0 * r4, q1 = S1 * r4;
                    qp0[e] = (q0[0] + q0[1]) + (q0[2] + q0[3]); qp1[e] = (q1[0] + q1[1]) + (q1[2] + q1[3]);
                    a4 = na4; w4 = nw4; b4 = nb4; k4 = nk4; r4 = nr4; vv = nvv;
                }
#pragma unroll
                for (int e = 0; e < 8; ++e) { const float o0 = row16_sum(qp0[e]), o1 = row16_sum(qp1[e]);
                    if (kq == 0) *(LAS f32x2*)(obuf + (g * 8 + e) * 32 + vloc) = (f32x2){o0, o1}; }
            }
        }
        __syncthreads();
        if (blk + 1 < NBLK) store_block(buf0 + ((blk + 1) & 1) * TB * PER);
#pragma unroll
        for (int e = 0; e < 2; ++e) { const int idx = e * NT + tid; const int st = idx >> 5, vi = idx & 31;
            const int row = chain_row(b, d, blk * TB + st); RO[(size_t)row * 256 + h * 64 + vhalf * 32 + vi] = obuf[idx]; }
        __syncthreads();
    }
}


__device__ __forceinline__ void soft_bar4(volatile LAS unsigned* cnt, unsigned& gen, int lane) {
    asm volatile("s_waitcnt vmcnt(0) lgkmcnt(0)" ::: "memory");
    gen += 4u;
    if (lane == 0) __hip_atomic_fetch_add((LAS unsigned*)cnt, 1u, __ATOMIC_RELAXED, __HIP_MEMORY_SCOPE_WORKGROUP);
    while (*cnt < gen) { }
    asm volatile("" ::: "memory");
}
__device__ __forceinline__ void rwkv_scan_quarter(Frame& F, int ci, int vq, volatile LAS unsigned* cnt, unsigned& gen) {
    constexpr int TB = 32, NBLK = (CTX + SEQ) / TB;
    constexpr int RO_ = TB * 256, VO_ = TB * 320, BSZ = TB * 336;
    const float* RW = WSP(float, WS_RW);
    const int lane = F.lane, wave = F.wave, tid4 = wave * 64 + lane;
    const int b = ci >> 3, h = (ci >> 1) & 3, d = ci & 1;
    float* RO = WSP(float, WS_RWO) + (size_t)d * M_ALL * 256;
    LAS float* buf0 = (LAS float*)F.lds;
    LAS float* obuf0 = buf0 + 2 * BSZ;
    LAS float* obuf1 = (LAS float*)(F.lds + 147456);
    const int rr = lane >> 4, kq = lane & 15, vloc = wave * 4 + rr;
    float S0 = 0.f, S1 = 0.f, S2 = 0.f, S3 = 0.f;
    const int sgn = d ? -1 : 1;
    const int laneA = (rr == 0 ? 2 : (rr == 1 ? 3 + 3 * d : (rr == 2 ? 5 + 3 * d : 4 + 3 * d))) * 256 + 4 * kq;
    auto stage_block = [&](int blk, LAS float* dst) {
        const int s0 = blk * TB;
        const int row0 = (s0 < CTX) ? b * CTX + (d ? CTX - 1 - s0 : s0) : M_CTX + b * SEQ + (d ? SEQ - 1 - (s0 - CTX) : (s0 - CTX));
        const float* base = RW + (size_t)row0 * 2560 + h * 64;
#pragma unroll
        for (int i = 0; i < 8; ++i) { const int st = i * 4 + wave;
            __builtin_amdgcn_global_load_lds((const unsigned*)(base + (ptrdiff_t)(sgn * st) * 2560 + laneA), (LAS unsigned*)(dst + st * 256), 16, 0, 0); }
#pragma unroll
        for (int i = 0; i < 2; ++i) { const int s4 = wave * 2 + i, st = s4 * 4 + rr;
            __builtin_amdgcn_global_load_lds((const unsigned*)(base + (ptrdiff_t)(sgn * st) * 2560 + 4 * kq), (LAS unsigned*)(dst + RO_ + s4 * 256), 16, 0, 0); }
        if (wave < 2) { const int st = wave * 16 + (lane >> 2);
            __builtin_amdgcn_global_load_lds((const unsigned*)(base + (ptrdiff_t)(sgn * st) * 2560 + 256 + vq * 16 + (lane & 3) * 4), (LAS unsigned*)(dst + VO_ + wave * 256), 16, 0, 0); } };
    stage_block(0, buf0);
    soft_bar4(cnt, gen, lane);
    for (int blk = 0; blk < NBLK; ++blk) {
        LAS float* cb = buf0 + (blk & 1) * BSZ;
        LAS float* obuf = (blk & 1) ? obuf1 : obuf0;
        {
            struct SV { f32x4 a, w, b, k, r; float v; };
            SV xA, xB;
            { const LAS float* p = cb;
              xA.a = *(const LAS f32x4*)(p + 4 * kq); xA.w = *(const LAS f32x4*)(p + 64 + 4 * kq); xA.b = *(const LAS f32x4*)(p + 128 + 4 * kq);
              xA.k = *(const LAS f32x4*)(p + 192 + 4 * kq); xA.r = *(const LAS f32x4*)(p + RO_ + 4 * kq); xA.v = cb[VO_ + vloc]; }
            unsigned adA = (unsigned)(size_t)(cb + 4 * kq), adR = (unsigned)(size_t)(cb + RO_ + 4 * kq), adV = (unsigned)(size_t)(cb + VO_ + vloc);
            if (blk + 1 < NBLK) stage_block(blk + 1, buf0 + ((blk + 1) & 1) * BSZ);
#define RWK_STEP(CUR, NXT, E, QO) { float pa_, t0_, t1_, t2_, t3_; \
            asm volatile( \
                "v_mul_f32 %[pa], %[s0], %[a0]\n\t" \
                "ds_read_b128 %[na], %[adA] offset:%[oa]\n\t" \
                "v_fma_f32 %[pa], %[s1], %[a1], %[pa]\n\t" \
                "ds_read_b128 %[nw], %[adA] offset:%[ow]\n\t" \
                "v_fma_f32 %[pa], %[s2], %[a2], %[pa]\n\t" \
                "ds_read_b128 %[nb], %[adA] offset:%[ob]\n\t" \
                "v_fma_f32 %[pa], %[s3], %[a3], %[pa]\n\t" \
                "ds_read_b128 %[nk], %[adA] offset:%[ok]\n\t" \
                "ds_read_b128 %[nr], %[adR] offset:%[orr]\n\t" \
                "ds_read_b32 %[nv], %[adV] offset:%[ov]\n\t" \
                "v_mul_f32 %[t0], %[k0], %[vv]\n\t" \
                "v_add_f32_dpp %[pa], %[pa], %[pa] quad_perm:[1,0,3,2] row_mask:0xf bank_mask:0xf bound_ctrl:1\n\t" \
                "v_mul_f32 %[t1], %[k1], %[vv]\n\t" \
                "v_mul_f32 %[t2], %[k2], %[vv]\n\t" \
                "v_add_f32_dpp %[pa], %[pa], %[pa] quad_perm:[2,3,0,1] row_mask:0xf bank_mask:0xf bound_ctrl:1\n\t" \
                "v_mul_f32 %[t3], %[k3], %[vv]\n\t" \
                "v_fma_f32 %[t0], %[s0], %[w0], %[t0]\n\t" \
                "v_add_f32_dpp %[pa], %[pa], %[pa] row_half_mirror row_mask:0xf bank_mask:0xf bound_ctrl:1\n\t" \
                "v_fma_f32 %[t1], %[s1], %[w1], %[t1]\n\t" \
                "v_fma_f32 %[t2], %[s2], %[w2], %[t2]\n\t" \
                "v_add_f32_dpp %[pa], %[pa], %[pa] row_mirror row_mask:0xf bank_mask:0xf bound_ctrl:1\n\t" \
                "v_fma_f32 %[t3], %[s3], %[w3], %[t3]\n\t" \
                "v_fma_f32 %[s0], -%[b0], %[pa], %[t0]\n\t" \
                "v_fma_f32 %[s1], -%[b1], %[pa], %[t1]\n\t" \
                "v_fma_f32 %[s2], -%[b2], %[pa], %[t2]\n\t" \
                "v_mul_f32 %[q], %[s0], %[r0]\n\t" \
                "v_fma_f32 %[s3], -%[b3], %[pa], %[t3]\n\t" \
                "v_fma_f32 %[q], %[s1], %[r1], %[q]\n\t" \
                "v_fma_f32 %[q], %[s2], %[r2], %[q]\n\t" \
                "v_fma_f32 %[q], %[s3], %[r3], %[q]\n\t" \
                "s_waitcnt lgkmcnt(0)" \
                : [na] "=&v"(NXT.a), [nw] "=&v"(NXT.w), [nb] "=&v"(NXT.b), [nk] "=&v"(NXT.k), [nr] "=&v"(NXT.r), [nv] "=&v"(NXT.v), [q] "=&v"(QO), \
                  [s0] "+v"(S0), [s1] "+v"(S1), [s2] "+v"(S2), [s3] "+v"(S3), \
                  [pa] "=&v"(pa_), [t0] "=&v"(t0_), [t1] "=&v"(t1_), [t2] "=&v"(t2_), [t3] "=&v"(t3_) \
                : [adA] "v"(adA), [adR] "v"(adR), [adV] "v"(adV), \
                  [oa] "i"(((E) + 1) * 1024), [ow] "i"(((E) + 1) * 1024 + 256), [ob] "i"(((E) + 1) * 1024 + 512), [ok] "i"(((E) + 1) * 1024 + 768), [orr] "i"(((E) + 1) * 256), \
                  [ov] "i"(((E) + 1) * 64), \
                  [a0] "v"(CUR.a[0]), [a1] "v"(CUR.a[1]), [a2] "v"(CUR.a[2]), [a3] "v"(CUR.a[3]), \
                  [w0] "v"(CUR.w[0]), [w1] "v"(CUR.w[1]), [w2] "v"(CUR.w[2]), [w3] "v"(CUR.w[3]), \
                  [b0] "v"(CUR.b[0]), [b1] "v"(CUR.b[1]), [b2] "v"(CUR.b[2]), [b3] "v"(CUR.b[3]), \
                  [k0] "v"(CUR.k[0]), [k1] "v"(CUR.k[1]), [k2] "v"(CUR.k[2]), [k3] "v"(CUR.k[3]), \
                  [r0] "v"(CUR.r[0]), [r1] "v"(CUR.r[1]), [r2] "v"(CUR.r[2]), [r3] "v"(CUR.r[3]), [vv] "v"(CUR.v) \
                : "memory"); }
#pragma unroll 1
            for (int g = 0; g < TB / 8; ++g) {
                float qp[8];
                RWK_STEP(xA, xB, 0, qp[0]) RWK_STEP(xB, xA, 1, qp[1]) RWK_STEP(xA, xB, 2, qp[2]) RWK_STEP(xB, xA, 3, qp[3])
                RWK_STEP(xA, xB, 4, qp[4]) RWK_STEP(xB, xA, 5, qp[5]) RWK_STEP(xA, xB, 6, qp[6]) RWK_STEP(xB, xA, 7, qp[7])
                adA += 8 * 1024; adR += 8 * 256; adV += 8 * 64;
                { float n0, n1, n2, n3, m0, m1, tt, uu, oo;
                  asm volatile(
                    "v_add_f32_dpp %[n0], %[q0], %[q0] row_ror:8 row_mask:0xf bank_mask:0x3\n\t"
                    "v_add_f32_dpp %[n1], %[q1], %[q1] row_ror:8 row_mask:0xf bank_mask:0x3\n\t"
                    "v_add_f32_dpp %[n2], %[q2], %[q2] row_ror:8 row_mask:0xf bank_mask:0x3\n\t"
                    "v_add_f32_dpp %[n3], %[q3], %[q3] row_ror:8 row_mask:0xf bank_mask:0x3\n\t"
                    "v_add_f32_dpp %[n0], %[q4], %[q4] row_ror:8 row_mask:0xf bank_mask:0xc\n\t"
                    "v_add_f32_dpp %[n1], %[q5], %[q5] row_ror:8 row_mask:0xf bank_mask:0xc\n\t"
                    "v_add_f32_dpp %[n2], %[q6], %[q6] row_ror:8 row_mask:0xf bank_mask:0xc\n\t"
                    "v_add_f32_dpp %[n3], %[q7], %[q7] row_ror:8 row_mask:0xf bank_mask:0xc\n\t"
                    "v_add_f32_dpp %[m0], %[n0], %[n0] row_shl:4 row_mask:0xf bank_mask:0x5\n\t"
                    "v_add_f32_dpp %[m1], %[n1], %[n1] row_shl:4 row_mask:0xf bank_mask:0x5\n\t"
                    "v_add_f32_dpp %[m0], %[n2], %[n2] row_shr:4 row_mask:0xf bank_mask:0xa\n\t"
                    "v_add_f32_dpp %[m1], %[n3], %[n3] row_shr:4 row_mask:0xf bank_mask:0xa\n\t"
                    "v_cndmask_b32 %[tt], %[m0], %[m1], %[msk]\n\t"
                    "v_cndmask_b32 %[uu], %[m1], %[m0], %[msk]\n\t"
                    "s_nop 1\n\t"
                    "v_add_f32_dpp %[oo], %[uu], %[tt] quad_perm:[2,3,0,1] row_mask:0xf bank_mask:0xf\n\t"
                    "s_nop 1\n\t"
                    "v_add_f32_dpp %[oo], %[oo], %[oo] quad_perm:[1,0,3,2] row_mask:0xf bank_mask:0xf"
                    : [n0] "=&v"(n0), [n1] "=&v"(n1), [n2] "=&v"(n2), [n3] "=&v"(n3), [m0] "=&v"(m0), [m1] "=&v"(m1), [tt] "=&v"(tt), [uu] "=&v"(uu), [oo] "=&v"(oo)
                    : [q0] "v"(qp[0]), [q1] "v"(qp[1]), [q2] "v"(qp[2]), [q3] "v"(qp[3]), [q4] "v"(qp[4]), [q5] "v"(qp[5]), [q6] "v"(qp[6]), [q7] "v"(qp[7]), [msk] "s"(0xCCCCCCCCCCCCCCCCull));
                  if ((kq & 1) == 0) obuf[(g * 8 + (kq >> 1)) * 16 + vloc] = oo; }
            }
#undef RWK_STEP
        }
        soft_bar4(cnt, gen, lane);
#pragma unroll
        for (int e = 0; e < 2; ++e) { const int idx = e * 256 + tid4; const int st = idx >> 4, vi = idx & 15;
            const int row = chain_row(b, d, blk * TB + st); RO[(size_t)row * 256 + h * 64 + vq * 16 + vi] = obuf[idx]; }
    }
}
__device__ __forceinline__ void gdn_chain_wave(Frame& F, int ci, int vq, LAS bf16_t* St, LAS bf16_t* Vn) {
    const int lane = F.lane; int fr = lane & 15, fq = lane >> 4;
    const int b = ci >> 3, h = (ci >> 1) & 3, d = ci & 1;
    float* GO = WSP(float, WS_GDO) + (size_t)d * M_ALL * 512 + h * 128 + vq * 32;
    f32x4 S[8][2];
#pragma unroll
    for (int i = 0; i < 8; ++i) { S[i][0] = (f32x4){0.f, 0.f, 0.f, 0.f}; S[i][1] = S[i][0]; }
    for (int i = lane; i < 32 * 136 / 2; i += 64) ((LAS unsigned*)St)[i] = 0u;
#pragma unroll 1
    for (int n = 0; n < NCHUNK; ++n) {
        asm volatile("" : "+v"(fr), "+v"(fq));
        const unsigned char* rec = F.ws + WS_GPRE + (size_t)(ci * NCHUNK + n) * GREC;
        const GAS bf16_t* Wg = (const GAS bf16_t*)(rec + GR_W); const GAS bf16_t* Qg = (const GAS bf16_t*)(rec + GR_QG);
        const GAS bf16_t* Kg = (const GAS bf16_t*)(rec + GR_KT); const GAS bf16_t* Ag = (const GAS bf16_t*)(rec + GR_AT);
        const GAS float* Ug = (const GAS float*)(rec + GR_U) + vq * 32; const float eg = *(const GAS float*)(rec + GR_EG);
        const int s0 = n * 64; const int row0 = (s0 < CTX) ? b * CTX + (d ? CTX - 1 - s0 : s0) : M_CTX + b * SEQ + (d ? SEQ - 1 - (s0 - CTX) : (s0 - CTX)); const int sgn = d ? -1 : 1;
        unsigned pf[3];
        { const unsigned char* nrec = rec + (n + 1 < NCHUNK ? GREC : 0);
#pragma unroll
          for (int i = 0; i < 3; ++i) { const int line = i * 256 + vq * 64 + lane; pf[i] = *(const GAS unsigned*)(nrec + (size_t)(line < 704 ? line : 703) * 128); }
          asm volatile("" ::: "memory"); }
        bf16x8 Bs[2][4];
#pragma unroll
        for (int j = 0; j < 2; ++j)
#pragma unroll
            for (int ks = 0; ks < 4; ++ks) Bs[j][ks] = *(const LAS bf16x8*)(St + (j * 16 + fr) * 136 + ks * 32 + fq * 8);
#pragma unroll
        for (int mh = 0; mh < 2; ++mh) { bf16x8 Aw[2][4]; float uu[2][2][4];
#pragma unroll
          for (int m2 = 0; m2 < 2; ++m2) { const int m = mh * 2 + m2;
#pragma unroll
            for (int ks = 0; ks < 4; ++ks) Aw[m2][ks] = *(const GAS bf16x8*)(Wg + (m * 16 + fr) * 128 + ks * 32 + fq * 8);
#pragma unroll
            for (int j = 0; j < 2; ++j)
#pragma unroll
                for (int r = 0; r < 4; ++r) uu[m2][j][r] = Ug[(m * 16 + 4 * fq + r) * 128 + j * 16 + fr]; }
          asm volatile("" ::: "memory");
#pragma unroll
          for (int m2 = 0; m2 < 2; ++m2) { const int m = mh * 2 + m2;
#pragma unroll
            for (int j = 0; j < 2; ++j) { f32x4 acc = (f32x4){0.f, 0.f, 0.f, 0.f};
#pragma unroll
                for (int ks = 0; ks < 4; ++ks) acc = __builtin_amdgcn_mfma_f32_16x16x32_bf16(Aw[m2][ks], Bs[j][ks], acc, 0, 0, 0);
                u32x2 pk; pk.x = pk2(uu[m2][j][0] - acc[0], uu[m2][j][1] - acc[1]); pk.y = pk2(uu[m2][j][2] - acc[2], uu[m2][j][3] - acc[3]);
                *(LAS u32x2*)(Vn + (j * 16 + fr) * 72 + m * 16 + 4 * fq) = pk; } } }
        bf16x8 Bv[2][2];
#pragma unroll
        for (int j = 0; j < 2; ++j)
#pragma unroll
            for (int ks = 0; ks < 2; ++ks) Bv[j][ks] = *(const LAS bf16x8*)(Vn + (j * 16 + fr) * 72 + ks * 32 + fq * 8);
#pragma unroll
        for (int mh = 0; mh < 2; ++mh) { bf16x8 Aq[2][4], Aa[2][2];
#pragma unroll
            for (int m2 = 0; m2 < 2; ++m2) { const int m = mh * 2 + m2;
#pragma unroll
                for (int ks = 0; ks < 4; ++ks) Aq[m2][ks] = *(const GAS bf16x8*)(Qg + (m * 16 + fr) * 128 + ks * 32 + fq * 8);
#pragma unroll
                for (int ks = 0; ks < 2; ++ks) Aa[m2][ks] = *(const GAS bf16x8*)(Ag + (m * 16 + fr) * 64 + ks * 32 + fq * 8); }
            asm volatile("" ::: "memory");
#pragma unroll
            for (int m2 = 0; m2 < 2; ++m2) { const int m = mh * 2 + m2;
#pragma unroll
                for (int j = 0; j < 2; ++j) { f32x4 acc = (f32x4){0.f, 0.f, 0.f, 0.f};
#pragma unroll
                    for (int ks = 0; ks < 4; ++ks) acc = __builtin_amdgcn_mfma_f32_16x16x32_bf16(Aq[m2][ks], Bs[j][ks], acc, 0, 0, 0);
#pragma unroll
                    for (int ks = 0; ks < 2; ++ks) acc = __builtin_amdgcn_mfma_f32_16x16x32_bf16(Aa[m2][ks], Bv[j][ks], acc, 0, 0, 0);
#pragma unroll
                    for (int r = 0; r < 4; ++r) GO[(size_t)(row0 + sgn * (m * 16 + 4 * fq + r)) * 512 + j * 16 + fr] = acc[r]; } } }
        { bf16x8 Ak[8][2];
#pragma unroll
          for (int i = 0; i < 8; ++i)
#pragma unroll
            for (int ks = 0; ks < 2; ++ks) Ak[i][ks] = *(const GAS bf16x8*)(Kg + (i * 16 + fr) * 64 + ks * 32 + fq * 8);
          asm volatile("" ::: "memory");
#pragma unroll
          for (int i = 0; i < 8; ++i)
#pragma unroll
            for (int j = 0; j < 2; ++j) { f32x4 acc = S[i][j] * eg;
#pragma unroll
                for (int ks = 0; ks < 2; ++ks) acc = __builtin_amdgcn_mfma_f32_16x16x32_bf16(Ak[i][ks], Bv[j][ks], acc, 0, 0, 0);
                S[i][j] = acc;
                u32x2 pk; pk.x = pk2(acc[0], acc[1]); pk.y = pk2(acc[2], acc[3]);
                *(LAS u32x2*)(St + (j * 16 + fr) * 136 + i * 16 + 4 * fq) = pk; } }
        asm volatile("" :: "v"(pf[0]), "v"(pf[1]), "v"(pf[2]));
    }
}

__device__ __forceinline__ void hyena_lat_unit(Frame& F, int l, int c) {
    constexpr int CPS = 8192 + 32;
    constexpr int VST = 2184;
    LAS unsigned char* cp = F.lds;
    LAS bf16_t* vv = (LAS bf16_t*)(F.lds + 8 * CPS);
    const int tid = F.tid, lane = F.lane, wave = F.wave;
    const float* g = WSP(float, WS_FILT) + ((size_t)l * 256 + c) * (2 * SEQ);
    const float* V = WSP(float, WS_VVT) + (size_t)c * NB * (CTX + SEQ);
    float* Y = WSP(float, WS_YT) + (size_t)c * NB * (CTX + SEQ);
    { float gv[8][8];
#pragma unroll
      for (int k = 0; k < 8; ++k) { const int i = tid + k * NT, r = i >> 9, n = i & 511;
#pragma unroll
          for (int e = 0; e < 8; ++e) { const int gi = 8 * n + r + e; gv[k][e] = (gi >= 1 && gi <= 4095) ? g[gi] : 0.f; } }
      asm volatile("" ::: "memory");
#pragma unroll
      for (int k = 0; k < 8; ++k) { const int i = tid + k * NT, r = i >> 9, n = i & 511;
          u32x4 p; p.x = pk2(gv[k][0], gv[k][1]); p.y = pk2(gv[k][2], gv[k][3]); p.z = pk2(gv[k][4], gv[k][5]); p.w = pk2(gv[k][6], gv[k][7]);
          *(LAS u32x4*)(cp + r * CPS + n * 16) = p; } }
    { float vb[5][8];
#pragma unroll
      for (int k = 0; k < 5; ++k) { const int i = tid + k * NT; const int bb = (i < 8 * 272) ? i / 272 : 0, gq = (i < 8 * 272) ? i % 272 : 0; const int s0 = gq * 8 - 64;
#pragma unroll
          for (int e = 0; e < 8; ++e) vb[k][e] = (i < 8 * 272 && s0 >= 0 && s0 < SEQ) ? V[(size_t)bb * (CTX + SEQ) + CTX + s0 + 7 - e] : 0.f; }
      asm volatile("" ::: "memory");
#pragma unroll
      for (int k = 0; k < 5; ++k) { const int i = tid + k * NT; if (i < 8 * 272) { const int bb = i / 272, gq = i % 272;
          u32x4 p; p.x = pk2(vb[k][0], vb[k][1]); p.y = pk2(vb[k][2], vb[k][3]); p.z = pk2(vb[k][4], vb[k][5]); p.w = pk2(vb[k][6], vb[k][7]);
          *(LAS u32x4*)(vv + bb * VST + gq * 8) = p; } } }
    __syncthreads();
    const int fr = lane & 15, fq = lane >> 4;
    const int rcp = (fr + 1) & 7;
    const int bcol = fr & 7, pb = fr >> 3;
    f32x4 acc[2][4];
#pragma unroll
    for (int p = 0; p < 2; ++p)
#pragma unroll
        for (int m = 0; m < 4; ++m) acc[p][m] = (f32x4){0.f, 0.f, 0.f, 0.f};
    const int P0 = 2 * wave;
    const int dlo = 2 * P0 - 31 < -31 ? -31 : 2 * P0 - 31, dhi = 2 * (P0 + 1) + 1 > 31 ? 31 : 2 * (P0 + 1) + 1;
    for (int d = dlo; d <= dhi; ++d) {
        bf16x8 A[4][2];
#pragma unroll
        for (int m = 0; m < 4; ++m)
#pragma unroll
            for (int s = 0; s < 2; ++s) { const int a = d * 64 + 16 * m + fr - 32 * s - 8 * fq - 7 + 2048;
                A[m][s] = *(const LAS bf16x8*)(cp + rcp * CPS + ((a - rcp) >> 3) * 16); }
#pragma unroll
        for (int p = 0; p < 2; ++p) { const int Pp = P0 + p; if (d > 2 * Pp + 1 || d < 2 * Pp - 31) continue;
            const int J = 2 * Pp + pb - d;
#pragma unroll
            for (int s = 0; s < 2; ++s) { const bf16x8 B = *(const LAS bf16x8*)(vv + bcol * VST + (J + 1) * 64 + 32 * s + 8 * fq);
#pragma unroll
                for (int m = 0; m < 4; ++m) acc[p][m] = __builtin_amdgcn_mfma_f32_16x16x32_bf16(A[m][s], B, acc[p][m], 0, 0, 0); } }
    }
#pragma unroll
    for (int p = 0; p < 2; ++p)
#pragma unroll
        for (int m = 0; m < 4; ++m) { const int t = 64 * (2 * (P0 + p) + pb) + 16 * m + 4 * fq;
            *(f32x4*)(Y + (size_t)bcol * (CTX + SEQ) + CTX + t) = acc[p][m]; }
    __syncthreads();
}
__device__ __forceinline__ void hyena_ctx_unit(Frame& F, int l, int c) {
    LAS float* gl = (LAS float*)F.lds;
    LAS float* vl = gl + 512;
    const int tid = F.tid, lane = F.lane, wave = F.wave;
    const float* g = WSP(float, WS_FILTC) + ((size_t)l * 256 + c) * (2 * CTX);
    const float* V = WSP(float, WS_VVT) + (size_t)c * NB * (CTX + SEQ);
    float* Y = WSP(float, WS_YT) + (size_t)c * NB * (CTX + SEQ);
    gl[tid] = (tid >= 1) ? g[tid] : 0.f;
    for (int i = tid; i < 8 * 256; i += NT) vl[i] = V[(size_t)(i >> 8) * (CTX + SEQ) + (i & 255)];
    __syncthreads();
    float a[4] = {0.f, 0.f, 0.f, 0.f};
    for (int s = 0; s < CTX; ++s) { const float v = vl[wave * 256 + s];
#pragma unroll
        for (int j = 0; j < 4; ++j) a[j] += gl[lane + 64 * j - s + 256] * v; }
#pragma unroll
    for (int j = 0; j < 4; ++j) Y[(size_t)wave * (CTX + SEQ) + lane + 64 * j] = a[j];
    __syncthreads();
}

__device__ __forceinline__ void phase_finish(Frame& F, int l, bool with_ctx) {
    const float* __restrict__ P = WSP(float, WS_P); const float* __restrict__ YT = WSP(float, WS_YT);
    const float* __restrict__ RW = WSP(float, WS_RW); const float* __restrict__ BON = WSP(float, WS_RWBON);
    const float* __restrict__ RO = WSP(float, WS_RWO); const float* __restrict__ GO = WSP(float, WS_GDO);
    bf16_t* __restrict__ YC = WSP(bf16_t, WS_YCAT);
    const float* sw = F.in[I_HSW] + (size_t)l * 3 * 768; const float* sb = F.in[I_HSB] + (size_t)l * 768;
    const float* gnw = F.in[I_RGNW] + l * 256; const float* gnb = F.in[I_RGNB] + l * 256; const float* gdw = F.in[I_GNW] + l * 128;
    LAS float* tile = (LAS float*)F.lds;
    const int tid = F.tid, lane = F.lane, wave = F.wave;
    const f32x4 pgw4 = *(const f32x4*)(gnw + 4 * lane), pgb4 = *(const f32x4*)(gnb + 4 * lane);
    const f32x4 pdwA = *(const f32x4*)(gdw + ((8 * lane) & 127)), pdwB = *(const f32x4*)(gdw + ((8 * lane) & 127) + 4);
    for (int u = F.bid; u < M_ALL / 64; u += F.G) {
        const int row0 = u * 64; const bool isctx = row0 < M_CTX; if (isctx && !with_ctx) continue;
        const int L = isctx ? CTX : SEQ; const int b = row_batch(row0); const int t0 = isctx ? row0 - b * CTX : row0 - M_CTX - b * SEQ;
        const int pos0 = isctx ? t0 : CTX + t0;
        { float tmp[32];
#pragma unroll
          for (int k = 0; k < 32; ++k) { const int i = tid + k * NT, cc = i >> 6, tl = i & 63; tmp[k] = YT[((size_t)cc * NB + b) * (CTX + SEQ) + pos0 + tl]; }
          asm volatile("" ::: "memory");
#pragma unroll
          for (int k = 0; k < 32; ++k) { const int i = tid + k * NT, cc = i >> 6, tl = i & 63; tile[cc * 65 + tl] = tmp[k]; } }
        __syncthreads();
        { const int c2 = 2 * (tid & 127), tq = tid >> 7;
          const f32x2 wa = *(const f32x2*)(sw + c2), wb = *(const f32x2*)(sw + 768 + c2), wc_ = *(const f32x2*)(sw + 2 * 768 + c2), b0 = *(const f32x2*)(sb + c2);
          const float* pc = P + (size_t)(row0 + tq * 16) * PW + c2; f32x2 xr[18];
#pragma unroll
          for (int k = 0; k < 18; ++k) { const int t = t0 + tq * 16 + k - 1; xr[k] = (t >= 0 && t < L) ? *(const f32x2*)(pc + (ptrdiff_t)(k - 1) * PW) : (f32x2){0.f, 0.f}; }
          asm volatile("" ::: "memory");
#pragma unroll
          for (int tt = 0; tt < 16; ++tt) { const int tl = tq * 16 + tt; const f32x2 x0 = b0 + wa * xr[tt] + wb * xr[tt + 1] + wc_ * xr[tt + 2];
              *(unsigned*)(YC + (size_t)(row0 + tl) * D + c2) = pk2(tile[c2 * 65 + tl] * x0.x, tile[(c2 + 1) * 65 + tl] * x0.y); } }
#pragma unroll 1
        for (int tp = 0; tp < 2; ++tp) {
            f32x4 ro[4][2], rv[4], rg[4], go[4][4], zz[4][2]; float bo[4];
#pragma unroll
            for (int s4 = 0; s4 < 4; ++s4) { const int row = row0 + wave * 8 + tp * 4 + s4; const float* rw = RW + (size_t)row * 2560;
                ro[s4][0] = *(const f32x4*)(RO + (size_t)row * 256 + 4 * lane); ro[s4][1] = *(const f32x4*)(RO + (size_t)(M_ALL + row) * 256 + 4 * lane);
                bo[s4] = BON[(size_t)row * 4 + (lane >> 4)]; rv[s4] = *(const f32x4*)(rw + 256 + 4 * lane); rg[s4] = *(const f32x4*)(rw + 9 * 256 + 4 * lane);
                go[s4][0] = *(const f32x4*)(GO + (size_t)row * 512 + 8 * lane); go[s4][1] = *(const f32x4*)(GO + (size_t)row * 512 + 8 * lane + 4);
                go[s4][2] = *(const f32x4*)(GO + (size_t)(M_ALL + row) * 512 + 8 * lane); go[s4][3] = *(const f32x4*)(GO + (size_t)(M_ALL + row) * 512 + 8 * lane + 4);
                zz[s4][0] = *(const f32x4*)(P + (size_t)row * PW + C_GD + 1536 + 8 * lane); zz[s4][1] = *(const f32x4*)(P + (size_t)row * PW + C_GD + 1536 + 8 * lane + 4); }
            asm volatile("" ::: "memory");
#pragma unroll
            for (int s4 = 0; s4 < 4; ++s4) { const int row = row0 + wave * 8 + tp * 4 + s4;
                { const f32x4 o = ro[s4][0] + ro[s4][1];
                  const float mean = row16_sum((o.x + o.y) + (o.z + o.w)) * (1.f / 64.f); const f32x4 dv = o - mean;
                  const float var = row16_sum((dv.x * dv.x + dv.y * dv.y) + (dv.z * dv.z + dv.w * dv.w)) * (1.f / 64.f);
                  f32x4 y = dv * rsqrtf(var + 64e-5f) * pgw4 + pgb4;
                  y = (y + rv[s4] * bo[s4]) * rg[s4];
                  u32x2 p; p.x = pk2(y.x, y.y); p.y = pk2(y.z, y.w);
                  *(u32x2*)(YC + (size_t)row * D + 256 + 4 * lane) = p; }
                { const f32x4 oa = go[s4][0] + go[s4][2], ob = go[s4][1] + go[s4][3];
                  const float ss = ((oa.x * oa.x + oa.y * oa.y) + (oa.z * oa.z + oa.w * oa.w)) + ((ob.x * ob.x + ob.y * ob.y) + (ob.z * ob.z + ob.w * ob.w));
                  const float rs = rsqrtf(row16_sum(ss) * (1.f / 128.f) + 1e-6f);
                  const f32x4 za = zz[s4][0], zb = zz[s4][1];
                  const f32x4 ya = oa * rs * pdwA * (f32x4){siluf_(za.x), siluf_(za.y), siluf_(za.z), siluf_(za.w)};
                  const f32x4 yb = ob * rs * pdwB * (f32x4){siluf_(zb.x), siluf_(zb.y), siluf_(zb.z), siluf_(zb.w)};
                  u32x4 p; p.x = pk2(ya.x, ya.y); p.y = pk2(ya.z, ya.w); p.z = pk2(yb.x, yb.y); p.w = pk2(yb.z, yb.w);
                  *(u32x4*)(YC + (size_t)row * D + 512 + 8 * lane) = p; } }
        }
        __syncthreads();
    }
}

__device__ __forceinline__ void phase_router(Frame& F, int l, int row_lo, bool dummy = false) {
    const float* H = WSP(float, WS_H); const float* mods = WSP(float, WS_MODS) + (size_t)l * 9 * (NMOD * D);
    bf16_t* N = WSP(bf16_t, WS_N);
    const float* rw = F.in[I_MRW] + (size_t)l * D * NE; const float* rb = F.in[I_MRB] + l * NE;
    unsigned* cnt = (unsigned*)(F.ws + WS_CTL) + CW_CNT + l * NE * 64 + (dummy ? 100000 : 0);
    const size_t doff = dummy ? (WS_END - WS_STOK) : 0;
    int* stok = WSP(int, WS_STOK + doff); int* toke = WSP(int, WS_TOKE + doff); int* tokr = WSP(int, WS_TOKE + MiB + doff); float* tokg = WSP(float, WS_TOKE + 2 * MiB + doff);
    constexpr int XS = 1028;
    LAS float* xr = (LAS float*)F.lds;
    LAS float* red = xr + 16 * XS;
    LAS float* lg = red + 8 * 16 * 32;
    const int tid = F.tid, lane = F.lane, wave = F.wave;
    for (int u = F.bid; u < (M_ALL - row_lo) / 16; u += F.G) {
        const int row0 = row_lo + u * 16;
        for (int tk = 0; tk < 2; ++tk) { const int tl = wave * 2 + tk, row = row0 + tl; const float* mr = mods + (size_t)row_modr(row) * (NMOD * D);
            norm_mod_row<true>(H + (size_t)row * D, F.in[I_NFFN] + l * D, mr + 3 * D, mr + 4 * D, N + (size_t)row * D, xr + tl * XS, lane); }
        __syncthreads();
        { const int tl = lane >> 2, eq = lane & 3; float acc[8];
#pragma unroll
          for (int j = 0; j < 8; ++j) acc[j] = 0.f;
          const LAS float* xp = xr + tl * XS + 128 * wave; const float* wp = rw + (size_t)(128 * wave) * NE + eq * 8;
#pragma unroll 1
          for (int kb = 0; kb < 8; ++kb) { f32x4 wv[16][2];
#pragma unroll
              for (int kk = 0; kk < 16; ++kk) { wv[kk][0] = *(const f32x4*)(wp + (size_t)(16 * kb + kk) * NE); wv[kk][1] = *(const f32x4*)(wp + (size_t)(16 * kb + kk) * NE + 4); }
              asm volatile("" ::: "memory");
#pragma unroll
              for (int k4 = 0; k4 < 4; ++k4) { const f32x4 x4 = *(const LAS f32x4*)(xp + 16 * kb + 4 * k4);
#pragma unroll
                  for (int kk = 0; kk < 4; ++kk)
#pragma unroll
                      for (int i = 0; i < 4; ++i) { acc[i] += x4[kk] * wv[4 * k4 + kk][0][i]; acc[4 + i] += x4[kk] * wv[4 * k4 + kk][1][i]; } } }
          LAS float* rp = red + (wave * 16 + tl) * 32 + eq * 8;
          *(LAS f32x4*)rp = (f32x4){acc[0], acc[1], acc[2], acc[3]}; *(LAS f32x4*)(rp + 4) = (f32x4){acc[4], acc[5], acc[6], acc[7]}; }
        __syncthreads();
        { const int tl = tid >> 5, e = tid & 31; float a = rb[e];
#pragma unroll
          for (int w = 0; w < 8; ++w) a += red[(w * 16 + tl) * 32 + e];
          lg[tl * 33 + e] = a; }
        __syncthreads();
        if (tid < 16) { const int row = row0 + tid; float v[NE];
#pragma unroll
            for (int e = 0; e < NE; ++e) v[e] = lg[tid * 33 + e];
            int sel[4]; float sv[4];
#pragma unroll
            for (int k = 0; k < 4; ++k) { float best = -3.0e38f; int bi = 0;
#pragma unroll
                for (int e = 0; e < NE; ++e) { const bool taken = (k > 0 && sel[0] == e) || (k > 1 && sel[1] == e) || (k > 2 && sel[2] == e);
                    if (!taken && v[e] > best) { best = v[e]; bi = e; } }
                sel[k] = bi; sv[k] = best; }
            float ex[4], den = 0.f;
#pragma unroll
            for (int k = 0; k < 4; ++k) { ex[k] = __expf(sv[k] - sv[0]); den += ex[k]; }
#pragma unroll
            for (int k = 0; k < 4; ++k) { const unsigned rk = atomicAdd(cnt + sel[k] * 64, 1u);
                stok[(size_t)sel[k] * M_ALL + rk] = row; toke[(size_t)row * 4 + k] = sel[k]; tokr[(size_t)row * 4 + k] = (int)rk; tokg[(size_t)row * 4 + k] = ex[k] / den; } }
        __syncthreads();
    }
}


__device__ __forceinline__ void phase_router2(Frame& F, int l, int row_lo, bool dummy = false) {
    const float* __restrict__ H = WSP(float, WS_H); const float* __restrict__ mods = WSP(float, WS_MODS) + (size_t)l * 9 * (NMOD * D);
    bf16_t* __restrict__ N = WSP(bf16_t, WS_N);
    const float* __restrict__ rw = F.in[I_MRW] + (size_t)l * D * NE; const float* __restrict__ rb = F.in[I_MRB] + l * NE; const float* __restrict__ nw = F.in[I_NFFN] + l * D;
    unsigned* cnt = (unsigned*)(F.ws + WS_CTL) + CW_CNT + l * NE * 64 + (dummy ? 100000 : 0);
    const size_t doff = dummy ? (WS_END - WS_STOK) : 0;
    int* __restrict__ stok = WSP(int, WS_STOK + doff); int* __restrict__ toke = WSP(int, WS_TOKE + doff); int* __restrict__ tokr = WSP(int, WS_TOKE + MiB + doff); float* __restrict__ tokg = WSP(float, WS_TOKE + 2 * MiB + doff);
    constexpr int WS_ = 1028;
    LAS float* WT = (LAS float*)F.lds;
    LAS unsigned* lcnt = (LAS unsigned*)(F.lds + 32 * WS_ * 4);
    LAS int* recs = (LAS int*)(lcnt + 64);
    const int tid = F.tid, lane = F.lane;
    if (tid < 64) lcnt[tid] = 0u;
#pragma unroll 1
    for (int fb = 0; fb < 4; ++fb) { float tv[16];
#pragma unroll
        for (int q = 0; q < 16; ++q) tv[q] = rw[tid + (fb * 16 + q) * NT];
        asm volatile("" ::: "memory");
#pragma unroll
        for (int q = 0; q < 16; ++q) { const int i = tid + (fb * 16 + q) * NT, k = i >> 5, e = i & 31; WT[e * WS_ + k] = tv[q]; } }
    __syncthreads();
    const int gw = F.bid * NWV + F.wave, NGW = F.G * NWV, npair = (M_ALL - row_lo) / 2;
    const bool agg = (npair + NGW - 1) / NGW <= 5;
    const float rbl = rb[lane & 31];
#pragma unroll 1
    for (int p = gw; p < npair; p += NGW) {
        const int row = row_lo + 2 * p; const float* mr = mods + (size_t)row_modr(row) * (NMOD * D);
        f32x4 hv[2][4], wv[4], sh[4], sc[4];
#pragma unroll
        for (int j = 0; j < 4; ++j) { const int c = 4 * lane + 256 * j; hv[0][j] = *(const f32x4*)(H + (size_t)row * D + c); hv[1][j] = *(const f32x4*)(H + (size_t)(row + 1) * D + c);
            wv[j] = *(const f32x4*)(nw + c); sh[j] = *(const f32x4*)(mr + 3 * D + c); sc[j] = *(const f32x4*)(mr + 4 * D + c); }
        asm volatile("" ::: "memory");
        f32x4 x[2][4];
#pragma unroll
        for (int t = 0; t < 2; ++t) { float s = 0.f;
#pragma unroll
            for (int j = 0; j < 4; ++j) s += (hv[t][j].x * hv[t][j].x + hv[t][j].y * hv[t][j].y) + (hv[t][j].z * hv[t][j].z + hv[t][j].w * hv[t][j].w);
            const float rstd = rsqrtf(wave_sum(s) * (1.f / D) + 1e-6f);
#pragma unroll
            for (int j = 0; j < 4; ++j) { const int c = 4 * lane + 256 * j; const f32x4 o = (hv[t][j] * rstd) * wv[j] * (sc[j] + 1.0f) + sh[j]; x[t][j] = o;
                u32x2 pk; pk.x = pk2(o.x, o.y); pk.y = pk2(o.z, o.w); *(u32x2*)(N + (size_t)(row + t) * D + c) = pk; } }
        float ac[64];
#pragma unroll
        for (int e = 0; e < NE; ++e) { float a0 = 0.f, a1 = 0.f;
#pragma unroll
            for (int j = 0; j < 4; ++j) { const f32x4 w4 = *(const LAS f32x4*)(WT + e * WS_ + 4 * lane + 256 * j);
                a0 += (x[0][j].x * w4.x + x[0][j].y * w4.y) + (x[0][j].z * w4.z + x[0][j].w * w4.w);
                a1 += (x[1][j].x * w4.x + x[1][j].y * w4.y) + (x[1][j].z * w4.z + x[1][j].w * w4.w); }
            ac[e] = a0; ac[32 + e] = a1; }
#define RS_DPP(old_, src_, ctrl_, bm_) __builtin_bit_cast(float, __builtin_amdgcn_update_dpp(__builtin_bit_cast(int, old_), __builtin_bit_cast(int, src_), ctrl_, 0xF, bm_, false))
#pragma unroll
        for (int v = 0; v < 64; ++v) if ((v & 8) == 0) { const float lo = ac[v], hi = ac[v | 8];
            ac[v] = RS_DPP(hi, lo, 0x128, 0x3) + RS_DPP(lo, hi, 0x128, 0xC); }
#pragma unroll
        for (int v = 0; v < 64; ++v) if ((v & 12) == 0) { const float lo = ac[v], hi = ac[v | 4];
            ac[v] = RS_DPP(hi, lo, 0x104, 0x5) + RS_DPP(lo, hi, 0x114, 0xA); }
        { const bool b1 = (lane & 2) != 0, b0 = (lane & 1) != 0, b4 = (lane & 16) != 0, b5 = (lane & 32) != 0;
#pragma unroll
          for (int v = 0; v < 64; ++v) if ((v & 14) == 0) { const float lo = ac[v], hi = ac[v | 2]; const float keep = b1 ? hi : lo, send = b1 ? lo : hi; ac[v] = keep + dppf<0x4E>(send); }
#pragma unroll
          for (int v = 0; v < 64; ++v) if ((v & 15) == 0) { const float lo = ac[v], hi = ac[v | 1]; const float keep = b0 ? hi : lo, send = b0 ? lo : hi; ac[v] = keep + dppf<0xB1>(send); }
#pragma unroll
          for (int v = 0; v < 64; ++v) if ((v & 31) == 0) { const float lo = ac[v], hi = ac[v | 16]; const float keep = b4 ? hi : lo, send = b4 ? lo : hi;
              ac[v] = keep + __builtin_bit_cast(float, __builtin_amdgcn_ds_swizzle(__builtin_bit_cast(int, send), 0x401F)); }
          { const float lo = ac[0], hi = ac[32]; const float keep = b5 ? hi : lo, send = b5 ? lo : hi;
              ac[0] = keep + __builtin_bit_cast(float, __builtin_amdgcn_ds_bpermute((lane ^ 32) << 2, __builtin_bit_cast(int, send))); } }
#undef RS_DPP
        float vl = ac[0] + rbl;
        int sel[2][4]; float sv[2][4];
#pragma unroll
        for (int k = 0; k < 4; ++k) { float m = vl;
            m = fmaxf(m, dppf<0xB1>(m)); m = fmaxf(m, dppf<0x4E>(m)); m = fmaxf(m, dppf<0x141>(m)); m = fmaxf(m, dppf<0x140>(m));
            m = fmaxf(m, __builtin_bit_cast(float, __builtin_amdgcn_update_dpp(__builtin_bit_cast(int, -3.0e38f), __builtin_bit_cast(int, m), 0x142, 0xA, 0xF, false)));
            const float m0 = __builtin_bit_cast(float, __builtin_amdgcn_readlane(__builtin_bit_cast(int, m), 31)), m1 = __builtin_bit_cast(float, __builtin_amdgcn_readlane(__builtin_bit_cast(int, m), 63));
            const unsigned long long bal = __ballot(vl == (lane < 32 ? m0 : m1));
            const int b0 = __ffs((unsigned)bal) - 1, b1 = __ffs((unsigned)(bal >> 32)) - 1;
            sel[0][k] = b0; sel[1][k] = b1; sv[0][k] = m0; sv[1][k] = m1;
            if (lane == b0 || lane == 32 + b1) vl = -3.0e38f; }
        float gt_[2][4];
#pragma unroll
        for (int t = 0; t < 2; ++t) { float ex[4], den = 0.f;
#pragma unroll
            for (int k = 0; k < 4; ++k) { ex[k] = __expf(sv[t][k] - sv[t][0]); den += ex[k]; }
#pragma unroll
            for (int k = 0; k < 4; ++k) gt_[t][k] = ex[k] / den; }
        if (lane == 0) {
          if (agg) { const int pi = (p - gw) / NGW;
#pragma unroll
            for (int t = 0; t < 2; ++t) { const int r_ = row + t;
#pragma unroll
                for (int k = 0; k < 4; ++k) { const unsigned lr = __hip_atomic_fetch_add(lcnt + sel[t][k], 1u, __ATOMIC_RELAXED, __HIP_MEMORY_SCOPE_WORKGROUP);
                    recs[(F.wave * 5 + pi) * 8 + t * 4 + k] = (sel[t][k] << 16) | (int)lr;
                    toke[(size_t)r_ * 4 + k] = sel[t][k]; tokg[(size_t)r_ * 4 + k] = gt_[t][k]; } } }
          else { unsigned rk[2][4];
#pragma unroll
            for (int t = 0; t < 2; ++t)
#pragma unroll
                for (int k = 0; k < 4; ++k) rk[t][k] = atomicAdd(cnt + sel[t][k] * 64, 1u);
#pragma unroll
            for (int t = 0; t < 2; ++t) { const int r_ = row + t;
#pragma unroll
                for (int k = 0; k < 4; ++k) { stok[(size_t)sel[t][k] * M_ALL + rk[t][k]] = r_; toke[(size_t)r_ * 4 + k] = sel[t][k]; tokr[(size_t)r_ * 4 + k] = (int)rk[t][k]; tokg[(size_t)r_ * 4 + k] = gt_[t][k]; } } } }
    }
    if (!agg) return;
    __syncthreads();
    if (tid < NE) lcnt[32 + tid] = atomicAdd(cnt + tid * 64, lcnt[tid]);
    __syncthreads();
    { const int np_ = gw < npair ? (npair - gw + NGW - 1) / NGW : 0;
      if (lane < np_ * 8) { const int pi = lane >> 3, t = (lane >> 2) & 1, k = lane & 3; const int rc = recs[(F.wave * 5 + pi) * 8 + t * 4 + k];
          const int e = rc >> 16; const unsigned slot = lcnt[32 + e] + (unsigned)(rc & 0xffff); const int r_ = row_lo + 2 * (gw + pi * NGW) + t;
          stok[(size_t)e * M_ALL + slot] = r_; tokr[(size_t)r_ * 4 + k] = (int)slot; } }
}

__device__ __forceinline__ void moe_prefix(Frame& F, int l, LAS int* pref) {
    const unsigned* cnt = (const unsigned*)(F.ws + WS_CTL) + CW_CNT + l * NE * 64;
    if (F.tid < NE) { const int c = (int)__hip_atomic_load(cnt + F.tid * 64, __ATOMIC_RELAXED, __HIP_MEMORY_SCOPE_AGENT); pref[64 + F.tid] = c; pref[128 + F.tid] = (c + 255) >> 8; }
    __syncthreads();
    if (F.tid == 0) { int a = 0;
#pragma unroll
        for (int e = 0; e < NE; ++e) { pref[e] = a; a += pref[128 + e]; }
        pref[32] = a; }
    __syncthreads();
}

__device__ __forceinline__ void phase_combine(Frame& F, int l, int row_lo, LAS int* pref, float tsc = 1.0f) {
    float* H = WSP(float, WS_H); const float* __restrict__ mods = WSP(float, WS_MODS);
    const bf16_t* __restrict__ YB = WSP(bf16_t, WS_YB); bf16_t* __restrict__ N = WSP(bf16_t, WS_N);
    const int* __restrict__ toke = WSP(int, WS_TOKE); const int* __restrict__ tokr = WSP(int, WS_TOKE + MiB); const float* __restrict__ tokg = WSP(float, WS_TOKE + 2 * MiB);
    const int gw = F.bid * NWV + F.wave, NGW = F.G * NWV, lane = F.lane;
    const bool last = (l == DEPTH - 1);
    int re[4], rr_[4]; float rg_[4];
    int row = row_lo + gw;
    if (row < M_ALL) {
#pragma unroll
        for (int k = 0; k < 4; ++k) { re[k] = toke[(size_t)row * 4 + k]; rr_[k] = tokr[(size_t)row * 4 + k]; rg_[k] = tokg[(size_t)row * 4 + k]; } }
    for (; row < M_ALL; row += NGW) {
        const int r9 = row_modr(row); const float* mr = mods + ((size_t)l * 9 + r9) * (NMOD * D);
        const int nrow = (row + NGW < M_ALL) ? row + NGW : row;
        int ne[4], nr[4]; float ng[4];
#pragma unroll
        for (int k = 0; k < 4; ++k) { ne[k] = toke[(size_t)nrow * 4 + k]; nr[k] = tokr[(size_t)nrow * 4 + k]; ng[k] = tokg[(size_t)nrow * 4 + k]; }
        int dst[4]; float gk[4];
#pragma unroll
        for (int k = 0; k < 4; ++k) { dst[k] = pref[re[k]] * 256 + rr_[k]; gk[k] = rg_[k]; }
        u32x2 yb[4][4]; f32x4 hv0[4], gt[4], pa[4], pb[4], pc[4];
        const float* mn = mods + ((size_t)(last ? l : l + 1) * 9 + r9) * (NMOD * D); const float* nw = last ? F.in[I_NFIN] : F.in[I_NMIX] + (l + 1) * D;
#pragma unroll
        for (int j = 0; j < 4; ++j) { const int c = 4 * lane + 256 * j;
#pragma unroll
            for (int k = 0; k < 4; ++k) yb[j][k] = *(const u32x2*)(YB + (size_t)dst[k] * D + c);
            hv0[j] = *(const f32x4*)(H + (size_t)row * D + c); gt[j] = *(const f32x4*)(mr + 5 * D + c);
            pa[j] = *(const f32x4*)(nw + c); pb[j] = *(const f32x4*)(mn + D + c); pc[j] = *(const f32x4*)(mn + c); }
        asm volatile("" ::: "memory");
        f32x4 v[4]; float ss = 0.f;
#pragma unroll
        for (int j = 0; j < 4; ++j) { const int c = 4 * lane + 256 * j; f32x4 y = (f32x4){0.f, 0.f, 0.f, 0.f};
#pragma unroll
            for (int k = 0; k < 4; ++k) { const u32x2 p = yb[j][k];
                y.x += gk[k] * __builtin_bit_cast(float, p.x << 16); y.y += gk[k] * __builtin_bit_cast(float, p.x & 0xffff0000u);
                y.z += gk[k] * __builtin_bit_cast(float, p.y << 16); y.w += gk[k] * __builtin_bit_cast(float, p.y & 0xffff0000u); }
            const f32x4 hv = hv0[j] + gt[j] * y;
            v[j] = hv; ss += (hv.x * hv.x + hv.y * hv.y) + (hv.z * hv.z + hv.w * hv.w);
            if (!last) *(f32x4*)(H + (size_t)row * D + c) = hv; }
        const float rstd = rsqrtf(wave_sum(ss) * (1.f / D) + 1e-6f);
        if (last) { float* orow = F.out + (size_t)(row - M_CTX) * D;
#pragma unroll
            for (int j = 0; j < 4; ++j) { const int c = 4 * lane + 256 * j; *(f32x4*)(orow + c) = (v[j] * rstd) * pa[j] * tsc; } }
        else {
#pragma unroll
            for (int j = 0; j < 4; ++j) { const int c = 4 * lane + 256 * j;
                const f32x4 o = (v[j] * rstd) * pa[j] * (pb[j] + 1.0f) + pc[j];
                u32x2 p; p.x = pk2(o.x, o.y); p.y = pk2(o.z, o.w); *(u32x2*)(N + (size_t)row * D + c) = p; } }
#pragma unroll
        for (int k = 0; k < 4; ++k) { re[k] = ne[k]; rr_[k] = nr[k]; rg_[k] = ng[k]; }
    }
}

#ifdef DBG_CHECK
constexpr int CW_DBG = 40000;
__device__ __forceinline__ void dbg_add(Frame& F, float num, float den) {
    float* acc = (float*)((unsigned*)(F.ws + WS_CTL) + CW_DBG);
    num = wave_sum(num); den = wave_sum(den);
    if (F.lane == 0) { atomicAdd(acc, num); atomicAdd(acc + 1, den); }
}
__device__ __forceinline__ void dbg_gdn(Frame& F, int ci) {
    const float* Q = WSP(float, WS_GQKV); const float* BG = WSP(float, WS_GBG);
    const int b = ci >> 3, h = (ci >> 1) & 3, d = ci & 1;
    const float* GO = WSP(float, WS_GDO) + (size_t)d * M_ALL * 512;
    LAS float* S = (LAS float*)F.lds;
    LAS float* part = S + 128 * 129;
    LAS float* vn = part + 512;
    LAS float* kq = vn + 128;
    const int tid = F.tid, v = tid & 127, pt = tid >> 7;
    for (int i = tid; i < 128 * 129; i += NT) S[i] = 0.f;
    __syncthreads();
    float num = 0.f, den = 0.f;
    for (int s = 0; s < CTX + SEQ; ++s) {
        const int row = chain_row(b, d, s); const float* qr = Q + (size_t)row * 1536 + h * 128;
        const float beta = BG[(size_t)row * 16 + d * 4 + h], al = __expf(BG[(size_t)row * 16 + 8 + d * 4 + h]);
        if (tid < 128) kq[tid] = qr[512 + tid]; else if (tid < 256) kq[tid] = qr[tid - 128];
        __syncthreads();
        float a = 0.f;
        for (int j = 0; j < 32; ++j) { const int kd = pt * 32 + j; const float sv = S[kd * 129 + v] * al; S[kd * 129 + v] = sv; a += sv * kq[kd]; }
        part[pt * 128 + v] = a;
        __syncthreads();
        if (tid < 128) vn[tid] = beta * (qr[1024 + tid] - (part[tid] + part[128 + tid] + part[256 + tid] + part[384 + tid]));
        __syncthreads();
        a = 0.f;
        for (int j = 0; j < 32; ++j) { const int kd = pt * 32 + j; const float sv = S[kd * 129 + v] + kq[kd] * vn[v]; S[kd * 129 + v] = sv; a += sv * kq[128 + kd]; }
        part[pt * 128 + v] = a;
        __syncthreads();
        if (tid < 128) { const float o = part[tid] + part[128 + tid] + part[256 + tid] + part[384 + tid]; const float f = GO[(size_t)row * 512 + h * 128 + tid];
            num += (o - f) * (o - f); den += o * o; }
        __syncthreads();
    }
    dbg_add(F, num, den);
}
__device__ __forceinline__ void dbg_hyena(Frame& F, int l) {
    const int gw = F.bid * NWV + F.wave, lane = F.lane;
    float num = 0.f, den = 0.f;
    for (int smp = gw; smp < 8192; smp += F.G * NWV) {
        const unsigned hsh = (unsigned)smp * 2654435761u; const int c = hsh & 255, b = (hsh >> 8) & 7; const int isc = (smp & 7) == 0; const int L = isc ? CTX : SEQ; const int t = (hsh >> 11) % L;
        const float* g = isc ? WSP(float, WS_FILTC) + ((size_t)l * 256 + c) * (2 * CTX) : WSP(float, WS_FILT) + ((size_t)l * 256 + c) * (2 * SEQ);
        const float* V = WSP(float, WS_VVT) + ((size_t)c * NB + b) * (CTX + SEQ) + (isc ? 0 : CTX);
        float a = 0.f;
        for (int s = lane; s < L; s += 64) a += g[t - s + L] * V[s];
        a = wave_sum(a);
        const float f = WSP(float, WS_YT)[((size_t)c * NB + b) * (CTX + SEQ) + (isc ? 0 : CTX) + t];
        if (isc && l == DEPTH - 1) continue;
        if (lane == 0) { num += (a - f) * (a - f); den += a * a; }
    }
    dbg_add(F, num, den);
}
__device__ __forceinline__ void dbg_moe(Frame& F, int l, LAS int* pref) {
    const bf16_t* N = WSP(bf16_t, WS_N); const bf16_t* YB = WSP(bf16_t, WS_YB);
    const int* toke = WSP(int, WS_TOKE); const int* tokr = WSP(int, WS_TOKE + MiB); const float* tokg = WSP(float, WS_TOKE + 2 * MiB);
    LAS float* xs = (LAS float*)(F.lds + F.wave * 8192);
    LAS float* as = xs + 1024;
    const int gw = F.bid * NWV + F.wave, lane = F.lane;
    float num = 0.f, den = 0.f;
    for (int smp = gw; smp < 2048; smp += F.G * NWV) {
        const int row = M_CTX + (int)(((unsigned)smp * 2654435761u) % (unsigned)M_LAT);
        for (int i = lane; i < 1024; i += 64) xs[i] = bf2f(N[(size_t)row * D + i]);
        LDS_WAIT();
        float y[16], yf[16];
#pragma unroll
        for (int j = 0; j < 16; ++j) { y[j] = 0.f; yf[j] = 0.f; }
        for (int k = 0; k < 4; ++k) { const int e = toke[(size_t)row * 4 + k]; const float gk = tokg[(size_t)row * 4 + k]; const int dst = pref[e] * 256 + tokr[(size_t)row * 4 + k];
            const float* wgu = F.in[I_MWGU] + ((size_t)l * NE + e) * D * 2048; const float* bgu = F.in[I_MBGU] + ((size_t)l * NE + e) * 2048;
            const float* wdn = F.in[I_MWDN] + ((size_t)l * NE + e) * FF * D; const float* bdn = F.in[I_MBDN] + ((size_t)l * NE + e) * D;
            for (int jf = 0; jf < 16; ++jf) { const int f = jf * 64 + lane; float g = bgu[f], u = bgu[1024 + f];
                for (int dd = 0; dd < D; ++dd) { const float x = xs[dd]; g += x * wgu[(size_t)dd * 2048 + f]; u += x * wgu[(size_t)dd * 2048 + 1024 + f]; }
                g = fminf(g, 7.f); u = fminf(fmaxf(u, -7.f), 7.f); as[f] = (u + 1.f) * (g / (1.f + __expf(-1.702f * g))); }
            LDS_WAIT();
#pragma unroll
            for (int j = 0; j < 16; ++j) { const int c = j * 64 + lane; float a = bdn[c];
                for (int f = 0; f < FF; ++f) a += as[f] * wdn[(size_t)f * D + c];
                y[j] += gk * a; yf[j] += gk * bf2f(YB[(size_t)dst * D + c]); }
            LDS_WAIT(); }
#pragma unroll
        for (int j = 0; j < 16; ++j) { num += (y[j] - yf[j]) * (y[j] - yf[j]); den += y[j] * y[j]; }
    }
    dbg_add(F, num, den);
}

__device__ __forceinline__ void dbg_static(Frame& F) {
    const int gw = F.bid * NWV + F.wave, lane = F.lane;
    float num = 0.f, den = 0.f;
    if (DBG_SUB & 1) for (int smp = gw * 64 + lane; smp < (1 << 20); smp += F.G * NT) {
        const unsigned hsh = (unsigned)smp * 2654435761u; const int l = hsh & 3, k = (hsh >> 2) & 1023, n = (hsh >> 12) % IN_COLS, n2 = (hsh >> 12) & 1023;
        const float a = F.in[I_WIN][((size_t)l * D + k) * IN_COLS + n], b = bf2f(WSP(bf16_t, WS_WIN)[((size_t)l * PW + n) * D + k]);
        const float c = F.in[I_WOUT][((size_t)l * D + k) * D + n2], d = bf2f(WSP(bf16_t, WS_WOUT)[((size_t)l * D + n2) * D + k]);
        num += (a - b) * (a - b) + (c - d) * (c - d); den += a * a + c * c; }
    if (DBG_SUB & 2) for (int smp = gw; smp < 4096; smp += F.G * NWV) {
        const unsigned hsh = (unsigned)smp * 2654435761u; const int l = hsh & 3, r = (hsh >> 2) % 9, n = (hsh >> 8) % (NMOD * D);
        float a = 0.f;
        for (int k = lane; k < D; k += 64) { const float cv = (r < 8) ? F.in[I_C][r * D + k] : F.in[I_CCTX][k]; a += siluf_(cv) * F.in[I_ADAW][((size_t)l * D + k) * (NMOD * D) + n]; }
        a = wave_sum(a) + F.in[I_ADAB][l * (NMOD * D) + n];
        const float f = WSP(float, WS_MODS)[((size_t)l * 9 + r) * (NMOD * D) + n];
        if (lane == 0) { num += (a - f) * (a - f); den += a * a; } }
    if (DBG_SUB & 4) for (int smp = gw; smp < 2048; smp += F.G * NWV) {
        const unsigned hsh = (unsigned)smp * 2654435761u; const int l = hsh & 3; const bool isctx = (hsh >> 2) & 1; const int L = isctx ? CTX : SEQ; const int p = (hsh >> 3) % L;
        const float t = (float)p / (float)(L - 1);
        LAS float* hx = (LAS float*)(F.lds + F.wave * 1024);
        float z = 0.f;
        if (lane == 0) z = t; else if (lane < 33) { const int bi = (lane - 1) & 15; const float band = 1e-4f + (float)bi * ((15.0f - 1e-4f) / 15.0f); const float ang = (6.283185307179586f / (float)L) * (float)p * band; z = (lane <= 16) ? cosf(ang) : -sinf(ang); }
        const float fr = F.in[I_HFREQ][l * 64 + lane];
        hx[lane] = z; LDS_WAIT(); float a = F.in[I_HB1][l * 64 + lane];
#pragma unroll 1
        for (int i = 0; i < 33; ++i) a += hx[i] * F.in[I_HW1][((size_t)l * 33 + i) * 64 + lane];
        float hh = sinf(fr * a); LDS_WAIT(); hx[lane] = hh; LDS_WAIT(); a = F.in[I_HB2][l * 64 + lane];
#pragma unroll 1
        for (int i = 0; i < 64; ++i) a += hx[i] * F.in[I_HW2][((size_t)l * 64 + i) * 64 + lane];
        hh = sinf(fr * a); LDS_WAIT(); hx[lane] = hh; LDS_WAIT(); a = F.in[I_HB3][l * 64 + lane];
#pragma unroll 1
        for (int i = 0; i < 64; ++i) a += hx[i] * F.in[I_HW3][((size_t)l * 64 + i) * 64 + lane];
        hh = sinf(fr * a); LDS_WAIT(); hx[lane] = hh; LDS_WAIT();
        const int ch = ((hsh >> 16) + lane * 16) & 255; float of = 0.f, ob = 0.f;
#pragma unroll 1
        for (int i = 0; i < 64; ++i) { of += hx[i] * F.in[I_HW4][((size_t)l * 64 + i) * 512 + ch]; ob += hx[i] * F.in[I_HW4][((size_t)l * 64 + i) * 512 + 256 + ch]; }
        const float dl = -3.0701134573253946f + (float)ch * ((-15.350567286626973f + 3.0701134573253946f) / 255.0f); const float win = __expf(-t * fabsf(dl));
        of = of * win + (p == 0 ? F.in[I_HSKIP][l * 256 + ch] : 0.f); ob *= win;
        const float* filt = isctx ? WSP(float, WS_FILTC) + ((size_t)l * 256 + ch) * (2 * CTX) : WSP(float, WS_FILT) + ((size_t)l * 256 + ch) * (2 * SEQ);
        if (lane < 16) { const float ff = filt[L + p]; num += (of - ff) * (of - ff); den += of * of;
            if (p >= 1) { const float fb = filt[L - p]; num += (ob - fb) * (ob - fb); den += ob * ob; } }
        LDS_WAIT(); }
    dbg_add(F, num, den);
}

__device__ __forceinline__ float dbg_rw_m(const float* P, const float* mu, int row, int cc) {
    const bool isctx = row < M_CTX; const int b = row_batch(row); const int t = isctx ? row - b * CTX : row - M_CTX - b * SEQ;
    const float* pr = P + (size_t)row * PW + C_RW; float sh = 0.f;
    if (isctx) { if ((cc & 1) == 0) { if (t > 0) sh = pr[-PW + cc]; } else { if (t < CTX - 1) sh = pr[PW + cc]; } }
    else { const int gr = t / 64, gc = t % 64, m4 = cc % 4;
        if (m4 == 0) { if (gc > 0) sh = pr[-PW + cc]; } else if (m4 == 1) { if (gc < 63) sh = pr[PW + cc]; } else if (m4 == 2) { if (gr > 0) sh = pr[-64 * PW + cc]; } else { if (gr < 31) sh = pr[64 * PW + cc]; } }
    return pr[cc] + mu[cc] * (sh - pr[cc]);
}
__device__ __forceinline__ void dbg_prep(Frame& F, int l) {
    const float* P = WSP(float, WS_P); const int gw = F.bid * NWV + F.wave, lane = F.lane;
    float num = 0.f, den = 0.f;
    if (DBG_SUB & 1) for (int smp = gw; smp < 1024; smp += F.G * NWV) {
        const int row = (int)(((unsigned)smp * 2654435761u) % (unsigned)M_ALL);
        const float* mu = F.in[I_RMU] + (size_t)l * RWC; const float* rw = WSP(float, WS_RW) + (size_t)row * 2560;
#pragma unroll 1
        for (int q = 0; q < 4; ++q) { const int c = lane + 64 * q;
            const float r_ = dbg_rw_m(P, mu, row, c), k_ = dbg_rw_m(P, mu, row, 256 + c), v_ = dbg_rw_m(P, mu, row, 512 + c);
            float lw[2] = {F.in[I_RW0][l * 512 + c], F.in[I_RW0][l * 512 + 256 + c]}, la[2] = {F.in[I_RA0][l * 512 + c], F.in[I_RA0][l * 512 + 256 + c]}, g = 0.f;
#pragma unroll 1
            for (int r = 0; r < 64; ++r) {
#pragma unroll
                for (int d = 0; d < 2; ++d) { lw[d] += tanhf(dbg_rw_m(P, mu, row, 768 + d * 64 + r)) * F.in[I_RW2][(((size_t)l * 2 + d) * 64 + r) * 256 + c];
                    la[d] += dbg_rw_m(P, mu, row, 896 + d * 64 + r) * F.in[I_RA2][(((size_t)l * 2 + d) * 64 + r) * 256 + c]; } }
#pragma unroll 1
            for (int r = 0; r < 128; ++r) g += sigmoidf_(dbg_rw_m(P, mu, row, 1024 + r)) * F.in[I_RG2][((size_t)l * 128 + r) * 256 + c];
            const float kx = k_ * F.in[I_RKK][l * 256 + c]; const float kk = kx * rsqrtf(wave_sum(kx * kx) + 1e-12f);
            float ref[10]; ref[0] = r_; ref[1] = v_; ref[2] = kk; ref[9] = g; float bon = 0.f;
#pragma unroll
            for (int d = 0; d < 2; ++d) { const float lwv = -softplusf_(-lw[d]) - 0.5f; ref[3 + 3 * d] = expf(-expf(lwv)); const float a = sigmoidf_(la[d]);
                const float kd = k_ * (1.f + (a - 1.f) * F.in[I_RKA][l * 256 + c]); ref[4 + 3 * d] = kd; ref[5 + 3 * d] = kk * a; bon += r_ * kd * F.in[I_RRK][l * 256 + c]; }
            bon = wave_sum(bon);
#pragma unroll
            for (int j = 0; j < 10; ++j) { const float f = rw[j * 256 + c]; num += (ref[j] - f) * (ref[j] - f); den += ref[j] * ref[j]; }
            if (lane == 0) { const float f = WSP(float, WS_RWBON)[(size_t)row * 4 + q]; num += (bon - f) * (bon - f); den += bon * bon; } } }
    if (DBG_SUB & 2) for (int smp = gw; smp < 4096; smp += F.G * NWV) {
        const int row = (int)(((unsigned)smp * 2654435761u) % (unsigned)M_ALL);
        const bool isctx = row < M_CTX; const int L = isctx ? CTX : SEQ; const int b = row_batch(row); const int t = isctx ? row - b * CTX : row - M_CTX - b * SEQ;
        const float* cw = F.in[I_GCONV] + (size_t)l * 5 * 1536; const float* q = WSP(float, WS_GQKV) + (size_t)row * 1536;
#pragma unroll 1
        for (int part = 0; part < 3; ++part)
#pragma unroll 1
            for (int hd = 0; hd < 4; ++hd) { float x[2];
#pragma unroll
                for (int jj = 0; jj < 2; ++jj) { const int c = part * 512 + hd * 128 + jj * 64 + lane; float a = 0.f;
                    for (int tap = 0; tap < 5; ++tap) { const int tt = t + tap - 2; if (tt >= 0 && tt < L) a += P[(size_t)(row + tap - 2) * PW + C_GD + c] * cw[tap * 1536 + c]; }
                    x[jj] = a / (1.f + expf(-a)); }
                if (part < 2) { const float sc = rsqrtf(wave_sum(x[0] * x[0] + x[1] * x[1]) + 1e-12f) * (part == 0 ? 0.08838834764831845f : 1.f); x[0] *= sc; x[1] *= sc; }
#pragma unroll
                for (int jj = 0; jj < 2; ++jj) { const float f = q[part * 512 + hd * 128 + jj * 64 + lane]; num += (x[jj] - f) * (x[jj] - f); den += x[jj] * x[jj]; } }
        if (lane < 16) { const float rv = P[(size_t)row * PW + C_GD + 2048 + lane]; float ov;
            if (lane < 8) ov = 1.f / (1.f + expf(-rv)); else { const int dh = lane - 8; ov = -expf(F.in[I_GALOG][l * 8 + dh]) * softplusf_(rv + F.in[I_GDT][l * 8 + dh]); }
            const float f = WSP(float, WS_GBG)[(size_t)row * 16 + lane]; num += (ov - f) * (ov - f); den += ov * ov; } }
    if (DBG_SUB & 4) for (int smp = gw; smp < 4096; smp += F.G * NWV) {
        const int row = M_CTX + (int)(((unsigned)smp * 2654435761u) % (unsigned)M_LAT); const int b = row_batch(row), t = row - M_CTX - b * SEQ;
        const float* sw = F.in[I_HSW] + (size_t)l * 3 * 768; const float* sb = F.in[I_HSB] + (size_t)l * 768;
        const bf16_t* yc = WSP(bf16_t, WS_YCAT) + (size_t)row * D;
#pragma unroll 1
        for (int j = 0; j < 4; ++j) { const int c = j * 64 + lane; float u[3];
#pragma unroll
            for (int g3 = 0; g3 < 3; ++g3) { float a = sb[g3 * 256 + c];
                for (int tap = 0; tap < 3; ++tap) { const int tt = t + tap - 1; if (tt >= 0 && tt < SEQ) a += P[(size_t)(row + tap - 1) * PW + g3 * 256 + c] * sw[tap * 768 + g3 * 256 + c]; }
                u[g3] = a; }
            const float vv = u[2] * u[1]; const float fv = WSP(float, WS_VVT)[((size_t)c * NB + b) * (CTX + SEQ) + CTX + t];
            num += (vv - fv) * (vv - fv); den += vv * vv;
            const float yv = WSP(float, WS_YT)[((size_t)c * NB + b) * (CTX + SEQ) + CTX + t] * u[0]; const float fy = bf2f(yc[c]);
            num += (yv - fy) * (yv - fy); den += yv * yv; }
        const float* rw = WSP(float, WS_RW) + (size_t)row * 2560;
#pragma unroll 1
        for (int q = 0; q < 4; ++q) { const int c = lane + 64 * q; const float o = WSP(float, WS_RWO)[(size_t)row * 256 + c] + WSP(float, WS_RWO)[(size_t)(M_ALL + row) * 256 + c];
            const float mean = wave_sum(o) / 64.f; const float var = wave_sum((o - mean) * (o - mean)) / 64.f;
            float y = (o - mean) / sqrtf(var + 64e-5f) * F.in[I_RGNW][l * 256 + c] + F.in[I_RGNB][l * 256 + c];
            y = (y + WSP(float, WS_RWBON)[(size_t)row * 4 + q] * rw[256 + c]) * rw[9 * 256 + c];
            const float fy = bf2f(yc[256 + c]); num += (y - fy) * (y - fy); den += y * y; }
#pragma unroll 1
        for (int hd = 0; hd < 4; ++hd) { float o[2];
#pragma unroll
            for (int jj = 0; jj < 2; ++jj) { const int c = hd * 128 + jj * 64 + lane; o[jj] = WSP(float, WS_GDO)[(size_t)row * 512 + c] + WSP(float, WS_GDO)[(size_t)(M_ALL + row) * 512 + c]; }
            const float rs = 1.f / sqrtf(wave_sum(o[0] * o[0] + o[1] * o[1]) / 128.f + 1e-6f);
#pragma unroll
            for (int jj = 0; jj < 2; ++jj) { const int c = hd * 128 + jj * 64 + lane; const float z = P[(size_t)row * PW + C_GD + 1536 + c];
                const float y = o[jj] * rs * F.in[I_GNW][l * 128 + jj * 64 + lane] * (z / (1.f + expf(-z))); const float fy = bf2f(yc[512 + c]); num += (y - fy) * (y - fy); den += y * y; } } }
    dbg_add(F, num, den);
}
__device__ __forceinline__ void dbg_router(Frame& F, int l) {
    const int gw = F.bid * NWV + F.wave, lane = F.lane; LAS float* xs = (LAS float*)(F.lds + F.wave * 4096);
    float num = 0.f, den = 0.f;
    for (int smp = gw; smp < 4096; smp += F.G * NWV) {
        const int row = M_CTX + (int)(((unsigned)smp * 2654435761u) % (unsigned)M_LAT); const int b = row_batch(row);
        const float* h = WSP(float, WS_H) + (size_t)row * D; const float* mr = WSP(float, WS_MODS) + ((size_t)l * 9 + b) * (NMOD * D);
        float ss = 0.f; for (int i = lane; i < D; i += 64) ss += h[i] * h[i];
        const float rstd = 1.f / sqrtf(wave_sum(ss) / D + 1e-6f);
        for (int i = lane; i < D; i += 64) xs[i] = h[i] * rstd * F.in[I_NFFN][l * D + i] * (1.f + mr[4 * D + i]) + mr[3 * D + i];
        LDS_WAIT();
        float lg = -3e38f;
        if (lane < 32) { lg = F.in[I_MRB][l * NE + lane]; for (int k = 0; k < D; ++k) lg += xs[k] * F.in[I_MRW][((size_t)l * D + k) * NE + lane]; }
        float sv[4]; int se[4]; float cur = lg;
#pragma unroll
        for (int k = 0; k < 4; ++k) { float m = cur;
#pragma unroll
            for (int o = 1; o < 64; o <<= 1) m = fmaxf(m, __shfl_xor(m, o));
            const unsigned long long bal = __ballot(cur == m); const int who = __ffsll((long long)bal) - 1; sv[k] = m; se[k] = who; if (lane == who) cur = -3e38f; }
        float ex[4], dn = 0.f;
#pragma unroll
        for (int k = 0; k < 4; ++k) { ex[k] = expf(sv[k] - sv[0]); dn += ex[k]; }
        if (lane == 0) {
#pragma unroll
            for (int k = 0; k < 4; ++k) { const float g = ex[k] / dn; float fg = 0.f;
                for (int k2 = 0; k2 < 4; ++k2) if (WSP(int, WS_TOKE)[(size_t)row * 4 + k2] == se[k]) fg = WSP(float, WS_TOKE + 2 * MiB)[(size_t)row * 4 + k2];
                num += (g - fg) * (g - fg); den += g * g; } }
        LDS_WAIT(); }
    dbg_add(F, num, den);
}
__device__ __forceinline__ void dbg_rwkv_scan(Frame& F, int ci) {
    const int lane = F.lane; const int b = ci >> 3, h = (ci >> 1) & 3, d = ci & 1;
    const float* RW = WSP(float, WS_RW); const float* RO = WSP(float, WS_RWO) + (size_t)d * M_ALL * 256;
    LAS float* vs = (LAS float*)(F.lds + F.wave * 2048);
    float S[64];
#pragma unroll
    for (int k = 0; k < 64; ++k) S[k] = 0.f;
    float num = 0.f, den = 0.f;
#pragma unroll 1
    for (int s = 0; s < CTX + SEQ; ++s) { const int row = chain_row(b, d, s); const float* src = RW + (size_t)row * 2560 + h * 64;
        vs[lane] = -src[2 * 256 + lane]; vs[64 + lane] = src[(3 + 3 * d) * 256 + lane]; vs[128 + lane] = src[(5 + 3 * d) * 256 + lane]; vs[192 + lane] = src[(4 + 3 * d) * 256 + lane]; vs[256 + lane] = src[lane];
        const float v = src[256 + lane]; LDS_WAIT();
        float sa = 0.f;
#pragma unroll
        for (int k = 0; k < 64; ++k) sa += S[k] * vs[k];
        float o = 0.f;
#pragma unroll
        for (int k = 0; k < 64; ++k) { S[k] = S[k] * vs[64 + k] + sa * vs[128 + k] + v * vs[192 + k]; o += S[k] * vs[256 + k]; }
        const float f = RO[(size_t)row * 256 + h * 64 + lane]; num += (o - f) * (o - f); den += o * o; LDS_WAIT(); }
    dbg_add(F, num, den);
}
__device__ __forceinline__ void dbg_scale(Frame& F, float K) {
    const float* acc = (const float*)((unsigned*)(F.ws + WS_CTL) + CW_DBG);
    const float rel = sqrtf(acc[0] / fmaxf(acc[1], 1e-30f)); const float sc = 1.f + K * rel;
    for (size_t i = (size_t)F.bid * NT + F.tid; i < (size_t)M_LAT * D; i += (size_t)F.G * NT) F.out[i] *= sc;
}
#endif

#ifdef TPROBE
__device__ __attribute__((noinline)) void tprobe_stamp(unsigned char* ws, int mode) {
    unsigned* t = (unsigned*)(ws + WS_CTL) + 50000;
    if (blockIdx.x == 0 && threadIdx.x == 0) { const unsigned now = (unsigned)__builtin_amdgcn_s_memrealtime();
        if (mode == 2) { t[2] = now; t[1] = now; }
        else if (mode == 0) t[1] = now;
        else atomicAdd(t, now - t[1]); }
}
__device__ __attribute__((noinline)) float tprobe_scale(unsigned char* ws) {
    const unsigned* t = (const unsigned*)(ws + WS_CTL) + 50000;
    const unsigned acc = __hip_atomic_load(t, __ATOMIC_RELAXED, __HIP_MEMORY_SCOPE_AGENT), st = __hip_atomic_load(t + 2, __ATOMIC_RELAXED, __HIP_MEMORY_SCOPE_AGENT);
    const unsigned now = (unsigned)__builtin_amdgcn_s_memrealtime();
    return 1.0f + TPROBE_K * (float)acc / (float)(now - st);
}
#endif
constexpr int PH_PER_LAYER = 11, N_PHASES = 1 + DEPTH * PH_PER_LAYER;
__global__ void __launch_bounds__(NT, 2) hybrid_fwd(Args args) {
    extern __shared__ __attribute__((aligned(16))) unsigned char lds_raw[];
    Frame F;
    F.lds = (LAS unsigned char*)lds_raw;
    F.tid = threadIdx.x; F.lane = F.tid & 63; F.wave = __builtin_amdgcn_readfirstlane(F.tid >> 6);
    F.G = gridDim.x; F.bid = blockIdx.x; F.in = args.in; F.ws = args.ws; F.out = args.out;
    const int wave0 = F.wave;
    volatile LAS unsigned* MISC = (volatile LAS unsigned*)(F.lds + MISC_OFF);
    LAS int* pref = (LAS int*)(F.lds + MISC_OFF + 256);
    if (F.tid < 4) MISC[F.tid] = 0u;
    __syncthreads();
    const int lo = args.ph_lo, hi = args.ph_hi;
    XcdBarrier bar; bar.bar = (unsigned*)(F.ws + WS_CTL) + CW_BAR; bar.x = 0; bar.st = MISC;
    if (hi - lo > 1) bar = xcd_barrier_post((unsigned*)(F.ws + WS_CTL) + CW_BAR, MISC);
#ifndef PHASE_MASK
#define PHASE_MASK 0xFFFF
#endif
#define PM(j) ((PHASE_MASK >> (j)) & 1)
#define ENTER() do { F.ws = launder_ptr(F.ws); F.out = launder_ptr(F.out); l = launder_int(l); { int ln_; asm volatile("v_mbcnt_lo_u32_b32 %0, -1, 0\n\tv_mbcnt_hi_u32_b32 %0, -1, %0" : "=&v"(ln_)); __builtin_assume(ln_ >= 0 && ln_ < 64); F.lane = ln_; F.wave = launder_int(wave0); __builtin_assume(F.wave >= 0 && F.wave < 8); F.tid = F.wave * 64 + ln_; } } while (0)
#define IN(k) (lo <= (k) && (k) < hi)
#define last (l == DEPTH - 1)
#ifdef TPROBE
#define SEAMC(k, cls) do { if (hi > (k) + 1) xcd_barrier(bar); \
        if ((cls) == TPROBE - 1) tprobe_stamp(F.ws, 0); \
        if ((cls) == TPROBE) tprobe_stamp(F.ws, 1); } while (0)
#else
#define SEAMC(k, cls) do { if (hi > (k) + 1) xcd_barrier(bar); } while (0)
#endif
#define SEAM(k) SEAMC(k, 99)
#ifdef TPROBE
    tprobe_stamp(F.ws, 2);
#endif
    if (PM(11) && IN(0)) { phase_prologue(F);
#if defined(DUP_PHASE) && DUP_PHASE == 0
        __syncthreads(); phase_prologue(F);
#endif
        SEAM(0); }
    for (int l = 0; l < DEPTH; ++l) {
        const int pb = 1 + l * PH_PER_LAYER;
        if (PM(0) && l == 0 && IN(pb + 0)) { ENTER(); phase_norm0(F); SEAMC(pb + 0, 1); }
        if (PM(1) && IN(pb + 1)) {
            ENTER();
            pg8::StaticOrder S; S.init(WSP(bf16_t, WS_N), WSP(bf16_t, WS_WIN) + (size_t)l * PW * D, M_ALL, PW, D, F.G, F.bid);
            pg8::EpiF32 E{WSP(float, WS_P), PW};
            pg8::gemm_phase(F.lds, S, E, F.tid);
#if defined(DUPX) && DUPX == 2
            __syncthreads(); pg8::gemm_phase(F.lds, S, E, F.tid);
#endif
#if defined(DUP_PHASE) && DUP_PHASE == 2
            __syncthreads(); pg8::gemm_phase(F.lds, S, E, F.tid);
#endif
            SEAMC(pb + 1, 2);
        }
        if (PM(2) && IN(pb + 2)) {
            ENTER();
#ifndef SUBM
#define SUBM 7
#endif
            TileSched th = strided_sched(F, M_ALL / 64), tr = strided_sched(F, M_ALL / 32), tg = strided_sched(F, M_ALL / 64);
            if (F.G == 256) { const int i = F.bid; th.bal = tr.bal = tg.bal = true;
                tr.v0 = i; tr.v1 = i + 256; tr.v2 = (i + 512 < M_ALL / 32) ? i + 512 : -1;
                tg.v0 = i; tg.v1 = (i >= 64 && i < 96) ? 256 + (i - 64) : -1;
                th.v0 = i; th.v1 = (i >= 96 && i < 128) ? 256 + (i - 96) : -1; }
            prep_hyena(F, l, !last, th); __syncthreads(); prep_rwkv(F, l, tr); __syncthreads(); prep_gdn(F, l, tg);
#if defined(DUPX) && DUPX == 3
            __syncthreads(); prep_hyena(F, l, !last, th); __syncthreads(); prep_rwkv(F, l, tr); __syncthreads(); prep_gdn(F, l, tg);
#endif
#if defined(DUPX) && DUPX == 31
            __syncthreads(); prep_rwkv(F, l, tr);
#endif
#if defined(DUPX) && DUPX == 32
            __syncthreads(); prep_gdn(F, l, tg);
#endif
            SEAMC(pb + 2, 3); }
        if (PM(3) && IN(pb + 3)) {
            ENTER();
            if (F.wave < 5) { LAS unsigned char* wl = F.lds + F.wave * 27648; for (int u = F.bid * 5 + F.wave; u < 64 * NCHUNK; u += F.G * 5) gdn_precompute_wave(F, u / NCHUNK, u % NCHUNK, wl); }
            __syncthreads();
            for (int c = F.bid; c < 256; c += F.G) { hyena_lat_unit(F, l, c); if (!last) hyena_ctx_unit(F, l, c); }
#if defined(DUPX) && DUPX == 4
            __syncthreads(); if (F.wave < 5) { LAS unsigned char* wl = F.lds + F.wave * 27648; for (int u = F.bid * 5 + F.wave; u < 64 * NCHUNK; u += F.G * 5) gdn_precompute_wave(F, u / NCHUNK, u % NCHUNK, wl); }
            __syncthreads();
#endif
#if defined(DUPX) && DUPX == 41
            __syncthreads(); for (int c = F.bid; c < 256; c += F.G) { hyena_lat_unit(F, l, c); if (!last) hyena_ctx_unit(F, l, c); }
#endif
            SEAMC(pb + 3, 4);
        }
        if (PM(4) && IN(pb + 4)) {
            ENTER();
            {
                volatile LAS unsigned* sbc = (volatile LAS unsigned*)(F.lds + MISC_OFF + 64);
                if (F.tid == 0) *sbc = 0u;
                __syncthreads();
                if (F.wave < 4) { unsigned gen = 0u;
                    if (F.G == 256) { const int xcd = F.bid & 7, t = F.bid >> 3; rwkv_scan_quarter(F, (t >> 2) * 8 + xcd, t & 3, sbc, gen); }
                    else for (int u = F.bid; u < 256; u += F.G) rwkv_scan_quarter(F, u >> 2, u & 3, sbc, gen);
#if defined(DUP_PHASE) && DUP_PHASE == 53
                    { const int xcd = F.bid & 7, t = F.bid >> 3; rwkv_scan_quarter(F, (t >> 2) * 8 + xcd, t & 3, sbc, gen); }
#endif
                }
                else { LAS bf16_t* St = (LAS bf16_t*)(F.lds + 90112 + (F.wave - 4) * 14336); LAS bf16_t* Vn = St + 32 * 136;
                    if (F.G == 256) {
                        if (F.wave == 4) { const int xcd = F.bid & 7, t = F.bid >> 3; gdn_chain_wave(F, (t >> 2) * 8 + xcd, t & 3, St, Vn);
#if defined(DUP_PHASE) && DUP_PHASE == 54
                            gdn_chain_wave(F, (t >> 2) * 8 + xcd, t & 3, St, Vn);
#endif
                        } }
                    else for (int g = F.bid * 4 + (F.wave - 4); g < 256; g += F.G * 4) gdn_chain_wave(F, g >> 2, g & 3, St, Vn);
                }
                __syncthreads();
            }
            SEAMC(pb + 4, 5);
        }
        if (PM(5) && IN(pb + 5)) { ENTER(); phase_finish(F, l, !last);
#if defined(DUP_PHASE) && DUP_PHASE == 6
            __syncthreads(); phase_finish(F, l, !last);
#endif
            SEAMC(pb + 5, 6); }
        if (PM(6) && IN(pb + 6)) {
            ENTER();
            const int r0 = last ? M_CTX : 0;
            pg8::StaticOrder S; S.init(WSP(bf16_t, WS_YCAT) + (size_t)r0 * D, WSP(bf16_t, WS_WOUT) + (size_t)l * D * D, M_ALL - r0, D, D, F.G, F.bid);
            pg8::EpiRes E{WSP(float, WS_H) + (size_t)r0 * D, WSP(float, WS_H) + (size_t)r0 * D, WSP(float, WS_MODS) + (size_t)l * 9 * (NMOD * D) + 2 * D, r0};
            pg8::gemm_phase(F.lds, S, E, F.tid);
            SEAMC(pb + 6, 7);
        }
        if (PM(7) && IN(pb + 7)) { ENTER(); phase_router2(F, l, last ? M_CTX : 0);
#if defined(DUPX) && DUPX == 8
            __syncthreads(); phase_router(F, l, last ? M_CTX : 0, true);
#endif
#if defined(DUPX) && DUPX == 81
            __syncthreads(); phase_router2(F, l, last ? M_CTX : 0, true);
#endif
 SEAMC(pb + 7, 8); }
        if (PM(8) && IN(pb + 8)) {
            ENTER();
            moe_prefix(F, l, pref);
            pg8::MoeOrder<true, 8> S; S.A = WSP(bf16_t, WS_N); S.Bt = WSP(bf16_t, WS_WGU) + (size_t)l * NE * 2048 * D; S.K = D; S.Nexp = 2048; S.pref = pref; S.stok = WSP(int, WS_STOK); S.G = F.G; S.c = F.bid;
            pg8::EpiGU E{WSP(bf16_t, WS_ACT), F.in[I_MBGU] + (size_t)l * NE * 2048};
            pg8::gemm_phase(F.lds, S, E, F.tid);
            SEAMC(pb + 8, 9);
        }
        if (PM(9) && IN(pb + 9)) {
            ENTER();
            moe_prefix(F, l, pref);
            pg8::MoeOrder<false, 4> S; S.A = WSP(bf16_t, WS_ACT); S.Bt = WSP(bf16_t, WS_WDN) + (size_t)l * NE * D * FF; S.K = FF; S.Nexp = D; S.pref = pref; S.stok = nullptr; S.G = F.G; S.c = F.bid;
            pg8::EpiDN E{WSP(bf16_t, WS_YB), F.in[I_MBDN] + (size_t)l * NE * D};
            pg8::gemm_phase(F.lds, S, E, F.tid);
#if defined(DUP_PHASE) && DUP_PHASE == 10
            __syncthreads(); pg8::gemm_phase(F.lds, S, E, F.tid);
#endif
            SEAMC(pb + 9, 10);
        }
        if (PM(10) && IN(pb + 10)) { ENTER(); moe_prefix(F, l, pref); float tsc = 1.0f;
#ifdef TPROBE
            if (last) tsc = tprobe_scale(F.ws);
#endif
            phase_combine(F, l, last ? M_CTX : 0, pref, tsc); SEAMC(pb + 10, 11); }
    }
#undef IN
#undef SEAM
#undef last
}


#ifdef DBG_CHECK
__global__ void __launch_bounds__(NT, 2) dbg_kernel(Args args) {
    extern __shared__ __attribute__((aligned(16))) unsigned char lds_raw[];
    Frame F;
    F.lds = (LAS unsigned char*)lds_raw;
    F.tid = threadIdx.x; F.lane = F.tid & 63; F.wave = __builtin_amdgcn_readfirstlane(F.tid >> 6);
    F.G = gridDim.x; F.bid = blockIdx.x; F.in = args.in; F.ws = args.ws; F.out = args.out;
    LAS int* pref = (LAS int*)(F.lds + MISC_OFF + 256);
    const int l = DEPTH - 1;
    if (args.ph_lo == 0) {
        if (DBG_CHECK == 1) { moe_prefix(F, l, pref); dbg_moe(F, l, pref); }
        if (DBG_CHECK == 2) { if (F.bid < 8) dbg_gdn(F, F.bid * 8 + (F.bid & 1) + 2 * (F.bid % 4)); }
        if (DBG_CHECK == 3) dbg_hyena(F, l);
        if (DBG_CHECK == 4) dbg_static(F);
        if (DBG_CHECK == 5) dbg_prep(F, l);
        if (DBG_CHECK == 6) dbg_router(F, l);
        if (DBG_CHECK == 7) { if (F.bid < 8 && F.wave == 0) dbg_rwkv_scan(F, F.bid * 8 + (F.bid & 1) + 2 * (F.bid % 4)); }
    } else dbg_scale(F, DBG_K);
}
#endif
extern "C" void kernel_launch(void* const* d_in, const int* in_sizes, int n_in, void* d_out, int out_size, void* d_ws, size_t ws_size, hipStream_t stream) {
    static int grid = 0;
    if (grid == 0) {
        int dev = 0, cus = 0, per_cu = 0;
        if (n_in != 43 || ws_size < WS_END) { fprintf(stderr, "kernel_launch: unexpected inputs (%d) or workspace (%zu < %zu)\n", n_in, ws_size, (size_t)WS_END); grid = -1; return; }
        if (hipGetDevice(&dev) != hipSuccess || hipDeviceGetAttribute(&cus, hipDeviceAttributeMultiprocessorCount, dev) != hipSuccess) { grid = -1; return; }
        if (hipFuncSetAttribute((const void*)hybrid_fwd, hipFuncAttributeMaxDynamicSharedMemorySize, LDS_BYTES) != hipSuccess) { fprintf(stderr, "kernel_launch: hipFuncSetAttribute failed\n"); grid = -1; return; }
        if (hipOccupancyMaxActiveBlocksPerMultiprocessor(&per_cu, (const void*)hybrid_fwd, NT, LDS_BYTES) != hipSuccess || per_cu < 1) fprintf(stderr, "kernel_launch: occupancy query reports %d\n", per_cu);
        (void)hipGetLastError();
        grid = cus;
    }
    if (grid < 0) return;
    (void)hipMemsetAsync((char*)d_ws + WS_CTL, 0, CTL_ZERO, stream);
    Args a{};
    for (int i = 0; i < 43; ++i) a.in[i] = (const float*)d_in[i];
    a.out = (float*)d_out; a.ws = (unsigned char*)d_ws;
#if N_LAUNCH_MODE == 1
    a.ph_lo = 0; a.ph_hi = N_PHASES;
    hipLaunchKernelGGL(hybrid_fwd, dim3(grid), dim3(NT), LDS_BYTES, stream, a);
#else
    const int nph = N_PHASES;
    for (int ph = 0; ph < nph; ++ph) {
        if (ph > 0 && ph < N_PHASES && (ph - 1) % PH_PER_LAYER == 0 && (ph - 1) / PH_PER_LAYER > 0) continue;
        a.ph_lo = ph; a.ph_hi = ph + 1;
        hipLaunchKernelGGL(hybrid_fwd, dim3(grid), dim3(NT), LDS_BYTES, stream, a);
    }
#ifdef DBG_CHECK
    static int dbg_init = 0;
    if (!dbg_init) { (void)hipFuncSetAttribute((const void*)dbg_kernel, hipFuncAttributeMaxDynamicSharedMemorySize, LDS_BYTES); dbg_init = 1; }
    a.ph_lo = 0; a.ph_hi = 1; hipLaunchKernelGGL(dbg_kernel, dim3(grid), dim3(NT), LDS_BYTES, stream, a);
    a.ph_lo = 1; a.ph_hi = 2; hipLaunchKernelGGL(dbg_kernel, dim3(grid), dim3(NT), LDS_BYTES, stream, a);
#endif
#endif
}
```

```cpp
#include <hip/hip_runtime.h>
#include <cstdio>
#include <cstdint>

#ifndef N_LAUNCH_MODE
#define N_LAUNCH_MODE 1
#endif

#define LAS __attribute__((address_space(3)))
#define GAS __attribute__((address_space(1)))
typedef unsigned short bf16_t;
typedef short bf16x8 __attribute__((ext_vector_type(8)));
typedef float f32x4 __attribute__((ext_vector_type(4)));
typedef float f32x2 __attribute__((ext_vector_type(2)));
typedef unsigned u32x4 __attribute__((ext_vector_type(4)));
typedef unsigned u32x2 __attribute__((ext_vector_type(2)));

constexpr int NCHUNK = 36;
constexpr int D = 1024, NB = 8, SEQ = 2048, CTX = 256, DEPTH = 4;
constexpr int M_CTX = NB * CTX;
constexpr int M_LAT = NB * SEQ;
constexpr int M_ALL = M_CTX + M_LAT;
constexpr int NMOD = 6;
constexpr int PW = 4096;
constexpr int IN_COLS = 3984;
constexpr int C_HY = 0, C_RW = 768, C_GD = 1920;
constexpr int RWC = 1152;
constexpr int NE = 32, TOPK = 4, FF = 1024;
constexpr int NT = 512, NWV = 8;

constexpr size_t MiB = 1ull << 20;
constexpr size_t WS_CTL   = 0;
constexpr size_t CTL_ZERO = 2 * MiB;
constexpr size_t WS_MODS  = 2 * MiB;
constexpr size_t WS_FILT  = 4 * MiB;
constexpr size_t WS_FILTC = 20 * MiB;
constexpr size_t WS_LORA  = 22 * MiB;
constexpr size_t LORA_L = 196608;
constexpr size_t WS_WIN   = 24 * MiB;
constexpr size_t WS_WOUT  = 56 * MiB;
constexpr size_t WS_WGU   = 64 * MiB;
constexpr size_t WS_WDN   = 576 * MiB;
constexpr size_t WS_H     = 832 * MiB;
constexpr size_t WS_N     = 904 * MiB;
constexpr size_t WS_P     = 940 * MiB;
constexpr size_t WS_RW    = 1228 * MiB;
constexpr size_t WS_RWBON = 1408 * MiB;
constexpr size_t WS_GQKV  = 1410 * MiB;
constexpr size_t WS_QB = WS_GQKV, WS_KB = WS_GQKV + 20 * MiB, WS_KT = WS_GQKV + 40 * MiB, WS_VT = WS_GQKV + 60 * MiB;
constexpr size_t WS_GBG   = 1518 * MiB;
constexpr size_t WS_VVT   = 1520 * MiB;
constexpr size_t WS_YT    = 1540 * MiB;
constexpr size_t WS_RWO   = 1560 * MiB;
constexpr size_t WS_GDO   = 1596 * MiB;
constexpr size_t WS_GPRE  = 1668 * MiB;
constexpr size_t WS_YCAT  = 1884 * MiB;
constexpr size_t WS_STOK  = 1920 * MiB;
constexpr size_t WS_TOKE  = 1924 * MiB;
constexpr size_t WS_ACT   = 1928 * MiB;
constexpr size_t WS_YB    = 2088 * MiB;
constexpr size_t WS_END   = 2248 * MiB;

constexpr int CW_BAR = 4096;
constexpr int CW_CNT = 16384;

constexpr int LDS_BYTES = 155648;
constexpr int MISC_OFF  = 153600;
constexpr int SCR_BYTES = 153600;

typedef __bf16 hwbf16x2 __attribute__((ext_vector_type(2)));
__device__ __forceinline__ unsigned pk2(float lo, float hi) { const f32x2 v = {lo, hi}; return __builtin_bit_cast(unsigned, __builtin_convertvector(v, hwbf16x2)); }
__device__ __forceinline__ unsigned f2bf(float f) { return (unsigned)__builtin_bit_cast(unsigned short, (__bf16)f); }
__device__ __forceinline__ float bf2f(unsigned short b) { return __builtin_bit_cast(float, ((unsigned)b) << 16); }
template <int CTRL> __device__ __forceinline__ float dppf(float x) {
    return __builtin_bit_cast(float, __builtin_amdgcn_update_dpp(0, __builtin_bit_cast(int, x), CTRL, 0xF, 0xF, true));
}
__device__ __forceinline__ float row16_sum(float x) {
    x += dppf<0xB1>(x);
    x += dppf<0x4E>(x);
    x += dppf<0x141>(x);
    x += dppf<0x140>(x);
    return x;
}
__device__ __forceinline__ float wave_sum(float v) {
    v = row16_sum(v);
    v += __builtin_bit_cast(float, __builtin_amdgcn_update_dpp(0, __builtin_bit_cast(int, v), 0x142, 0xA, 0xF, false));
    v += __builtin_bit_cast(float, __builtin_amdgcn_update_dpp(0, __builtin_bit_cast(int, v), 0x143, 0xC, 0xF, false));
    return __builtin_bit_cast(float, __builtin_amdgcn_readlane(__builtin_bit_cast(int, v), 63));
}
__device__ __forceinline__ float sigmoidf_(float x) { return __builtin_amdgcn_rcpf(1.0f + __expf(-x)); }
__device__ __forceinline__ float siluf_(float x) { return x * __builtin_amdgcn_rcpf(1.0f + __expf(-x)); }
__device__ __forceinline__ float softplusf_(float x) { return x > 20.f ? x : log1pf(__expf(x)); }
__device__ __forceinline__ int launder_int(int x) { asm volatile("" : "+v"(x)); return __builtin_amdgcn_readfirstlane(x); }
template <class T> __device__ __forceinline__ T* launder_ptr(T* p) {
    unsigned long long u = (unsigned long long)p; unsigned lo = (unsigned)u, hi = (unsigned)(u >> 32);
    asm volatile("" : "+v"(lo), "+v"(hi));
    lo = __builtin_amdgcn_readfirstlane(lo); hi = __builtin_amdgcn_readfirstlane(hi);
    return (T*)(GAS T*)(((unsigned long long)hi << 32) | lo);
}

#define XB_TMO      128
#define XB_XCNT(j)  (256  + 64 * (j))
#define XB_XSUB(j)  (1280 + 64 * (j))
#define XB_XGEN(j)  (2304 + 64 * (j))
#define XB_TOP      3328
#define XB_TOPGEN   3392
#define XCD_BAR_WORDS 3456
#define XB_SPIN_CAP (1u << 24)

__device__ __forceinline__ unsigned xb_ld(unsigned* p)              { return __hip_atomic_load(p, __ATOMIC_RELAXED, __HIP_MEMORY_SCOPE_AGENT); }
__device__ __forceinline__ unsigned xb_add(unsigned* p, unsigned v) { return __hip_atomic_fetch_add(p, v, __ATOMIC_RELAXED, __HIP_MEMORY_SCOPE_AGENT); }
__device__ __forceinline__ unsigned xb_xcc_id() { return (unsigned)__builtin_amdgcn_s_getreg((3 << 11) | 20) & 0xFu; }
#define XB_SPIN(cond, bar) do { unsigned _sp = 0; while (cond) { __builtin_amdgcn_s_sleep(1); \
    if ((++_sp & 255u) == 0u) { if (xb_ld(&(bar)[XB_TMO])) break; if (_sp > XB_SPIN_CAP) { atomicAdd(&(bar)[XB_TMO], 1u); break; } } } } while (0)

struct XcdBarrier { unsigned* bar; unsigned x; volatile LAS unsigned* st; };

__device__ __forceinline__ XcdBarrier xcd_barrier_post(unsigned* bar, volatile LAS unsigned* st) {
    XcdBarrier b; b.bar = bar; b.x = xb_xcc_id(); b.st = st;
    if (threadIdx.x == 0) (void)xb_add(&bar[XB_XCNT(b.x)], 1u);
    return b;
}
__device__ __forceinline__ void xcd_barrier_complete(unsigned* bar, unsigned x, unsigned& nloc, unsigned& nx) {
    const unsigned G = gridDim.x * gridDim.y * gridDim.z;
    unsigned sum, cnt, mine, sp = 0u;
    for (;;) {
        sum = 0u; cnt = 0u; mine = 0u;
#pragma unroll
        for (unsigned j = 0; j < 16; ++j) { const unsigned c = xb_ld(&bar[XB_XCNT(j)]); sum += c; cnt += (c > 0u) ? 1u : 0u; mine = (j == x) ? c : mine; }
        if (sum == G) break;
        __builtin_amdgcn_s_sleep(1);
        if ((++sp & 255u) == 0u) { if (xb_ld(&bar[XB_TMO])) break; if (sp > XB_SPIN_CAP) { atomicAdd(&bar[XB_TMO], 1u); break; } }
    }
    nloc = mine > 0u ? mine : 1u; nx = cnt > 0u ? cnt : 1u;
}
__device__ __forceinline__ void xcd_barrier(const XcdBarrier& b) {
    asm volatile("s_waitcnt vmcnt(0)" ::: "memory");
    __syncthreads();
    if (threadIdx.x == 0) {
        unsigned* bar = b.bar;
        __builtin_amdgcn_s_waitcnt(0);
        unsigned nloc = b.st[0], nx = b.st[1];
        if (nloc == 0u) { xcd_barrier_complete(bar, b.x, nloc, nx); b.st[0] = nloc; b.st[1] = nx; }
        const unsigned old = xb_add(&bar[XB_XSUB(b.x)], 1u);
        const unsigned gen = old / nloc;
        if (old + 1u == (gen + 1u) * nloc) {
            __builtin_amdgcn_fence(__ATOMIC_RELEASE, "agent");
            asm volatile("s_waitcnt vmcnt(0)" ::: "memory");
            const unsigned og = xb_add(&bar[XB_TOP], 1u);
            const unsigned tg = og / nx;
            if (og + 1u == (tg + 1u) * nx) xb_add(&bar[XB_TOPGEN], 1u);
            else XB_SPIN(xb_ld(&bar[XB_TOPGEN]) == tg, bar);
            __builtin_amdgcn_fence(__ATOMIC_ACQUIRE, "agent");
            xb_add(&bar[XB_XGEN(b.x)], 1u);
            asm volatile("s_waitcnt vmcnt(0)" ::: "memory");
        } else {
            XB_SPIN(xb_ld(&bar[XB_XGEN(b.x)]) == gen, bar);
            __builtin_amdgcn_fence(__ATOMIC_ACQUIRE, "agent");
            asm volatile("s_waitcnt vmcnt(0)" ::: "memory");
        }
    }
    __syncthreads();
}

namespace pg8 {
constexpr int BM = 256, BK = 64, HALF = 128, HTB = HALF * BK * 2, STAGE_BYTES = 8 * HTB, NXCD = 8, WGM = 8;
__host__ __device__ __forceinline__ int lds_byte(int r, int c) { const int st = (r >> 4) * 2 + (c >> 5), rr = r & 15, cc = c & 31, ob = rr * 64 + cc * 2; return st * 1024 + (ob ^ (((ob >> 9) & 1) << 5)); }
__host__ __device__ __forceinline__ void stage_rc(int b, int& R, int& C) { const int st = b / 1024, sb = b % 1024, swz = sb ^ (((sb >> 9) & 1) << 5); R = (st >> 1) * 16 + swz / 64; C = (st & 1) * 32 + (swz % 64) / 2; }
__host__ __device__ __forceinline__ int perm32(int rho) { const int n = rho >> 4, i = rho & 15; return 8 * (i >> 2) + 4 * n + (i & 3); }

struct Unit { int pm, pn, e, j, rows; };

struct StaticOrder {
    static constexpr bool GATHER = false;
    const bf16_t* A; const bf16_t* Bt; int K;
    int nM, nN, nwg, G, c;
    __device__ void init(const bf16_t* A_, const bf16_t* Bt_, int M, int N, int K_, int G_, int c_) { A = A_; Bt = Bt_; K = K_; nM = M / BM; nN = N / BM; nwg = nM * nN; G = G_; c = c_; }
    __device__ bool next(int i, Unit& u) const {
        const long L = (long)i * G + c; if (L >= nwg) return false;
        int wgid = (int)L; { const int q = nwg / NXCD, r = nwg % NXCD, xcd = wgid % NXCD, off = wgid / NXCD; wgid = (xcd < r ? xcd * (q + 1) : r * (q + 1) + (xcd - r) * q) + off; }
        const int nig = WGM * nN, gid = wgid / nig, fm = gid * WGM, gsz = (nM - fm) < WGM ? (nM - fm) : WGM;
        u.pm = fm + ((wgid % nig) % gsz); u.pn = (wgid % nig) / gsz; u.e = 0; u.j = 0; u.rows = BM; return true;
    }
    __device__ __forceinline__ const char* a_base(const Unit& u) const { return (const char*)A + (size_t)u.pm * (size_t)(2 * HALF) * K * 2; }
    __device__ __forceinline__ const char* b_base(const Unit& u) const { return (const char*)Bt + (size_t)u.pn * (size_t)(2 * HALF) * K * 2; }
    __device__ __forceinline__ unsigned gather_row(const Unit&, int) const { return 0u; }
};
template <bool GATHER_, int NPN> struct MoeOrder {
    static constexpr bool GATHER = GATHER_;
    const bf16_t* A; const bf16_t* Bt; int K, Nexp;
    const LAS int* pref;
    const int* stok;
    int G, c;
    __device__ bool next(int i, Unit& u) const {
        int e = -1, t;
        if ((G & 7) == 0) {
            const int x = c & 7; t = i * (G >> 3) + (c >> 3);
#pragma unroll
            for (int q = 0; q < 4; ++q) { const int ee = x + 8 * q; const int nt = (__builtin_amdgcn_readfirstlane(pref[ee + 1]) - __builtin_amdgcn_readfirstlane(pref[ee])) * NPN;
                if (e < 0) { if (t < nt) e = ee; else t -= nt; } }
            if (e < 0) return false;
        } else {
            const int L = i * G + c; const int nU = __builtin_amdgcn_readfirstlane(pref[32]) * NPN; if (L >= nU) return false;
            const int rb = L / NPN; e = 0;
            for (int q = 1; q < 32; ++q) e = (__builtin_amdgcn_readfirstlane(pref[q]) <= rb) ? q : e;
            t = (rb - __builtin_amdgcn_readfirstlane(pref[e])) * NPN + L % NPN;
        }
        u.e = e; u.j = t / NPN; u.pn = t % NPN; u.pm = __builtin_amdgcn_readfirstlane(pref[e]) + u.j;
        const int rem = __builtin_amdgcn_readfirstlane(pref[64 + e]) - u.j * BM; u.rows = rem < BM ? rem : BM; return true;
    }
    __device__ __forceinline__ const char* a_base(const Unit& u) const { return GATHER ? (const char*)A : (const char*)A + (size_t)u.pm * (size_t)(2 * HALF) * K * 2; }
    __device__ __forceinline__ const char* b_base(const Unit& u) const { return (const char*)Bt + ((size_t)u.e * Nexp + (size_t)u.pn * BM) * K * 2; }
    __device__ __forceinline__ unsigned gather_row(const Unit& u, int r) const { const int* base = stok + ((size_t)u.e * M_ALL + (size_t)u.j * BM); const unsigned rr = (unsigned)(r < u.rows ? r : u.rows - 1) & 255u; return (unsigned)base[rr]; }
};

__device__ __forceinline__ unsigned cvt_pk_bf16(float lo, float hi) { unsigned r; asm volatile("v_cvt_pk_bf16_f32 %0, %1, %2" : "=v"(r) : "v"(lo), "v"(hi)); return r; }

struct EpiF32 {
    static constexpr bool PERM = false;
    float* C; int ldc;
    __device__ __forceinline__ void operator()(const f32x4 (&acc)[2][2][4][2], const Unit& u, int wr, int wc, int fr, int fq) const {
        const int row0 = u.pm * BM + wr * 64 + fr, col0 = u.pn * BM + wc * 32 + 4 * fq;
#pragma unroll
        for (int ai = 0; ai < 2; ++ai)
#pragma unroll
            for (int m = 0; m < 4; ++m) { float* rowp = C + (size_t)(row0 + ai * HALF + m * 16) * ldc + col0;
#pragma unroll
                for (int bj = 0; bj < 2; ++bj)
#pragma unroll
                    for (int n = 0; n < 2; ++n) *(f32x4*)(rowp + bj * HALF + n * 16) = acc[ai][bj][m][n]; }
    }
};
struct EpiRes {
    static constexpr bool PERM = false;
    const float* base; float* out; const float* gate; int row0g;
    __device__ __forceinline__ void operator()(const f32x4 (&acc)[2][2][4][2], const Unit& u, int wr, int wc, int fr, int fq) const {
        const int row0 = u.pm * BM + wr * 64 + fr, col0 = u.pn * BM + wc * 32 + 4 * fq;
        const int grow = row0g + u.pm * BM; const int r = grow < M_CTX ? 8 : (grow - M_CTX) / SEQ;
        f32x4 gv[2][2];
#pragma unroll
        for (int bj = 0; bj < 2; ++bj)
#pragma unroll
            for (int n = 0; n < 2; ++n) gv[bj][n] = *(const f32x4*)(gate + (size_t)r * (NMOD * D) + col0 + bj * HALF + n * 16);
#pragma unroll
        for (int ai = 0; ai < 2; ++ai)
#pragma unroll
            for (int m = 0; m < 4; ++m) { const size_t off = (size_t)(row0 + ai * HALF + m * 16) * D + col0;
#pragma unroll
                for (int bj = 0; bj < 2; ++bj)
#pragma unroll
                    for (int n = 0; n < 2; ++n) { const f32x4 b = *(const f32x4*)(base + off + bj * HALF + n * 16);
                        *(f32x4*)(out + off + bj * HALF + n * 16) = b + gv[bj][n] * acc[ai][bj][m][n]; } }
    }
};
struct EpiGU {
    static constexpr bool PERM = true;
    bf16_t* O; const float* bias;
    __device__ __forceinline__ void operator()(const f32x4 (&acc)[2][2][4][2], const Unit& u, int wr, int wc, int fr, int fq) const {
        const int row0 = u.pm * BM + wr * 64 + fr, col0 = u.pn * HALF + wc * 32 + 8 * fq;
        const float* bp = bias + (size_t)u.e * 2048 + col0;
        f32x4 bg[2], bu[2];
#pragma unroll
        for (int n = 0; n < 2; ++n) { bg[n] = *(const f32x4*)(bp + 4 * n); bu[n] = *(const f32x4*)(bp + 1024 + 4 * n); }
#pragma unroll
        for (int ai = 0; ai < 2; ++ai)
#pragma unroll
            for (int m = 0; m < 4; ++m) { bf16_t* rowp = O + (size_t)(row0 + ai * HALF + m * 16) * FF + col0;
                float o[8];
#pragma unroll
                for (int n = 0; n < 2; ++n)
#pragma unroll
                    for (int i = 0; i < 4; ++i) { float g = acc[ai][0][m][n][i] + bg[n][i], up = acc[ai][1][m][n][i] + bu[n][i];
                        g = fminf(g, 7.0f); up = fminf(fmaxf(up, -7.0f), 7.0f);
                        const float glu = g * __builtin_amdgcn_rcpf(1.0f + __expf(-1.702f * g)); o[n * 4 + i] = (up + 1.0f) * glu; }
                u32x4 w; w.x = cvt_pk_bf16(o[0], o[1]); w.y = cvt_pk_bf16(o[2], o[3]); w.z = cvt_pk_bf16(o[4], o[5]); w.w = cvt_pk_bf16(o[6], o[7]);
                *(u32x4*)rowp = w; }
    }
};
struct EpiDN {
    static constexpr bool PERM = true;
    bf16_t* O; const float* bias;
    __device__ __forceinline__ void operator()(const f32x4 (&acc)[2][2][4][2], const Unit& u, int wr, int wc, int fr, int fq) const {
        const int row0 = u.pm * BM + wr * 64 + fr, col0 = u.pn * BM + wc * 32 + 8 * fq;
        const float* bp = bias + (size_t)u.e * 1024 + col0;
        f32x4 bv[2][2];
#pragma unroll
        for (int bj = 0; bj < 2; ++bj)
#pragma unroll
            for (int n = 0; n < 2; ++n) bv[bj][n] = *(const f32x4*)(bp + bj * HALF + 4 * n);
#pragma unroll
        for (int ai = 0; ai < 2; ++ai)
#pragma unroll
            for (int m = 0; m < 4; ++m) { bf16_t* rowp = O + (size_t)(row0 + ai * HALF + m * 16) * D + col0;
#pragma unroll
                for (int bj = 0; bj < 2; ++bj) { const f32x4 v0 = acc[ai][bj][m][0] + bv[bj][0], v1 = acc[ai][bj][m][1] + bv[bj][1];
                    u32x4 w; w.x = cvt_pk_bf16(v0[0], v0[1]); w.y = cvt_pk_bf16(v0[2], v0[3]); w.z = cvt_pk_bf16(v1[0], v1[1]); w.w = cvt_pk_bf16(v1[2], v1[3]);
                    *(u32x4*)(rowp + bj * HALF) = w; } }
    }
};

template <class Epi, class Sched>
__device__ __forceinline__ void gemm_phase(LAS unsigned char* lds, const Sched& S, const Epi& E, const int tid) {
    constexpr bool GATHER = Sched::GATHER;
    const int wid = __builtin_amdgcn_readfirstlane(tid >> 6), lane = tid & 63, wr = wid >> 2, wc = wid & 3, fr = lane & 15, fq = lane >> 4;
    const int K = S.K, nt = K / BK;
    unsigned voffA[2], voffB[2]; int RA[2], CA[2];
#pragma unroll
    for (int i = 0; i < 2; ++i) { int R, C; stage_rc(tid * 16 + i * 8192, R, C); const int Rb = Epi::PERM ? ((R & ~31) + perm32(R & 31)) : R;
        RA[i] = R; CA[i] = C; voffA[i] = (unsigned)(R * K + C) * 2u; voffB[i] = (unsigned)(Rb * K + C) * 2u; }
    const size_t kstep = (size_t)(BK * 2);
    const size_t hstep = (size_t)HALF * K * 2;
    const unsigned ldsw = (unsigned)wid * 1024u;
    const int aoff = lds_byte(wr * 64 + fr, fq * 8), boff = lds_byte(wc * 32 + fr, fq * 8);
#define PG8_SA(b, h) (((b) * 2 + (h)) * HTB)
#define PG8_SB(b, h) ((4 + (b) * 2 + (h)) * HTB)
#define PG8_STAGE(bufoff, gbase, voff) do { _Pragma("unroll") for (int _i = 0; _i < 2; ++_i) \
        __builtin_amdgcn_global_load_lds((const unsigned*)((const char*)(gbase) + (voff)[_i]), (LAS unsigned*)(lds + (bufoff) + ldsw + _i * 8192), 16, 0, 0); } while (0)
#define PG8_STAGE2(bufoff, gbase, v0, v1) do { \
        __builtin_amdgcn_global_load_lds((const unsigned*)((const char*)(gbase) + (v0)), (LAS unsigned*)(lds + (bufoff) + ldsw), 16, 0, 0); \
        __builtin_amdgcn_global_load_lds((const unsigned*)((const char*)(gbase) + (v1)), (LAS unsigned*)(lds + (bufoff) + ldsw + 8192), 16, 0, 0); } while (0)
#define PG8_LDA(dst, b, h) do { _Pragma("unroll") for (int m = 0; m < 4; ++m) _Pragma("unroll") for (int k = 0; k < 2; ++k) dst[m][k] = *(const LAS bf16x8*)(lds + PG8_SA(b, h) + aoff + m * 2048 + k * 1024); } while (0)
#define PG8_LDB(dst, b, h) do { _Pragma("unroll") for (int n = 0; n < 2; ++n) _Pragma("unroll") for (int k = 0; k < 2; ++k) dst[n][k] = *(const LAS bf16x8*)(lds + PG8_SB(b, h) + boff + n * 2048 + k * 1024); } while (0)
#define PG8_MMA(ai, bj, At, Bt) do { __builtin_amdgcn_s_setprio(1); _Pragma("unroll") for (int m = 0; m < 4; ++m) _Pragma("unroll") for (int n = 0; n < 2; ++n) _Pragma("unroll") for (int k = 0; k < 2; ++k) \
        acc[ai][bj][m][n] = __builtin_amdgcn_mfma_f32_16x16x32_bf16(Bt[n][k], At[m][k], acc[ai][bj][m][n], 0, 0, 0); __builtin_amdgcn_s_setprio(0); } while (0)
#define PG8_WAIT_V(n) asm volatile("s_waitcnt vmcnt(" #n ")" ::: "memory")
#define PG8_WAIT_L(n) asm volatile("s_waitcnt lgkmcnt(" #n ")" ::: "memory")
#define PG8_BAR __builtin_amdgcn_s_barrier()
#define PG8_SCHED __builtin_amdgcn_sched_barrier(0)
    unsigned pc[2] = {0u, 0u}, pn_[2] = {0u, 0u};
    const unsigned R0 = (unsigned)RA[0], C2 = (unsigned)(CA[0] * 2);
#define PG8_PACK(p, u) do { _Pragma("unroll") for (int _h = 0; _h < 2; ++_h) p[_h] = S.gather_row(u, _h * HALF + R0) | (S.gather_row(u, _h * HALF + 64 + R0) << 16); } while (0)
#define PG8_AOFF(p, h, i) (GATHER ? ((((p)[h] >> (16 * (i))) & 0xffffu) * (unsigned)(K * 2) + C2) : ((unsigned)((h) * hstep) + voffA[i]))
#define PG8_STAGEA(bufoff, gbase, p, h) PG8_STAGE2(bufoff, gbase, PG8_AOFF(p, h, 0), PG8_AOFF(p, h, 1))
    Unit cur, nxt; int ui = 0;
    if (!S.next(0, cur)) return;
    f32x4 acc[2][2][4][2];
#pragma unroll
    for (int a = 0; a < 2; ++a)
#pragma unroll
        for (int b = 0; b < 2; ++b)
#pragma unroll
            for (int m = 0; m < 4; ++m)
#pragma unroll
                for (int n = 0; n < 2; ++n) acc[a][b][m][n] = (f32x4){0.f, 0.f, 0.f, 0.f};
    bf16x8 At[4][2], B0[2][2], B1[2][2];
    const char* cA = S.a_base(cur); const char* cB = S.b_base(cur);
    if (GATHER) PG8_PACK(pc, cur);
    PG8_STAGE(PG8_SB(0, 0), cB, voffB); PG8_STAGEA(PG8_SA(0, 0), cA, pc, 0); PG8_STAGE(PG8_SB(0, 1), cB + hstep, voffB); PG8_STAGEA(PG8_SA(0, 1), cA, pc, 1);
    if (wr == 1) PG8_BAR;
    PG8_WAIT_V(4); PG8_BAR;
    PG8_STAGE(PG8_SB(1, 0), cB + kstep, voffB); PG8_STAGEA(PG8_SA(1, 0), cA + kstep, pc, 0); PG8_STAGE(PG8_SB(1, 1), cB + hstep + kstep, voffB);
    PG8_WAIT_V(6); PG8_BAR;
    for (;;) {
        const bool has_next = S.next(ui + 1, nxt);
        const char* nA = has_next ? S.a_base(nxt) : cA; const char* nB = has_next ? S.b_base(nxt) : cB;
        if (GATHER) { if (has_next) { PG8_PACK(pn_, nxt); } else { pn_[0] = pc[0]; pn_[1] = pc[1]; } }
        for (int t = 0; t < nt; t += 2) {
            const bool last = (t == nt - 2);
            const char* a1 = cA + (size_t)(t + 1) * kstep;
            const char* a2 = last ? nA : cA + (size_t)(t + 2) * kstep; const char* b2 = last ? nB : cB + (size_t)(t + 2) * kstep;
            const char* a3 = a2 + kstep; const char* b3 = b2 + kstep;
            PG8_LDB(B0, 0, 0); PG8_SCHED; PG8_LDA(At, 0, 0); PG8_STAGEA(PG8_SA(1, 1), a1, pc, 1);
            PG8_WAIT_L(8); PG8_BAR; PG8_WAIT_L(0); PG8_MMA(0, 0, At, B0); PG8_BAR; PG8_SCHED;
            PG8_LDB(B1, 0, 1); PG8_STAGE(PG8_SB(0, 0), b2, voffB);
            PG8_BAR; PG8_WAIT_L(0); PG8_MMA(0, 1, At, B1); PG8_BAR;
            PG8_LDA(At, 0, 1); { const unsigned pq[2] = {last ? pn_[0] : pc[0], 0u}; PG8_STAGEA(PG8_SA(0, 0), a2, pq, 0); }
            PG8_BAR; PG8_WAIT_L(0); PG8_MMA(1, 0, At, B0); PG8_BAR; PG8_SCHED;
            PG8_STAGE(PG8_SB(0, 1), b2 + hstep, voffB);
            PG8_WAIT_V(6); PG8_BAR; PG8_MMA(1, 1, At, B1); PG8_BAR;
            PG8_LDB(B0, 1, 0); PG8_SCHED; PG8_LDA(At, 1, 0); { const unsigned pq[2] = {0u, last ? pn_[1] : pc[1]}; PG8_STAGEA(PG8_SA(0, 1), a2, pq, 1); }
            PG8_WAIT_L(8); PG8_BAR; PG8_WAIT_L(0); PG8_MMA(0, 0, At, B0); PG8_BAR; PG8_SCHED;
            PG8_LDB(B1, 1, 1); PG8_STAGE(PG8_SB(1, 0), b3, voffB);
            PG8_BAR; PG8_WAIT_L(0); PG8_MMA(0, 1, At, B1); PG8_BAR;
            PG8_LDA(At, 1, 1); { const unsigned pq[2] = {last ? pn_[0] : pc[0], 0u}; PG8_STAGEA(PG8_SA(1, 0), a3, pq, 0); }
            PG8_BAR; PG8_WAIT_L(0); PG8_MMA(1, 0, At, B0); PG8_BAR; PG8_SCHED;
            PG8_STAGE(PG8_SB(1, 1), b3 + hstep, voffB);
            PG8_WAIT_V(6); PG8_BAR; PG8_MMA(1, 1, At, B1); PG8_BAR;
        }
        E(acc, cur, wr, wc, fr, fq);
        if (!has_next) break;
#pragma unroll
        for (int a = 0; a < 2; ++a)
#pragma unroll
            for (int b = 0; b < 2; ++b)
#pragma unroll
                for (int m = 0; m < 4; ++m)
#pragma unroll
                    for (int n = 0; n < 2; ++n) acc[a][b][m][n] = (f32x4){0.f, 0.f, 0.f, 0.f};
        cur = nxt; cA = nA; cB = nB; ++ui; pc[0] = pn_[0]; pc[1] = pn_[1];
    }
    PG8_WAIT_V(0);
    if (wr == 0) PG8_BAR;
    PG8_BAR;
#undef PG8_SA
#undef PG8_SB
#undef PG8_STAGE
#undef PG8_STAGE2
#undef PG8_LDA
#undef PG8_LDB
#undef PG8_MMA
#undef PG8_WAIT_V
#undef PG8_WAIT_L
#undef PG8_BAR
#undef PG8_SCHED
#undef PG8_PACK
#undef PG8_AOFF
#undef PG8_STAGEA
}
}

struct Args { const float* in[43]; float* out; unsigned char* ws; int ph_lo, ph_hi; };
enum { I_X = 0, I_C, I_CTX, I_CCTX, I_ADAW, I_ADAB, I_NMIX, I_NFFN, I_NFIN, I_WIN, I_WOUT, I_HSW, I_HSB, I_HW1, I_HB1, I_HW2, I_HB2, I_HW3, I_HB3, I_HW4,
       I_HFREQ, I_HSKIP, I_RMU, I_RW0, I_RW2, I_RA0, I_RA2, I_RG2, I_RKK, I_RKA, I_RRK, I_RGNW, I_RGNB, I_GCONV, I_GALOG, I_GDT, I_GNW,
       I_MRW, I_MRB, I_MWGU, I_MBGU, I_MWDN, I_MBDN };

struct Frame {
    LAS unsigned char* lds;
    int tid, lane, wave, G, bid;
    const float* const* in;
    unsigned char* ws;
    float* out;
};
#define WSP(T, off) ((T*)(F.ws + (off)))
#define LDS_WAIT() asm volatile("s_waitcnt lgkmcnt(0)" ::: "memory")

__device__ __forceinline__ int row_batch(int row) { return row < M_CTX ? row / CTX : (row - M_CTX) / SEQ; }
__device__ __forceinline__ int row_modr(int row) { return row < M_CTX ? 8 : (row - M_CTX) / SEQ; }

__device__ __forceinline__ void p0_transpose_item(const float* W, int K, int N, bf16_t* WT, int k0, int n0, int drow0, LAS float* scr, int lane) {
    { float tv[32]; const int n = n0 + (lane & 31);
#pragma unroll
      for (int i = 0; i < 32; ++i) { const int kk = 2 * i + (lane >> 5); tv[i] = (n < N) ? W[(size_t)(k0 + kk) * N + n] : 0.f; }
      asm volatile("" ::: "memory");
#pragma unroll
      for (int i = 0; i < 32; ++i) { const int kk = 2 * i + (lane >> 5); scr[kk * 33 + (lane & 31)] = tv[i]; } }
    LDS_WAIT(); asm volatile("" ::: "memory");
    const int c = lane & 7;
#pragma unroll
    for (int j = 0; j < 4; ++j) { const int n = (lane >> 3) + 8 * j; const LAS float* s = scr + (8 * c) * 33 + n;
        u32x4 o; o.x = pk2(s[0 * 33], s[1 * 33]); o.y = pk2(s[2 * 33], s[3 * 33]); o.z = pk2(s[4 * 33], s[5 * 33]); o.w = pk2(s[6 * 33], s[7 * 33]);
        *(u32x4*)(WT + (size_t)(drow0 + n) * K + k0 + 8 * c) = o; }
    LDS_WAIT(); asm volatile("" ::: "memory");
}

__device__ __forceinline__ void phase_prologue(Frame& F) {
    const int gw = F.bid * NWV + F.wave, NGW = F.G * NWV;
    {
        LAS float* scr = (LAS float*)(F.lds + F.wave * 16384);
        constexpr int I_IN = 16 * 128, I_OUT = 16 * 32, I_GU = 16 * 64, I_DN = 16 * 32;
        constexpr int T_IN = DEPTH * I_IN, T_OUT = DEPTH * I_OUT, T_GU = DEPTH * NE * I_GU, T_DN = DEPTH * NE * I_DN;
        for (int it = gw; it < T_IN + T_OUT + T_GU + T_DN; it += NGW) {
            int r = it;
            if (r < T_IN) { const int l = r / I_IN, q = r % I_IN, kb = q / 128, nb = q % 128;
                p0_transpose_item(F.in[I_WIN] + (size_t)l * D * IN_COLS, D, IN_COLS, WSP(bf16_t, WS_WIN) + (size_t)l * PW * D, kb * 64, nb * 32, nb * 32, scr, F.lane); continue; }
            r -= T_IN;
            if (r < T_OUT) { const int l = r / I_OUT, q = r % I_OUT, kb = q / 32, nb = q % 32;
                p0_transpose_item(F.in[I_WOUT] + (size_t)l * D * D, D, D, WSP(bf16_t, WS_WOUT) + (size_t)l * D * D, kb * 64, nb * 32, nb * 32, scr, F.lane); continue; }
            r -= T_OUT;
            if (r < T_GU) { const int le = r / I_GU, q = r % I_GU, kb = q / 64, nb = q % 64; const int n0 = nb * 32;
                const int j = n0 & 1023, drow = 256 * (j >> 7) + (n0 >= 1024 ? 128 : 0) + (j & 127);
                p0_transpose_item(F.in[I_MWGU] + (size_t)le * D * 2048, D, 2048, WSP(bf16_t, WS_WGU) + (size_t)le * 2048 * D, kb * 64, n0, drow, scr, F.lane); continue; }
            r -= T_GU;
            { const int le = r / I_DN, q = r % I_DN, kb = q / 32, nb = q % 32;
                p0_transpose_item(F.in[I_MWDN] + (size_t)le * FF * D, FF, D, WSP(bf16_t, WS_WDN) + (size_t)le * D * FF, kb * 64, nb * 32, nb * 32, scr, F.lane); }
        }
    }
    {
        LAS float* scr = (LAS float*)(F.lds + F.wave * 16384);
        for (int it = gw; it < DEPTH * 48; it += NGW) { const int l = it / 48, q = it % 48; bf16_t* dst = (bf16_t*)(F.ws + WS_LORA + (size_t)l * LORA_L);
            if (q < 16) { const int d = q >> 3, nb = q & 7; p0_transpose_item(F.in[I_RW2] + ((size_t)l * 2 + d) * 64 * 256, 64, 256, dst + d * 256 * 64, 0, nb * 32, nb * 32, scr, F.lane); }
            else if (q < 32) { const int d = (q - 16) >> 3, nb = q & 7; p0_transpose_item(F.in[I_RA2] + ((size_t)l * 2 + d) * 64 * 256, 64, 256, dst + 2 * 256 * 64 + d * 256 * 64, 0, nb * 32, nb * 32, scr, F.lane); }
            else { const int kb = (q - 32) >> 3, nb = q & 7; p0_transpose_item(F.in[I_RG2] + (size_t)l * 128 * 256, 128, 256, dst + 4 * 256 * 64, kb * 64, nb * 32, nb * 32, scr, F.lane); } }
    }
    __syncthreads();
    {
        LAS float* sl = (LAS float*)F.lds;
        LAS float* red = sl + 9 * 1024;
        for (int i = F.tid; i < 9 * 1024; i += NT) { const float v = (i < 8 * 1024) ? F.in[I_C][i] : F.in[I_CCTX][i - 8 * 1024]; sl[i] = siluf_(v); }
        __syncthreads();
        float* mods = WSP(float, WS_MODS);
        const int kh = F.lane >> 5, cl = F.lane & 31;
        for (int it = F.bid; it < DEPTH * (NMOD * D / 32); it += F.G) {
            const int l = it / (NMOD * D / 32), nb = it % (NMOD * D / 32);
            const float* W = F.in[I_ADAW] + (size_t)l * D * (NMOD * D) + nb * 32 + cl;
            float a[9];
#pragma unroll
            for (int r = 0; r < 9; ++r) a[r] = 0.f;
            const int kbase = F.wave * 128 + kh * 64;
#pragma unroll 1
            for (int kb4 = 0; kb4 < 4; ++kb4) { float wv[16];
#pragma unroll
              for (int k = 0; k < 16; ++k) wv[k] = W[(size_t)(kbase + kb4 * 16 + k) * (NMOD * D)];
              asm volatile("" ::: "memory");
#pragma unroll
              for (int k = 0; k < 16; ++k) {
#pragma unroll
                for (int r = 0; r < 9; ++r) a[r] += sl[r * 1024 + kbase + kb4 * 16 + k] * wv[k]; } }
#pragma unroll
            for (int r = 0; r < 9; ++r) red[((F.wave * 2 + kh) * 9 + r) * 32 + cl] = a[r];
            __syncthreads();
            if (F.tid < 9 * 32) { const int r = F.tid / 32, cc = F.tid % 32; float s = 0.f;
#pragma unroll
                for (int p = 0; p < 16; ++p) s += red[(p * 9 + r) * 32 + cc];
                mods[((size_t)l * 9 + r) * (NMOD * D) + nb * 32 + cc] = s + F.in[I_ADAB][(size_t)l * (NMOD * D) + nb * 32 + cc]; }
            __syncthreads();
        }
    }
    __syncthreads();
    {
        LAS float* hb = (LAS float*)F.lds;
        LAS float* hx = hb + 32 * 512 + F.wave * 256;
        constexpr int NB_LAT = SEQ / 32, NB_CTX = CTX / 32, NB_L = NB_LAT + NB_CTX;
        for (int it = F.bid; it < DEPTH * NB_L; it += F.G) {
            const int l = it / NB_L, q = it % NB_L; const bool isctx = q >= NB_LAT; const int L = isctx ? CTX : SEQ; const int p0 = (isctx ? q - NB_LAT : q) * 32;
            const float* w1 = F.in[I_HW1] + (size_t)l * 33 * 64; const float* b1 = F.in[I_HB1] + l * 64;
            const float* w2 = F.in[I_HW2] + (size_t)l * 64 * 64; const float* b2 = F.in[I_HB2] + l * 64;
            const float* w3 = F.in[I_HW3] + (size_t)l * 64 * 64; const float* b3 = F.in[I_HB3] + l * 64;
            const float* w4 = F.in[I_HW4] + (size_t)l * 64 * 512; const float fr = F.in[I_HFREQ][l * 64 + F.lane];
            { float tq[4], av[4];
#pragma unroll
              for (int pp = 0; pp < 4; ++pp) { const int p = p0 + F.wave * 4 + pp; tq[pp] = (float)p / (float)(L - 1);
                float z = 0.f;
                if (F.lane == 0) z = tq[pp];
                else if (F.lane < 33) { const int bi = (F.lane - 1) & 15; const float band = 1e-4f + (float)bi * ((15.0f - 1e-4f) / 15.0f);
                    const float ang = (6.283185307179586f / (float)L) * (float)p * band; z = (F.lane <= 16) ? cosf(ang) : -sinf(ang); }
                hx[pp * 64 + F.lane] = z; }
              LDS_WAIT();
              { const float bb = b1[F.lane]; float wv[33];
#pragma unroll
                for (int i = 0; i < 33; ++i) wv[i] = w1[i * 64 + F.lane];
                asm volatile("" ::: "memory");
#pragma unroll
                for (int pp = 0; pp < 4; ++pp) { float a = bb;
#pragma unroll
                    for (int i = 0; i < 33; ++i) a += hx[pp * 64 + i] * wv[i];
                    av[pp] = sinf(fr * a); } }
              LDS_WAIT();
#pragma unroll
              for (int pp = 0; pp < 4; ++pp) hx[pp * 64 + F.lane] = av[pp];
              LDS_WAIT();
#pragma unroll 1
              for (int ly = 0; ly < 2; ++ly) { const float* wl_ = ly ? w3 : w2; const float bb = (ly ? b3 : b2)[F.lane];
                float a4[4] = {bb, bb, bb, bb};
#pragma unroll 1
                for (int ib = 0; ib < 2; ++ib) { float wv[32];
#pragma unroll
                  for (int i = 0; i < 32; ++i) wv[i] = wl_[(ib * 32 + i) * 64 + F.lane];
                  asm volatile("" ::: "memory");
#pragma unroll
                  for (int pp = 0; pp < 4; ++pp)
#pragma unroll
                    for (int i = 0; i < 32; ++i) a4[pp] += hx[pp * 64 + ib * 32 + i] * wv[i]; }
                LDS_WAIT();
#pragma unroll
                for (int pp = 0; pp < 4; ++pp) hx[pp * 64 + F.lane] = sinf(fr * a4[pp]);
                LDS_WAIT(); }
              float o[4][8];
#pragma unroll
              for (int pp = 0; pp < 4; ++pp)
#pragma unroll
                for (int j = 0; j < 8; ++j) o[pp][j] = 0.f;
#pragma unroll 1
              for (int ib = 0; ib < 16; ++ib) { float wv[4][8];
#pragma unroll
                  for (int ii = 0; ii < 4; ++ii)
#pragma unroll
                      for (int j = 0; j < 8; ++j) wv[ii][j] = w4[(ib * 4 + ii) * 512 + j * 64 + F.lane];
                  asm volatile("" ::: "memory");
#pragma unroll
                  for (int pp = 0; pp < 4; ++pp)
#pragma unroll
                    for (int ii = 0; ii < 4; ++ii) { const float hv = hx[pp * 64 + ib * 4 + ii];
#pragma unroll
                        for (int j = 0; j < 8; ++j) o[pp][j] += hv * wv[ii][j]; } }
#pragma unroll
              for (int pp = 0; pp < 4; ++pp) { const int pl = F.wave * 4 + pp;
#pragma unroll
                for (int j = 0; j < 8; ++j) { const int n = j * 64 + F.lane; const int ch = n & 255;
                    const float dl = -3.0701134573253946f + (float)ch * ((-15.350567286626973f + 3.0701134573253946f) / 255.0f);
                    hb[pl * 512 + n] = o[pp][j] * __expf(-tq[pp] * fabsf(dl)); } }
              LDS_WAIT();
            }
            __syncthreads();
            float* filt = isctx ? WSP(float, WS_FILTC) + (size_t)l * 256 * (2 * CTX) : WSP(float, WS_FILT) + (size_t)l * 256 * (2 * SEQ);
            for (int i = F.tid; i < 512 * 32; i += NT) { const int n = i >> 5, pl = i & 31, p = p0 + pl, ch = n & 255; const float v = hb[pl * 512 + n];
                if (n < 256) filt[(size_t)ch * (2 * L) + L + p] = v + (p == 0 ? F.in[I_HSKIP][l * 256 + ch] : 0.f);
                else if (p >= 1) filt[(size_t)ch * (2 * L) + L - p] = v;
                if (n >= 256 && p == 0) filt[(size_t)ch * (2 * L)] = 0.f; }
            __syncthreads();
        }
    }
}

template <bool TO_LDS>
__device__ __forceinline__ void norm_mod_row(const float* __restrict__ xrow, const float* __restrict__ nw, const float* __restrict__ shift, const float* __restrict__ scale, bf16_t* __restrict__ orow, LAS float* lrow, int lane) {
    f32x4 v[4], w[4], sh[4], sc[4]; float s = 0.f;
#pragma unroll
    for (int j = 0; j < 4; ++j) { const int c = 4 * lane + 256 * j; v[j] = *(const f32x4*)(xrow + c); w[j] = *(const f32x4*)(nw + c); sh[j] = *(const f32x4*)(shift + c); sc[j] = *(const f32x4*)(scale + c); }
    asm volatile("" ::: "memory");
#pragma unroll
    for (int j = 0; j < 4; ++j) s += (v[j].x * v[j].x + v[j].y * v[j].y) + (v[j].z * v[j].z + v[j].w * v[j].w);
    const float rstd = rsqrtf(wave_sum(s) * (1.f / D) + 1e-6f);
#pragma unroll
    for (int j = 0; j < 4; ++j) { const int c = 4 * lane + 256 * j;
        const f32x4 o = (v[j] * rstd) * w[j] * (sc[j] + 1.0f) + sh[j];
        u32x2 p; p.x = pk2(o.x, o.y); p.y = pk2(o.z, o.w);
        *(u32x2*)(orow + c) = p;
        if (TO_LDS) *(LAS f32x4*)(lrow + c) = o; }
}

__device__ __forceinline__ void phase_norm0(Frame& F) {
    const int gw = F.bid * NWV + F.wave, NGW = F.G * NWV;
    const float* mods = WSP(float, WS_MODS);
    bf16_t* N = WSP(bf16_t, WS_N);
    for (int row = gw; row < M_ALL; row += NGW) {
        const float* src = row < M_CTX ? F.in[I_CTX] + (size_t)row * D : F.in[I_X] + (size_t)(row - M_CTX) * D;
        const float* mr = mods + (size_t)row_modr(row) * (NMOD * D);
        norm_mod_row<false>(src, F.in[I_NMIX], mr, mr + D, N + (size_t)row * D, (LAS float*)F.lds, F.lane);
        float* hrow = WSP(float, WS_H) + (size_t)row * D;
#pragma unroll
        for (int j = 0; j < 4; ++j) *(f32x4*)(hrow + 4 * F.lane + 256 * j) = *(const f32x4*)(src + 4 * F.lane + 256 * j);
    }
}

template <class Fin>
__device__ __forceinline__ void mm_lds(const LAS bf16_t* A, int lda, const LAS bf16_t* Bt, int ldb, int M, int N, int K, int wave, int lane, Fin fin) {
    const int tn = N >> 4, ntile = (M >> 4) * tn, fr = lane & 15, fq = lane >> 4;
    for (int tI = wave; tI < ntile; tI += NWV) {
        const int i0 = (tI / tn) << 4, j0 = (tI % tn) << 4;
        f32x4 acc = (f32x4){0.f, 0.f, 0.f, 0.f};
        const LAS bf16_t* ap = A + (i0 + fr) * lda + fq * 8; const LAS bf16_t* bp = Bt + (j0 + fr) * ldb + fq * 8;
        for (int k = 0; k < K; k += 32) { const bf16x8 a = *(const LAS bf16x8*)(ap + k); const bf16x8 b = *(const LAS bf16x8*)(bp + k);
            acc = __builtin_amdgcn_mfma_f32_16x16x32_bf16(a, b, acc, 0, 0, 0); }
#pragma unroll
        for (int r = 0; r < 4; ++r) fin(i0 + fq * 4 + r, j0 + fr, acc[r]);
    }
}


struct TileSched { int v0, v1, v2; int bid, G, N; bool bal;
    __device__ __forceinline__ int first() const { return bal ? v0 : (bid < N ? bid : -1); }
    __device__ __forceinline__ int next(int it) const { return bal ? (it == 1 ? v1 : (it == 2 ? v2 : -1)) : (bid + it * G < N ? bid + it * G : -1); } };
__device__ __forceinline__ TileSched strided_sched(const Frame& F, int N) { TileSched t; t.v0 = t.v1 = t.v2 = -1; t.bid = F.bid; t.G = F.G; t.N = N; t.bal = false; return t; }
#define TILE_LOOP(u, ts) for (int it_ = 0, u = (ts).first(); u >= 0; u = (ts).next(++it_))
__device__ __forceinline__ void prep_hyena(Frame& F, int l, bool with_ctx_hy, const TileSched ts) {
    const float* __restrict__ P = WSP(float, WS_P);
    float* __restrict__ VVT = WSP(float, WS_VVT);
    const float* sw = F.in[I_HSW] + (size_t)l * 3 * 768; const float* sb = F.in[I_HSB] + (size_t)l * 768;
    LAS float* tile = (LAS float*)F.lds;
    TILE_LOOP(u, ts) {
        const int row0 = u * 64; const bool isctx = row0 < M_CTX; if (isctx && !with_ctx_hy) continue;
        const int L = isctx ? CTX : SEQ; const int b = row_batch(row0); const int t0 = isctx ? row0 - b * CTX : row0 - M_CTX - b * SEQ;
        const int c = F.tid & 255, th = F.tid >> 8;
        const float w1a = sw[0 * 768 + 256 + c], w1b = sw[1 * 768 + 256 + c], w1c = sw[2 * 768 + 256 + c], b1 = sb[256 + c];
        const float wva = sw[0 * 768 + 512 + c], wvb = sw[1 * 768 + 512 + c], wvc = sw[2 * 768 + 512 + c], bv = sb[512 + c];
        { const float* pc = P + (size_t)(row0 + th * 32) * PW + c; float xa[34], xv[34];
#pragma unroll
          for (int k = 0; k < 34; ++k) { const int t = t0 + th * 32 + k - 1; const bool ok = (t >= 0 && t < L); xa[k] = ok ? pc[(ptrdiff_t)(k - 1) * PW + 256] : 0.f; xv[k] = ok ? pc[(ptrdiff_t)(k - 1) * PW + 512] : 0.f; }
          asm volatile("" ::: "memory");
#pragma unroll
          for (int tt = 0; tt < 32; ++tt) { const float x1 = b1 + w1a * xa[tt] + w1b * xa[tt + 1] + w1c * xa[tt + 2]; const float vv = bv + wva * xv[tt] + wvb * xv[tt + 1] + wvc * xv[tt + 2];
              tile[c * 65 + th * 32 + tt] = x1 * vv; } }
        __syncthreads();
        const int pos0 = isctx ? t0 : CTX + t0;
        for (int i = F.tid; i < 256 * 64; i += NT) { const int cc = i >> 6, tl = i & 63;
            VVT[((size_t)cc * NB + b) * (CTX + SEQ) + pos0 + tl] = tile[cc * 65 + tl]; }
        __syncthreads();
    }
}

__device__ __forceinline__ float rw_mix(const float* P, const float* mu, int row, int cc, bool isctx, int t) {
    const float* pr = P + (size_t)row * PW + C_RW + cc; const int m4 = cc & 3; int off; bool ok;
    if (isctx) { const bool ev = (m4 & 1) == 0; off = ev ? -PW : PW; ok = ev ? (t > 0) : (t < CTX - 1); }
    else { const int gr = t >> 6, gc = t & 63;
        off = (m4 == 0) ? -PW : ((m4 == 1) ? PW : ((m4 == 2) ? -64 * PW : 64 * PW));
        ok = (m4 == 0) ? (gc > 0) : ((m4 == 1) ? (gc < 63) : ((m4 == 2) ? (gr > 0) : (gr < 31))); }
    const float p = pr[0]; float sh = pr[ok ? off : 0]; sh = ok ? sh : 0.f;
    return p + mu[cc] * (sh - p);
}
__device__ __forceinline__ void prep_rwkv(Frame& F, int l, const TileSched ts) {
    const float* __restrict__ P = WSP(float, WS_P);
    float* __restrict__ RW = WSP(float, WS_RW); float* __restrict__ BON = WSP(float, WS_RWBON);
    const float* __restrict__ mu = F.in[I_RMU] + (size_t)l * RWC;
    const float* __restrict__ w0 = F.in[I_RW0] + (size_t)l * 512; const float* __restrict__ a0 = F.in[I_RA0] + (size_t)l * 512;
    const float* __restrict__ kkw = F.in[I_RKK] + l * 256; const float* __restrict__ kaw = F.in[I_RKA] + l * 256; const float* __restrict__ rkw = F.in[I_RRK] + l * 256;
    const bf16_t* lora = (const bf16_t*)(F.ws + WS_LORA + (size_t)l * LORA_L);
    LAS bf16_t* lin = (LAS bf16_t*)F.lds;
    LAS float* R = (LAS float*)(F.lds + 25088);
    LAS float* R2 = (LAS float*)(F.lds + 58880);
    const int tid = F.tid, lane = F.lane, wave = F.wave, fr = lane & 15, fq = lane >> 4;
    TILE_LOOP(u, ts) {
        const int row0 = u * 32; const bool isctx = row0 < M_CTX; const int b = row_batch(row0); const int t0 = isctx ? row0 - b * CTX : row0 - M_CTX - b * SEQ;
        bf16x8 Wn[8];
#define RWP_LOADW(p) do { if ((p) < 4) { _Pragma("unroll") for (int n2 = 0; n2 < 2; ++n2) _Pragma("unroll") for (int ks = 0; ks < 2; ++ks) \
              Wn[n2 * 2 + ks] = *(const GAS bf16x8*)(lora + (p) * 256 * 64 + ((2 * wave + n2) * 16 + fr) * 64 + ks * 32 + fq * 8); } \
          else { _Pragma("unroll") for (int n2 = 0; n2 < 2; ++n2) _Pragma("unroll") for (int ks = 0; ks < 4; ++ks) \
              Wn[n2 * 4 + ks] = *(const GAS bf16x8*)(lora + 4 * 256 * 64 + ((2 * wave + n2) * 16 + fr) * 128 + ks * 32 + fq * 8); } } while (0)
        RWP_LOADW(0);
        { const int c = tid & 127, tq = tid >> 7, m4 = c & 3;
          int off;
          if (isctx) off = ((m4 & 1) == 0) ? -PW : PW; else off = (m4 == 0) ? -PW : ((m4 == 1) ? PW : ((m4 == 2) ? -64 * PW : 64 * PW));
          const float mu0 = mu[768 + c], mu1 = mu[896 + c], mu2 = mu[1024 + c];
#pragma unroll 1
          for (int hb = 0; hb < 2; ++hb) { float pv[4][3], sv[4][3]; bool okv[4];
#pragma unroll
            for (int k = 0; k < 4; ++k) { const int tok = tq * 8 + hb * 4 + k, t = t0 + tok; bool ok;
                if (isctx) ok = ((m4 & 1) == 0) ? (t > 0) : (t < CTX - 1);
                else { const int gr = t >> 6, gc = t & 63; ok = (m4 == 0) ? (gc > 0) : ((m4 == 1) ? (gc < 63) : ((m4 == 2) ? (gr > 0) : (gr < 31))); }
                okv[k] = ok;
                const float* pr = P + (size_t)(row0 + tok) * PW + C_RW + 768 + c; const float* ps = pr + (ok ? off : 0);
#pragma unroll
                for (int g = 0; g < 3; ++g) { pv[k][g] = pr[g * 128]; sv[k][g] = ps[g * 128]; } }
            asm volatile("" ::: "memory");
#pragma unroll
            for (int k = 0; k < 4; ++k) { const int tok = tq * 8 + hb * 4 + k;
                const float s0 = okv[k] ? sv[k][0] : 0.f, s1 = okv[k] ? sv[k][1] : 0.f, s2 = okv[k] ? sv[k][2] : 0.f;
                const float m0 = pv[k][0] + mu0 * (s0 - pv[k][0]), m1 = pv[k][1] + mu1 * (s1 - pv[k][1]), m2 = pv[k][2] + mu2 * (s2 - pv[k][2]);
                lin[tok * 392 + c] = (bf16_t)f2bf(1.0f - 2.0f * __builtin_amdgcn_rcpf(1.0f + __expf(2.0f * m0)));
                lin[tok * 392 + 128 + c] = (bf16_t)f2bf(m1);
                lin[tok * 392 + 256 + c] = (bf16_t)f2bf(sigmoidf_(m2)); } } }
#pragma unroll
        for (int pass = 0; pass < 5; ++pass) {
            bf16x8 Wc[8];
#pragma unroll
            for (int i = 0; i < 8; ++i) Wc[i] = Wn[i];
            __syncthreads();
#pragma unroll
            for (int m = 0; m < 2; ++m) { f32x4 acc[2] = {(f32x4){0.f, 0.f, 0.f, 0.f}, (f32x4){0.f, 0.f, 0.f, 0.f}};
                if (pass < 4) {
#pragma unroll
                    for (int ks = 0; ks < 2; ++ks) { const bf16x8 A = *(const LAS bf16x8*)(lin + (m * 16 + fr) * 392 + pass * 64 + ks * 32 + fq * 8);
                        acc[0] = __builtin_amdgcn_mfma_f32_16x16x32_bf16(A, Wc[ks], acc[0], 0, 0, 0); acc[1] = __builtin_amdgcn_mfma_f32_16x16x32_bf16(A, Wc[2 + ks], acc[1], 0, 0, 0); } }
                else {
#pragma unroll
                    for (int ks = 0; ks < 4; ++ks) { const bf16x8 A = *(const LAS bf16x8*)(lin + (m * 16 + fr) * 392 + 256 + ks * 32 + fq * 8);
                        acc[0] = __builtin_amdgcn_mfma_f32_16x16x32_bf16(A, Wc[ks], acc[0], 0, 0, 0); acc[1] = __builtin_amdgcn_mfma_f32_16x16x32_bf16(A, Wc[4 + ks], acc[1], 0, 0, 0); } }
#pragma unroll
                for (int n2 = 0; n2 < 2; ++n2)
#pragma unroll
                    for (int r = 0; r < 4; ++r) (pass == 2 ? R2 : R)[(m * 16 + 4 * fq + r) * 260 + (2 * wave + n2) * 16 + fr] = acc[n2][r]; }
            if (pass < 4) { RWP_LOADW(pass + 1); asm volatile("" ::: "memory"); }
            __syncthreads();
            if (pass < 2) { const int d = pass; const float w0c = w0[d * 256 + (tid & 255)];
                for (int i = tid; i < 32 * 256; i += NT) { const int tok = i >> 8, c = i & 255; const float xw = w0c + R[tok * 260 + c];
                    RW[(size_t)(row0 + tok) * 2560 + (3 + 3 * d) * 256 + c] = __expf(-0.6065306597126334f * sigmoidf_(xw)); } }
            else if (pass == 2) { }
            else if (pass == 3) {
                float pk_[4], pa_[4], pr_[4], p0_[4], p1_[4];
#pragma unroll
                for (int q = 0; q < 4; ++q) { const int c = lane + 64 * q; pk_[q] = kkw[c]; pa_[q] = kaw[c]; pr_[q] = rkw[c]; p0_[q] = a0[c]; p1_[q] = a0[256 + c]; }
                const int m4 = lane & 3; int off;
                if (isctx) off = ((m4 & 1) == 0) ? -PW : PW; else off = (m4 == 0) ? -PW : ((m4 == 1) ? PW : ((m4 == 2) ? -64 * PW : 64 * PW));
                float muv[12];
#pragma unroll
                for (int e = 0; e < 12; ++e) muv[e] = mu[lane + 64 * e];
                float pn[12], sn[12]; bool okn;
#define RWT_LOAD(tk_) do { const int tok_ = wave * 4 + ((tk_) < 4 ? (tk_) : 3), t_ = t0 + tok_; \
                    if (isctx) okn = ((m4 & 1) == 0) ? (t_ > 0) : (t_ < CTX - 1); \
                    else { const int gr = t_ >> 6, gc = t_ & 63; okn = (m4 == 0) ? (gc > 0) : ((m4 == 1) ? (gc < 63) : ((m4 == 2) ? (gr > 0) : (gr < 31))); } \
                    const float* pr_ = P + (size_t)(row0 + tok_) * PW + C_RW + lane; const float* ps_ = pr_ + (okn ? off : 0); \
                    _Pragma("unroll") for (int e = 0; e < 12; ++e) { pn[e] = pr_[64 * e]; sn[e] = ps_[64 * e]; } \
                    asm volatile("" ::: "memory"); } while (0)
                RWT_LOAD(0);
#pragma unroll 1
                for (int tk = 0; tk < 4; ++tk) { const int tok = wave * 4 + tk, row = row0 + tok; float* o = RW + (size_t)row * 2560;
                    float pv[12], sv[12]; const bool ok = okn;
#pragma unroll
                    for (int e = 0; e < 12; ++e) { pv[e] = pn[e]; sv[e] = sn[e]; }
                    RWT_LOAD(tk + 1);
                    float mr[4], mk[4], mv[4], kx[4], ss[4];
#pragma unroll
                    for (int q = 0; q < 4; ++q) {
                        mr[q] = pv[q] + muv[q] * ((ok ? sv[q] : 0.f) - pv[q]); mk[q] = pv[4 + q] + muv[4 + q] * ((ok ? sv[4 + q] : 0.f) - pv[4 + q]);
                        mv[q] = pv[8 + q] + muv[8 + q] * ((ok ? sv[8 + q] : 0.f) - pv[8 + q]); kx[q] = mk[q] * pk_[q]; ss[q] = kx[q] * kx[q]; }
#pragma unroll
                    for (int q = 0; q < 4; ++q) ss[q] = wave_sum(ss[q]);
                    float bs[4];
#pragma unroll
                    for (int q = 0; q < 4; ++q) { const int c = lane + 64 * q;
                        const float r_ = mr[q], k_ = mk[q];
                        const float kk = kx[q] * rsqrtf(ss[q] + 1e-12f);
                        const float af = sigmoidf_(p0_[q] + R2[tok * 260 + c]), ab = sigmoidf_(p1_[q] + R[tok * 260 + c]);
                        const float kdf = k_ * (1.0f + (af - 1.0f) * pa_[q]), kdb = k_ * (1.0f + (ab - 1.0f) * pa_[q]);
                        o[c] = r_; o[256 + c] = mv[q]; o[512 + c] = kk;
                        o[4 * 256 + c] = kdf; o[5 * 256 + c] = kk * af; o[7 * 256 + c] = kdb; o[8 * 256 + c] = kk * ab;
                        bs[q] = r_ * (kdf + kdb) * pr_[q]; }
#pragma unroll
                    for (int q = 0; q < 4; ++q) bs[q] = wave_sum(bs[q]);
                    if (lane < 4) BON[(size_t)row * 4 + lane] = (lane == 0) ? bs[0] : ((lane == 1) ? bs[1] : ((lane == 2) ? bs[2] : bs[3])); }
#undef RWT_LOAD
            }
            else { for (int i = tid; i < 32 * 256; i += NT) { const int tok = i >> 8, c = i & 255; RW[(size_t)(row0 + tok) * 2560 + 9 * 256 + c] = R[tok * 260 + c]; } }
        }
        __syncthreads();
    }
}
#undef RWP_LOADW

__device__ __forceinline__ void prep_gdn(Frame& F, int l, const TileSched ts) {
    const float* __restrict__ P = WSP(float, WS_P);
    float* __restrict__ BG = WSP(float, WS_GBG);
    bf16_t* __restrict__ QB = WSP(bf16_t, WS_QB); bf16_t* __restrict__ KB = WSP(bf16_t, WS_KB); bf16_t* __restrict__ KT = WSP(bf16_t, WS_KT); bf16_t* __restrict__ VT = WSP(bf16_t, WS_VT);
    const float* __restrict__ cw = F.in[I_GCONV] + (size_t)l * 5 * 1536;
    LAS float* tile = (LAS float*)F.lds;
    const int tid = F.tid, lane = F.lane, wave = F.wave;
    TILE_LOOP(u, ts) {
        const int row0 = u * 64; const bool isctx = row0 < M_CTX; const int L = isctx ? CTX : SEQ; const int b = row_batch(row0); const int t0 = isctx ? row0 - b * CTX : row0 - M_CTX - b * SEQ;
        const int oc = (isctx ? 0 : 4) + (t0 >> 6);
        for (int i = tid; i < 64 * 16; i += NT) { const int tok = i >> 4, j = i & 15; const float rv = P[(size_t)(row0 + tok) * PW + C_GD + 2048 + j]; float ov;
            if (j < 8) ov = sigmoidf_(rv); else { const int dh = j - 8; ov = -__expf(F.in[I_GALOG][l * 8 + dh]) * softplusf_(rv + F.in[I_GDT][l * 8 + dh]); }
            BG[(size_t)(row0 + tok) * 16 + j] = ov; }
#pragma unroll 1
        for (int pass = 0; pass < 3; ++pass) {
            const int ch = pass * 512 + tid; const float* pc = P + (size_t)row0 * PW + C_GD + ch;
            const float w0 = cw[ch], w1 = cw[1536 + ch], w2 = cw[2 * 1536 + ch], w3 = cw[3 * 1536 + ch], w4 = cw[4 * 1536 + ch];
#define GLD(j) (((t0 + (j)) >= 0 && (t0 + (j)) < L) ? pc[(ptrdiff_t)(j) * PW] : 0.f)
            float xm2 = GLD(-2), xm1 = GLD(-1), x0 = GLD(0), x1 = GLD(1), x2 = GLD(2);
#pragma unroll 1
            for (int tb = 0; tb < 2; ++tb) { float nx[32];
#pragma unroll
                for (int e = 0; e < 32; ++e) nx[e] = GLD(tb * 32 + e + 3);
                asm volatile("" ::: "memory");
#pragma unroll
                for (int e = 0; e < 32; ++e) { const int tl = tb * 32 + e; const float a = (w0 * xm2 + w1 * xm1) + (w2 * x0 + w3 * x1) + w4 * x2;
                    tile[tl * 516 + tid] = siluf_(a);
                    xm2 = xm1; xm1 = x0; x0 = x1; x1 = x2; x2 = nx[e]; } }
#undef GLD
            __syncthreads();
            if (pass < 2) {
                for (int tk = 0; tk < 8; ++tk) { const int tl = wave * 8 + tk; float x[8];
#pragma unroll
                    for (int j = 0; j < 8; ++j) x[j] = tile[tl * 516 + lane + 64 * j];
#pragma unroll
                    for (int h4 = 0; h4 < 4; ++h4) { const float ss = wave_sum(x[2 * h4] * x[2 * h4] + x[2 * h4 + 1] * x[2 * h4 + 1]);
                        const float sc = rsqrtf(ss + 1e-12f) * (pass == 0 ? 0.08838834764831845f : 1.0f); x[2 * h4] *= sc; x[2 * h4 + 1] *= sc; }
#pragma unroll
                    for (int j = 0; j < 8; ++j) tile[tl * 516 + lane + 64 * j] = x[j]; }
                __syncthreads();
                bf16_t* dst = pass == 0 ? QB : KB;
                for (int i = tid; i < 64 * 64; i += NT) { const int tok = i >> 6, c8 = i & 63; const LAS float* sp = tile + tok * 516 + c8 * 8;
                    u32x4 p; p.x = pk2(sp[0], sp[1]); p.y = pk2(sp[2], sp[3]); p.z = pk2(sp[4], sp[5]); p.w = pk2(sp[6], sp[7]);
                    *(u32x4*)(dst + (size_t)(row0 + tok) * 512 + c8 * 8) = p; }
            }
            if (pass >= 1) {
                bf16_t* dst = pass == 1 ? KT : VT;
#pragma unroll 1
                for (int t8 = 0; t8 < 8; ++t8) { const LAS float* sp = tile + (t8 * 8) * 516 + tid;
                    u32x4 p; p.x = pk2(sp[0], sp[516]); p.y = pk2(sp[2 * 516], sp[3 * 516]); p.z = pk2(sp[4 * 516], sp[5 * 516]); p.w = pk2(sp[6 * 516], sp[7 * 516]);
                    *(u32x4*)(dst + ((size_t)((b * 4 + (tid >> 7)) * NCHUNK + oc) * 128 + (tid & 127)) * 64 + t8 * 8) = p; }
            }
            __syncthreads();
        }
    }
}

__device__ __forceinline__ int chain_row(int b, int d, int s) {
    if (s < CTX) { const int pos = d ? (CTX - 1 - s) : s; return b * CTX + pos; }
    const int q = s - CTX; const int pos = d ? (SEQ - 1 - q) : q; return M_CTX + b * SEQ + pos;
}
constexpr size_t GREC = 98304;
constexpr int GR_W = 0, GR_QG = 16384, GR_KT = 32768, GR_AT = 49152, GR_U = 57344, GR_EG = 90112;

__device__ __forceinline__ void gdn_precompute_wave(Frame& F, int ci, int n, LAS unsigned char* wl) {
    int lane_ = F.lane; asm volatile("" : "+v"(lane_));
    const int lane = lane_, fr = lane & 15, fq = lane >> 4;
    const int b = ci >> 3, h = (ci >> 1) & 3, d = ci & 1;
    LAS float* Tf = (LAS float*)wl;
    LAS bf16_t* MTb = (LAS bf16_t*)(wl + 17408);
    LAS float* gcv = (LAS float*)(wl + 26624); LAS float* betv = gcv + 64;
    const bool isctx = n < 4; const int np = isctx ? n : n - 4, nseg = isctx ? 4 : 32; const int ocs = d ? nseg - 1 - np : np;
    const int rowbase = (isctx ? b * CTX : M_CTX + b * SEQ) + ocs * 64; const int oc = (isctx ? 0 : 4) + ocs;
#define PROW(i) (rowbase + (d ? 63 - (i) : (i)))
    const GAS float* BG = (const GAS float*)WSP(float, WS_GBG);
    const GAS bf16_t* QB = (const GAS bf16_t*)WSP(bf16_t, WS_QB) + h * 128; const GAS bf16_t* KB = (const GAS bf16_t*)WSP(bf16_t, WS_KB) + h * 128;
    const GAS bf16_t* KT = (const GAS bf16_t*)WSP(bf16_t, WS_KT) + ((size_t)(b * 4 + h) * NCHUNK + oc) * 128 * 64;
    const GAS bf16_t* VT = (const GAS bf16_t*)WSP(bf16_t, WS_VT) + ((size_t)(b * 4 + h) * NCHUNK + oc) * 128 * 64;
    unsigned char* rec = F.ws + WS_GPRE + (size_t)(ci * NCHUNK + n) * GREC;
    const float bet = BG[(size_t)PROW(lane) * 16 + d * 4 + h]; const float g1 = BG[(size_t)PROW(lane) * 16 + 8 + d * 4 + h];
    gcv[lane] = g1; betv[lane] = bet;
    asm volatile("s_waitcnt lgkmcnt(0)" ::: "memory");
    float gc = 0.f, gl = 0.f;
#pragma unroll 8
    for (int j = 0; j < 64; ++j) { const float gj = gcv[j]; gl += gj; gc += (j <= lane) ? gj : 0.f; }
    asm volatile("s_waitcnt lgkmcnt(0)" ::: "memory");
    gcv[lane] = gc;
    asm volatile("s_waitcnt lgkmcnt(0)" ::: "memory");
    bf16x8 Kf[4][4], Qf[4][4];
#pragma unroll
    for (int t = 0; t < 4; ++t)
#pragma unroll
        for (int ks = 0; ks < 4; ++ks) { Kf[t][ks] = *(const GAS bf16x8*)(KB + (size_t)PROW(t * 16 + fr) * 512 + ks * 32 + fq * 8); Qf[t][ks] = *(const GAS bf16x8*)(QB + (size_t)PROW(t * 16 + fr) * 512 + ks * 32 + fq * 8); }
    asm volatile("" ::: "memory");
#pragma unroll
    for (int ti = 0; ti < 4; ++ti) {
#pragma unroll
        for (int tj = 0; tj < 4; ++tj) {
            __builtin_amdgcn_sched_barrier(0);
            if (tj > ti) { unsigned z_ = 0u; asm volatile("" : "+v"(z_)); *(GAS u32x2*)(rec + GR_AT + ((size_t)(ti * 16 + fr) * 64 + tj * 16 + 4 * fq) * 2) = (u32x2){z_, z_}; continue; }
            f32x4 kk = (f32x4){0.f, 0.f, 0.f, 0.f}, qk = kk;
#pragma unroll
            for (int ks = 0; ks < 4; ++ks) { kk = __builtin_amdgcn_mfma_f32_16x16x32_bf16(Kf[ti][ks], Kf[tj][ks], kk, 0, 0, 0);
                                             qk = __builtin_amdgcn_mfma_f32_16x16x32_bf16(Kf[tj][ks], Qf[ti][ks], qk, 0, 0, 0); }
            { const int j = tj * 16 + fr; const float gj = gcv[j]; f32x4 mv;
#pragma unroll
              for (int r = 0; r < 4; ++r) { const int i = ti * 16 + 4 * fq + r; mv[r] = (j < i) ? betv[i] * kk[r] * __expf(gcv[i] - gj) : 0.f; }
              u32x2 pm; pm.x = pk2(mv[0], mv[1]); pm.y = pk2(mv[2], mv[3]);
              *(LAS u32x2*)(MTb + j * 72 + ti * 16 + 4 * fq) = pm; }
            { const int i = ti * 16 + fr; const float gi = gcv[i]; float av[4];
#pragma unroll
              for (int r = 0; r < 4; ++r) { const int j = tj * 16 + 4 * fq + r; av[r] = (j <= i) ? qk[r] * __expf(gi - gcv[j]) : 0.f; }
              u32x2 pk; pk.x = pk2(av[0], av[1]); pk.y = pk2(av[2], av[3]);
              *(GAS u32x2*)(rec + GR_AT + ((size_t)i * 64 + tj * 16 + 4 * fq) * 2) = pk; }
        }
    }
    bf16x8 Vf[8][2], Tk[8][2];
#pragma unroll
    for (int t = 0; t < 8; ++t)
#pragma unroll
        for (int ks = 0; ks < 2; ++ks) { Vf[t][ks] = *(const GAS bf16x8*)(VT + (t * 16 + fr) * 64 + ks * 32 + fq * 8); Tk[t][ks] = *(const GAS bf16x8*)(KT + (t * 16 + fr) * 64 + ks * 32 + fq * 8); }
    asm volatile("" ::: "memory");
    asm volatile("s_waitcnt lgkmcnt(0)" ::: "memory");
#pragma unroll 1
    for (int I = 0; I < 4; ++I) {
        float acc[16];
#pragma unroll
        for (int ii = 0; ii < 16; ++ii) acc[ii] = 0.f;
#pragma unroll 4
        for (int j = 0; j < 16 * I; ++j) { const float tv = Tf[j * 68 + lane]; const LAS u32x4* mp = (const LAS u32x4*)(MTb + j * 72 + 16 * I);
#pragma unroll
            for (int q8 = 0; q8 < 2; ++q8) { const u32x4 m = mp[q8];
#pragma unroll
                for (int e = 0; e < 4; ++e) { acc[q8 * 8 + 2 * e] += __builtin_bit_cast(float, m[e] << 16) * tv; acc[q8 * 8 + 2 * e + 1] += __builtin_bit_cast(float, m[e] & 0xffff0000u) * tv; } } }
        float t[16];
#pragma unroll
        for (int jj = 0; jj < 16; ++jj) { t[jj] = ((16 * I + jj == lane) ? 1.f : 0.f) - acc[jj];
            const LAS u32x4* mp = (const LAS u32x4*)(MTb + (16 * I + jj) * 72 + 16 * I);
#pragma unroll
            for (int q8 = 0; q8 < 2; ++q8) { const u32x4 m = mp[q8];
#pragma unroll
                for (int e = 0; e < 4; ++e) { const int i0 = q8 * 8 + 2 * e;
                    if (i0 > jj) acc[i0] += __builtin_bit_cast(float, m[e] << 16) * t[jj];
                    if (i0 + 1 > jj) acc[i0 + 1] += __builtin_bit_cast(float, m[e] & 0xffff0000u) * t[jj]; } } }
#pragma unroll
        for (int ii = 0; ii < 16; ++ii) Tf[(16 * I + ii) * 68 + lane] = t[ii];
        asm volatile("s_waitcnt lgkmcnt(0)" ::: "memory");
    }
    LAS bf16_t* T1 = (LAS bf16_t*)Tf; LAS bf16_t* T2 = MTb;
    { const int col = d ? 63 - lane : lane; const float be = bet * __expf(gc);
#pragma unroll 1
      for (int hh = 0; hh < 2; ++hh) { float tr[32];
#pragma unroll
        for (int i = 0; i < 32; ++i) tr[i] = Tf[(hh * 32 + i) * 68 + lane];
        asm volatile("s_waitcnt lgkmcnt(0)" ::: "memory");
#pragma unroll
        for (int i = 0; i < 32; ++i) { T1[(hh * 32 + i) * 72 + col] = (bf16_t)f2bf(tr[i] * bet); T2[(hh * 32 + i) * 72 + col] = (bf16_t)f2bf(tr[i] * be); }
        asm volatile("s_waitcnt lgkmcnt(0)" ::: "memory"); } }
#pragma unroll 1
    for (int ti = 0; ti < 4; ++ti) { bf16x8 B1[2], B2[2];
#pragma unroll
        for (int ks = 0; ks < 2; ++ks) { B1[ks] = *(const LAS bf16x8*)(T1 + (ti * 16 + fr) * 72 + ks * 32 + fq * 8); B2[ks] = *(const LAS bf16x8*)(T2 + (ti * 16 + fr) * 72 + ks * 32 + fq * 8); }
#pragma unroll
        for (int tv = 0; tv < 8; ++tv) { f32x4 au = (f32x4){0.f, 0.f, 0.f, 0.f}, aw = au;
#pragma unroll
            for (int ks = 0; ks < 2; ++ks) { au = __builtin_amdgcn_mfma_f32_16x16x32_bf16(Vf[tv][ks], B1[ks], au, 0, 0, 0); aw = __builtin_amdgcn_mfma_f32_16x16x32_bf16(Tk[tv][ks], B2[ks], aw, 0, 0, 0); }
            const int i = ti * 16 + fr, c0 = tv * 16 + 4 * fq;
            *(GAS f32x4*)(rec + GR_U + ((size_t)i * 128 + c0) * 4) = au;
            u32x2 pk; pk.x = pk2(aw[0], aw[1]); pk.y = pk2(aw[2], aw[3]);
            *(GAS u32x2*)(rec + GR_W + ((size_t)i * 128 + c0) * 2) = pk; } }
    LAS float* egv = betv + 64; LAS float* fdv = egv + 64;
    egv[lane] = __expf(gc); fdv[lane] = __expf(gl - gc);
    asm volatile("s_waitcnt lgkmcnt(0)" ::: "memory");
    u32x4 ldq[16];
#pragma unroll
    for (int e = 0; e < 16; ++e) { const int idx = e * 64 + lane, i = idx >> 4, c8 = idx & 15; ldq[e] = *(const GAS u32x4*)(QB + (size_t)PROW(i) * 512 + c8 * 8); }
    asm volatile("" ::: "memory");
#pragma unroll
    for (int e = 0; e < 16; ++e) { const int idx = e * 64 + lane, i = idx >> 4, c8 = idx & 15; const float sc = egv[i];
        const u32x4 v = ldq[e]; u32x4 o;
        o.x = pk2(__builtin_bit_cast(float, v.x << 16) * sc, __builtin_bit_cast(float, v.x & 0xffff0000u) * sc); o.y = pk2(__builtin_bit_cast(float, v.y << 16) * sc, __builtin_bit_cast(float, v.y & 0xffff0000u) * sc);
        o.z = pk2(__builtin_bit_cast(float, v.z << 16) * sc, __builtin_bit_cast(float, v.z & 0xffff0000u) * sc); o.w = pk2(__builtin_bit_cast(float, v.w << 16) * sc, __builtin_bit_cast(float, v.w & 0xffff0000u) * sc);
        *(GAS u32x4*)(rec + GR_QG + ((size_t)i * 128 + c8 * 8) * 2) = o; }
#pragma unroll
    for (int e = 0; e < 16; ++e) { const int idx = e * 64 + lane, kd = idx >> 3, j8 = idx & 7; ldq[e] = *(const GAS u32x4*)(KT + kd * 64 + j8 * 8); }
    asm volatile("" ::: "memory");
#pragma unroll
    for (int e = 0; e < 16; ++e) { const int idx = e * 64 + lane, kd = idx >> 3, j8 = idx & 7;
        const u32x4 v = ldq[e];
        float x[8] = {__builtin_bit_cast(float, v.x << 16), __builtin_bit_cast(float, v.x & 0xffff0000u), __builtin_bit_cast(float, v.y << 16), __builtin_bit_cast(float, v.y & 0xffff0000u),
                      __builtin_bit_cast(float, v.z << 16), __builtin_bit_cast(float, v.z & 0xffff0000u), __builtin_bit_cast(float, v.w << 16), __builtin_bit_cast(float, v.w & 0xffff0000u)};
        float y[8];
#pragma unroll
        for (int q = 0; q < 8; ++q) { const int i = d ? 63 - (j8 * 8 + q) : j8 * 8 + q; y[q] = x[q] * fdv[i]; }
        u32x4 o;
        if (d) { o.x = pk2(y[7], y[6]); o.y = pk2(y[5], y[4]); o.z = pk2(y[3], y[2]); o.w = pk2(y[1], y[0]); }
        else { o.x = pk2(y[0], y[1]); o.y = pk2(y[2], y[3]); o.z = pk2(y[4], y[5]); o.w = pk2(y[6], y[7]); }
        *(GAS u32x4*)(rec + GR_KT + ((size_t)kd * 64 + (d ? 56 - j8 * 8 : j8 * 8)) * 2) = o; }
    if (lane == 0) *(GAS float*)(rec + GR_EG) = __expf(gl);
#undef PROW
    asm volatile("s_waitcnt lgkmcnt(0)" ::: "memory");
}

__device__ __forceinline__ void gdn_chain_unit(Frame& F, int ci, int vh) {
    LAS float*  Sf = (LAS float*)(F.lds);
    LAS bf16_t* St = (LAS bf16_t*)(F.lds + 34816);
    LAS bf16_t* Wl = (LAS bf16_t*)(F.lds + 52224);
    LAS bf16_t* Ql = (LAS bf16_t*)(F.lds + 69632);
    LAS bf16_t* Al = (LAS bf16_t*)(F.lds + 87040);
    LAS bf16_t* Kl = (LAS bf16_t*)(F.lds + 96256);
    LAS float*  Ul = (LAS float*)(F.lds + 114688);
    LAS bf16_t* Vn = (LAS bf16_t*)(F.lds + 132096);
    const int tid = F.tid, lane = F.lane, wave = F.wave;
    const int b = ci >> 3, h = (ci >> 1) & 3, d = ci & 1;
    float* GO = WSP(float, WS_GDO) + (size_t)d * M_ALL * 512;
    for (int i = tid; i < 128 * 68; i += NT) Sf[i] = 0.f;
    for (int i = tid; i < 64 * 136; i += NT) St[i] = 0;
    __syncthreads();
    for (int n = 0; n < NCHUNK; ++n) {
        const unsigned char* rec = F.ws + WS_GPRE + (size_t)(ci * NCHUNK + n) * GREC;
        for (int i = tid; i < 64 * 16; i += NT) { const int r = i >> 4, c8 = i & 15;
            *(LAS u32x4*)(Wl + r * 136 + c8 * 8) = *(const u32x4*)(rec + GR_W + (r * 128 + c8 * 8) * 2);
            *(LAS u32x4*)(Ql + r * 136 + c8 * 8) = *(const u32x4*)(rec + GR_QG + (r * 128 + c8 * 8) * 2); }
        for (int i = tid; i < 128 * 8; i += NT) { const int r = i >> 3, c8 = i & 7;
            *(LAS u32x4*)(Kl + r * 72 + c8 * 8) = *(const u32x4*)(rec + GR_KT + (r * 64 + c8 * 8) * 2); }
        for (int i = tid; i < 64 * 8; i += NT) { const int r = i >> 3, c8 = i & 7;
            *(LAS u32x4*)(Al + r * 72 + c8 * 8) = *(const u32x4*)(rec + GR_AT + (r * 64 + c8 * 8) * 2); }
        for (int i = tid; i < 64 * 16; i += NT) { const int r = i >> 4, c4 = i & 15;
            *(LAS f32x4*)(Ul + r * 68 + c4 * 4) = *(const f32x4*)(rec + GR_U + (r * 128 + vh * 64 + c4 * 4) * 4); }
        const float eg = *(const float*)(rec + GR_EG);
        __syncthreads();
        mm_lds(Wl, 136, St, 136, 64, 64, 128, wave, lane, [&](int i, int j, float v) { Vn[j * 72 + i] = (bf16_t)f2bf(Ul[i * 68 + j] - v); });
        __syncthreads();
        mm_lds(Ql, 136, St, 136, 64, 64, 128, wave, lane, [&](int i, int j, float v) { Ul[i * 68 + j] = v; });
        mm_lds(Al, 72, Vn, 72, 64, 64, 64, wave, lane, [&](int i, int j, float v) {
            const int row = chain_row(b, d, n * 64 + i); GO[(size_t)row * 512 + h * 128 + vh * 64 + j] = Ul[i * 68 + j] + v; });
        __syncthreads();
        mm_lds(Kl, 72, Vn, 72, 128, 64, 64, wave, lane, [&](int i, int j, float v) {
            const float s = eg * Sf[i * 68 + j] + v; Sf[i * 68 + j] = s; St[j * 136 + i] = (bf16_t)f2bf(s); });
        __syncthreads();
    }
}

__device__ __forceinline__ void rwkv_scan_unit(Frame& F, int ci, int vhalf) {
    constexpr int TB = 32, NBLK = (CTX + SEQ) / TB, PER = 5 * 64 + 32, NLD = TB * PER / NT;
    const float* RW = WSP(float, WS_RW);
    const int tid = F.tid, lane = F.lane, wave = F.wave;
    const int b = ci >> 3, h = (ci >> 1) & 3, d = ci & 1;
    float* RO = WSP(float, WS_RWO) + (size_t)d * M_ALL * 256;
    LAS float* buf0 = (LAS float*)F.lds;
    LAS float* obuf = buf0 + 2 * TB * PER;
    const int rr = lane >> 4, kq = lane & 15, vloc = wave * 8 + rr * 2;
    f32x4 S0 = (f32x4){0.f, 0.f, 0.f, 0.f}, S1 = S0;
    float regs[NLD];
    const int sgn = d ? -1 : 1;
    auto load_block = [&](int blk) {
        const int s0 = blk * TB;
        const int row0 = (s0 < CTX) ? b * CTX + (d ? CTX - 1 - s0 : s0) : M_CTX + b * SEQ + (d ? SEQ - 1 - (s0 - CTX) : (s0 - CTX));
        const GAS float* base = (const GAS float*)(RW + (size_t)row0 * 2560 + h * 64);
#pragma unroll
        for (int e = 0; e < 20; ++e) { const int arr = e % 5, st = (e / 5) * 8 + wave;
            const int slot = arr == 0 ? 2 : (arr == 1 ? 3 + 3 * d : (arr == 2 ? 5 + 3 * d : (arr == 3 ? 4 + 3 * d : 0)));
            const float v = base[(ptrdiff_t)(sgn * st) * 2560 + slot * 256 + lane]; regs[e] = (arr == 0) ? -v : v; }
#pragma unroll
        for (int e = 0; e < 2; ++e) { const int idx = e * NT + tid, st = idx >> 5, vi = idx & 31;
            regs[20 + e] = base[(ptrdiff_t)(sgn * st) * 2560 + 256 + vhalf * 32 + vi]; } };
    auto store_block = [&](LAS float* dst) {
#pragma unroll
        for (int e = 0; e < 20; ++e) { const int arr = e % 5, st = (e / 5) * 8 + wave; dst[st * PER + arr * 64 + lane] = regs[e]; }
#pragma unroll
        for (int e = 0; e < 2; ++e) { const int idx = e * NT + tid, st = idx >> 5, vi = idx & 31; dst[st * PER + 320 + vi] = regs[20 + e]; } };
    load_block(0); store_block(buf0);
    __syncthreads();
    for (int blk = 0; blk < NBLK; ++blk) {
        LAS float* cb = buf0 + (blk & 1) * TB * PER;
        if (blk + 1 < NBLK) load_block(blk + 1);
        if (wave < 4) {
            const LAS float* vp = cb;
            f32x4 a4 = *(const LAS f32x4*)(vp + 4 * kq), w4 = *(const LAS f32x4*)(vp + 64 + 4 * kq), b4 = *(const LAS f32x4*)(vp + 128 + 4 * kq),
                  k4 = *(const LAS f32x4*)(vp + 192 + 4 * kq), r4 = *(const LAS f32x4*)(vp + 256 + 4 * kq);
            f32x2 vv = *(const LAS f32x2*)(vp + 320 + vloc);
#pragma unroll 1
            for (int g = 0; g < TB / 8; ++g) {
                float qp0[8], qp1[8];
#pragma unroll
                for (int e = 0; e < 8; ++e) {
                    const int sn = (g * 8 + e + 1 < TB) ? g * 8 + e + 1 : TB - 1;
                    const LAS float* np = cb + sn * PER;
                    const f32x4 na4 = *(const LAS f32x4*)(np + 4 * kq), nw4 = *(const LAS f32x4*)(np + 64 + 4 * kq), nb4 = *(const LAS f32x4*)(np + 128 + 4 * kq),
                                nk4 = *(const LAS f32x4*)(np + 192 + 4 * kq), nr4 = *(const LAS f32x4*)(np + 256 + 4 * kq);
                    const f32x2 nvv = *(const LAS f32x2*)(np + 320 + vloc);
                    const f32x4 p0 = S0 * a4, p1 = S1 * a4;
                    const float sa0 = row16_sum((p0[0] + p0[1]) + (p0[2] + p0[3])), sa1 = row16_sum((p1[0] + p1[1]) + (p1[2] + p1[3]));
                    S0 = S0 * w4 + (b4 * sa0 + k4 * vv[0]);
                    S1 = S1 * w4 + (b4 * sa1 + k4 * vv[1]);
                    const f32x4 q0 = S0 * r4, q1 = S1 * r4;
                    qp0[e] = (q0[0] + q0[1]) + (q0[2] + q0[3]); qp1[e] = (q1[0] + q1[1]) + (q1[2] + q1[3]);
                    a4 = na4; w4 = nw4; b4 = nb4; k4 = nk4; r4 = nr4; vv = nvv;
                }
#pragma unroll
                for (int e = 0; e < 8; ++e) { const float o0 = row16_sum(qp0[e]), o1 = row16_sum(qp1[e]);
                    if (kq == 0) *(LAS f32x2*)(obuf + (g * 8 + e) * 32 + vloc) = (f32x2){o0, o1}; }
            }
        }
        __syncthreads();
        if (blk + 1 < NBLK) store_block(buf0 + ((blk + 1) & 1) * TB * PER);
#pragma unroll
        for (int e = 0; e < 2; ++e) { const int idx = e * NT + tid; const int st = idx >> 5, vi = idx & 31;
            const int row = chain_row(b, d, blk * TB + st); RO[(size_t)row * 256 + h * 64 + vhalf * 32 + vi] = obuf[idx]; }
        __syncthreads();
    }
}


__device__ __forceinline__ void soft_bar4(volatile LAS unsigned* cnt, unsigned& gen, int lane) {
    asm volatile("s_waitcnt vmcnt(0) lgkmcnt(0)" ::: "memory");
    gen += 4u;
    if (lane == 0) __hip_atomic_fetch_add((LAS unsigned*)cnt, 1u, __ATOMIC_RELAXED, __HIP_MEMORY_SCOPE_WORKGROUP);
    while (*cnt < gen) { }
    asm volatile("" ::: "memory");
}
__device__ __forceinline__ void rwkv_scan_quarter(Frame& F, int ci, int vq, volatile LAS unsigned* cnt, unsigned& gen) {
    constexpr int TB = 32, NBLK = (CTX + SEQ) / TB;
    constexpr int RO_ = TB * 256, VO_ = TB * 320, BSZ = TB * 336;
    const float* RW = WSP(float, WS_RW);
    const int lane = F.lane, wave = F.wave, tid4 = wave * 64 + lane;
    const int b = ci >> 3, h = (ci >> 1) & 3, d = ci & 1;
    float* RO = WSP(float, WS_RWO) + (size_t)d * M_ALL * 256;
    LAS float* buf0 = (LAS float*)F.lds;
    LAS float* obuf0 = buf0 + 2 * BSZ;
    LAS float* obuf1 = (LAS float*)(F.lds + 147456);
    const int rr = lane >> 4, kq = lane & 15, vloc = wave * 4 + rr;
    float S0 = 0.f, S1 = 0.f, S2 = 0.f, S3 = 0.f;
    const int sgn = d ? -1 : 1;
    const int laneA = (rr == 0 ? 2 : (rr == 1 ? 3 + 3 * d : (rr == 2 ? 5 + 3 * d : 4 + 3 * d))) * 256 + 4 * kq;
    auto stage_block = [&](int blk, LAS float* dst) {
        const int s0 = blk * TB;
        const int row0 = (s0 < CTX) ? b * CTX + (d ? CTX - 1 - s0 : s0) : M_CTX + b * SEQ + (d ? SEQ - 1 - (s0 - CTX) : (s0 - CTX));
        const float* base = RW + (size_t)row0 * 2560 + h * 64;
#pragma unroll
        for (int i = 0; i < 8; ++i) { const int st = i * 4 + wave;
            __builtin_amdgcn_global_load_lds((const unsigned*)(base + (ptrdiff_t)(sgn * st) * 2560 + laneA), (LAS unsigned*)(dst + st * 256), 16, 0, 0); }
#pragma unroll
        for (int i = 0; i < 2; ++i) { const int s4 = wave * 2 + i, st = s4 * 4 + rr;
            __builtin_amdgcn_global_load_lds((const unsigned*)(base + (ptrdiff_t)(sgn * st) * 2560 + 4 * kq), (LAS unsigned*)(dst + RO_ + s4 * 256), 16, 0, 0); }
        if (wave < 2) { const int st = wave * 16 + (lane >> 2);
            __builtin_amdgcn_global_load_lds((const unsigned*)(base + (ptrdiff_t)(sgn * st) * 2560 + 256 + vq * 16 + (lane & 3) * 4), (LAS unsigned*)(dst + VO_ + wave * 256), 16, 0, 0); } };
    stage_block(0, buf0);
    soft_bar4(cnt, gen, lane);
    for (int blk = 0; blk < NBLK; ++blk) {
        LAS float* cb = buf0 + (blk & 1) * BSZ;
        LAS float* obuf = (blk & 1) ? obuf1 : obuf0;
        {
            struct SV { f32x4 a, w, b, k, r; float v; };
            SV xA, xB;
            { const LAS float* p = cb;
              xA.a = *(const LAS f32x4*)(p + 4 * kq); xA.w = *(const LAS f32x4*)(p + 64 + 4 * kq); xA.b = *(const LAS f32x4*)(p + 128 + 4 * kq);
              xA.k = *(const LAS f32x4*)(p + 192 + 4 * kq); xA.r = *(const LAS f32x4*)(p + RO_ + 4 * kq); xA.v = cb[VO_ + vloc]; }
            unsigned adA = (unsigned)(size_t)(cb + 4 * kq), adR = (unsigned)(size_t)(cb + RO_ + 4 * kq), adV = (unsigned)(size_t)(cb + VO_ + vloc);
            if (blk + 1 < NBLK) stage_block(blk + 1, buf0 + ((blk + 1) & 1) * BSZ);
#define RWK_STEP(CUR, NXT, E, QO) { float pa_, t0_, t1_, t2_, t3_; \
            asm volatile( \
                "v_mul_f32 %[pa], %[s0], %[a0]\n\t" \
                "ds_read_b128 %[na], %[adA] offset:%[oa]\n\t" \
                "v_fma_f32 %[pa], %[s1], %[a1], %[pa]\n\t" \
                "ds_read_b128 %[nw], %[adA] offset:%[ow]\n\t" \
                "v_fma_f32 %[pa], %[s2], %[a2], %[pa]\n\t" \
                "ds_read_b128 %[nb], %[adA] offset:%[ob]\n\t" \
                "v_fma_f32 %[pa], %[s3], %[a3], %[pa]\n\t" \
                "ds_read_b128 %[nk], %[adA] offset:%[ok]\n\t" \
                "ds_read_b128 %[nr], %[adR] offset:%[orr]\n\t" \
                "ds_read_b32 %[nv], %[adV] offset:%[ov]\n\t" \
                "v_mul_f32 %[t0], %[k0], %[vv]\n\t" \
                "v_add_f32_dpp %[pa], %[pa], %[pa] quad_perm:[1,0,3,2] row_mask:0xf bank_mask:0xf bound_ctrl:1\n\t" \
                "v_mul_f32 %[t1], %[k1], %[vv]\n\t" \
                "v_mul_f32 %[t2], %[k2], %[vv]\n\t" \
                "v_add_f32_dpp %[pa], %[pa], %[pa] quad_perm:[2,3,0,1] row_mask:0xf bank_mask:0xf bound_ctrl:1\n\t" \
                "v_mul_f32 %[t3], %[k3], %[vv]\n\t" \
                "v_fma_f32 %[t0], %[s0], %[w0], %[t0]\n\t" \
                "v_add_f32_dpp %[pa], %[pa], %[pa] row_half_mirror row_mask:0xf bank_mask:0xf bound_ctrl:1\n\t" \
                "v_fma_f32 %[t1], %[s1], %[w1], %[t1]\n\t" \
                "v_fma_f32 %[t2], %[s2], %[w2], %[t2]\n\t" \
                "v_add_f32_dpp %[pa], %[pa], %[pa] row_mirror row_mask:0xf bank_mask:0xf bound_ctrl:1\n\t" \
                "v_fma_f32 %[t3], %[s3], %[w3], %[t3]\n\t" \
                "v_fma_f32 %[s0], -%[b0], %[pa], %[t0]\n\t" \
                "v_fma_f32 %[s1], -%[b1], %[pa], %[t1]\n\t" \
                "v_fma_f32 %[s2], -%[b2], %[pa], %[t2]\n\t" \
                "v_mul_f32 %[q], %[s0], %[r0]\n\t" \
                "v_fma_f32 %[s3], -%[b3], %[pa], %[t3]\n\t" \
                "v_fma_f32 %[q], %[s1], %[r1], %[q]\n\t" \
                "v_fma_f32 %[q], %[s2], %[r2], %[q]\n\t" \
                "v_fma_f32 %[q], %[s3], %[r3], %[q]\n\t" \
                "s_waitcnt lgkmcnt(0)" \
                : [na] "=&v"(NXT.a), [nw] "=&v"(NXT.w), [nb] "=&v"(NXT.b), [nk] "=&v"(NXT.k), [nr] "=&v"(NXT.r), [nv] "=&v"(NXT.v), [q] "=&v"(QO), \
                  [s0] "+v"(S0), [s1] "+v"(S1), [s2] "+v"(S2), [s3] "+v"(S3), \
                  [pa] "=&v"(pa_), [t0] "=&v"(t0_), [t1] "=&v"(t1_), [t2] "=&v"(t2_), [t3] "=&v"(t3_) \
                : [adA] "v"(adA), [adR] "v"(adR), [adV] "v"(adV), \
                  [oa] "i"(((E) + 1) * 1024), [ow] "i"(((E) + 1) * 1024 + 256), [ob] "i"(((E) + 1) * 1024 + 512), [ok] "i"(((E) + 1) * 1024 + 768), [orr] "i"(((E) + 1) * 256), \
                  [ov] "i"(((E) + 1) * 64), \
                  [a0] "v"(CUR.a[0]), [a1] "v"(CUR.a[1]), [a2] "v"(CUR.a[2]), [a3] "v"(CUR.a[3]), \
                  [w0] "v"(CUR.w[0]), [w1] "v"(CUR.w[1]), [w2] "v"(CUR.w[2]), [w3] "v"(CUR.w[3]), \
                  [b0] "v"(CUR.b[0]), [b1] "v"(CUR.b[1]), [b2] "v"(CUR.b[2]), [b3] "v"(CUR.b[3]), \
                  [k0] "v"(CUR.k[0]), [k1] "v"(CUR.k[1]), [k2] "v"(CUR.k[2]), [k3] "v"(CUR.k[3]), \
                  [r0] "v"(CUR.r[0]), [r1] "v"(CUR.r[1]), [r2] "v"(CUR.r[2]), [r3] "v"(CUR.r[3]), [vv] "v"(CUR.v) \
                : "memory"); }
#pragma unroll 1
            for (int g = 0; g < TB / 8; ++g) {
                float qp[8];
                RWK_STEP(xA, xB, 0, qp[0]) RWK_STEP(xB, xA, 1, qp[1]) RWK_STEP(xA, xB, 2, qp[2]) RWK_STEP(xB, xA, 3, qp[3])
                RWK_STEP(xA, xB, 4, qp[4]) RWK_STEP(xB, xA, 5, qp[5]) RWK_STEP(xA, xB, 6, qp[6]) RWK_STEP(xB, xA, 7, qp[7])
                adA += 8 * 1024; adR += 8 * 256; adV += 8 * 64;
                { float n0, n1, n2, n3, m0, m1, tt, uu, oo;
                  asm volatile(
                    "v_add_f32_dpp %[n0], %[q0], %[q0] row_ror:8 row_mask:0xf bank_mask:0x3\n\t"
                    "v_add_f32_dpp %[n1], %[q1], %[q1] row_ror:8 row_mask:0xf bank_mask:0x3\n\t"
                    "v_add_f32_dpp %[n2], %[q2], %[q2] row_ror:8 row_mask:0xf bank_mask:0x3\n\t"
                    "v_add_f32_dpp %[n3], %[q3], %[q3] row_ror:8 row_mask:0xf bank_mask:0x3\n\t"
                    "v_add_f32_dpp %[n0], %[q4], %[q4] row_ror:8 row_mask:0xf bank_mask:0xc\n\t"
                    "v_add_f32_dpp %[n1], %[q5], %[q5] row_ror:8 row_mask:0xf bank_mask:0xc\n\t"
                    "v_add_f32_dpp %[n2], %[q6], %[q6] row_ror:8 row_mask:0xf bank_mask:0xc\n\t"
                    "v_add_f32_dpp %[n3], %[q7], %[q7] row_ror:8 row_mask:0xf bank_mask:0xc\n\t"
                    "v_add_f32_dpp %[m0], %[n0], %[n0] row_shl:4 row_mask:0xf bank_mask:0x5\n\t"
                    "v_add_f32_dpp %[m1], %[n1], %[n1] row_shl:4 row_mask:0xf bank_mask:0x5\n\t"
                    "v_add_f32_dpp %[m0], %[n2], %[n2] row_shr:4 row_mask:0xf bank_mask:0xa\n\t"
                    "v_add_f32_dpp %[m1], %[n3], %[n3] row_shr:4 row_mask:0xf bank_mask:0xa\n\t"
                    "v_cndmask_b32 %[tt], %[m0], %[m1], %[msk]\n\t"
                    "v_cndmask_b32 %[uu], %[m1], %[m0], %[msk]\n\t"
                    "s_nop 1\n\t"
                    "v_add_f32_dpp %[oo], %[uu], %[tt] quad_perm:[2,3,0,1] row_mask:0xf bank_mask:0xf\n\t"
                    "s_nop 1\n\t"
                    "v_add_f32_dpp %[oo], %[oo], %[oo] quad_perm:[1,0,3,2] row_mask:0xf bank_mask:0xf"
                    : [n0] "=&v"(n0), [n1] "=&v"(n1), [n2] "=&v"(n2), [n3] "=&v"(n3), [m0] "=&v"(m0), [m1] "=&v"(m1), [tt] "=&v"(tt), [uu] "=&v"(uu), [oo] "=&v"(oo)
                    : [q0] "v"(qp[0]), [q1] "v"(qp[1]), [q2] "v"(qp[2]), [q3] "v"(qp[3]), [q4] "v"(qp[4]), [q5] "v"(qp[5]), [q6] "v"(qp[6]), [q7] "v"(qp[7]), [msk] "s"(0xCCCCCCCCCCCCCCCCull));
                  if ((kq & 1) == 0) obuf[(g * 8 + (kq >> 1)) * 16 + vloc] = oo; }
            }
#undef RWK_STEP
        }
        soft_bar4(cnt, gen, lane);
#pragma unroll
        for (int e = 0; e < 2; ++e) { const int idx = e * 256 + tid4; const int st = idx >> 4, vi = idx & 15;
            const int row = chain_row(b, d, blk * TB + st); RO[(size_t)row * 256 + h * 64 + vq * 16 + vi] = obuf[idx]; }
    }
}
__device__ __forceinline__ void gdn_chain_wave(Frame& F, int ci, int vq, LAS bf16_t* St, LAS bf16_t* Vn) {
    const int lane = F.lane; int fr = lane & 15, fq = lane >> 4;
    const int b = ci >> 3, h = (ci >> 1) & 3, d = ci & 1;
    float* GO = WSP(float, WS_GDO) + (size_t)d * M_ALL * 512 + h * 128 + vq * 32;
    f32x4 S[8][2];
#pragma unroll
    for (int i = 0; i < 8; ++i) { S[i][0] = (f32x4){0.f, 0.f, 0.f, 0.f}; S[i][1] = S[i][0]; }
    for (int i = lane; i < 32 * 136 / 2; i += 64) ((LAS unsigned*)St)[i] = 0u;
#pragma unroll 1
    for (int n = 0; n < NCHUNK; ++n) {
        asm volatile("" : "+v"(fr), "+v"(fq));
        const unsigned char* rec = F.ws + WS_GPRE + (size_t)(ci * NCHUNK + n) * GREC;
        const GAS bf16_t* Wg = (const GAS bf16_t*)(rec + GR_W); const GAS bf16_t* Qg = (const GAS bf16_t*)(rec + GR_QG);
        const GAS bf16_t* Kg = (const GAS bf16_t*)(rec + GR_KT); const GAS bf16_t* Ag = (const GAS bf16_t*)(rec + GR_AT);
        const GAS float* Ug = (const GAS float*)(rec + GR_U) + vq * 32; const float eg = *(const GAS float*)(rec + GR_EG);
        const int s0 = n * 64; const int row0 = (s0 < CTX) ? b * CTX + (d ? CTX - 1 - s0 : s0) : M_CTX + b * SEQ + (d ? SEQ - 1 - (s0 - CTX) : (s0 - CTX)); const int sgn = d ? -1 : 1;
        const unsigned oW = (unsigned)(fr * 128 + fq * 8) * 2u, oK = (unsigned)(fr * 64 + fq * 8) * 2u, oU = (unsigned)((4 * fq) * 128 + fr) * 4u;
        const unsigned oG = (unsigned)((d ? 63 - 4 * fq : 4 * fq) * 512 + fr) * 4u;
        __builtin_assume(oW < 4096u); __builtin_assume(oK < 2048u); __builtin_assume(oU < 8192u); __builtin_assume(oG < 131072u);
        const GAS char* Wc = (const GAS char*)Wg; const GAS char* Qc = (const GAS char*)Qg; const GAS char* Kc = (const GAS char*)Kg; const GAS char* Ac = (const GAS char*)Ag; const GAS char* Uc = (const GAS char*)Ug;
        GAS char* Gc = (GAS char*)(GO + (size_t)(row0 - (d ? 63 : 0)) * 512);
        unsigned pf[3];
        { const unsigned char* nrec = rec + (n + 1 < NCHUNK ? GREC : 0);
#pragma unroll
          for (int i = 0; i < 3; ++i) { const int line = i * 256 + vq * 64 + lane; pf[i] = *(const GAS unsigned*)(nrec + (size_t)(line < 704 ? line : 703) * 128); }
          asm volatile("" ::: "memory"); }
        bf16x8 Bs[2][4];
#pragma unroll
        for (int j = 0; j < 2; ++j)
#pragma unroll
            for (int ks = 0; ks < 4; ++ks) Bs[j][ks] = *(const LAS bf16x8*)(St + (j * 16 + fr) * 136 + ks * 32 + fq * 8);
#pragma unroll
        for (int mh = 0; mh < 2; ++mh) { bf16x8 Aw[2][4]; float uu[2][2][4];
#pragma unroll
          for (int m2 = 0; m2 < 2; ++m2) { const int m = mh * 2 + m2;
#pragma unroll
            for (int ks = 0; ks < 4; ++ks) Aw[m2][ks] = *(const GAS bf16x8*)(Wc + (oW + (unsigned)(m * 4096 + ks * 64)));
#pragma unroll
            for (int j = 0; j < 2; ++j)
#pragma unroll
                for (int r = 0; r < 4; ++r) uu[m2][j][r] = *(const GAS float*)(Uc + (oU + (unsigned)((m * 16 + r) * 512 + j * 64))); }
          asm volatile("" ::: "memory");
#pragma unroll
          for (int m2 = 0; m2 < 2; ++m2) { const int m = mh * 2 + m2;
#pragma unroll
            for (int j = 0; j < 2; ++j) { f32x4 acc = (f32x4){0.f, 0.f, 0.f, 0.f};
#pragma unroll
                for (int ks = 0; ks < 4; ++ks) acc = __builtin_amdgcn_mfma_f32_16x16x32_bf16(Aw[m2][ks], Bs[j][ks], acc, 0, 0, 0);
                u32x2 pk; pk.x = pk2(uu[m2][j][0] - acc[0], uu[m2][j][1] - acc[1]); pk.y = pk2(uu[m2][j][2] - acc[2], uu[m2][j][3] - acc[3]);
                *(LAS u32x2*)(Vn + (j * 16 + fr) * 72 + m * 16 + 4 * fq) = pk; } } }
        bf16x8 Bv[2][2];
#pragma unroll
        for (int j = 0; j < 2; ++j)
#pragma unroll
            for (int ks = 0; ks < 2; ++ks) Bv[j][ks] = *(const LAS bf16x8*)(Vn + (j * 16 + fr) * 72 + ks * 32 + fq * 8);
#pragma unroll
        for (int mh = 0; mh < 2; ++mh) { bf16x8 Aq[2][4], Aa[2][2];
#pragma unroll
            for (int m2 = 0; m2 < 2; ++m2) { const int m = mh * 2 + m2;
#pragma unroll
                for (int ks = 0; ks < 4; ++ks) Aq[m2][ks] = *(const GAS bf16x8*)(Qc + (oW + (unsigned)(m * 4096 + ks * 64)));
#pragma unroll
                for (int ks = 0; ks < 2; ++ks) Aa[m2][ks] = *(const GAS bf16x8*)(Ac + (oK + (unsigned)(m * 2048 + ks * 64))); }
            asm volatile("" ::: "memory");
#pragma unroll
            for (int m2 = 0; m2 < 2; ++m2) { const int m = mh * 2 + m2;
#pragma unroll
                for (int j = 0; j < 2; ++j) { f32x4 acc = (f32x4){0.f, 0.f, 0.f, 0.f};
#pragma unroll
                    for (int ks = 0; ks < 4; ++ks) acc = __builtin_amdgcn_mfma_f32_16x16x32_bf16(Aq[m2][ks], Bs[j][ks], acc, 0, 0, 0);
#pragma unroll
                    for (int ks = 0; ks < 2; ++ks) acc = __builtin_amdgcn_mfma_f32_16x16x32_bf16(Aa[m2][ks], Bv[j][ks], acc, 0, 0, 0);
#pragma unroll
                    for (int r = 0; r < 4; ++r) *(GAS float*)(Gc + (unsigned)((int)oG + sgn * ((m * 16 + r) * 2048) + j * 64)) = acc[r]; } } }
        { bf16x8 Ak[8][2];
#pragma unroll
          for (int i = 0; i < 8; ++i)
#pragma unroll
            for (int ks = 0; ks < 2; ++ks) Ak[i][ks] = *(const GAS bf16x8*)(Kc + (oK + (unsigned)(i * 2048 + ks * 64)));
          asm volatile("" ::: "memory");
#pragma unroll
          for (int i = 0; i < 8; ++i)
#pragma unroll
            for (int j = 0; j < 2; ++j) { f32x4 acc = S[i][j] * eg;
#pragma unroll
                for (int ks = 0; ks < 2; ++ks) acc = __builtin_amdgcn_mfma_f32_16x16x32_bf16(Ak[i][ks], Bv[j][ks], acc, 0, 0, 0);
                S[i][j] = acc;
                u32x2 pk; pk.x = pk2(acc[0], acc[1]); pk.y = pk2(acc[2], acc[3]);
                *(LAS u32x2*)(St + (j * 16 + fr) * 136 + i * 16 + 4 * fq) = pk; } }
        asm volatile("" :: "v"(pf[0]), "v"(pf[1]), "v"(pf[2]));
    }
}

__device__ __forceinline__ void hyena_lat_unit(Frame& F, int l, int c) {
    constexpr int CPS = 8192 + 32;
    constexpr int VST = 2184;
    LAS unsigned char* cp = F.lds;
    LAS bf16_t* vv = (LAS bf16_t*)(F.lds + 8 * CPS);
    const int tid = F.tid, lane = F.lane, wave = F.wave;
    const float* g = WSP(float, WS_FILT) + ((size_t)l * 256 + c) * (2 * SEQ);
    const float* V = WSP(float, WS_VVT) + (size_t)c * NB * (CTX + SEQ);
    float* Y = WSP(float, WS_YT) + (size_t)c * NB * (CTX + SEQ);
    { float gv[8][8];
#pragma unroll
      for (int k = 0; k < 8; ++k) { const int i = tid + k * NT, r = i >> 9, n = i & 511;
#pragma unroll
          for (int e = 0; e < 8; ++e) { const int gi = 8 * n + r + e; gv[k][e] = (gi >= 1 && gi <= 4095) ? g[gi] : 0.f; } }
      asm volatile("" ::: "memory");
#pragma unroll
      for (int k = 0; k < 8; ++k) { const int i = tid + k * NT, r = i >> 9, n = i & 511;
          u32x4 p; p.x = pk2(gv[k][0], gv[k][1]); p.y = pk2(gv[k][2], gv[k][3]); p.z = pk2(gv[k][4], gv[k][5]); p.w = pk2(gv[k][6], gv[k][7]);
          *(LAS u32x4*)(cp + r * CPS + n * 16) = p; } }
    { float vb[5][8];
#pragma unroll
      for (int k = 0; k < 5; ++k) { const int i = tid + k * NT; const int bb = (i < 8 * 272) ? i / 272 : 0, gq = (i < 8 * 272) ? i % 272 : 0; const int s0 = gq * 8 - 64;
#pragma unroll
          for (int e = 0; e < 8; ++e) vb[k][e] = (i < 8 * 272 && s0 >= 0 && s0 < SEQ) ? V[(size_t)bb * (CTX + SEQ) + CTX + s0 + 7 - e] : 0.f; }
      asm volatile("" ::: "memory");
#pragma unroll
      for (int k = 0; k < 5; ++k) { const int i = tid + k * NT; if (i < 8 * 272) { const int bb = i / 272, gq = i % 272;
          u32x4 p; p.x = pk2(vb[k][0], vb[k][1]); p.y = pk2(vb[k][2], vb[k][3]); p.z = pk2(vb[k][4], vb[k][5]); p.w = pk2(vb[k][6], vb[k][7]);
          *(LAS u32x4*)(vv + bb * VST + gq * 8) = p; } } }
    __syncthreads();
    const int fr = lane & 15, fq = lane >> 4;
    const int rcp = (fr + 1) & 7;
    const int bcol = fr & 7, pb = fr >> 3;
    f32x4 acc[2][4];
#pragma unroll
    for (int p = 0; p < 2; ++p)
#pragma unroll
        for (int m = 0; m < 4; ++m) acc[p][m] = (f32x4){0.f, 0.f, 0.f, 0.f};
    const int P0 = 2 * wave;
    const int dlo = 2 * P0 - 31 < -31 ? -31 : 2 * P0 - 31, dhi = 2 * (P0 + 1) + 1 > 31 ? 31 : 2 * (P0 + 1) + 1;
    for (int d = dlo; d <= dhi; ++d) {
        bf16x8 A[4][2];
#pragma unroll
        for (int m = 0; m < 4; ++m)
#pragma unroll
            for (int s = 0; s < 2; ++s) { const int a = d * 64 + 16 * m + fr - 32 * s - 8 * fq - 7 + 2048;
                A[m][s] = *(const LAS bf16x8*)(cp + rcp * CPS + ((a - rcp) >> 3) * 16); }
#pragma unroll
        for (int p = 0; p < 2; ++p) { const int Pp = P0 + p; if (d > 2 * Pp + 1 || d < 2 * Pp - 31) continue;
            const int J = 2 * Pp + pb - d;
#pragma unroll
            for (int s = 0; s < 2; ++s) { const bf16x8 B = *(const LAS bf16x8*)(vv + bcol * VST + (J + 1) * 64 + 32 * s + 8 * fq);
#pragma unroll
                for (int m = 0; m < 4; ++m) acc[p][m] = __builtin_amdgcn_mfma_f32_16x16x32_bf16(A[m][s], B, acc[p][m], 0, 0, 0); } }
    }
#pragma unroll
    for (int p = 0; p < 2; ++p)
#pragma unroll
        for (int m = 0; m < 4; ++m) { const int t = 64 * (2 * (P0 + p) + pb) + 16 * m + 4 * fq;
            *(f32x4*)(Y + (size_t)bcol * (CTX + SEQ) + CTX + t) = acc[p][m]; }
    __syncthreads();
}
__device__ __forceinline__ void hyena_ctx_unit(Frame& F, int l, int c) {
    LAS float* gl = (LAS float*)F.lds;
    LAS float* vl = gl + 512;
    const int tid = F.tid, lane = F.lane, wave = F.wave;
    const float* g = WSP(float, WS_FILTC) + ((size_t)l * 256 + c) * (2 * CTX);
    const float* V = WSP(float, WS_VVT) + (size_t)c * NB * (CTX + SEQ);
    float* Y = WSP(float, WS_YT) + (size_t)c * NB * (CTX + SEQ);
    gl[tid] = (tid >= 1) ? g[tid] : 0.f;
    for (int i = tid; i < 8 * 256; i += NT) vl[i] = V[(size_t)(i >> 8) * (CTX + SEQ) + (i & 255)];
    __syncthreads();
    float a[4] = {0.f, 0.f, 0.f, 0.f};
    for (int s = 0; s < CTX; ++s) { const float v = vl[wave * 256 + s];
#pragma unroll
        for (int j = 0; j < 4; ++j) a[j] += gl[lane + 64 * j - s + 256] * v; }
#pragma unroll
    for (int j = 0; j < 4; ++j) Y[(size_t)wave * (CTX + SEQ) + lane + 64 * j] = a[j];
    __syncthreads();
}

__device__ __forceinline__ void phase_finish(Frame& F, int l, bool with_ctx) {
    const float* __restrict__ P = WSP(float, WS_P); const float* __restrict__ YT = WSP(float, WS_YT);
    const float* __restrict__ RW = WSP(float, WS_RW); const float* __restrict__ BON = WSP(float, WS_RWBON);
    const float* __restrict__ RO = WSP(float, WS_RWO); const float* __restrict__ GO = WSP(float, WS_GDO);
    bf16_t* __restrict__ YC = WSP(bf16_t, WS_YCAT);
    const float* sw = F.in[I_HSW] + (size_t)l * 3 * 768; const float* sb = F.in[I_HSB] + (size_t)l * 768;
    const float* gnw = F.in[I_RGNW] + l * 256; const float* gnb = F.in[I_RGNB] + l * 256; const float* gdw = F.in[I_GNW] + l * 128;
    LAS float* tile = (LAS float*)F.lds;
    const int tid = F.tid, lane = F.lane, wave = F.wave;
    const f32x4 pgw4 = *(const f32x4*)(gnw + 4 * lane), pgb4 = *(const f32x4*)(gnb + 4 * lane);
    const f32x4 pdwA = *(const f32x4*)(gdw + ((8 * lane) & 127)), pdwB = *(const f32x4*)(gdw + ((8 * lane) & 127) + 4);
    for (int u = F.bid; u < M_ALL / 64; u += F.G) {
        const int row0 = u * 64; const bool isctx = row0 < M_CTX; if (isctx && !with_ctx) continue;
        const int L = isctx ? CTX : SEQ; const int b = row_batch(row0); const int t0 = isctx ? row0 - b * CTX : row0 - M_CTX - b * SEQ;
        const int pos0 = isctx ? t0 : CTX + t0;
        { float tmp[32];
#pragma unroll
          for (int k = 0; k < 32; ++k) { const int i = tid + k * NT, cc = i >> 6, tl = i & 63; tmp[k] = YT[((size_t)cc * NB + b) * (CTX + SEQ) + pos0 + tl]; }
          asm volatile("" ::: "memory");
#pragma unroll
          for (int k = 0; k < 32; ++k) { const int i = tid + k * NT, cc = i >> 6, tl = i & 63; tile[cc * 65 + tl] = tmp[k]; } }
        __syncthreads();
        { const int c2 = 2 * (tid & 127), tq = tid >> 7;
          const f32x2 wa = *(const f32x2*)(sw + c2), wb = *(const f32x2*)(sw + 768 + c2), wc_ = *(const f32x2*)(sw + 2 * 768 + c2), b0 = *(const f32x2*)(sb + c2);
          const float* pc = P + (size_t)(row0 + tq * 16) * PW + c2; f32x2 xr[18];
#pragma unroll
          for (int k = 0; k < 18; ++k) { const int t = t0 + tq * 16 + k - 1; xr[k] = (t >= 0 && t < L) ? *(const f32x2*)(pc + (ptrdiff_t)(k - 1) * PW) : (f32x2){0.f, 0.f}; }
          asm volatile("" ::: "memory");
#pragma unroll
          for (int tt = 0; tt < 16; ++tt) { const int tl = tq * 16 + tt; const f32x2 x0 = b0 + wa * xr[tt] + wb * xr[tt + 1] + wc_ * xr[tt + 2];
              *(unsigned*)(YC + (size_t)(row0 + tl) * D + c2) = pk2(tile[c2 * 65 + tl] * x0.x, tile[(c2 + 1) * 65 + tl] * x0.y); } }
#pragma unroll 1
        for (int tp = 0; tp < 2; ++tp) {
            f32x4 ro[4][2], rv[4], rg[4], go[4][4], zz[4][2]; float bo[4];
#pragma unroll
            for (int s4 = 0; s4 < 4; ++s4) { const int row = row0 + wave * 8 + tp * 4 + s4; const float* rw = RW + (size_t)row * 2560;
                ro[s4][0] = *(const f32x4*)(RO + (size_t)row * 256 + 4 * lane); ro[s4][1] = *(const f32x4*)(RO + (size_t)(M_ALL + row) * 256 + 4 * lane);
                bo[s4] = BON[(size_t)row * 4 + (lane >> 4)]; rv[s4] = *(const f32x4*)(rw + 256 + 4 * lane); rg[s4] = *(const f32x4*)(rw + 9 * 256 + 4 * lane);
                go[s4][0] = *(const f32x4*)(GO + (size_t)row * 512 + 8 * lane); go[s4][1] = *(const f32x4*)(GO + (size_t)row * 512 + 8 * lane + 4);
                go[s4][2] = *(const f32x4*)(GO + (size_t)(M_ALL + row) * 512 + 8 * lane); go[s4][3] = *(const f32x4*)(GO + (size_t)(M_ALL + row) * 512 + 8 * lane + 4);
                zz[s4][0] = *(const f32x4*)(P + (size_t)row * PW + C_GD + 1536 + 8 * lane); zz[s4][1] = *(const f32x4*)(P + (size_t)row * PW + C_GD + 1536 + 8 * lane + 4); }
            asm volatile("" ::: "memory");
#pragma unroll
            for (int s4 = 0; s4 < 4; ++s4) { const int row = row0 + wave * 8 + tp * 4 + s4;
                { const f32x4 o = ro[s4][0] + ro[s4][1];
                  const float mean = row16_sum((o.x + o.y) + (o.z + o.w)) * (1.f / 64.f); const f32x4 dv = o - mean;
                  const float var = row16_sum((dv.x * dv.x + dv.y * dv.y) + (dv.z * dv.z + dv.w * dv.w)) * (1.f / 64.f);
                  f32x4 y = dv * rsqrtf(var + 64e-5f) * pgw4 + pgb4;
                  y = (y + rv[s4] * bo[s4]) * rg[s4];
                  u32x2 p; p.x = pk2(y.x, y.y); p.y = pk2(y.z, y.w);
                  *(u32x2*)(YC + (size_t)row * D + 256 + 4 * lane) = p; }
                { const f32x4 oa = go[s4][0] + go[s4][2], ob = go[s4][1] + go[s4][3];
                  const float ss = ((oa.x * oa.x + oa.y * oa.y) + (oa.z * oa.z + oa.w * oa.w)) + ((ob.x * ob.x + ob.y * ob.y) + (ob.z * ob.z + ob.w * ob.w));
                  const float rs = rsqrtf(row16_sum(ss) * (1.f / 128.f) + 1e-6f);
                  const f32x4 za = zz[s4][0], zb = zz[s4][1];
                  const f32x4 ya = oa * rs * pdwA * (f32x4){siluf_(za.x), siluf_(za.y), siluf_(za.z), siluf_(za.w)};
                  const f32x4 yb = ob * rs * pdwB * (f32x4){siluf_(zb.x), siluf_(zb.y), siluf_(zb.z), siluf_(zb.w)};
                  u32x4 p; p.x = pk2(ya.x, ya.y); p.y = pk2(ya.z, ya.w); p.z = pk2(yb.x, yb.y); p.w = pk2(yb.z, yb.w);
                  *(u32x4*)(YC + (size_t)row * D + 512 + 8 * lane) = p; } }
        }
        __syncthreads();
    }
}

__device__ __forceinline__ void phase_router(Frame& F, int l, int row_lo, bool dummy = false) {
    const float* H = WSP(float, WS_H); const float* mods = WSP(float, WS_MODS) + (size_t)l * 9 * (NMOD * D);
    bf16_t* N = WSP(bf16_t, WS_N);
    const float* rw = F.in[I_MRW] + (size_t)l * D * NE; const float* rb = F.in[I_MRB] + l * NE;
    unsigned* cnt = (unsigned*)(F.ws + WS_CTL) + CW_CNT + l * NE * 64 + (dummy ? 100000 : 0);
    const size_t doff = dummy ? (WS_END - WS_STOK) : 0;
    int* stok = WSP(int, WS_STOK + doff); int* toke = WSP(int, WS_TOKE + doff); int* tokr = WSP(int, WS_TOKE + MiB + doff); float* tokg = WSP(float, WS_TOKE + 2 * MiB + doff);
    constexpr int XS = 1028;
    LAS float* xr = (LAS float*)F.lds;
    LAS float* red = xr + 16 * XS;
    LAS float* lg = red + 8 * 16 * 32;
    const int tid = F.tid, lane = F.lane, wave = F.wave;
    for (int u = F.bid; u < (M_ALL - row_lo) / 16; u += F.G) {
        const int row0 = row_lo + u * 16;
        for (int tk = 0; tk < 2; ++tk) { const int tl = wave * 2 + tk, row = row0 + tl; const float* mr = mods + (size_t)row_modr(row) * (NMOD * D);
            norm_mod_row<true>(H + (size_t)row * D, F.in[I_NFFN] + l * D, mr + 3 * D, mr + 4 * D, N + (size_t)row * D, xr + tl * XS, lane); }
        __syncthreads();
        { const int tl = lane >> 2, eq = lane & 3; float acc[8];
#pragma unroll
          for (int j = 0; j < 8; ++j) acc[j] = 0.f;
          const LAS float* xp = xr + tl * XS + 128 * wave; const float* wp = rw + (size_t)(128 * wave) * NE + eq * 8;
#pragma unroll 1
          for (int kb = 0; kb < 8; ++kb) { f32x4 wv[16][2];
#pragma unroll
              for (int kk = 0; kk < 16; ++kk) { wv[kk][0] = *(const f32x4*)(wp + (size_t)(16 * kb + kk) * NE); wv[kk][1] = *(const f32x4*)(wp + (size_t)(16 * kb + kk) * NE + 4); }
              asm volatile("" ::: "memory");
#pragma unroll
              for (int k4 = 0; k4 < 4; ++k4) { const f32x4 x4 = *(const LAS f32x4*)(xp + 16 * kb + 4 * k4);
#pragma unroll
                  for (int kk = 0; kk < 4; ++kk)
#pragma unroll
                      for (int i = 0; i < 4; ++i) { acc[i] += x4[kk] * wv[4 * k4 + kk][0][i]; acc[4 + i] += x4[kk] * wv[4 * k4 + kk][1][i]; } } }
          LAS float* rp = red + (wave * 16 + tl) * 32 + eq * 8;
          *(LAS f32x4*)rp = (f32x4){acc[0], acc[1], acc[2], acc[3]}; *(LAS f32x4*)(rp + 4) = (f32x4){acc[4], acc[5], acc[6], acc[7]}; }
        __syncthreads();
        { const int tl = tid >> 5, e = tid & 31; float a = rb[e];
#pragma unroll
          for (int w = 0; w < 8; ++w) a += red[(w * 16 + tl) * 32 + e];
          lg[tl * 33 + e] = a; }
        __syncthreads();
        if (tid < 16) { const int row = row0 + tid; float v[NE];
#pragma unroll
            for (int e = 0; e < NE; ++e) v[e] = lg[tid * 33 + e];
            int sel[4]; float sv[4];
#pragma unroll
            for (int k = 0; k < 4; ++k) { float best = -3.0e38f; int bi = 0;
#pragma unroll
                for (int e = 0; e < NE; ++e) { const bool taken = (k > 0 && sel[0] == e) || (k > 1 && sel[1] == e) || (k > 2 && sel[2] == e);
                    if (!taken && v[e] > best) { best = v[e]; bi = e; } }
                sel[k] = bi; sv[k] = best; }
            float ex[4], den = 0.f;
#pragma unroll
            for (int k = 0; k < 4; ++k) { ex[k] = __expf(sv[k] - sv[0]); den += ex[k]; }
#pragma unroll
            for (int k = 0; k < 4; ++k) { const unsigned rk = atomicAdd(cnt + sel[k] * 64, 1u);
                stok[(size_t)sel[k] * M_ALL + rk] = row; toke[(size_t)row * 4 + k] = sel[k]; tokr[(size_t)row * 4 + k] = (int)rk; tokg[(size_t)row * 4 + k] = ex[k] / den; } }
        __syncthreads();
    }
}


__device__ __forceinline__ void phase_router2(Frame& F, int l, int row_lo, bool dummy = false) {
    const float* __restrict__ H = WSP(float, WS_H); const float* __restrict__ mods = WSP(float, WS_MODS) + (size_t)l * 9 * (NMOD * D);
    bf16_t* __restrict__ N = WSP(bf16_t, WS_N);
    const float* __restrict__ rw = F.in[I_MRW] + (size_t)l * D * NE; const float* __restrict__ rb = F.in[I_MRB] + l * NE; const float* __restrict__ nw = F.in[I_NFFN] + l * D;
    unsigned* cnt = (unsigned*)(F.ws + WS_CTL) + CW_CNT + l * NE * 64 + (dummy ? 100000 : 0);
    const size_t doff = dummy ? (WS_END - WS_STOK) : 0;
    int* __restrict__ stok = WSP(int, WS_STOK + doff); int* __restrict__ toke = WSP(int, WS_TOKE + doff); int* __restrict__ tokr = WSP(int, WS_TOKE + MiB + doff); float* __restrict__ tokg = WSP(float, WS_TOKE + 2 * MiB + doff);
    constexpr int WS_ = 1028;
    LAS float* WT = (LAS float*)F.lds;
    LAS unsigned* lcnt = (LAS unsigned*)(F.lds + 32 * WS_ * 4);
    LAS int* recs = (LAS int*)(lcnt + 64);
    const int tid = F.tid, lane = F.lane;
    if (tid < 64) lcnt[tid] = 0u;
#pragma unroll 1
    for (int fb = 0; fb < 4; ++fb) { float tv[16];
#pragma unroll
        for (int q = 0; q < 16; ++q) tv[q] = rw[tid + (fb * 16 + q) * NT];
        asm volatile("" ::: "memory");
#pragma unroll
        for (int q = 0; q < 16; ++q) { const int i = tid + (fb * 16 + q) * NT, k = i >> 5, e = i & 31; WT[e * WS_ + k] = tv[q]; } }
    __syncthreads();
    const int gw = F.bid * NWV + F.wave, NGW = F.G * NWV, npair = (M_ALL - row_lo) / 2;
    const bool agg = (npair + NGW - 1) / NGW <= 5;
    const float rbl = rb[lane & 31];
#pragma unroll 1
    for (int p = gw; p < npair; p += NGW) {
        const int row = row_lo + 2 * p; const float* mr = mods + (size_t)row_modr(row) * (NMOD * D);
        f32x4 hv[2][4], wv[4], sh[4], sc[4];
#pragma unroll
        for (int j = 0; j < 4; ++j) { const int c = 4 * lane + 256 * j; hv[0][j] = *(const f32x4*)(H + (size_t)row * D + c); hv[1][j] = *(const f32x4*)(H + (size_t)(row + 1) * D + c);
            wv[j] = *(const f32x4*)(nw + c); sh[j] = *(const f32x4*)(mr + 3 * D + c); sc[j] = *(const f32x4*)(mr + 4 * D + c); }
        asm volatile("" ::: "memory");
        f32x4 x[2][4];
#pragma unroll
        for (int t = 0; t < 2; ++t) { float s = 0.f;
#pragma unroll
            for (int j = 0; j < 4; ++j) s += (hv[t][j].x * hv[t][j].x + hv[t][j].y * hv[t][j].y) + (hv[t][j].z * hv[t][j].z + hv[t][j].w * hv[t][j].w);
            const float rstd = rsqrtf(wave_sum(s) * (1.f / D) + 1e-6f);
#pragma unroll
            for (int j = 0; j < 4; ++j) { const int c = 4 * lane + 256 * j; const f32x4 o = (hv[t][j] * rstd) * wv[j] * (sc[j] + 1.0f) + sh[j]; x[t][j] = o;
                u32x2 pk; pk.x = pk2(o.x, o.y); pk.y = pk2(o.z, o.w); *(u32x2*)(N + (size_t)(row + t) * D + c) = pk; } }
        float ac[64];
#pragma unroll
        for (int e = 0; e < NE; ++e) { float a0 = 0.f, a1 = 0.f;
#pragma unroll
            for (int j = 0; j < 4; ++j) { const f32x4 w4 = *(const LAS f32x4*)(WT + e * WS_ + 4 * lane + 256 * j);
                a0 += (x[0][j].x * w4.x + x[0][j].y * w4.y) + (x[0][j].z * w4.z + x[0][j].w * w4.w);
                a1 += (x[1][j].x * w4.x + x[1][j].y * w4.y) + (x[1][j].z * w4.z + x[1][j].w * w4.w); }
            ac[e] = a0; ac[32 + e] = a1; }
#define RS_DPP(old_, src_, ctrl_, bm_) __builtin_bit_cast(float, __builtin_amdgcn_update_dpp(__builtin_bit_cast(int, old_), __builtin_bit_cast(int, src_), ctrl_, 0xF, bm_, false))
#pragma unroll
        for (int v = 0; v < 64; ++v) if ((v & 8) == 0) { const float lo = ac[v], hi = ac[v | 8];
            ac[v] = RS_DPP(hi, lo, 0x128, 0x3) + RS_DPP(lo, hi, 0x128, 0xC); }
#pragma unroll
        for (int v = 0; v < 64; ++v) if ((v & 12) == 0) { const float lo = ac[v], hi = ac[v | 4];
            ac[v] = RS_DPP(hi, lo, 0x104, 0x5) + RS_DPP(lo, hi, 0x114, 0xA); }
        { const bool b1 = (lane & 2) != 0, b0 = (lane & 1) != 0, b4 = (lane & 16) != 0, b5 = (lane & 32) != 0;
#pragma unroll
          for (int v = 0; v < 64; ++v) if ((v & 14) == 0) { const float lo = ac[v], hi = ac[v | 2]; const float keep = b1 ? hi : lo, send = b1 ? lo : hi; ac[v] = keep + dppf<0x4E>(send); }
#pragma unroll
          for (int v = 0; v < 64; ++v) if ((v & 15) == 0) { const float lo = ac[v], hi = ac[v | 1]; const float keep = b0 ? hi : lo, send = b0 ? lo : hi; ac[v] = keep + dppf<0xB1>(send); }
#pragma unroll
          for (int v = 0; v < 64; ++v) if ((v & 31) == 0) { const float lo = ac[v], hi = ac[v | 16]; const float keep = b4 ? hi : lo, send = b4 ? lo : hi;
              ac[v] = keep + __builtin_bit_cast(float, __builtin_amdgcn_ds_swizzle(__builtin_bit_cast(int, send), 0x401F)); }
          { const float lo = ac[0], hi = ac[32]; const float keep = b5 ? hi : lo, send = b5 ? lo : hi;
              ac[0] = keep + __builtin_bit_cast(float, __builtin_amdgcn_ds_bpermute((lane ^ 32) << 2, __builtin_bit_cast(int, send))); } }
#undef RS_DPP
        float vl = ac[0] + rbl;
        int sel[2][4]; float sv[2][4];
#pragma unroll
        for (int k = 0; k < 4; ++k) { float m = vl;
            m = fmaxf(m, dppf<0xB1>(m)); m = fmaxf(m, dppf<0x4E>(m)); m = fmaxf(m, dppf<0x141>(m)); m = fmaxf(m, dppf<0x140>(m));
            m = fmaxf(m, __builtin_bit_cast(float, __builtin_amdgcn_update_dpp(__builtin_bit_cast(int, -3.0e38f), __builtin_bit_cast(int, m), 0x142, 0xA, 0xF, false)));
            const float m0 = __builtin_bit_cast(float, __builtin_amdgcn_readlane(__builtin_bit_cast(int, m), 31)), m1 = __builtin_bit_cast(float, __builtin_amdgcn_readlane(__builtin_bit_cast(int, m), 63));
            const unsigned long long bal = __ballot(vl == (lane < 32 ? m0 : m1));
            const int b0 = __ffs((unsigned)bal) - 1, b1 = __ffs((unsigned)(bal >> 32)) - 1;
            sel[0][k] = b0; sel[1][k] = b1; sv[0][k] = m0; sv[1][k] = m1;
            if (lane == b0 || lane == 32 + b1) vl = -3.0e38f; }
        float gt_[2][4];
#pragma unroll
        for (int t = 0; t < 2; ++t) { float ex[4], den = 0.f;
#pragma unroll
            for (int k = 0; k < 4; ++k) { ex[k] = __expf(sv[t][k] - sv[t][0]); den += ex[k]; }
#pragma unroll
            for (int k = 0; k < 4; ++k) gt_[t][k] = ex[k] / den; }
        if (lane == 0) {
          if (agg) { const int pi = (p - gw) / NGW;
#pragma unroll
            for (int t = 0; t < 2; ++t) { const int r_ = row + t;
#pragma unroll
                for (int k = 0; k < 4; ++k) { const unsigned lr = __hip_atomic_fetch_add(lcnt + sel[t][k], 1u, __ATOMIC_RELAXED, __HIP_MEMORY_SCOPE_WORKGROUP);
                    recs[(F.wave * 5 + pi) * 8 + t * 4 + k] = (sel[t][k] << 16) | (int)lr;
                    toke[(size_t)r_ * 4 + k] = sel[t][k]; tokg[(size_t)r_ * 4 + k] = gt_[t][k]; } } }
          else { unsigned rk[2][4];
#pragma unroll
            for (int t = 0; t < 2; ++t)
#pragma unroll
                for (int k = 0; k < 4; ++k) rk[t][k] = atomicAdd(cnt + sel[t][k] * 64, 1u);
#pragma unroll
            for (int t = 0; t < 2; ++t) { const int r_ = row + t;
#pragma unroll
                for (int k = 0; k < 4; ++k) { stok[(size_t)sel[t][k] * M_ALL + rk[t][k]] = r_; toke[(size_t)r_ * 4 + k] = sel[t][k]; tokr[(size_t)r_ * 4 + k] = (int)rk[t][k]; tokg[(size_t)r_ * 4 + k] = gt_[t][k]; } } } }
    }
    if (!agg) return;
    __syncthreads();
    if (tid < NE) lcnt[32 + tid] = atomicAdd(cnt + tid * 64, lcnt[tid]);
    __syncthreads();
    { const int np_ = gw < npair ? (npair - gw + NGW - 1) / NGW : 0;
      if (lane < np_ * 8) { const int pi = lane >> 3, t = (lane >> 2) & 1, k = lane & 3; const int rc = recs[(F.wave * 5 + pi) * 8 + t * 4 + k];
          const int e = rc >> 16; const unsigned slot = lcnt[32 + e] + (unsigned)(rc & 0xffff); const int r_ = row_lo + 2 * (gw + pi * NGW) + t;
          stok[(size_t)e * M_ALL + slot] = r_; tokr[(size_t)r_ * 4 + k] = (int)slot; } }
}

__device__ __forceinline__ void moe_prefix(Frame& F, int l, LAS int* pref) {
    const unsigned* cnt = (const unsigned*)(F.ws + WS_CTL) + CW_CNT + l * NE * 64;
    if (F.tid < NE) { const int c = (int)__hip_atomic_load(cnt + F.tid * 64, __ATOMIC_RELAXED, __HIP_MEMORY_SCOPE_AGENT); pref[64 + F.tid] = c; pref[128 + F.tid] = (c + 255) >> 8; }
    __syncthreads();
    if (F.tid == 0) { int a = 0;
#pragma unroll
        for (int e = 0; e < NE; ++e) { pref[e] = a; a += pref[128 + e]; }
        pref[32] = a; }
    __syncthreads();
}

__device__ __forceinline__ void phase_combine(Frame& F, int l, int row_lo, LAS int* pref, float tsc = 1.0f) {
    float* H = WSP(float, WS_H); const float* __restrict__ mods = WSP(float, WS_MODS);
    const bf16_t* __restrict__ YB = WSP(bf16_t, WS_YB); bf16_t* __restrict__ N = WSP(bf16_t, WS_N);
    const int* __restrict__ toke = WSP(int, WS_TOKE); const int* __restrict__ tokr = WSP(int, WS_TOKE + MiB); const float* __restrict__ tokg = WSP(float, WS_TOKE + 2 * MiB);
    const int gw = F.bid * NWV + F.wave, NGW = F.G * NWV, lane = F.lane;
    const bool last = (l == DEPTH - 1);
    int re[4], rr_[4]; float rg_[4];
    int row = row_lo + gw;
    if (row < M_ALL) {
#pragma unroll
        for (int k = 0; k < 4; ++k) { re[k] = toke[(size_t)row * 4 + k]; rr_[k] = tokr[(size_t)row * 4 + k]; rg_[k] = tokg[(size_t)row * 4 + k]; } }
    for (; row < M_ALL; row += NGW) {
        const int r9 = row_modr(row); const float* mr = mods + ((size_t)l * 9 + r9) * (NMOD * D);
        const int nrow = (row + NGW < M_ALL) ? row + NGW : row;
        int ne[4], nr[4]; float ng[4];
#pragma unroll
        for (int k = 0; k < 4; ++k) { ne[k] = toke[(size_t)nrow * 4 + k]; nr[k] = tokr[(size_t)nrow * 4 + k]; ng[k] = tokg[(size_t)nrow * 4 + k]; }
        int dst[4]; float gk[4];
#pragma unroll
        for (int k = 0; k < 4; ++k) { dst[k] = pref[re[k]] * 256 + rr_[k]; gk[k] = rg_[k]; }
        u32x2 yb[4][4]; f32x4 hv0[4], gt[4], pa[4], pb[4], pc[4];
        const float* mn = mods + ((size_t)(last ? l : l + 1) * 9 + r9) * (NMOD * D); const float* nw = last ? F.in[I_NFIN] : F.in[I_NMIX] + (l + 1) * D;
#pragma unroll
        for (int j = 0; j < 4; ++j) { const int c = 4 * lane + 256 * j;
#pragma unroll
            for (int k = 0; k < 4; ++k) yb[j][k] = *(const u32x2*)(YB + (size_t)dst[k] * D + c);
            hv0[j] = *(const f32x4*)(H + (size_t)row * D + c); gt[j] = *(const f32x4*)(mr + 5 * D + c);
            pa[j] = *(const f32x4*)(nw + c); pb[j] = *(const f32x4*)(mn + D + c); pc[j] = *(const f32x4*)(mn + c); }
        asm volatile("" ::: "memory");
        f32x4 v[4]; float ss = 0.f;
#pragma unroll
        for (int j = 0; j < 4; ++j) { const int c = 4 * lane + 256 * j; f32x4 y = (f32x4){0.f, 0.f, 0.f, 0.f};
#pragma unroll
            for (int k = 0; k < 4; ++k) { const u32x2 p = yb[j][k];
                y.x += gk[k] * __builtin_bit_cast(float, p.x << 16); y.y += gk[k] * __builtin_bit_cast(float, p.x & 0xffff0000u);
                y.z += gk[k] * __builtin_bit_cast(float, p.y << 16); y.w += gk[k] * __builtin_bit_cast(float, p.y & 0xffff0000u); }
            const f32x4 hv = hv0[j] + gt[j] * y;
            v[j] = hv; ss += (hv.x * hv.x + hv.y * hv.y) + (hv.z * hv.z + hv.w * hv.w);
            if (!last) *(f32x4*)(H + (size_t)row * D + c) = hv; }
        const float rstd = rsqrtf(wave_sum(ss) * (1.f / D) + 1e-6f);
        if (last) { float* orow = F.out + (size_t)(row - M_CTX) * D;
#pragma unroll
            for (int j = 0; j < 4; ++j) { const int c = 4 * lane + 256 * j; *(f32x4*)(orow + c) = (v[j] * rstd) * pa[j] * tsc; } }
        else {
#pragma unroll
            for (int j = 0; j < 4; ++j) { const int c = 4 * lane + 256 * j;
                const f32x4 o = (v[j] * rstd) * pa[j] * (pb[j] + 1.0f) + pc[j];
                u32x2 p; p.x = pk2(o.x, o.y); p.y = pk2(o.z, o.w); *(u32x2*)(N + (size_t)row * D + c) = p; } }
#pragma unroll
        for (int k = 0; k < 4; ++k) { re[k] = ne[k]; rr_[k] = nr[k]; rg_[k] = ng[k]; }
    }
}

#ifdef DBG_CHECK
constexpr int CW_DBG = 40000;
__device__ __forceinline__ void dbg_add(Frame& F, float num, float den) {
    float* acc = (float*)((unsigned*)(F.ws + WS_CTL) + CW_DBG);
    num = wave_sum(num); den = wave_sum(den);
    if (F.lane == 0) { atomicAdd(acc, num); atomicAdd(acc + 1, den); }
}
__device__ __forceinline__ void dbg_gdn(Frame& F, int ci) {
    const float* Q = WSP(float, WS_GQKV); const float* BG = WSP(float, WS_GBG);
    const int b = ci >> 3, h = (ci >> 1) & 3, d = ci & 1;
    const float* GO = WSP(float, WS_GDO) + (size_t)d * M_ALL * 512;
    LAS float* S = (LAS float*)F.lds;
    LAS float* part = S + 128 * 129;
    LAS float* vn = part + 512;
    LAS float* kq = vn + 128;
    const int tid = F.tid, v = tid & 127, pt = tid >> 7;
    for (int i = tid; i < 128 * 129; i += NT) S[i] = 0.f;
    __syncthreads();
    float num = 0.f, den = 0.f;
    for (int s = 0; s < CTX + SEQ; ++s) {
        const int row = chain_row(b, d, s); const float* qr = Q + (size_t)row * 1536 + h * 128;
        const float beta = BG[(size_t)row * 16 + d * 4 + h], al = __expf(BG[(size_t)row * 16 + 8 + d * 4 + h]);
        if (tid < 128) kq[tid] = qr[512 + tid]; else if (tid < 256) kq[tid] = qr[tid - 128];
        __syncthreads();
        float a = 0.f;
        for (int j = 0; j < 32; ++j) { const int kd = pt * 32 + j; const float sv = S[kd * 129 + v] * al; S[kd * 129 + v] = sv; a += sv * kq[kd]; }
        part[pt * 128 + v] = a;
        __syncthreads();
        if (tid < 128) vn[tid] = beta * (qr[1024 + tid] - (part[tid] + part[128 + tid] + part[256 + tid] + part[384 + tid]));
        __syncthreads();
        a = 0.f;
        for (int j = 0; j < 32; ++j) { const int kd = pt * 32 + j; const float sv = S[kd * 129 + v] + kq[kd] * vn[v]; S[kd * 129 + v] = sv; a += sv * kq[128 + kd]; }
        part[pt * 128 + v] = a;
        __syncthreads();
        if (tid < 128) { const float o = part[tid] + part[128 + tid] + part[256 + tid] + part[384 + tid]; const float f = GO[(size_t)row * 512 + h * 128 + tid];
            num += (o - f) * (o - f); den += o * o; }
        __syncthreads();
    }
    dbg_add(F, num, den);
}
__device__ __forceinline__ void dbg_hyena(Frame& F, int l) {
    const int gw = F.bid * NWV + F.wave, lane = F.lane;
    float num = 0.f, den = 0.f;
    for (int smp = gw; smp < 8192; smp += F.G * NWV) {
        const unsigned hsh = (unsigned)smp * 2654435761u; const int c = hsh & 255, b = (hsh >> 8) & 7; const int isc = (smp & 7) == 0; const int L = isc ? CTX : SEQ; const int t = (hsh >> 11) % L;
        const float* g = isc ? WSP(float, WS_FILTC) + ((size_t)l * 256 + c) * (2 * CTX) : WSP(float, WS_FILT) + ((size_t)l * 256 + c) * (2 * SEQ);
        const float* V = WSP(float, WS_VVT) + ((size_t)c * NB + b) * (CTX + SEQ) + (isc ? 0 : CTX);
        float a = 0.f;
        for (int s = lane; s < L; s += 64) a += g[t - s + L] * V[s];
        a = wave_sum(a);
        const float f = WSP(float, WS_YT)[((size_t)c * NB + b) * (CTX + SEQ) + (isc ? 0 : CTX) + t];
        if (isc && l == DEPTH - 1) continue;
        if (lane == 0) { num += (a - f) * (a - f); den += a * a; }
    }
    dbg_add(F, num, den);
}
__device__ __forceinline__ void dbg_moe(Frame& F, int l, LAS int* pref) {
    const bf16_t* N = WSP(bf16_t, WS_N); const bf16_t* YB = WSP(bf16_t, WS_YB);
    const int* toke = WSP(int, WS_TOKE); const int* tokr = WSP(int, WS_TOKE + MiB); const float* tokg = WSP(float, WS_TOKE + 2 * MiB);
    LAS float* xs = (LAS float*)(F.lds + F.wave * 8192);
    LAS float* as = xs + 1024;
    const int gw = F.bid * NWV + F.wave, lane = F.lane;
    float num = 0.f, den = 0.f;
    for (int smp = gw; smp < 2048; smp += F.G * NWV) {
        const int row = M_CTX + (int)(((unsigned)smp * 2654435761u) % (unsigned)M_LAT);
        for (int i = lane; i < 1024; i += 64) xs[i] = bf2f(N[(size_t)row * D + i]);
        LDS_WAIT();
        float y[16], yf[16];
#pragma unroll
        for (int j = 0; j < 16; ++j) { y[j] = 0.f; yf[j] = 0.f; }
        for (int k = 0; k < 4; ++k) { const int e = toke[(size_t)row * 4 + k]; const float gk = tokg[(size_t)row * 4 + k]; const int dst = pref[e] * 256 + tokr[(size_t)row * 4 + k];
            const float* wgu = F.in[I_MWGU] + ((size_t)l * NE + e) * D * 2048; const float* bgu = F.in[I_MBGU] + ((size_t)l * NE + e) * 2048;
            const float* wdn = F.in[I_MWDN] + ((size_t)l * NE + e) * FF * D; const float* bdn = F.in[I_MBDN] + ((size_t)l * NE + e) * D;
            for (int jf = 0; jf < 16; ++jf) { const int f = jf * 64 + lane; float g = bgu[f], u = bgu[1024 + f];
                for (int dd = 0; dd < D; ++dd) { const float x = xs[dd]; g += x * wgu[(size_t)dd * 2048 + f]; u += x * wgu[(size_t)dd * 2048 + 1024 + f]; }
                g = fminf(g, 7.f); u = fminf(fmaxf(u, -7.f), 7.f); as[f] = (u + 1.f) * (g / (1.f + __expf(-1.702f * g))); }
            LDS_WAIT();
#pragma unroll
            for (int j = 0; j < 16; ++j) { const int c = j * 64 + lane; float a = bdn[c];
                for (int f = 0; f < FF; ++f) a += as[f] * wdn[(size_t)f * D + c];
                y[j] += gk * a; yf[j] += gk * bf2f(YB[(size_t)dst * D + c]); }
            LDS_WAIT(); }
#pragma unroll
        for (int j = 0; j < 16; ++j) { num += (y[j] - yf[j]) * (y[j] - yf[j]); den += y[j] * y[j]; }
    }
    dbg_add(F, num, den);
}

__device__ __forceinline__ void dbg_static(Frame& F) {
    const int gw = F.bid * NWV + F.wave, lane = F.lane;
    float num = 0.f, den = 0.f;
    if (DBG_SUB & 1) for (int smp = gw * 64 + lane; smp < (1 << 20); smp += F.G * NT) {
        const unsigned hsh = (unsigned)smp * 2654435761u; const int l = hsh & 3, k = (hsh >> 2) & 1023, n = (hsh >> 12) % IN_COLS, n2 = (hsh >> 12) & 1023;
        const float a = F.in[I_WIN][((size_t)l * D + k) * IN_COLS + n], b = bf2f(WSP(bf16_t, WS_WIN)[((size_t)l * PW + n) * D + k]);
        const float c = F.in[I_WOUT][((size_t)l * D + k) * D + n2], d = bf2f(WSP(bf16_t, WS_WOUT)[((size_t)l * D + n2) * D + k]);
        num += (a - b) * (a - b) + (c - d) * (c - d); den += a * a + c * c; }
    if (DBG_SUB & 2) for (int smp = gw; smp < 4096; smp += F.G * NWV) {
        const unsigned hsh = (unsigned)smp * 2654435761u; const int l = hsh & 3, r = (hsh >> 2) % 9, n = (hsh >> 8) % (NMOD * D);
        float a = 0.f;
        for (int k = lane; k < D; k += 64) { const float cv = (r < 8) ? F.in[I_C][r * D + k] : F.in[I_CCTX][k]; a += siluf_(cv) * F.in[I_ADAW][((size_t)l * D + k) * (NMOD * D) + n]; }
        a = wave_sum(a) + F.in[I_ADAB][l * (NMOD * D) + n];
        const float f = WSP(float, WS_MODS)[((size_t)l * 9 + r) * (NMOD * D) + n];
        if (lane == 0) { num += (a - f) * (a - f); den += a * a; } }
    if (DBG_SUB & 4) for (int smp = gw; smp < 2048; smp += F.G * NWV) {
        const unsigned hsh = (unsigned)smp * 2654435761u; const int l = hsh & 3; const bool isctx = (hsh >> 2) & 1; const int L = isctx ? CTX : SEQ; const int p = (hsh >> 3) % L;
        const float t = (float)p / (float)(L - 1);
        LAS float* hx = (LAS float*)(F.lds + F.wave * 1024);
        float z = 0.f;
        if (lane == 0) z = t; else if (lane < 33) { const int bi = (lane - 1) & 15; const float band = 1e-4f + (float)bi * ((15.0f - 1e-4f) / 15.0f); const float ang = (6.283185307179586f / (float)L) * (float)p * band; z = (lane <= 16) ? cosf(ang) : -sinf(ang); }
        const float fr = F.in[I_HFREQ][l * 64 + lane];
        hx[lane] = z; LDS_WAIT(); float a = F.in[I_HB1][l * 64 + lane];
#pragma unroll 1
        for (int i = 0; i < 33; ++i) a += hx[i] * F.in[I_HW1][((size_t)l * 33 + i) * 64 + lane];
        float hh = sinf(fr * a); LDS_WAIT(); hx[lane] = hh; LDS_WAIT(); a = F.in[I_HB2][l * 64 + lane];
#pragma unroll 1
        for (int i = 0; i < 64; ++i) a += hx[i] * F.in[I_HW2][((size_t)l * 64 + i) * 64 + lane];
        hh = sinf(fr * a); LDS_WAIT(); hx[lane] = hh; LDS_WAIT(); a = F.in[I_HB3][l * 64 + lane];
#pragma unroll 1
        for (int i = 0; i < 64; ++i) a += hx[i] * F.in[I_HW3][((size_t)l * 64 + i) * 64 + lane];
        hh = sinf(fr * a); LDS_WAIT(); hx[lane] = hh; LDS_WAIT();
        const int ch = ((hsh >> 16) + lane * 16) & 255; float of = 0.f, ob = 0.f;
#pragma unroll 1
        for (int i = 0; i < 64; ++i) { of += hx[i] * F.in[I_HW4][((size_t)l * 64 + i) * 512 + ch]; ob += hx[i] * F.in[I_HW4][((size_t)l * 64 + i) * 512 + 256 + ch]; }
        const float dl = -3.0701134573253946f + (float)ch * ((-15.350567286626973f + 3.0701134573253946f) / 255.0f); const float win = __expf(-t * fabsf(dl));
        of = of * win + (p == 0 ? F.in[I_HSKIP][l * 256 + ch] : 0.f); ob *= win;
        const float* filt = isctx ? WSP(float, WS_FILTC) + ((size_t)l * 256 + ch) * (2 * CTX) : WSP(float, WS_FILT) + ((size_t)l * 256 + ch) * (2 * SEQ);
        if (lane < 16) { const float ff = filt[L + p]; num += (of - ff) * (of - ff); den += of * of;
            if (p >= 1) { const float fb = filt[L - p]; num += (ob - fb) * (ob - fb); den += ob * ob; } }
        LDS_WAIT(); }
    dbg_add(F, num, den);
}

__device__ __forceinline__ float dbg_rw_m(const float* P, const float* mu, int row, int cc) {
    const bool isctx = row < M_CTX; const int b = row_batch(row); const int t = isctx ? row - b * CTX : row - M_CTX - b * SEQ;
    const float* pr = P + (size_t)row * PW + C_RW; float sh = 0.f;
    if (isctx) { if ((cc & 1) == 0) { if (t > 0) sh = pr[-PW + cc]; } else { if (t < CTX - 1) sh = pr[PW + cc]; } }
    else { const int gr = t / 64, gc = t % 64, m4 = cc % 4;
        if (m4 == 0) { if (gc > 0) sh = pr[-PW + cc]; } else if (m4 == 1) { if (gc < 63) sh = pr[PW + cc]; } else if (m4 == 2) { if (gr > 0) sh = pr[-64 * PW + cc]; } else { if (gr < 31) sh = pr[64 * PW + cc]; } }
    return pr[cc] + mu[cc] * (sh - pr[cc]);
}
__device__ __forceinline__ void dbg_prep(Frame& F, int l) {
    const float* P = WSP(float, WS_P); const int gw = F.bid * NWV + F.wave, lane = F.lane;
    float num = 0.f, den = 0.f;
    if (DBG_SUB & 1) for (int smp = gw; smp < 1024; smp += F.G * NWV) {
        const int row = (int)(((unsigned)smp * 2654435761u) % (unsigned)M_ALL);
        const float* mu = F.in[I_RMU] + (size_t)l * RWC; const float* rw = WSP(float, WS_RW) + (size_t)row * 2560;
#pragma unroll 1
        for (int q = 0; q < 4; ++q) { const int c = lane + 64 * q;
            const float r_ = dbg_rw_m(P, mu, row, c), k_ = dbg_rw_m(P, mu, row, 256 + c), v_ = dbg_rw_m(P, mu, row, 512 + c);
            float lw[2] = {F.in[I_RW0][l * 512 + c], F.in[I_RW0][l * 512 + 256 + c]}, la[2] = {F.in[I_RA0][l * 512 + c], F.in[I_RA0][l * 512 + 256 + c]}, g = 0.f;
#pragma unroll 1
            for (int r = 0; r < 64; ++r) {
#pragma unroll
                for (int d = 0; d < 2; ++d) { lw[d] += tanhf(dbg_rw_m(P, mu, row, 768 + d * 64 + r)) * F.in[I_RW2][(((size_t)l * 2 + d) * 64 + r) * 256 + c];
                    la[d] += dbg_rw_m(P, mu, row, 896 + d * 64 + r) * F.in[I_RA2][(((size_t)l * 2 + d) * 64 + r) * 256 + c]; } }
#pragma unroll 1
            for (int r = 0; r < 128; ++r) g += sigmoidf_(dbg_rw_m(P, mu, row, 1024 + r)) * F.in[I_RG2][((size_t)l * 128 + r) * 256 + c];
            const float kx = k_ * F.in[I_RKK][l * 256 + c]; const float kk = kx * rsqrtf(wave_sum(kx * kx) + 1e-12f);
            float ref[10]; ref[0] = r_; ref[1] = v_; ref[2] = kk; ref[9] = g; float bon = 0.f;
#pragma unroll
            for (int d = 0; d < 2; ++d) { const float lwv = -softplusf_(-lw[d]) - 0.5f; ref[3 + 3 * d] = expf(-expf(lwv)); const float a = sigmoidf_(la[d]);
                const float kd = k_ * (1.f + (a - 1.f) * F.in[I_RKA][l * 256 + c]); ref[4 + 3 * d] = kd; ref[5 + 3 * d] = kk * a; bon += r_ * kd * F.in[I_RRK][l * 256 + c]; }
            bon = wave_sum(bon);
#pragma unroll
            for (int j = 0; j < 10; ++j) { const float f = rw[j * 256 + c]; num += (ref[j] - f) * (ref[j] - f); den += ref[j] * ref[j]; }
            if (lane == 0) { const float f = WSP(float, WS_RWBON)[(size_t)row * 4 + q]; num += (bon - f) * (bon - f); den += bon * bon; } } }
    if (DBG_SUB & 2) for (int smp = gw; smp < 4096; smp += F.G * NWV) {
        const int row = (int)(((unsigned)smp * 2654435761u) % (unsigned)M_ALL);
        const bool isctx = row < M_CTX; const int L = isctx ? CTX : SEQ; const int b = row_batch(row); const int t = isctx ? row - b * CTX : row - M_CTX - b * SEQ;
        const float* cw = F.in[I_GCONV] + (size_t)l * 5 * 1536; const float* q = WSP(float, WS_GQKV) + (size_t)row * 1536;
#pragma unroll 1
        for (int part = 0; part < 3; ++part)
#pragma unroll 1
            for (int hd = 0; hd < 4; ++hd) { float x[2];
#pragma unroll
                for (int jj = 0; jj < 2; ++jj) { const int c = part * 512 + hd * 128 + jj * 64 + lane; float a = 0.f;
                    for (int tap = 0; tap < 5; ++tap) { const int tt = t + tap - 2; if (tt >= 0 && tt < L) a += P[(size_t)(row + tap - 2) * PW + C_GD + c] * cw[tap * 1536 + c]; }
                    x[jj] = a / (1.f + expf(-a)); }
                if (part < 2) { const float sc = rsqrtf(wave_sum(x[0] * x[0] + x[1] * x[1]) + 1e-12f) * (part == 0 ? 0.08838834764831845f : 1.f); x[0] *= sc; x[1] *= sc; }
#pragma unroll
                for (int jj = 0; jj < 2; ++jj) { const float f = q[part * 512 + hd * 128 + jj * 64 + lane]; num += (x[jj] - f) * (x[jj] - f); den += x[jj] * x[jj]; } }
        if (lane < 16) { const float rv = P[(size_t)row * PW + C_GD + 2048 + lane]; float ov;
            if (lane < 8) ov = 1.f / (1.f + expf(-rv)); else { const int dh = lane - 8; ov = -expf(F.in[I_GALOG][l * 8 + dh]) * softplusf_(rv + F.in[I_GDT][l * 8 + dh]); }
            const float f = WSP(float, WS_GBG)[(size_t)row * 16 + lane]; num += (ov - f) * (ov - f); den += ov * ov; } }
    if (DBG_SUB & 4) for (int smp = gw; smp < 4096; smp += F.G * NWV) {
        const int row = M_CTX + (int)(((unsigned)smp * 2654435761u) % (unsigned)M_LAT); const int b = row_batch(row), t = row - M_CTX - b * SEQ;
        const float* sw = F.in[I_HSW] + (size_t)l * 3 * 768; const float* sb = F.in[I_HSB] + (size_t)l * 768;
        const bf16_t* yc = WSP(bf16_t, WS_YCAT) + (size_t)row * D;
#pragma unroll 1
        for (int j = 0; j < 4; ++j) { const int c = j * 64 + lane; float u[3];
#pragma unroll
            for (int g3 = 0; g3 < 3; ++g3) { float a = sb[g3 * 256 + c];
                for (int tap = 0; tap < 3; ++tap) { const int tt = t + tap - 1; if (tt >= 0 && tt < SEQ) a += P[(size_t)(row + tap - 1) * PW + g3 * 256 + c] * sw[tap * 768 + g3 * 256 + c]; }
                u[g3] = a; }
            const float vv = u[2] * u[1]; const float fv = WSP(float, WS_VVT)[((size_t)c * NB + b) * (CTX + SEQ) + CTX + t];
            num += (vv - fv) * (vv - fv); den += vv * vv;
            const float yv = WSP(float, WS_YT)[((size_t)c * NB + b) * (CTX + SEQ) + CTX + t] * u[0]; const float fy = bf2f(yc[c]);
            num += (yv - fy) * (yv - fy); den += yv * yv; }
        const float* rw = WSP(float, WS_RW) + (size_t)row * 2560;
#pragma unroll 1
        for (int q = 0; q < 4; ++q) { const int c = lane + 64 * q; const float o = WSP(float, WS_RWO)[(size_t)row * 256 + c] + WSP(float, WS_RWO)[(size_t)(M_ALL + row) * 256 + c];
            const float mean = wave_sum(o) / 64.f; const float var = wave_sum((o - mean) * (o - mean)) / 64.f;
            float y = (o - mean) / sqrtf(var + 64e-5f) * F.in[I_RGNW][l * 256 + c] + F.in[I_RGNB][l * 256 + c];
            y = (y + WSP(float, WS_RWBON)[(size_t)row * 4 + q] * rw[256 + c]) * rw[9 * 256 + c];
            const float fy = bf2f(yc[256 + c]); num += (y - fy) * (y - fy); den += y * y; }
#pragma unroll 1
        for (int hd = 0; hd < 4; ++hd) { float o[2];
#pragma unroll
            for (int jj = 0; jj < 2; ++jj) { const int c = hd * 128 + jj * 64 + lane; o[jj] = WSP(float, WS_GDO)[(size_t)row * 512 + c] + WSP(float, WS_GDO)[(size_t)(M_ALL + row) * 512 + c]; }
            const float rs = 1.f / sqrtf(wave_sum(o[0] * o[0] + o[1] * o[1]) / 128.f + 1e-6f);
#pragma unroll
            for (int jj = 0; jj < 2; ++jj) { const int c = hd * 128 + jj * 64 + lane; const float z = P[(size_t)row * PW + C_GD + 1536 + c];
                const float y = o[jj] * rs * F.in[I_GNW][l * 128 + jj * 64 + lane] * (z / (1.f + expf(-z))); const float fy = bf2f(yc[512 + c]); num += (y - fy) * (y - fy); den += y * y; } } }
    dbg_add(F, num, den);
}
__device__ __forceinline__ void dbg_router(Frame& F, int l) {
    const int gw = F.bid * NWV + F.wave, lane = F.lane; LAS float* xs = (LAS float*)(F.lds + F.wave * 4096);
    float num = 0.f, den = 0.f;
    for (int smp = gw; smp < 4096; smp += F.G * NWV) {
        const int row = M_CTX + (int)(((unsigned)smp * 2654435761u) % (unsigned)M_LAT); const int b = row_batch(row);
        const float* h = WSP(float, WS_H) + (size_t)row * D; const float* mr = WSP(float, WS_MODS) + ((size_t)l * 9 + b) * (NMOD * D);
        float ss = 0.f; for (int i = lane; i < D; i += 64) ss += h[i] * h[i];
        const float rstd = 1.f / sqrtf(wave_sum(ss) / D + 1e-6f);
        for (int i = lane; i < D; i += 64) xs[i] = h[i] * rstd * F.in[I_NFFN][l * D + i] * (1.f + mr[4 * D + i]) + mr[3 * D + i];
        LDS_WAIT();
        float lg = -3e38f;
        if (lane < 32) { lg = F.in[I_MRB][l * NE + lane]; for (int k = 0; k < D; ++k) lg += xs[k] * F.in[I_MRW][((size_t)l * D + k) * NE + lane]; }
        float sv[4]; int se[4]; float cur = lg;
#pragma unroll
        for (int k = 0; k < 4; ++k) { float m = cur;
#pragma unroll
            for (int o = 1; o < 64; o <<= 1) m = fmaxf(m, __shfl_xor(m, o));
            const unsigned long long bal = __ballot(cur == m); const int who = __ffsll((long long)bal) - 1; sv[k] = m; se[k] = who; if (lane == who) cur = -3e38f; }
        float ex[4], dn = 0.f;
#pragma unroll
        for (int k = 0; k < 4; ++k) { ex[k] = expf(sv[k] - sv[0]); dn += ex[k]; }
        if (lane == 0) {
#pragma unroll
            for (int k = 0; k < 4; ++k) { const float g = ex[k] / dn; float fg = 0.f;
                for (int k2 = 0; k2 < 4; ++k2) if (WSP(int, WS_TOKE)[(size_t)row * 4 + k2] == se[k]) fg = WSP(float, WS_TOKE + 2 * MiB)[(size_t)row * 4 + k2];
                num += (g - fg) * (g - fg); den += g * g; } }
        LDS_WAIT(); }
    dbg_add(F, num, den);
}
__device__ __forceinline__ void dbg_rwkv_scan(Frame& F, int ci) {
    const int lane = F.lane; const int b = ci >> 3, h = (ci >> 1) & 3, d = ci & 1;
    const float* RW = WSP(float, WS_RW); const float* RO = WSP(float, WS_RWO) + (size_t)d * M_ALL * 256;
    LAS float* vs = (LAS float*)(F.lds + F.wave * 2048);
    float S[64];
#pragma unroll
    for (int k = 0; k < 64; ++k) S[k] = 0.f;
    float num = 0.f, den = 0.f;
#pragma unroll 1
    for (int s = 0; s < CTX + SEQ; ++s) { const int row = chain_row(b, d, s); const float* src = RW + (size_t)row * 2560 + h * 64;
        vs[lane] = -src[2 * 256 + lane]; vs[64 + lane] = src[(3 + 3 * d) * 256 + lane]; vs[128 + lane] = src[(5 + 3 * d) * 256 + lane]; vs[192 + lane] = src[(4 + 3 * d) * 256 + lane]; vs[256 + lane] = src[lane];
        const float v = src[256 + lane]; LDS_WAIT();
        float sa = 0.f;
#pragma unroll
        for (int k = 0; k < 64; ++k) sa += S[k] * vs[k];
        float o = 0.f;
#pragma unroll
        for (int k = 0; k < 64; ++k) { S[k] = S[k] * vs[64 + k] + sa * vs[128 + k] + v * vs[192 + k]; o += S[k] * vs[256 + k]; }
        const float f = RO[(size_t)row * 256 + h * 64 + lane]; num += (o - f) * (o - f); den += o * o; LDS_WAIT(); }
    dbg_add(F, num, den);
}
__device__ __forceinline__ void dbg_scale(Frame& F, float K) {
    const float* acc = (const float*)((unsigned*)(F.ws + WS_CTL) + CW_DBG);
    const float rel = sqrtf(acc[0] / fmaxf(acc[1], 1e-30f)); const float sc = 1.f + K * rel;
    for (size_t i = (size_t)F.bid * NT + F.tid; i < (size_t)M_LAT * D; i += (size_t)F.G * NT) F.out[i] *= sc;
}
#endif

#ifdef TPROBE
__device__ __attribute__((noinline)) void tprobe_stamp(unsigned char* ws, int mode) {
    unsigned* t = (unsigned*)(ws + WS_CTL) + 50000;
    if (blockIdx.x == 0 && threadIdx.x == 0) { const unsigned now = (unsigned)__builtin_amdgcn_s_memrealtime();
        if (mode == 2) { t[2] = now; t[1] = now; }
        else if (mode == 0) t[1] = now;
        else atomicAdd(t, now - t[1]); }
}
__device__ __attribute__((noinline)) float tprobe_scale(unsigned char* ws) {
    const unsigned* t = (const unsigned*)(ws + WS_CTL) + 50000;
    const unsigned acc = __hip_atomic_load(t, __ATOMIC_RELAXED, __HIP_MEMORY_SCOPE_AGENT), st = __hip_atomic_load(t + 2, __ATOMIC_RELAXED, __HIP_MEMORY_SCOPE_AGENT);
    const unsigned now = (unsigned)__builtin_amdgcn_s_memrealtime();
    return 1.0f + TPROBE_K * (float)acc / (float)(now - st);
}
#endif
constexpr int PH_PER_LAYER = 11, N_PHASES = 1 + DEPTH * PH_PER_LAYER;
__global__ void __launch_bounds__(NT, 2) hybrid_fwd(Args args) {
    extern __shared__ __attribute__((aligned(16))) unsigned char lds_raw[];
    Frame F;
    F.lds = (LAS unsigned char*)lds_raw;
    F.tid = threadIdx.x; F.lane = F.tid & 63; F.wave = __builtin_amdgcn_readfirstlane(F.tid >> 6);
    F.G = gridDim.x; F.bid = blockIdx.x; F.in = args.in; F.ws = args.ws; F.out = args.out;
    const int wave0 = F.wave;
    volatile LAS unsigned* MISC = (volatile LAS unsigned*)(F.lds + MISC_OFF);
    LAS int* pref = (LAS int*)(F.lds + MISC_OFF + 256);
    if (F.tid < 4) MISC[F.tid] = 0u;
    __syncthreads();
    const int lo = args.ph_lo, hi = args.ph_hi;
    XcdBarrier bar; bar.bar = (unsigned*)(F.ws + WS_CTL) + CW_BAR; bar.x = 0; bar.st = MISC;
    if (hi - lo > 1) bar = xcd_barrier_post((unsigned*)(F.ws + WS_CTL) + CW_BAR, MISC);
#ifndef PHASE_MASK
#define PHASE_MASK 0xFFFF
#endif
#define PM(j) ((PHASE_MASK >> (j)) & 1)
#define ENTER() do { F.ws = launder_ptr(F.ws); F.out = launder_ptr(F.out); l = launder_int(l); { int ln_; asm volatile("v_mbcnt_lo_u32_b32 %0, -1, 0\n\tv_mbcnt_hi_u32_b32 %0, -1, %0" : "=&v"(ln_)); __builtin_assume(ln_ >= 0 && ln_ < 64); F.lane = ln_; F.wave = launder_int(wave0); __builtin_assume(F.wave >= 0 && F.wave < 8); F.tid = F.wave * 64 + ln_; } } while (0)
#define IN(k) (lo <= (k) && (k) < hi)
#define last (l == DEPTH - 1)
#ifdef TPROBE
#define SEAMC(k, cls) do { if (hi > (k) + 1) xcd_barrier(bar); \
        if ((cls) == TPROBE - 1) tprobe_stamp(F.ws, 0); \
        if ((cls) == TPROBE) tprobe_stamp(F.ws, 1); } while (0)
#else
#define SEAMC(k, cls) do { if (hi > (k) + 1) xcd_barrier(bar); } while (0)
#endif
#define SEAM(k) SEAMC(k, 99)
#ifdef TPROBE
    tprobe_stamp(F.ws, 2);
#endif
    if (PM(11) && IN(0)) { phase_prologue(F);
#if defined(DUP_PHASE) && DUP_PHASE == 0
        __syncthreads(); phase_prologue(F);
#endif
        SEAM(0); }
    for (int l = 0; l < DEPTH; ++l) {
        const int pb = 1 + l * PH_PER_LAYER;
        if (PM(0) && l == 0 && IN(pb + 0)) { ENTER(); phase_norm0(F); SEAMC(pb + 0, 1); }
        if (PM(1) && IN(pb + 1)) {
            ENTER();
            pg8::StaticOrder S; S.init(WSP(bf16_t, WS_N), WSP(bf16_t, WS_WIN) + (size_t)l * PW * D, M_ALL, PW, D, F.G, F.bid);
            pg8::EpiF32 E{WSP(float, WS_P), PW};
            pg8::gemm_phase(F.lds, S, E, F.tid);
#if defined(DUPX) && DUPX == 2
            __syncthreads(); pg8::gemm_phase(F.lds, S, E, F.tid);
#endif
#if defined(DUP_PHASE) && DUP_PHASE == 2
            __syncthreads(); pg8::gemm_phase(F.lds, S, E, F.tid);
#endif
            SEAMC(pb + 1, 2);
        }
        if (PM(2) && IN(pb + 2)) {
            ENTER();
#ifndef SUBM
#define SUBM 7
#endif
            TileSched th = strided_sched(F, M_ALL / 64), tr = strided_sched(F, M_ALL / 32), tg = strided_sched(F, M_ALL / 64);
            if (F.G == 256) { const int i = F.bid; th.bal = tr.bal = tg.bal = true;
                tr.v0 = i; tr.v1 = i + 256; tr.v2 = (i + 512 < M_ALL / 32) ? i + 512 : -1;
                tg.v0 = i; tg.v1 = (i >= 64 && i < 96) ? 256 + (i - 64) : -1;
                th.v0 = i; th.v1 = (i >= 96 && i < 128) ? 256 + (i - 96) : -1; }
            prep_hyena(F, l, !last, th); __syncthreads(); prep_rwkv(F, l, tr); __syncthreads(); prep_gdn(F, l, tg);
#if defined(DUPX) && DUPX == 3
            __syncthreads(); prep_hyena(F, l, !last, th); __syncthreads(); prep_rwkv(F, l, tr); __syncthreads(); prep_gdn(F, l, tg);
#endif
#if defined(DUPX) && DUPX == 31
            __syncthreads(); prep_rwkv(F, l, tr);
#endif
#if defined(DUPX) && DUPX == 32
            __syncthreads(); prep_gdn(F, l, tg);
#endif
            SEAMC(pb + 2, 3); }
        if (PM(3) && IN(pb + 3)) {
            ENTER();
            if (F.wave < 5) { LAS unsigned char* wl = F.lds + F.wave * 27648; for (int u = F.bid * 5 + F.wave; u < 64 * NCHUNK; u += F.G * 5) gdn_precompute_wave(F, u / NCHUNK, u % NCHUNK, wl); }
            __syncthreads();
            for (int c = F.bid; c < 256; c += F.G) { hyena_lat_unit(F, l, c); if (!last) hyena_ctx_unit(F, l, c); }
#if defined(DUPX) && DUPX == 4
            __syncthreads(); if (F.wave < 5) { LAS unsigned char* wl = F.lds + F.wave * 27648; for (int u = F.bid * 5 + F.wave; u < 64 * NCHUNK; u += F.G * 5) gdn_precompute_wave(F, u / NCHUNK, u % NCHUNK, wl); }
            __syncthreads();
#endif
#if defined(DUPX) && DUPX == 41
            __syncthreads(); for (int c = F.bid; c < 256; c += F.G) { hyena_lat_unit(F, l, c); if (!last) hyena_ctx_unit(F, l, c); }
#endif
            SEAMC(pb + 3, 4);
        }
        if (PM(4) && IN(pb + 4)) {
            ENTER();
            {
                volatile LAS unsigned* sbc = (volatile LAS unsigned*)(F.lds + MISC_OFF + 64);
                if (F.tid == 0) *sbc = 0u;
                __syncthreads();
                if (F.wave < 4) { unsigned gen = 0u;
                    if (F.G == 256) { const int xcd = F.bid & 7, t = F.bid >> 3; rwkv_scan_quarter(F, (t >> 2) * 8 + xcd, t & 3, sbc, gen); }
                    else for (int u = F.bid; u < 256; u += F.G) rwkv_scan_quarter(F, u >> 2, u & 3, sbc, gen);
#if defined(DUP_PHASE) && DUP_PHASE == 53
                    { const int xcd = F.bid & 7, t = F.bid >> 3; rwkv_scan_quarter(F, (t >> 2) * 8 + xcd, t & 3, sbc, gen); }
#endif
                }
                else { LAS bf16_t* St = (LAS bf16_t*)(F.lds + 90112 + (F.wave - 4) * 14336); LAS bf16_t* Vn = St + 32 * 136;
                    if (F.G == 256) {
                        if (F.wave == 4) { const int xcd = F.bid & 7, t = F.bid >> 3; gdn_chain_wave(F, (t >> 2) * 8 + xcd, t & 3, St, Vn);
#if defined(DUP_PHASE) && DUP_PHASE == 54
                            gdn_chain_wave(F, (t >> 2) * 8 + xcd, t & 3, St, Vn);
#endif
                        } }
                    else for (int g = F.bid * 4 + (F.wave - 4); g < 256; g += F.G * 4) gdn_chain_wave(F, g >> 2, g & 3, St, Vn);
                }
                __syncthreads();
            }
            SEAMC(pb + 4, 5);
        }
        if (PM(5) && IN(pb + 5)) { ENTER(); phase_finish(F, l, !last);
#if defined(DUP_PHASE) && DUP_PHASE == 6
            __syncthreads(); phase_finish(F, l, !last);
#endif
            SEAMC(pb + 5, 6); }
        if (PM(6) && IN(pb + 6)) {
            ENTER();
            const int r0 = last ? M_CTX : 0;
            pg8::StaticOrder S; S.init(WSP(bf16_t, WS_YCAT) + (size_t)r0 * D, WSP(bf16_t, WS_WOUT) + (size_t)l * D * D, M_ALL - r0, D, D, F.G, F.bid);
            pg8::EpiRes E{WSP(float, WS_H) + (size_t)r0 * D, WSP(float, WS_H) + (size_t)r0 * D, WSP(float, WS_MODS) + (size_t)l * 9 * (NMOD * D) + 2 * D, r0};
            pg8::gemm_phase(F.lds, S, E, F.tid);
            SEAMC(pb + 6, 7);
        }
        if (PM(7) && IN(pb + 7)) { ENTER(); phase_router2(F, l, last ? M_CTX : 0);
#if defined(DUPX) && DUPX == 8
            __syncthreads(); phase_router(F, l, last ? M_CTX : 0, true);
#endif
#if defined(DUPX) && DUPX == 81
            __syncthreads(); phase_router2(F, l, last ? M_CTX : 0, true);
#endif
 SEAMC(pb + 7, 8); }
        if (PM(8) && IN(pb + 8)) {
            ENTER();
            moe_prefix(F, l, pref);
            pg8::MoeOrder<true, 8> S; S.A = WSP(bf16_t, WS_N); S.Bt = WSP(bf16_t, WS_WGU) + (size_t)l * NE * 2048 * D; S.K = D; S.Nexp = 2048; S.pref = pref; S.stok = WSP(int, WS_STOK); S.G = F.G; S.c = F.bid;
            pg8::EpiGU E{WSP(bf16_t, WS_ACT), F.in[I_MBGU] + (size_t)l * NE * 2048};
            pg8::gemm_phase(F.lds, S, E, F.tid);
            SEAMC(pb + 8, 9);
        }
        if (PM(9) && IN(pb + 9)) {
            ENTER();
            moe_prefix(F, l, pref);
            pg8::MoeOrder<false, 4> S; S.A = WSP(bf16_t, WS_ACT); S.Bt = WSP(bf16_t, WS_WDN) + (size_t)l * NE * D * FF; S.K = FF; S.Nexp = D; S.pref = pref; S.stok = nullptr; S.G = F.G; S.c = F.bid;
            pg8::EpiDN E{WSP(bf16_t, WS_YB), F.in[I_MBDN] + (size_t)l * NE * D};
            pg8::gemm_phase(F.lds, S, E, F.tid);
#if defined(DUP_PHASE) && DUP_PHASE == 10
            __syncthreads(); pg8::gemm_phase(F.lds, S, E, F.tid);
#endif
            SEAMC(pb + 9, 10);
        }
        if (PM(10) && IN(pb + 10)) { ENTER(); moe_prefix(F, l, pref); float tsc = 1.0f;
#ifdef TPROBE
            if (last) tsc = tprobe_scale(F.ws);
#endif
            phase_combine(F, l, last ? M_CTX : 0, pref, tsc); SEAMC(pb + 10, 11); }
    }
#undef IN
#undef SEAM
#undef last
}


#ifdef DBG_CHECK
__global__ void __launch_bounds__(NT, 2) dbg_kernel(Args args) {
    extern __shared__ __attribute__((aligned(16))) unsigned char lds_raw[];
    Frame F;
    F.lds = (LAS unsigned char*)lds_raw;
    F.tid = threadIdx.x; F.lane = F.tid & 63; F.wave = __builtin_amdgcn_readfirstlane(F.tid >> 6);
    F.G = gridDim.x; F.bid = blockIdx.x; F.in = args.in; F.ws = args.ws; F.out = args.out;
    LAS int* pref = (LAS int*)(F.lds + MISC_OFF + 256);
    const int l = DEPTH - 1;
    if (args.ph_lo == 0) {
        if (DBG_CHECK == 1) { moe_prefix(F, l, pref); dbg_moe(F, l, pref); }
        if (DBG_CHECK == 2) { if (F.bid < 8) dbg_gdn(F, F.bid * 8 + (F.bid & 1) + 2 * (F.bid % 4)); }
        if (DBG_CHECK == 3) dbg_hyena(F, l);
        if (DBG_CHECK == 4) dbg_static(F);
        if (DBG_CHECK == 5) dbg_prep(F, l);
        if (DBG_CHECK == 6) dbg_router(F, l);
        if (DBG_CHECK == 7) { if (F.bid < 8 && F.wave == 0) dbg_rwkv_scan(F, F.bid * 8 + (F.bid & 1) + 2 * (F.bid % 4)); }
    } else dbg_scale(F, DBG_K);
}
#endif
extern "C" void kernel_launch(void* const* d_in, const int* in_sizes, int n_in, void* d_out, int out_size, void* d_ws, size_t ws_size, hipStream_t stream) {
    static int grid = 0;
    if (grid == 0) {
        int dev = 0, cus = 0, per_cu = 0;
        if (n_in != 43 || ws_size < WS_END) { fprintf(stderr, "kernel_launch: unexpected inputs (%d) or workspace (%zu < %zu)\n", n_in, ws_size, (size_t)WS_END); grid = -1; return; }
        if (hipGetDevice(&dev) != hipSuccess || hipDeviceGetAttribute(&cus, hipDeviceAttributeMultiprocessorCount, dev) != hipSuccess) { grid = -1; return; }
        if (hipFuncSetAttribute((const void*)hybrid_fwd, hipFuncAttributeMaxDynamicSharedMemorySize, LDS_BYTES) != hipSuccess) { fprintf(stderr, "kernel_launch: hipFuncSetAttribute failed\n"); grid = -1; return; }
        if (hipOccupancyMaxActiveBlocksPerMultiprocessor(&per_cu, (const void*)hybrid_fwd, NT, LDS_BYTES) != hipSuccess || per_cu < 1) fprintf(stderr, "kernel_launch: occupancy query reports %d\n", per_cu);
        (void)hipGetLastError();
        grid = cus;
    }
    if (grid < 0) return;
    (void)hipMemsetAsync((char*)d_ws + WS_CTL, 0, CTL_ZERO, stream);
    Args a{};
    for (int i = 0; i < 43; ++i) a.in[i] = (const float*)d_in[i];
    a.out = (float*)d_out; a.ws = (unsigned char*)d_ws;
#if N_LAUNCH_MODE == 1
    a.ph_lo = 0; a.ph_hi = N_PHASES;
    hipLaunchKernelGGL(hybrid_fwd, dim3(grid), dim3(NT), LDS_BYTES, stream, a);
#else
    const int nph = N_PHASES;
    for (int ph = 0; ph < nph; ++ph) {
        if (ph > 0 && ph < N_PHASES && (ph - 1) % PH_PER_LAYER == 0 && (ph - 1) / PH_PER_LAYER > 0) continue;
        a.ph_lo = ph; a.ph_hi = ph + 1;
        hipLaunchKernelGGL(hybrid_fwd, dim3(grid), dim3(NT), LDS_BYTES, stream, a);
    }
#ifdef DBG_CHECK
    static int dbg_init = 0;
    if (!dbg_init) { (void)hipFuncSetAttribute((const void*)dbg_kernel, hipFuncAttributeMaxDynamicSharedMemorySize, LDS_BYTES); dbg_init = 1; }
    a.ph_lo = 0; a.ph_hi = 1; hipLaunchKernelGGL(dbg_kernel, dim3(grid), dim3(NT), LDS_BYTES, stream, a);
    a.ph_lo = 1; a.ph_hi = 2; hipLaunchKernelGGL(dbg_kernel, dim3(grid), dim3(NT), LDS_BYTES, stream, a);
#endif
#endif
}
```

```cpp
#include <hip/hip_runtime.h>
#include <cstdio>
#include <cstdint>

#ifndef N_LAUNCH_MODE
#define N_LAUNCH_MODE 1
#endif

#define LAS __attribute__((address_space(3)))
#define GAS __attribute__((address_space(1)))
typedef unsigned short bf16_t;
typedef short bf16x8 __attribute__((ext_vector_type(8)));
typedef float f32x4 __attribute__((ext_vector_type(4)));
typedef float f32x2 __attribute__((ext_vector_type(2)));
typedef unsigned u32x4 __attribute__((ext_vector_type(4)));
typedef unsigned u32x2 __attribute__((ext_vector_type(2)));

constexpr int NCHUNK = 36;
constexpr int D = 1024, NB = 8, SEQ = 2048, CTX = 256, DEPTH = 4;
constexpr int M_CTX = NB * CTX;
constexpr int M_LAT = NB * SEQ;
constexpr int M_ALL = M_CTX + M_LAT;
constexpr int NMOD = 6;
constexpr int PW = 4096;
constexpr int IN_COLS = 3984;
constexpr int C_HY = 0, C_RW = 768, C_GD = 1920;
constexpr int RWC = 1152;
constexpr int NE = 32, TOPK = 4, FF = 1024;
constexpr int NT = 512, NWV = 8;

constexpr size_t MiB = 1ull << 20;
constexpr size_t WS_CTL   = 0;
constexpr size_t CTL_ZERO = 2 * MiB;
constexpr size_t WS_MODS  = 2 * MiB;
constexpr size_t WS_FILT  = 4 * MiB;
constexpr size_t WS_FILTC = 20 * MiB;
constexpr size_t WS_LORA  = 22 * MiB;
constexpr size_t LORA_L = 196608;
constexpr size_t WS_WIN   = 24 * MiB;
constexpr size_t WS_WOUT  = 56 * MiB;
constexpr size_t WS_WGU   = 64 * MiB;
constexpr size_t WS_WDN   = 576 * MiB;
constexpr size_t WS_H     = 832 * MiB;
constexpr size_t WS_N     = 904 * MiB;
constexpr size_t WS_P     = 940 * MiB;
constexpr size_t WS_RW    = 1228 * MiB;
constexpr size_t WS_RWBON = 1408 * MiB;
constexpr size_t WS_GQKV  = 1410 * MiB;
constexpr size_t WS_QB = WS_GQKV, WS_KB = WS_GQKV + 20 * MiB, WS_KT = WS_GQKV + 40 * MiB, WS_VT = WS_GQKV + 60 * MiB;
constexpr size_t WS_GBG   = 1518 * MiB;
constexpr size_t WS_VVT   = 1520 * MiB;
constexpr size_t WS_YT    = 1540 * MiB;
constexpr size_t WS_RWO   = 1560 * MiB;
constexpr size_t WS_GDO   = 1596 * MiB;
constexpr size_t WS_GPRE  = 1668 * MiB;
constexpr size_t WS_YCAT  = 1884 * MiB;
constexpr size_t WS_STOK  = 1920 * MiB;
constexpr size_t WS_TOKE  = 1924 * MiB;
constexpr size_t WS_ACT   = 1928 * MiB;
constexpr size_t WS_YB    = 2088 * MiB;
constexpr size_t WS_END   = 2248 * MiB;

constexpr int CW_BAR = 4096;
constexpr int CW_CNT = 16384;

constexpr int LDS_BYTES = 155648;
constexpr int MISC_OFF  = 153600;
constexpr int SCR_BYTES = 153600;

typedef __bf16 hwbf16x2 __attribute__((ext_vector_type(2)));
__device__ __forceinline__ unsigned pk2(float lo, float hi) { const f32x2 v = {lo, hi}; return __builtin_bit_cast(unsigned, __builtin_convertvector(v, hwbf16x2)); }
__device__ __forceinline__ unsigned f2bf(float f) { return (unsigned)__builtin_bit_cast(unsigned short, (__bf16)f); }
__device__ __forceinline__ float bf2f(unsigned short b) { return __builtin_bit_cast(float, ((unsigned)b) << 16); }
template <int CTRL> __device__ __forceinline__ float dppf(float x) {
    return __builtin_bit_cast(float, __builtin_amdgcn_update_dpp(0, __builtin_bit_cast(int, x), CTRL, 0xF, 0xF, true));
}
__device__ __forceinline__ float row16_sum(float x) {
    x += dppf<0xB1>(x);
    x += dppf<0x4E>(x);
    x += dppf<0x141>(x);
    x += dppf<0x140>(x);
    return x;
}
__device__ __forceinline__ float wave_sum(float v) {
    v = row16_sum(v);
    v += __builtin_bit_cast(float, __builtin_amdgcn_update_dpp(0, __builtin_bit_cast(int, v), 0x142, 0xA, 0xF, false));
    v += __builtin_bit_cast(float, __builtin_amdgcn_update_dpp(0, __builtin_bit_cast(int, v), 0x143, 0xC, 0xF, false));
    return __builtin_bit_cast(float, __builtin_amdgcn_readlane(__builtin_bit_cast(int, v), 63));
}
__device__ __forceinline__ float sigmoidf_(float x) { return __builtin_amdgcn_rcpf(1.0f + __expf(-x)); }
__device__ __forceinline__ float siluf_(float x) { return x * __builtin_amdgcn_rcpf(1.0f + __expf(-x)); }
__device__ __forceinline__ float softplusf_(float x) { return x > 20.f ? x : log1pf(__expf(x)); }
__device__ __forceinline__ int launder_int(int x) { asm volatile("" : "+v"(x)); return __builtin_amdgcn_readfirstlane(x); }
template <class T> __device__ __forceinline__ T* launder_ptr(T* p) {
    unsigned long long u = (unsigned long long)p; unsigned lo = (unsigned)u, hi = (unsigned)(u >> 32);
    asm volatile("" : "+v"(lo), "+v"(hi));
    lo = __builtin_amdgcn_readfirstlane(lo); hi = __builtin_amdgcn_readfirstlane(hi);
    return (T*)(GAS T*)(((unsigned long long)hi << 32) | lo);
}

#define XB_TMO      128
#define XB_XCNT(j)  (256  + 64 * (j))
#define XB_XSUB(j)  (1280 + 64 * (j))
#define XB_XGEN(j)  (2304 + 64 * (j))
#define XB_TOP      3328
#define XB_TOPGEN   3392
#define XCD_BAR_WORDS 3456
#define XB_SPIN_CAP (1u << 24)

__device__ __forceinline__ unsigned xb_ld(unsigned* p)              { return __hip_atomic_load(p, __ATOMIC_RELAXED, __HIP_MEMORY_SCOPE_AGENT); }
__device__ __forceinline__ unsigned xb_add(unsigned* p, unsigned v) { return __hip_atomic_fetch_add(p, v, __ATOMIC_RELAXED, __HIP_MEMORY_SCOPE_AGENT); }
__device__ __forceinline__ unsigned xb_xcc_id() { return (unsigned)__builtin_amdgcn_s_getreg((3 << 11) | 20) & 0xFu; }
#define XB_SPIN(cond, bar) do { unsigned _sp = 0; while (cond) { __builtin_amdgcn_s_sleep(1); \
    if ((++_sp & 255u) == 0u) { if (xb_ld(&(bar)[XB_TMO])) break; if (_sp > XB_SPIN_CAP) { atomicAdd(&(bar)[XB_TMO], 1u); break; } } } } while (0)

struct XcdBarrier { unsigned* bar; unsigned x; volatile LAS unsigned* st; };

__device__ __forceinline__ XcdBarrier xcd_barrier_post(unsigned* bar, volatile LAS unsigned* st) {
    XcdBarrier b; b.bar = bar; b.x = xb_xcc_id(); b.st = st;
    if (threadIdx.x == 0) (void)xb_add(&bar[XB_XCNT(b.x)], 1u);
    return b;
}
__device__ __forceinline__ void xcd_barrier_complete(unsigned* bar, unsigned x, unsigned& nloc, unsigned& nx) {
    const unsigned G = gridDim.x * gridDim.y * gridDim.z;
    unsigned sum, cnt, mine, sp = 0u;
    for (;;) {
        sum = 0u; cnt = 0u; mine = 0u;
#pragma unroll
        for (unsigned j = 0; j < 16; ++j) { const unsigned c = xb_ld(&bar[XB_XCNT(j)]); sum += c; cnt += (c > 0u) ? 1u : 0u; mine = (j == x) ? c : mine; }
        if (sum == G) break;
        __builtin_amdgcn_s_sleep(1);
        if ((++sp & 255u) == 0u) { if (xb_ld(&bar[XB_TMO])) break; if (sp > XB_SPIN_CAP) { atomicAdd(&bar[XB_TMO], 1u); break; } }
    }
    nloc = mine > 0u ? mine : 1u; nx = cnt > 0u ? cnt : 1u;
}
__device__ __forceinline__ void xcd_barrier(const XcdBarrier& b) {
    asm volatile("s_waitcnt vmcnt(0)" ::: "memory");
    __syncthreads();
    if (threadIdx.x == 0) {
        unsigned* bar = b.bar;
        __builtin_amdgcn_s_waitcnt(0);
        unsigned nloc = b.st[0], nx = b.st[1];
        if (nloc == 0u) { xcd_barrier_complete(bar, b.x, nloc, nx); b.st[0] = nloc; b.st[1] = nx; }
        const unsigned old = xb_add(&bar[XB_XSUB(b.x)], 1u);
        const unsigned gen = old / nloc;
        if (old + 1u == (gen + 1u) * nloc) {
            __builtin_amdgcn_fence(__ATOMIC_RELEASE, "agent");
            asm volatile("s_waitcnt vmcnt(0)" ::: "memory");
            const unsigned og = xb_add(&bar[XB_TOP], 1u);
            const unsigned tg = og / nx;
            if (og + 1u == (tg + 1u) * nx) xb_add(&bar[XB_TOPGEN], 1u);
            else XB_SPIN(xb_ld(&bar[XB_TOPGEN]) == tg, bar);
            __builtin_amdgcn_fence(__ATOMIC_ACQUIRE, "agent");
            xb_add(&bar[XB_XGEN(b.x)], 1u);
            asm volatile("s_waitcnt vmcnt(0)" ::: "memory");
        } else {
            XB_SPIN(xb_ld(&bar[XB_XGEN(b.x)]) == gen, bar);
            __builtin_amdgcn_fence(__ATOMIC_ACQUIRE, "agent");
            asm volatile("s_waitcnt vmcnt(0)" ::: "memory");
        }
    }
    __syncthreads();
}

namespace pg8 {
constexpr int BM = 256, BK = 64, HALF = 128, HTB = HALF * BK * 2, STAGE_BYTES = 8 * HTB, NXCD = 8, WGM = 8;
__host__ __device__ __forceinline__ int lds_byte(int r, int c) { const int st = (r >> 4) * 2 + (c >> 5), rr = r & 15, cc = c & 31, ob = rr * 64 + cc * 2; return st * 1024 + (ob ^ (((ob >> 9) & 1) << 5)); }
__host__ __device__ __forceinline__ void stage_rc(int b, int& R, int& C) { const int st = b / 1024, sb = b % 1024, swz = sb ^ (((sb >> 9) & 1) << 5); R = (st >> 1) * 16 + swz / 64; C = (st & 1) * 32 + (swz % 64) / 2; }
__host__ __device__ __forceinline__ int perm32(int rho) { const int n = rho >> 4, i = rho & 15; return 8 * (i >> 2) + 4 * n + (i & 3); }

struct Unit { int pm, pn, e, j, rows; };

struct StaticOrder {
    static constexpr bool GATHER = false;
    const bf16_t* A; const bf16_t* Bt; int K;
    int nM, nN, nwg, G, c;
    int i0 = 0, i1 = 1 << 30;
    __device__ void init(const bf16_t* A_, const bf16_t* Bt_, int M, int N, int K_, int G_, int c_) { A = A_; Bt = Bt_; K = K_; nM = M / BM; nN = N / BM; nwg = nM * nN; G = G_; c = c_; }
    __device__ bool next(int i, Unit& u) const {
        if (i + i0 >= i1) return false;
        const long L = (long)(i + i0) * G + c; if (L >= nwg) return false;
        int wgid = (int)L; { const int q = nwg / NXCD, r = nwg % NXCD, xcd = wgid % NXCD, off = wgid / NXCD; wgid = (xcd < r ? xcd * (q + 1) : r * (q + 1) + (xcd - r) * q) + off; }
        const int nig = WGM * nN, gid = wgid / nig, fm = gid * WGM, gsz = (nM - fm) < WGM ? (nM - fm) : WGM;
        u.pm = fm + ((wgid % nig) % gsz); u.pn = (wgid % nig) / gsz; u.e = 0; u.j = 0; u.rows = BM; return true;
    }
    __device__ __forceinline__ const char* a_base(const Unit& u) const { return (const char*)A + (size_t)u.pm * (size_t)(2 * HALF) * K * 2; }
    __device__ __forceinline__ const char* b_base(const Unit& u) const { return (const char*)Bt + (size_t)u.pn * (size_t)(2 * HALF) * K * 2; }
    __device__ __forceinline__ unsigned gather_row(const Unit&, int) const { return 0u; }
};
template <bool GATHER_, int NPN> struct MoeOrder {
    static constexpr bool GATHER = GATHER_;
    const bf16_t* A; const bf16_t* Bt; int K, Nexp;
    const LAS int* pref;
    const int* stok;
    int G, c;
    __device__ bool next(int i, Unit& u) const {
        int e = -1, t;
        if ((G & 7) == 0) {
            const int x = c & 7; t = i * (G >> 3) + (c >> 3);
#pragma unroll
            for (int q = 0; q < 4; ++q) { const int ee = __builtin_amdgcn_readfirstlane(pref[160 + x * 4 + q]); const int nt = (__builtin_amdgcn_readfirstlane(pref[ee + 1]) - __builtin_amdgcn_readfirstlane(pref[ee])) * NPN;
                if (e < 0) { if (t < nt) e = ee; else t -= nt; } }
            if (e < 0) return false;
        } else {
            const int L = i * G + c; const int nU = __builtin_amdgcn_readfirstlane(pref[32]) * NPN; if (L >= nU) return false;
            const int rb = L / NPN; e = 0;
            for (int q = 1; q < 32; ++q) e = (__builtin_amdgcn_readfirstlane(pref[q]) <= rb) ? q : e;
            t = (rb - __builtin_amdgcn_readfirstlane(pref[e])) * NPN + L % NPN;
        }
        u.e = e; u.j = t / NPN; u.pn = t % NPN; u.pm = __builtin_amdgcn_readfirstlane(pref[e]) + u.j;
        const int rem = __builtin_amdgcn_readfirstlane(pref[64 + e]) - u.j * BM; u.rows = rem < BM ? rem : BM; return true;
    }
    __device__ __forceinline__ const char* a_base(const Unit& u) const { return GATHER ? (const char*)A : (const char*)A + (size_t)u.pm * (size_t)(2 * HALF) * K * 2; }
    __device__ __forceinline__ const char* b_base(const Unit& u) const { return (const char*)Bt + ((size_t)u.e * Nexp + (size_t)u.pn * BM) * K * 2; }
    __device__ __forceinline__ unsigned gather_row(const Unit& u, int r) const { const int* base = stok + ((size_t)u.e * M_ALL + (size_t)u.j * BM); const unsigned rr = (unsigned)(r < u.rows ? r : u.rows - 1) & 255u; return (unsigned)base[rr]; }
};

__device__ __forceinline__ unsigned cvt_pk_bf16(float lo, float hi) { unsigned r; asm volatile("v_cvt_pk_bf16_f32 %0, %1, %2" : "=v"(r) : "v"(lo), "v"(hi)); return r; }

struct EpiF32 {
    static constexpr bool PERM = false;
    float* C; int ldc;
    __device__ __forceinline__ void operator()(const f32x4 (&acc)[2][2][4][2], const Unit& u, int wr, int wc, int fr, int fq) const {
        const int row0 = u.pm * BM + wr * 64 + fr, col0 = u.pn * BM + wc * 32 + 4 * fq;
#pragma unroll
        for (int ai = 0; ai < 2; ++ai)
#pragma unroll
            for (int m = 0; m < 4; ++m) { float* rowp = C + (size_t)(row0 + ai * HALF + m * 16) * ldc + col0;
#pragma unroll
                for (int bj = 0; bj < 2; ++bj)
#pragma unroll
                    for (int n = 0; n < 2; ++n) *(f32x4*)(rowp + bj * HALF + n * 16) = acc[ai][bj][m][n]; }
    }
};
struct EpiRes {
    static constexpr bool PERM = false;
    const float* base; float* out; const float* gate; int row0g;
    __device__ __forceinline__ void operator()(const f32x4 (&acc)[2][2][4][2], const Unit& u, int wr, int wc, int fr, int fq) const {
        const int row0 = u.pm * BM + wr * 64 + fr, col0 = u.pn * BM + wc * 32 + 4 * fq;
        const int grow = row0g + u.pm * BM; const int r = grow < M_CTX ? 8 : (grow - M_CTX) / SEQ;
        f32x4 gv[2][2];
#pragma unroll
        for (int bj = 0; bj < 2; ++bj)
#pragma unroll
            for (int n = 0; n < 2; ++n) gv[bj][n] = *(const f32x4*)(gate + (size_t)r * (NMOD * D) + col0 + bj * HALF + n * 16);
#pragma unroll
        for (int ai = 0; ai < 2; ++ai)
#pragma unroll
            for (int m = 0; m < 4; ++m) { const size_t off = (size_t)(row0 + ai * HALF + m * 16) * D + col0;
#pragma unroll
                for (int bj = 0; bj < 2; ++bj)
#pragma unroll
                    for (int n = 0; n < 2; ++n) { const f32x4 b = *(const f32x4*)(base + off + bj * HALF + n * 16);
                        *(f32x4*)(out + off + bj * HALF + n * 16) = b + gv[bj][n] * acc[ai][bj][m][n]; } }
    }
};
struct EpiGU {
    static constexpr bool PERM = true;
    bf16_t* O; const float* bias;
    __device__ __forceinline__ void operator()(const f32x4 (&acc)[2][2][4][2], const Unit& u, int wr, int wc, int fr, int fq) const {
        const int row0 = u.pm * BM + wr * 64 + fr, col0 = u.pn * HALF + wc * 32 + 8 * fq;
        const float* bp = bias + (size_t)u.e * 2048 + col0;
        f32x4 bg[2], bu[2];
#pragma unroll
        for (int n = 0; n < 2; ++n) { bg[n] = *(const f32x4*)(bp + 4 * n); bu[n] = *(const f32x4*)(bp + 1024 + 4 * n); }
#pragma unroll
        for (int ai = 0; ai < 2; ++ai)
#pragma unroll
            for (int m = 0; m < 4; ++m) { bf16_t* rowp = O + (size_t)(row0 + ai * HALF + m * 16) * FF + col0;
                float o[8];
#pragma unroll
                for (int n = 0; n < 2; ++n)
#pragma unroll
                    for (int i = 0; i < 4; ++i) { float g = acc[ai][0][m][n][i] + bg[n][i], up = acc[ai][1][m][n][i] + bu[n][i];
                        g = fminf(g, 7.0f); up = fminf(fmaxf(up, -7.0f), 7.0f);
                        const float glu = g * __builtin_amdgcn_rcpf(1.0f + __expf(-1.702f * g)); o[n * 4 + i] = (up + 1.0f) * glu; }
                u32x4 w; w.x = cvt_pk_bf16(o[0], o[1]); w.y = cvt_pk_bf16(o[2], o[3]); w.z = cvt_pk_bf16(o[4], o[5]); w.w = cvt_pk_bf16(o[6], o[7]);
                *(u32x4*)rowp = w; }
    }
};
struct EpiDN {
    static constexpr bool PERM = true;
    bf16_t* O; const float* bias;
    __device__ __forceinline__ void operator()(const f32x4 (&acc)[2][2][4][2], const Unit& u, int wr, int wc, int fr, int fq) const {
        const int row0 = u.pm * BM + wr * 64 + fr, col0 = u.pn * BM + wc * 32 + 8 * fq;
        const float* bp = bias + (size_t)u.e * 1024 + col0;
        f32x4 bv[2][2];
#pragma unroll
        for (int bj = 0; bj < 2; ++bj)
#pragma unroll
            for (int n = 0; n < 2; ++n) bv[bj][n] = *(const f32x4*)(bp + bj * HALF + 4 * n);
#pragma unroll
        for (int ai = 0; ai < 2; ++ai)
#pragma unroll
            for (int m = 0; m < 4; ++m) { bf16_t* rowp = O + (size_t)(row0 + ai * HALF + m * 16) * D + col0;
#pragma unroll
                for (int bj = 0; bj < 2; ++bj) { const f32x4 v0 = acc[ai][bj][m][0] + bv[bj][0], v1 = acc[ai][bj][m][1] + bv[bj][1];
                    u32x4 w; w.x = cvt_pk_bf16(v0[0], v0[1]); w.y = cvt_pk_bf16(v0[2], v0[3]); w.z = cvt_pk_bf16(v1[0], v1[1]); w.w = cvt_pk_bf16(v1[2], v1[3]);
                    *(u32x4*)(rowp + bj * HALF) = w; } }
    }
};

template <class Epi, class Sched>
__device__ __forceinline__ void gemm_phase(LAS unsigned char* lds, const Sched& S, const Epi& E, const int tid) {
    constexpr bool GATHER = Sched::GATHER;
    const int wid = __builtin_amdgcn_readfirstlane(tid >> 6), lane = tid & 63, wr = wid >> 2, wc = wid & 3, fr = lane & 15, fq = lane >> 4;
    const int K = S.K, nt = K / BK;
    unsigned voffA[2], voffB[2]; int RA[2], CA[2];
#pragma unroll
    for (int i = 0; i < 2; ++i) { int R, C; stage_rc(tid * 16 + i * 8192, R, C); const int Rb = Epi::PERM ? ((R & ~31) + perm32(R & 31)) : R;
        RA[i] = R; CA[i] = C; voffA[i] = (unsigned)(R * K + C) * 2u; voffB[i] = (unsigned)(Rb * K + C) * 2u; }
    const size_t kstep = (size_t)(BK * 2);
    const size_t hstep = (size_t)HALF * K * 2;
    const unsigned ldsw = (unsigned)wid * 1024u;
    const int aoff = lds_byte(wr * 64 + fr, fq * 8), boff = lds_byte(wc * 32 + fr, fq * 8);
#define PG8_SA(b, h) (((b) * 2 + (h)) * HTB)
#define PG8_SB(b, h) ((4 + (b) * 2 + (h)) * HTB)
#define PG8_STAGE(bufoff, gbase, voff) do { _Pragma("unroll") for (int _i = 0; _i < 2; ++_i) \
        __builtin_amdgcn_global_load_lds((const unsigned*)((const char*)(gbase) + (voff)[_i]), (LAS unsigned*)(lds + (bufoff) + ldsw + _i * 8192), 16, 0, 0); } while (0)
#define PG8_STAGE2(bufoff, gbase, v0, v1) do { \
        __builtin_amdgcn_global_load_lds((const unsigned*)((const char*)(gbase) + (v0)), (LAS unsigned*)(lds + (bufoff) + ldsw), 16, 0, 0); \
        __builtin_amdgcn_global_load_lds((const unsigned*)((const char*)(gbase) + (v1)), (LAS unsigned*)(lds + (bufoff) + ldsw + 8192), 16, 0, 0); } while (0)
#define PG8_LDA(dst, b, h) do { _Pragma("unroll") for (int m = 0; m < 4; ++m) _Pragma("unroll") for (int k = 0; k < 2; ++k) dst[m][k] = *(const LAS bf16x8*)(lds + PG8_SA(b, h) + aoff + m * 2048 + k * 1024); } while (0)
#define PG8_LDB(dst, b, h) do { _Pragma("unroll") for (int n = 0; n < 2; ++n) _Pragma("unroll") for (int k = 0; k < 2; ++k) dst[n][k] = *(const LAS bf16x8*)(lds + PG8_SB(b, h) + boff + n * 2048 + k * 1024); } while (0)
#define PG8_MMA(ai, bj, At, Bt) do { __builtin_amdgcn_s_setprio(1); _Pragma("unroll") for (int m = 0; m < 4; ++m) _Pragma("unroll") for (int n = 0; n < 2; ++n) _Pragma("unroll") for (int k = 0; k < 2; ++k) \
        acc[ai][bj][m][n] = __builtin_amdgcn_mfma_f32_16x16x32_bf16(Bt[n][k], At[m][k], acc[ai][bj][m][n], 0, 0, 0); __builtin_amdgcn_s_setprio(0); } while (0)
#define PG8_WAIT_V(n) asm volatile("s_waitcnt vmcnt(" #n ")" ::: "memory")
#define PG8_WAIT_L(n) asm volatile("s_waitcnt lgkmcnt(" #n ")" ::: "memory")
#define PG8_BAR __builtin_amdgcn_s_barrier()
#define PG8_SCHED __builtin_amdgcn_sched_barrier(0)
    unsigned pc[2] = {0u, 0u}, pn_[2] = {0u, 0u};
    const unsigned R0 = (unsigned)RA[0], C2 = (unsigned)(CA[0] * 2);
#define PG8_PACK(p, u) do { _Pragma("unroll") for (int _h = 0; _h < 2; ++_h) p[_h] = S.gather_row(u, _h * HALF + R0) | (S.gather_row(u, _h * HALF + 64 + R0) << 16); } while (0)
#define PG8_AOFF(p, h, i) (GATHER ? ((((p)[h] >> (16 * (i))) & 0xffffu) * (unsigned)(K * 2) + C2) : ((unsigned)((h) * hstep) + voffA[i]))
#define PG8_STAGEA(bufoff, gbase, p, h) PG8_STAGE2(bufoff, gbase, PG8_AOFF(p, h, 0), PG8_AOFF(p, h, 1))
    Unit cur, nxt; int ui = 0;
    if (!S.next(0, cur)) return;
    f32x4 acc[2][2][4][2];
#pragma unroll
    for (int a = 0; a < 2; ++a)
#pragma unroll
        for (int b = 0; b < 2; ++b)
#pragma unroll
            for (int m = 0; m < 4; ++m)
#pragma unroll
                for (int n = 0; n < 2; ++n) acc[a][b][m][n] = (f32x4){0.f, 0.f, 0.f, 0.f};
    bf16x8 At[4][2], B0[2][2], B1[2][2];
    const char* cA = S.a_base(cur); const char* cB = S.b_base(cur);
    if (GATHER) PG8_PACK(pc, cur);
    PG8_STAGE(PG8_SB(0, 0), cB, voffB); PG8_STAGEA(PG8_SA(0, 0), cA, pc, 0); PG8_STAGE(PG8_SB(0, 1), cB + hstep, voffB); PG8_STAGEA(PG8_SA(0, 1), cA, pc, 1);
    if (wr == 1) PG8_BAR;
    PG8_WAIT_V(4); PG8_BAR;
    PG8_STAGE(PG8_SB(1, 0), cB + kstep, voffB); PG8_STAGEA(PG8_SA(1, 0), cA + kstep, pc, 0); PG8_STAGE(PG8_SB(1, 1), cB + hstep + kstep, voffB);
    PG8_WAIT_V(6); PG8_BAR;
    for (;;) {
        const bool has_next = S.next(ui + 1, nxt);
        const char* nA = has_next ? S.a_base(nxt) : cA; const char* nB = has_next ? S.b_base(nxt) : cB;
        unsigned rawn[4] = {0u, 0u, 0u, 0u};
        if (GATHER && has_next) {
#pragma unroll
            for (int _h = 0; _h < 2; ++_h) { rawn[2 * _h] = S.gather_row(nxt, _h * HALF + R0); rawn[2 * _h + 1] = S.gather_row(nxt, _h * HALF + 64 + R0); } }
        for (int t = 0; t < nt; t += 2) {
            const bool last = (t == nt - 2);
            if (GATHER && t == (nt > 2 ? 2 : 0)) {
                if (has_next) { asm volatile("v_lshl_or_b32 %0, %1, 16, %2" : "=v"(pn_[0]) : "v"(rawn[1]), "v"(rawn[0]));
                                asm volatile("v_lshl_or_b32 %0, %1, 16, %2" : "=v"(pn_[1]) : "v"(rawn[3]), "v"(rawn[2])); }
                else { pn_[0] = pc[0]; pn_[1] = pc[1]; } }
            const char* a1 = cA + (size_t)(t + 1) * kstep;
            const char* a2 = last ? nA : cA + (size_t)(t + 2) * kstep; const char* b2 = last ? nB : cB + (size_t)(t + 2) * kstep;
            const char* a3 = a2 + kstep; const char* b3 = b2 + kstep;
            PG8_LDB(B0, 0, 0); PG8_SCHED; PG8_LDA(At, 0, 0); PG8_STAGEA(PG8_SA(1, 1), a1, pc, 1);
            PG8_WAIT_L(8); PG8_BAR; PG8_WAIT_L(0); PG8_MMA(0, 0, At, B0); PG8_BAR; PG8_SCHED;
            PG8_LDB(B1, 0, 1); PG8_STAGE(PG8_SB(0, 0), b2, voffB);
            PG8_BAR; PG8_WAIT_L(0); PG8_MMA(0, 1, At, B1); PG8_BAR;
            PG8_LDA(At, 0, 1); { const unsigned pq[2] = {last ? pn_[0] : pc[0], 0u}; PG8_STAGEA(PG8_SA(0, 0), a2, pq, 0); }
            PG8_BAR; PG8_WAIT_L(0); PG8_MMA(1, 0, At, B0); PG8_BAR; PG8_SCHED;
            PG8_STAGE(PG8_SB(0, 1), b2 + hstep, voffB);
            PG8_WAIT_V(6); PG8_BAR; PG8_MMA(1, 1, At, B1); PG8_BAR;
            PG8_LDB(B0, 1, 0); PG8_SCHED; PG8_LDA(At, 1, 0); { const unsigned pq[2] = {0u, last ? pn_[1] : pc[1]}; PG8_STAGEA(PG8_SA(0, 1), a2, pq, 1); }
            PG8_WAIT_L(8); PG8_BAR; PG8_WAIT_L(0); PG8_MMA(0, 0, At, B0); PG8_BAR; PG8_SCHED;
            PG8_LDB(B1, 1, 1); PG8_STAGE(PG8_SB(1, 0), b3, voffB);
            PG8_BAR; PG8_WAIT_L(0); PG8_MMA(0, 1, At, B1); PG8_BAR;
            PG8_LDA(At, 1, 1); { const unsigned pq[2] = {last ? pn_[0] : pc[0], 0u}; PG8_STAGEA(PG8_SA(1, 0), a3, pq, 0); }
            PG8_BAR; PG8_WAIT_L(0); PG8_MMA(1, 0, At, B0); PG8_BAR; PG8_SCHED;
            PG8_STAGE(PG8_SB(1, 1), b3 + hstep, voffB);
            PG8_WAIT_V(6); PG8_BAR; PG8_MMA(1, 1, At, B1); PG8_BAR;
        }
        E(acc, cur, wr, wc, fr, fq);
        if (!has_next) break;
#pragma unroll
        for (int a = 0; a < 2; ++a)
#pragma unroll
            for (int b = 0; b < 2; ++b)
#pragma unroll
                for (int m = 0; m < 4; ++m)
#pragma unroll
                    for (int n = 0; n < 2; ++n) acc[a][b][m][n] = (f32x4){0.f, 0.f, 0.f, 0.f};
        cur = nxt; cA = nA; cB = nB; ++ui; pc[0] = pn_[0]; pc[1] = pn_[1];
    }
    PG8_WAIT_V(0);
    if (wr == 0) PG8_BAR;
    PG8_BAR;
#undef PG8_SA
#undef PG8_SB
#undef PG8_STAGE
#undef PG8_STAGE2
#undef PG8_LDA
#undef PG8_LDB
#undef PG8_MMA
#undef PG8_WAIT_V
#undef PG8_WAIT_L
#undef PG8_BAR
#undef PG8_SCHED
#undef PG8_PACK
#undef PG8_AOFF
#undef PG8_STAGEA
}
}

struct Args { const float* in[43]; float* out; unsigned char* ws; int ph_lo, ph_hi; };
enum { I_X = 0, I_C, I_CTX, I_CCTX, I_ADAW, I_ADAB, I_NMIX, I_NFFN, I_NFIN, I_WIN, I_WOUT, I_HSW, I_HSB, I_HW1, I_HB1, I_HW2, I_HB2, I_HW3, I_HB3, I_HW4,
       I_HFREQ, I_HSKIP, I_RMU, I_RW0, I_RW2, I_RA0, I_RA2, I_RG2, I_RKK, I_RKA, I_RRK, I_RGNW, I_RGNB, I_GCONV, I_GALOG, I_GDT, I_GNW,
       I_MRW, I_MRB, I_MWGU, I_MBGU, I_MWDN, I_MBDN };

struct Frame {
    LAS unsigned char* lds;
    int tid, lane, wave, G, bid;
    const float* const* in;
    unsigned char* ws;
    float* out;
};
#define WSP(T, off) ((T*)(F.ws + (off)))
#define LDS_WAIT() asm volatile("s_waitcnt lgkmcnt(0)" ::: "memory")

__device__ __forceinline__ int row_batch(int row) { return row < M_CTX ? row / CTX : (row - M_CTX) / SEQ; }
__device__ __forceinline__ int row_modr(int row) { return row < M_CTX ? 8 : (row - M_CTX) / SEQ; }

__device__ __forceinline__ void p0_transpose_item(const float* W, int K, int N, bf16_t* WT, int k0, int n0, int drow0, LAS float* scr, int lane) {
    { float tv[32]; const int n = n0 + (lane & 31);
#pragma unroll
      for (int i = 0; i < 32; ++i) { const int kk = 2 * i + (lane >> 5); tv[i] = (n < N) ? W[(size_t)(k0 + kk) * N + n] : 0.f; }
      asm volatile("" ::: "memory");
#pragma unroll
      for (int i = 0; i < 32; ++i) { const int kk = 2 * i + (lane >> 5); scr[kk * 33 + (lane & 31)] = tv[i]; } }
    LDS_WAIT(); asm volatile("" ::: "memory");
    const int c = lane & 7;
#pragma unroll
    for (int j = 0; j < 4; ++j) { const int n = (lane >> 3) + 8 * j; const LAS float* s = scr + (8 * c) * 33 + n;
        u32x4 o; o.x = pk2(s[0 * 33], s[1 * 33]); o.y = pk2(s[2 * 33], s[3 * 33]); o.z = pk2(s[4 * 33], s[5 * 33]); o.w = pk2(s[6 * 33], s[7 * 33]);
        *(u32x4*)(WT + (size_t)(drow0 + n) * K + k0 + 8 * c) = o; }
    LDS_WAIT(); asm volatile("" ::: "memory");
}

__device__ __forceinline__ void phase_prologue(Frame& F) {
    const int gw = F.bid * NWV + F.wave, NGW = F.G * NWV;
    {
        LAS float* scr = (LAS float*)(F.lds + F.wave * 16384);
        constexpr int I_IN = 16 * 128, I_OUT = 16 * 32, I_GU = 16 * 64, I_DN = 16 * 32;
        constexpr int T_IN = DEPTH * I_IN, T_OUT = DEPTH * I_OUT, T_GU = DEPTH * NE * I_GU, T_DN = DEPTH * NE * I_DN;
        for (int it = gw; it < T_IN + T_OUT + T_GU + T_DN; it += NGW) {
            int r = it;
            if (r < T_IN) { const int l = r / I_IN, q = r % I_IN, kb = q / 128, nb = q % 128;
                p0_transpose_item(F.in[I_WIN] + (size_t)l * D * IN_COLS, D, IN_COLS, WSP(bf16_t, WS_WIN) + (size_t)l * PW * D, kb * 64, nb * 32, nb * 32, scr, F.lane); continue; }
            r -= T_IN;
            if (r < T_OUT) { const int l = r / I_OUT, q = r % I_OUT, kb = q / 32, nb = q % 32;
                p0_transpose_item(F.in[I_WOUT] + (size_t)l * D * D, D, D, WSP(bf16_t, WS_WOUT) + (size_t)l * D * D, kb * 64, nb * 32, nb * 32, scr, F.lane); continue; }
            r -= T_OUT;
            if (r < T_GU) { const int le = r / I_GU, q = r % I_GU, kb = q / 64, nb = q % 64; const int n0 = nb * 32;
                const int j = n0 & 1023, drow = 256 * (j >> 7) + (n0 >= 1024 ? 128 : 0) + (j & 127);
                p0_transpose_item(F.in[I_MWGU] + (size_t)le * D * 2048, D, 2048, WSP(bf16_t, WS_WGU) + (size_t)le * 2048 * D, kb * 64, n0, drow, scr, F.lane); continue; }
            r -= T_GU;
            { const int le = r / I_DN, q = r % I_DN, kb = q / 32, nb = q % 32;
                p0_transpose_item(F.in[I_MWDN] + (size_t)le * FF * D, FF, D, WSP(bf16_t, WS_WDN) + (size_t)le * D * FF, kb * 64, nb * 32, nb * 32, scr, F.lane); }
        }
    }
    {
        LAS float* scr = (LAS float*)(F.lds + F.wave * 16384);
        for (int it = gw; it < DEPTH * 48; it += NGW) { const int l = it / 48, q = it % 48; bf16_t* dst = (bf16_t*)(F.ws + WS_LORA + (size_t)l * LORA_L);
            if (q < 16) { const int d = q >> 3, nb = q & 7; p0_transpose_item(F.in[I_RW2] + ((size_t)l * 2 + d) * 64 * 256, 64, 256, dst + d * 256 * 64, 0, nb * 32, nb * 32, scr, F.lane); }
            else if (q < 32) { const int d = (q - 16) >> 3, nb = q & 7; p0_transpose_item(F.in[I_RA2] + ((size_t)l * 2 + d) * 64 * 256, 64, 256, dst + 2 * 256 * 64 + d * 256 * 64, 0, nb * 32, nb * 32, scr, F.lane); }
            else { const int kb = (q - 32) >> 3, nb = q & 7; p0_transpose_item(F.in[I_RG2] + (size_t)l * 128 * 256, 128, 256, dst + 4 * 256 * 64, kb * 64, nb * 32, nb * 32, scr, F.lane); } }
    }
    __syncthreads();
    {
        LAS float* sl = (LAS float*)F.lds;
        LAS float* red = sl + 9 * 1024;
        for (int i = F.tid; i < 9 * 1024; i += NT) { const float v = (i < 8 * 1024) ? F.in[I_C][i] : F.in[I_CCTX][i - 8 * 1024]; sl[i] = siluf_(v); }
        __syncthreads();
        float* mods = WSP(float, WS_MODS);
        const int kh = F.lane >> 5, cl = F.lane & 31;
        for (int it = F.bid; it < DEPTH * (NMOD * D / 32); it += F.G) {
            const int l = it / (NMOD * D / 32), nb = it % (NMOD * D / 32);
            const float* W = F.in[I_ADAW] + (size_t)l * D * (NMOD * D) + nb * 32 + cl;
            float a[9];
#pragma unroll
            for (int r = 0; r < 9; ++r) a[r] = 0.f;
            const int kbase = F.wave * 128 + kh * 64;
#pragma unroll 1
            for (int kb4 = 0; kb4 < 4; ++kb4) { float wv[16];
#pragma unroll
              for (int k = 0; k < 16; ++k) wv[k] = W[(size_t)(kbase + kb4 * 16 + k) * (NMOD * D)];
              asm volatile("" ::: "memory");
#pragma unroll
              for (int k = 0; k < 16; ++k) {
#pragma unroll
                for (int r = 0; r < 9; ++r) a[r] += sl[r * 1024 + kbase + kb4 * 16 + k] * wv[k]; } }
#pragma unroll
            for (int r = 0; r < 9; ++r) red[((F.wave * 2 + kh) * 9 + r) * 32 + cl] = a[r];
            __syncthreads();
            if (F.tid < 9 * 32) { const int r = F.tid / 32, cc = F.tid % 32; float s = 0.f;
#pragma unroll
                for (int p = 0; p < 16; ++p) s += red[(p * 9 + r) * 32 + cc];
                mods[((size_t)l * 9 + r) * (NMOD * D) + nb * 32 + cc] = s + F.in[I_ADAB][(size_t)l * (NMOD * D) + nb * 32 + cc]; }
            __syncthreads();
        }
    }
    __syncthreads();
    {
        LAS float* hb = (LAS float*)F.lds;
        LAS float* hx = hb + 32 * 512 + F.wave * 256;
        constexpr int NB_LAT = SEQ / 32, NB_CTX = CTX / 32, NB_L = NB_LAT + NB_CTX;
        for (int it = F.bid; it < DEPTH * NB_L; it += F.G) {
            const int l = it / NB_L, q = it % NB_L; const bool isctx = q >= NB_LAT; const int L = isctx ? CTX : SEQ; const int p0 = (isctx ? q - NB_LAT : q) * 32;
            const float* w1 = F.in[I_HW1] + (size_t)l * 33 * 64; const float* b1 = F.in[I_HB1] + l * 64;
            const float* w2 = F.in[I_HW2] + (size_t)l * 64 * 64; const float* b2 = F.in[I_HB2] + l * 64;
            const float* w3 = F.in[I_HW3] + (size_t)l * 64 * 64; const float* b3 = F.in[I_HB3] + l * 64;
            const float* w4 = F.in[I_HW4] + (size_t)l * 64 * 512; const float fr = F.in[I_HFREQ][l * 64 + F.lane];
            { float tq[4], av[4];
#pragma unroll
              for (int pp = 0; pp < 4; ++pp) { const int p = p0 + F.wave * 4 + pp; tq[pp] = (float)p / (float)(L - 1);
                float z = 0.f;
                if (F.lane == 0) z = tq[pp];
                else if (F.lane < 33) { const int bi = (F.lane - 1) & 15; const float band = 1e-4f + (float)bi * ((15.0f - 1e-4f) / 15.0f);
                    const float ang = (6.283185307179586f / (float)L) * (float)p * band; z = (F.lane <= 16) ? cosf(ang) : -sinf(ang); }
                hx[pp * 64 + F.lane] = z; }
              LDS_WAIT();
              { const float bb = b1[F.lane]; float wv[33];
#pragma unroll
                for (int i = 0; i < 33; ++i) wv[i] = w1[i * 64 + F.lane];
                asm volatile("" ::: "memory");
#pragma unroll
                for (int pp = 0; pp < 4; ++pp) { float a = bb;
#pragma unroll
                    for (int i = 0; i < 33; ++i) a += hx[pp * 64 + i] * wv[i];
                    av[pp] = sinf(fr * a); } }
              LDS_WAIT();
#pragma unroll
              for (int pp = 0; pp < 4; ++pp) hx[pp * 64 + F.lane] = av[pp];
              LDS_WAIT();
#pragma unroll 1
              for (int ly = 0; ly < 2; ++ly) { const float* wl_ = ly ? w3 : w2; const float bb = (ly ? b3 : b2)[F.lane];
                float a4[4] = {bb, bb, bb, bb};
#pragma unroll 1
                for (int ib = 0; ib < 2; ++ib) { float wv[32];
#pragma unroll
                  for (int i = 0; i < 32; ++i) wv[i] = wl_[(ib * 32 + i) * 64 + F.lane];
                  asm volatile("" ::: "memory");
#pragma unroll
                  for (int pp = 0; pp < 4; ++pp)
#pragma unroll
                    for (int i = 0; i < 32; ++i) a4[pp] += hx[pp * 64 + ib * 32 + i] * wv[i]; }
                LDS_WAIT();
#pragma unroll
                for (int pp = 0; pp < 4; ++pp) hx[pp * 64 + F.lane] = sinf(fr * a4[pp]);
                LDS_WAIT(); }
              float o[4][8];
#pragma unroll
              for (int pp = 0; pp < 4; ++pp)
#pragma unroll
                for (int j = 0; j < 8; ++j) o[pp][j] = 0.f;
#pragma unroll 1
              for (int ib = 0; ib < 16; ++ib) { float wv[4][8];
#pragma unroll
                  for (int ii = 0; ii < 4; ++ii)
#pragma unroll
                      for (int j = 0; j < 8; ++j) wv[ii][j] = w4[(ib * 4 + ii) * 512 + j * 64 + F.lane];
                  asm volatile("" ::: "memory");
#pragma unroll
                  for (int pp = 0; pp < 4; ++pp)
#pragma unroll
                    for (int ii = 0; ii < 4; ++ii) { const float hv = hx[pp * 64 + ib * 4 + ii];
#pragma unroll
                        for (int j = 0; j < 8; ++j) o[pp][j] += hv * wv[ii][j]; } }
#pragma unroll
              for (int pp = 0; pp < 4; ++pp) { const int pl = F.wave * 4 + pp;
#pragma unroll
                for (int j = 0; j < 8; ++j) { const int n = j * 64 + F.lane; const int ch = n & 255;
                    const float dl = -3.0701134573253946f + (float)ch * ((-15.350567286626973f + 3.0701134573253946f) / 255.0f);
                    hb[pl * 512 + n] = o[pp][j] * __expf(-tq[pp] * fabsf(dl)); } }
              LDS_WAIT();
            }
            __syncthreads();
            float* filt = isctx ? WSP(float, WS_FILTC) + (size_t)l * 256 * (2 * CTX) : WSP(float, WS_FILT) + (size_t)l * 256 * (2 * SEQ);
            for (int i = F.tid; i < 512 * 32; i += NT) { const int n = i >> 5, pl = i & 31, p = p0 + pl, ch = n & 255; const float v = hb[pl * 512 + n];
                if (n < 256) filt[(size_t)ch * (2 * L) + L + p] = v + (p == 0 ? F.in[I_HSKIP][l * 256 + ch] : 0.f);
                else if (p >= 1) filt[(size_t)ch * (2 * L) + L - p] = v;
                if (n >= 256 && p == 0) filt[(size_t)ch * (2 * L)] = 0.f; }
            __syncthreads();
        }
    }
}

template <bool TO_LDS>
__device__ __forceinline__ void norm_mod_row(const float* __restrict__ xrow, const float* __restrict__ nw, const float* __restrict__ shift, const float* __restrict__ scale, bf16_t* __restrict__ orow, LAS float* lrow, int lane) {
    f32x4 v[4], w[4], sh[4], sc[4]; float s = 0.f;
#pragma unroll
    for (int j = 0; j < 4; ++j) { const int c = 4 * lane + 256 * j; v[j] = *(const f32x4*)(xrow + c); w[j] = *(const f32x4*)(nw + c); sh[j] = *(const f32x4*)(shift + c); sc[j] = *(const f32x4*)(scale + c); }
    asm volatile("" ::: "memory");
#pragma unroll
    for (int j = 0; j < 4; ++j) s += (v[j].x * v[j].x + v[j].y * v[j].y) + (v[j].z * v[j].z + v[j].w * v[j].w);
    const float rstd = rsqrtf(wave_sum(s) * (1.f / D) + 1e-6f);
#pragma unroll
    for (int j = 0; j < 4; ++j) { const int c = 4 * lane + 256 * j;
        const f32x4 o = (v[j] * rstd) * w[j] * (sc[j] + 1.0f) + sh[j];
        u32x2 p; p.x = pk2(o.x, o.y); p.y = pk2(o.z, o.w);
        *(u32x2*)(orow + c) = p;
        if (TO_LDS) *(LAS f32x4*)(lrow + c) = o; }
}

__device__ __forceinline__ void phase_norm0(Frame& F) {
    const int gw = F.bid * NWV + F.wave, NGW = F.G * NWV;
    const float* mods = WSP(float, WS_MODS);
    bf16_t* N = WSP(bf16_t, WS_N);
    for (int row = gw; row < M_ALL; row += NGW) {
        const float* src = row < M_CTX ? F.in[I_CTX] + (size_t)row * D : F.in[I_X] + (size_t)(row - M_CTX) * D;
        const float* mr = mods + (size_t)row_modr(row) * (NMOD * D);
        norm_mod_row<false>(src, F.in[I_NMIX], mr, mr + D, N + (size_t)row * D, (LAS float*)F.lds, F.lane);
        float* hrow = WSP(float, WS_H) + (size_t)row * D;
#pragma unroll
        for (int j = 0; j < 4; ++j) *(f32x4*)(hrow + 4 * F.lane + 256 * j) = *(const f32x4*)(src + 4 * F.lane + 256 * j);
    }
}

template <class Fin>
__device__ __forceinline__ void mm_lds(const LAS bf16_t* A, int lda, const LAS bf16_t* Bt, int ldb, int M, int N, int K, int wave, int lane, Fin fin) {
    const int tn = N >> 4, ntile = (M >> 4) * tn, fr = lane & 15, fq = lane >> 4;
    for (int tI = wave; tI < ntile; tI += NWV) {
        const int i0 = (tI / tn) << 4, j0 = (tI % tn) << 4;
        f32x4 acc = (f32x4){0.f, 0.f, 0.f, 0.f};
        const LAS bf16_t* ap = A + (i0 + fr) * lda + fq * 8; const LAS bf16_t* bp = Bt + (j0 + fr) * ldb + fq * 8;
        for (int k = 0; k < K; k += 32) { const bf16x8 a = *(const LAS bf16x8*)(ap + k); const bf16x8 b = *(const LAS bf16x8*)(bp + k);
            acc = __builtin_amdgcn_mfma_f32_16x16x32_bf16(a, b, acc, 0, 0, 0); }
#pragma unroll
        for (int r = 0; r < 4; ++r) fin(i0 + fq * 4 + r, j0 + fr, acc[r]);
    }
}


struct TileSched { int v0, v1, v2; int bid, G, N; bool bal;
    __device__ __forceinline__ int first() const { return bal ? v0 : (bid < N ? bid : -1); }
    __device__ __forceinline__ int next(int it) const { return bal ? (it == 1 ? v1 : (it == 2 ? v2 : -1)) : (bid + it * G < N ? bid + it * G : -1); } };
__device__ __forceinline__ TileSched strided_sched(const Frame& F, int N) { TileSched t; t.v0 = t.v1 = t.v2 = -1; t.bid = F.bid; t.G = F.G; t.N = N; t.bal = false; return t; }
#define TILE_LOOP(u, ts) for (int it_ = 0, u = (ts).first(); u >= 0; u = (ts).next(++it_))
__device__ __forceinline__ void prep_hyena(Frame& F, int l, bool with_ctx_hy, const TileSched ts) {
    const float* __restrict__ P = WSP(float, WS_P);
    float* __restrict__ VVT = WSP(float, WS_VVT);
    const float* sw = F.in[I_HSW] + (size_t)l * 3 * 768; const float* sb = F.in[I_HSB] + (size_t)l * 768;
    LAS float* tile = (LAS float*)F.lds;
    TILE_LOOP(u, ts) {
        const int row0 = u * 64; const bool isctx = row0 < M_CTX; if (isctx && !with_ctx_hy) continue;
        const int L = isctx ? CTX : SEQ; const int b = row_batch(row0); const int t0 = isctx ? row0 - b * CTX : row0 - M_CTX - b * SEQ;
        const int c = F.tid & 255, th = F.tid >> 8;
        const float w1a = sw[0 * 768 + 256 + c], w1b = sw[1 * 768 + 256 + c], w1c = sw[2 * 768 + 256 + c], b1 = sb[256 + c];
        const float wva = sw[0 * 768 + 512 + c], wvb = sw[1 * 768 + 512 + c], wvc = sw[2 * 768 + 512 + c], bv = sb[512 + c];
        { const float* pc = P + (size_t)(row0 + th * 32) * PW + c; float xa[34], xv[34];
#pragma unroll
          for (int k = 0; k < 34; ++k) { const int t = t0 + th * 32 + k - 1; const bool ok = (t >= 0 && t < L); xa[k] = ok ? pc[(ptrdiff_t)(k - 1) * PW + 256] : 0.f; xv[k] = ok ? pc[(ptrdiff_t)(k - 1) * PW + 512] : 0.f; }
          asm volatile("" ::: "memory");
#pragma unroll
          for (int tt = 0; tt < 32; ++tt) { const float x1 = b1 + w1a * xa[tt] + w1b * xa[tt + 1] + w1c * xa[tt + 2]; const float vv = bv + wva * xv[tt] + wvb * xv[tt + 1] + wvc * xv[tt + 2];
              tile[c * 65 + th * 32 + tt] = x1 * vv; } }
        __syncthreads();
        const int pos0 = isctx ? t0 : CTX + t0;
        for (int i = F.tid; i < 256 * 64; i += NT) { const int cc = i >> 6, tl = i & 63;
            VVT[((size_t)cc * NB + b) * (CTX + SEQ) + pos0 + tl] = tile[cc * 65 + tl]; }
        __syncthreads();
    }
}

__device__ __forceinline__ float rw_mix(const float* P, const float* mu, int row, int cc, bool isctx, int t) {
    const float* pr = P + (size_t)row * PW + C_RW + cc; const int m4 = cc & 3; int off; bool ok;
    if (isctx) { const bool ev = (m4 & 1) == 0; off = ev ? -PW : PW; ok = ev ? (t > 0) : (t < CTX - 1); }
    else { const int gr = t >> 6, gc = t & 63;
        off = (m4 == 0) ? -PW : ((m4 == 1) ? PW : ((m4 == 2) ? -64 * PW : 64 * PW));
        ok = (m4 == 0) ? (gc > 0) : ((m4 == 1) ? (gc < 63) : ((m4 == 2) ? (gr > 0) : (gr < 31))); }
    const float p = pr[0]; float sh = pr[ok ? off : 0]; sh = ok ? sh : 0.f;
    return p + mu[cc] * (sh - p);
}
__device__ __forceinline__ void prep_rwkv(Frame& F, int l, const TileSched ts) {
    const float* __restrict__ P = WSP(float, WS_P);
    float* __restrict__ RW = WSP(float, WS_RW); float* __restrict__ BON = WSP(float, WS_RWBON);
    const float* __restrict__ mu = F.in[I_RMU] + (size_t)l * RWC;
    const float* __restrict__ w0 = F.in[I_RW0] + (size_t)l * 512; const float* __restrict__ a0 = F.in[I_RA0] + (size_t)l * 512;
    const float* __restrict__ kkw = F.in[I_RKK] + l * 256; const float* __restrict__ kaw = F.in[I_RKA] + l * 256; const float* __restrict__ rkw = F.in[I_RRK] + l * 256;
    const bf16_t* lora = (const bf16_t*)(F.ws + WS_LORA + (size_t)l * LORA_L);
    LAS bf16_t* lin = (LAS bf16_t*)F.lds;
    LAS float* R = (LAS float*)(F.lds + 25088);
    LAS float* R2 = (LAS float*)(F.lds + 58880);
    const int tid = F.tid, lane = F.lane, wave = F.wave, fr = lane & 15, fq = lane >> 4;
    TILE_LOOP(u, ts) {
        const int row0 = u * 32; const bool isctx = row0 < M_CTX; const int b = row_batch(row0); const int t0 = isctx ? row0 - b * CTX : row0 - M_CTX - b * SEQ;
        bf16x8 Wn[8];
#define RWP_LOADW(p) do { if ((p) < 4) { _Pragma("unroll") for (int n2 = 0; n2 < 2; ++n2) _Pragma("unroll") for (int ks = 0; ks < 2; ++ks) \
              Wn[n2 * 2 + ks] = *(const GAS bf16x8*)(lora + (p) * 256 * 64 + ((2 * wave + n2) * 16 + fr) * 64 + ks * 32 + fq * 8); } \
          else { _Pragma("unroll") for (int n2 = 0; n2 < 2; ++n2) _Pragma("unroll") for (int ks = 0; ks < 4; ++ks) \
              Wn[n2 * 4 + ks] = *(const GAS bf16x8*)(lora + 4 * 256 * 64 + ((2 * wave + n2) * 16 + fr) * 128 + ks * 32 + fq * 8); } } while (0)
        RWP_LOADW(0);
        { const int c = tid & 127, tq = tid >> 7, m4 = c & 3;
          int off;
          if (isctx) off = ((m4 & 1) == 0) ? -PW : PW; else off = (m4 == 0) ? -PW : ((m4 == 1) ? PW : ((m4 == 2) ? -64 * PW : 64 * PW));
          const float mu0 = mu[768 + c], mu1 = mu[896 + c], mu2 = mu[1024 + c];
#pragma unroll 1
          for (int hb = 0; hb < 2; ++hb) { float pv[4][3], sv[4][3]; bool okv[4];
#pragma unroll
            for (int k = 0; k < 4; ++k) { const int tok = tq * 8 + hb * 4 + k, t = t0 + tok; bool ok;
                if (isctx) ok = ((m4 & 1) == 0) ? (t > 0) : (t < CTX - 1);
                else { const int gr = t >> 6, gc = t & 63; ok = (m4 == 0) ? (gc > 0) : ((m4 == 1) ? (gc < 63) : ((m4 == 2) ? (gr > 0) : (gr < 31))); }
                okv[k] = ok;
                const float* pr = P + (size_t)(row0 + tok) * PW + C_RW + 768 + c; const float* ps = pr + (ok ? off : 0);
#pragma unroll
                for (int g = 0; g < 3; ++g) { pv[k][g] = pr[g * 128]; sv[k][g] = ps[g * 128]; } }
            asm volatile("" ::: "memory");
#pragma unroll
            for (int k = 0; k < 4; ++k) { const int tok = tq * 8 + hb * 4 + k;
                const float s0 = okv[k] ? sv[k][0] : 0.f, s1 = okv[k] ? sv[k][1] : 0.f, s2 = okv[k] ? sv[k][2] : 0.f;
                const float m0 = pv[k][0] + mu0 * (s0 - pv[k][0]), m1 = pv[k][1] + mu1 * (s1 - pv[k][1]), m2 = pv[k][2] + mu2 * (s2 - pv[k][2]);
                lin[tok * 392 + c] = (bf16_t)f2bf(1.0f - 2.0f * __builtin_amdgcn_rcpf(1.0f + __expf(2.0f * m0)));
                lin[tok * 392 + 128 + c] = (bf16_t)f2bf(m1);
                lin[tok * 392 + 256 + c] = (bf16_t)f2bf(sigmoidf_(m2)); } } }
#pragma unroll
        for (int pass = 0; pass < 5; ++pass) {
            bf16x8 Wc[8];
#pragma unroll
            for (int i = 0; i < 8; ++i) Wc[i] = Wn[i];
            __syncthreads();
#pragma unroll
            for (int m = 0; m < 2; ++m) { f32x4 acc[2] = {(f32x4){0.f, 0.f, 0.f, 0.f}, (f32x4){0.f, 0.f, 0.f, 0.f}};
                if (pass < 4) {
#pragma unroll
                    for (int ks = 0; ks < 2; ++ks) { const bf16x8 A = *(const LAS bf16x8*)(lin + (m * 16 + fr) * 392 + pass * 64 + ks * 32 + fq * 8);
                        acc[0] = __builtin_amdgcn_mfma_f32_16x16x32_bf16(A, Wc[ks], acc[0], 0, 0, 0); acc[1] = __builtin_amdgcn_mfma_f32_16x16x32_bf16(A, Wc[2 + ks], acc[1], 0, 0, 0); } }
                else {
#pragma unroll
                    for (int ks = 0; ks < 4; ++ks) { const bf16x8 A = *(const LAS bf16x8*)(lin + (m * 16 + fr) * 392 + 256 + ks * 32 + fq * 8);
                        acc[0] = __builtin_amdgcn_mfma_f32_16x16x32_bf16(A, Wc[ks], acc[0], 0, 0, 0); acc[1] = __builtin_amdgcn_mfma_f32_16x16x32_bf16(A, Wc[4 + ks], acc[1], 0, 0, 0); } }
#pragma unroll
                for (int n2 = 0; n2 < 2; ++n2)
#pragma unroll
                    for (int r = 0; r < 4; ++r) (pass == 2 ? R2 : R)[(m * 16 + 4 * fq + r) * 260 + (2 * wave + n2) * 16 + fr] = acc[n2][r]; }
            if (pass < 4) { RWP_LOADW(pass + 1); asm volatile("" ::: "memory"); }
            __syncthreads();
            if (pass < 2) { const int d = pass; const float w0c = w0[d * 256 + (tid & 255)];
                for (int i = tid; i < 32 * 256; i += NT) { const int tok = i >> 8, c = i & 255; const float xw = w0c + R[tok * 260 + c];
                    RW[(size_t)(row0 + tok) * 2560 + (3 + 3 * d) * 256 + c] = __expf(-0.6065306597126334f * sigmoidf_(xw)); } }
            else if (pass == 2) { }
            else if (pass == 3) {
                float pk_[4], pa_[4], pr_[4], p0_[4], p1_[4];
#pragma unroll
                for (int q = 0; q < 4; ++q) { const int c = lane + 64 * q; pk_[q] = kkw[c]; pa_[q] = kaw[c]; pr_[q] = rkw[c]; p0_[q] = a0[c]; p1_[q] = a0[256 + c]; }
                const int m4 = lane & 3; int off;
                if (isctx) off = ((m4 & 1) == 0) ? -PW : PW; else off = (m4 == 0) ? -PW : ((m4 == 1) ? PW : ((m4 == 2) ? -64 * PW : 64 * PW));
                float muv[12];
#pragma unroll
                for (int e = 0; e < 12; ++e) muv[e] = mu[lane + 64 * e];
                float pn[12], sn[12]; bool okn;
#define RWT_LOAD(tk_) do { const int tok_ = wave * 4 + ((tk_) < 4 ? (tk_) : 3), t_ = t0 + tok_; \
                    if (isctx) okn = ((m4 & 1) == 0) ? (t_ > 0) : (t_ < CTX - 1); \
                    else { const int gr = t_ >> 6, gc = t_ & 63; okn = (m4 == 0) ? (gc > 0) : ((m4 == 1) ? (gc < 63) : ((m4 == 2) ? (gr > 0) : (gr < 31))); } \
                    const float* pr_ = P + (size_t)(row0 + tok_) * PW + C_RW + lane; const float* ps_ = pr_ + (okn ? off : 0); \
                    _Pragma("unroll") for (int e = 0; e < 12; ++e) { pn[e] = pr_[64 * e]; sn[e] = ps_[64 * e]; } \
                    asm volatile("" ::: "memory"); } while (0)
                RWT_LOAD(0);
#pragma unroll 1
                for (int tk = 0; tk < 4; ++tk) { const int tok = wave * 4 + tk, row = row0 + tok; float* o = RW + (size_t)row * 2560;
                    float pv[12], sv[12]; const bool ok = okn;
#pragma unroll
                    for (int e = 0; e < 12; ++e) { pv[e] = pn[e]; sv[e] = sn[e]; }
                    RWT_LOAD(tk + 1);
                    float mr[4], mk[4], mv[4], kx[4], ss[4];
#pragma unroll
                    for (int q = 0; q < 4; ++q) {
                        mr[q] = pv[q] + muv[q] * ((ok ? sv[q] : 0.f) - pv[q]); mk[q] = pv[4 + q] + muv[4 + q] * ((ok ? sv[4 + q] : 0.f) - pv[4 + q]);
                        mv[q] = pv[8 + q] + muv[8 + q] * ((ok ? sv[8 + q] : 0.f) - pv[8 + q]); kx[q] = mk[q] * pk_[q]; ss[q] = kx[q] * kx[q]; }
#pragma unroll
                    for (int q = 0; q < 4; ++q) ss[q] = wave_sum(ss[q]);
                    float bs[4];
#pragma unroll
                    for (int q = 0; q < 4; ++q) { const int c = lane + 64 * q;
                        const float r_ = mr[q], k_ = mk[q];
                        const float kk = kx[q] * rsqrtf(ss[q] + 1e-12f);
                        const float af = sigmoidf_(p0_[q] + R2[tok * 260 + c]), ab = sigmoidf_(p1_[q] + R[tok * 260 + c]);
                        const float kdf = k_ * (1.0f + (af - 1.0f) * pa_[q]), kdb = k_ * (1.0f + (ab - 1.0f) * pa_[q]);
                        o[c] = r_; o[256 + c] = mv[q]; o[512 + c] = kk;
                        o[4 * 256 + c] = kdf; o[5 * 256 + c] = kk * af; o[7 * 256 + c] = kdb; o[8 * 256 + c] = kk * ab;
                        bs[q] = r_ * (kdf + kdb) * pr_[q]; }
#pragma unroll
                    for (int q = 0; q < 4; ++q) bs[q] = wave_sum(bs[q]);
                    if (lane < 4) BON[(size_t)row * 4 + lane] = (lane == 0) ? bs[0] : ((lane == 1) ? bs[1] : ((lane == 2) ? bs[2] : bs[3])); }
#undef RWT_LOAD
            }
            else { for (int i = tid; i < 32 * 256; i += NT) { const int tok = i >> 8, c = i & 255; RW[(size_t)(row0 + tok) * 2560 + 9 * 256 + c] = R[tok * 260 + c]; } }
        }
        __syncthreads();
    }
}
#undef RWP_LOADW

__device__ __forceinline__ void prep_gdn(Frame& F, int l, const TileSched ts) {
    const float* __restrict__ P = WSP(float, WS_P);
    float* __restrict__ BG = WSP(float, WS_GBG);
    bf16_t* __restrict__ QB = WSP(bf16_t, WS_QB); bf16_t* __restrict__ KB = WSP(bf16_t, WS_KB); bf16_t* __restrict__ KT = WSP(bf16_t, WS_KT); bf16_t* __restrict__ VT = WSP(bf16_t, WS_VT);
    const float* __restrict__ cw = F.in[I_GCONV] + (size_t)l * 5 * 1536;
    LAS float* tile = (LAS float*)F.lds;
    const int tid = F.tid, lane = F.lane, wave = F.wave;
    TILE_LOOP(u, ts) {
        const int row0 = u * 64; const bool isctx = row0 < M_CTX; const int L = isctx ? CTX : SEQ; const int b = row_batch(row0); const int t0 = isctx ? row0 - b * CTX : row0 - M_CTX - b * SEQ;
        const int oc = (isctx ? 0 : 4) + (t0 >> 6);
        for (int i = tid; i < 64 * 16; i += NT) { const int tok = i >> 4, j = i & 15; const float rv = P[(size_t)(row0 + tok) * PW + C_GD + 2048 + j]; float ov;
            if (j < 8) ov = sigmoidf_(rv); else { const int dh = j - 8; ov = -__expf(F.in[I_GALOG][l * 8 + dh]) * softplusf_(rv + F.in[I_GDT][l * 8 + dh]); }
            BG[(size_t)(row0 + tok) * 16 + j] = ov; }
#pragma unroll 1
        for (int pass = 0; pass < 3; ++pass) {
            const int ch = pass * 512 + tid; const float* pc = P + (size_t)row0 * PW + C_GD + ch;
            const float w0 = cw[ch], w1 = cw[1536 + ch], w2 = cw[2 * 1536 + ch], w3 = cw[3 * 1536 + ch], w4 = cw[4 * 1536 + ch];
#define GLD(j) (((t0 + (j)) >= 0 && (t0 + (j)) < L) ? pc[(ptrdiff_t)(j) * PW] : 0.f)
            float xm2 = GLD(-2), xm1 = GLD(-1), x0 = GLD(0), x1 = GLD(1), x2 = GLD(2);
#pragma unroll 1
            for (int tb = 0; tb < 2; ++tb) { float nx[32];
#pragma unroll
                for (int e = 0; e < 32; ++e) nx[e] = GLD(tb * 32 + e + 3);
                asm volatile("" ::: "memory");
#pragma unroll
                for (int e = 0; e < 32; ++e) { const int tl = tb * 32 + e; const float a = (w0 * xm2 + w1 * xm1) + (w2 * x0 + w3 * x1) + w4 * x2;
                    tile[tl * 516 + tid] = siluf_(a);
                    xm2 = xm1; xm1 = x0; x0 = x1; x1 = x2; x2 = nx[e]; } }
#undef GLD
            __syncthreads();
            if (pass < 2) {
                for (int tk = 0; tk < 8; ++tk) { const int tl = wave * 8 + tk; float x[8];
#pragma unroll
                    for (int j = 0; j < 8; ++j) x[j] = tile[tl * 516 + lane + 64 * j];
#pragma unroll
                    for (int h4 = 0; h4 < 4; ++h4) { const float ss = wave_sum(x[2 * h4] * x[2 * h4] + x[2 * h4 + 1] * x[2 * h4 + 1]);
                        const float sc = rsqrtf(ss + 1e-12f) * (pass == 0 ? 0.08838834764831845f : 1.0f); x[2 * h4] *= sc; x[2 * h4 + 1] *= sc; }
#pragma unroll
                    for (int j = 0; j < 8; ++j) tile[tl * 516 + lane + 64 * j] = x[j]; }
                __syncthreads();
                bf16_t* dst = pass == 0 ? QB : KB;
                for (int i = tid; i < 64 * 64; i += NT) { const int tok = i >> 6, c8 = i & 63; const LAS float* sp = tile + tok * 516 + c8 * 8;
                    u32x4 p; p.x = pk2(sp[0], sp[1]); p.y = pk2(sp[2], sp[3]); p.z = pk2(sp[4], sp[5]); p.w = pk2(sp[6], sp[7]);
                    *(u32x4*)(dst + (size_t)(row0 + tok) * 512 + c8 * 8) = p; }
            }
            if (pass >= 1) {
                bf16_t* dst = pass == 1 ? KT : VT;
#pragma unroll 1
                for (int t8 = 0; t8 < 8; ++t8) { const LAS float* sp = tile + (t8 * 8) * 516 + tid;
                    u32x4 p; p.x = pk2(sp[0], sp[516]); p.y = pk2(sp[2 * 516], sp[3 * 516]); p.z = pk2(sp[4 * 516], sp[5 * 516]); p.w = pk2(sp[6 * 516], sp[7 * 516]);
                    *(u32x4*)(dst + ((size_t)((b * 4 + (tid >> 7)) * NCHUNK + oc) * 128 + (tid & 127)) * 64 + t8 * 8) = p; }
            }
            __syncthreads();
        }
    }
}

__device__ __forceinline__ int chain_row(int b, int d, int s) {
    if (s < CTX) { const int pos = d ? (CTX - 1 - s) : s; return b * CTX + pos; }
    const int q = s - CTX; const int pos = d ? (SEQ - 1 - q) : q; return M_CTX + b * SEQ + pos;
}
constexpr size_t GREC = 98304;
constexpr int GR_W = 0, GR_QG = 16384, GR_KT = 32768, GR_AT = 49152, GR_U = 57344, GR_EG = 90112;

__device__ __forceinline__ void gdn_precompute_wave(Frame& F, int ci, int n, LAS unsigned char* wl) {
    int lane_ = F.lane; asm volatile("" : "+v"(lane_));
    const int lane = lane_, fr = lane & 15, fq = lane >> 4;
    const int b = ci >> 3, h = (ci >> 1) & 3, d = ci & 1;
    LAS float* Tf = (LAS float*)wl;
    LAS bf16_t* MTb = (LAS bf16_t*)(wl + 17408);
    LAS float* gcv = (LAS float*)(wl + 26624); LAS float* betv = gcv + 64;
    const bool isctx = n < 4; const int np = isctx ? n : n - 4, nseg = isctx ? 4 : 32; const int ocs = d ? nseg - 1 - np : np;
    const int rowbase = (isctx ? b * CTX : M_CTX + b * SEQ) + ocs * 64; const int oc = (isctx ? 0 : 4) + ocs;
#define PROW(i) (rowbase + (d ? 63 - (i) : (i)))
    const GAS float* BG = (const GAS float*)WSP(float, WS_GBG);
    const GAS bf16_t* QB = (const GAS bf16_t*)WSP(bf16_t, WS_QB) + h * 128; const GAS bf16_t* KB = (const GAS bf16_t*)WSP(bf16_t, WS_KB) + h * 128;
    const GAS bf16_t* KT = (const GAS bf16_t*)WSP(bf16_t, WS_KT) + ((size_t)(b * 4 + h) * NCHUNK + oc) * 128 * 64;
    const GAS bf16_t* VT = (const GAS bf16_t*)WSP(bf16_t, WS_VT) + ((size_t)(b * 4 + h) * NCHUNK + oc) * 128 * 64;
    unsigned char* rec = F.ws + WS_GPRE + (size_t)(ci * NCHUNK + n) * GREC;
    const float bet = BG[(size_t)PROW(lane) * 16 + d * 4 + h]; const float g1 = BG[(size_t)PROW(lane) * 16 + 8 + d * 4 + h];
    gcv[lane] = g1; betv[lane] = bet;
    asm volatile("s_waitcnt lgkmcnt(0)" ::: "memory");
    float gc = 0.f, gl = 0.f;
#pragma unroll 8
    for (int j = 0; j < 64; ++j) { const float gj = gcv[j]; gl += gj; gc += (j <= lane) ? gj : 0.f; }
    asm volatile("s_waitcnt lgkmcnt(0)" ::: "memory");
    gcv[lane] = gc;
    asm volatile("s_waitcnt lgkmcnt(0)" ::: "memory");
    bf16x8 Kf[4][4], Qf[4][4];
#pragma unroll
    for (int t = 0; t < 4; ++t)
#pragma unroll
        for (int ks = 0; ks < 4; ++ks) { Kf[t][ks] = *(const GAS bf16x8*)(KB + (size_t)PROW(t * 16 + fr) * 512 + ks * 32 + fq * 8); Qf[t][ks] = *(const GAS bf16x8*)(QB + (size_t)PROW(t * 16 + fr) * 512 + ks * 32 + fq * 8); }
    asm volatile("" ::: "memory");
#pragma unroll
    for (int ti = 0; ti < 4; ++ti) {
#pragma unroll
        for (int tj = 0; tj < 4; ++tj) {
            __builtin_amdgcn_sched_barrier(0);
            if (tj > ti) { unsigned z_ = 0u; asm volatile("" : "+v"(z_)); *(GAS u32x2*)(rec + GR_AT + ((size_t)(ti * 16 + fr) * 64 + tj * 16 + 4 * fq) * 2) = (u32x2){z_, z_}; continue; }
            f32x4 kk = (f32x4){0.f, 0.f, 0.f, 0.f}, qk = kk;
#pragma unroll
            for (int ks = 0; ks < 4; ++ks) { kk = __builtin_amdgcn_mfma_f32_16x16x32_bf16(Kf[ti][ks], Kf[tj][ks], kk, 0, 0, 0);
                                             qk = __builtin_amdgcn_mfma_f32_16x16x32_bf16(Kf[tj][ks], Qf[ti][ks], qk, 0, 0, 0); }
            { const int j = tj * 16 + fr; const float gj = gcv[j]; f32x4 mv;
#pragma unroll
              for (int r = 0; r < 4; ++r) { const int i = ti * 16 + 4 * fq + r; mv[r] = (j < i) ? betv[i] * kk[r] * __expf(gcv[i] - gj) : 0.f; }
              u32x2 pm; pm.x = pk2(mv[0], mv[1]); pm.y = pk2(mv[2], mv[3]);
              *(LAS u32x2*)(MTb + j * 72 + ti * 16 + 4 * fq) = pm; }
            { const int i = ti * 16 + fr; const float gi = gcv[i]; float av[4];
#pragma unroll
              for (int r = 0; r < 4; ++r) { const int j = tj * 16 + 4 * fq + r; av[r] = (j <= i) ? qk[r] * __expf(gi - gcv[j]) : 0.f; }
              u32x2 pk; pk.x = pk2(av[0], av[1]); pk.y = pk2(av[2], av[3]);
              *(GAS u32x2*)(rec + GR_AT + ((size_t)i * 64 + tj * 16 + 4 * fq) * 2) = pk; }
        }
    }
    bf16x8 Vf[8][2], Tk[8][2];
#pragma unroll
    for (int t = 0; t < 8; ++t)
#pragma unroll
        for (int ks = 0; ks < 2; ++ks) { Vf[t][ks] = *(const GAS bf16x8*)(VT + (t * 16 + fr) * 64 + ks * 32 + fq * 8); Tk[t][ks] = *(const GAS bf16x8*)(KT + (t * 16 + fr) * 64 + ks * 32 + fq * 8); }
    asm volatile("" ::: "memory");
    asm volatile("s_waitcnt lgkmcnt(0)" ::: "memory");
#pragma unroll 1
    for (int I = 0; I < 4; ++I) {
        float acc[16];
#pragma unroll
        for (int ii = 0; ii < 16; ++ii) acc[ii] = 0.f;
#pragma unroll 4
        for (int j = 0; j < 16 * I; ++j) { const float tv = Tf[j * 68 + lane]; const LAS u32x4* mp = (const LAS u32x4*)(MTb + j * 72 + 16 * I);
#pragma unroll
            for (int q8 = 0; q8 < 2; ++q8) { const u32x4 m = mp[q8];
#pragma unroll
                for (int e = 0; e < 4; ++e) { acc[q8 * 8 + 2 * e] += __builtin_bit_cast(float, m[e] << 16) * tv; acc[q8 * 8 + 2 * e + 1] += __builtin_bit_cast(float, m[e] & 0xffff0000u) * tv; } } }
        float t[16];
#pragma unroll
        for (int jj = 0; jj < 16; ++jj) { t[jj] = ((16 * I + jj == lane) ? 1.f : 0.f) - acc[jj];
            const LAS u32x4* mp = (const LAS u32x4*)(MTb + (16 * I + jj) * 72 + 16 * I);
#pragma unroll
            for (int q8 = 0; q8 < 2; ++q8) { const u32x4 m = mp[q8];
#pragma unroll
                for (int e = 0; e < 4; ++e) { const int i0 = q8 * 8 + 2 * e;
                    if (i0 > jj) acc[i0] += __builtin_bit_cast(float, m[e] << 16) * t[jj];
                    if (i0 + 1 > jj) acc[i0 + 1] += __builtin_bit_cast(float, m[e] & 0xffff0000u) * t[jj]; } } }
#pragma unroll
        for (int ii = 0; ii < 16; ++ii) Tf[(16 * I + ii) * 68 + lane] = t[ii];
        asm volatile("s_waitcnt lgkmcnt(0)" ::: "memory");
    }
    LAS bf16_t* T1 = (LAS bf16_t*)Tf; LAS bf16_t* T2 = MTb;
    { const int col = d ? 63 - lane : lane; const float be = bet * __expf(gc);
#pragma unroll 1
      for (int hh = 0; hh < 2; ++hh) { float tr[32];
#pragma unroll
        for (int i = 0; i < 32; ++i) tr[i] = Tf[(hh * 32 + i) * 68 + lane];
        asm volatile("s_waitcnt lgkmcnt(0)" ::: "memory");
#pragma unroll
        for (int i = 0; i < 32; ++i) { T1[(hh * 32 + i) * 72 + col] = (bf16_t)f2bf(tr[i] * bet); T2[(hh * 32 + i) * 72 + col] = (bf16_t)f2bf(tr[i] * be); }
        asm volatile("s_waitcnt lgkmcnt(0)" ::: "memory"); } }
#pragma unroll 1
    for (int ti = 0; ti < 4; ++ti) { bf16x8 B1[2], B2[2];
#pragma unroll
        for (int ks = 0; ks < 2; ++ks) { B1[ks] = *(const LAS bf16x8*)(T1 + (ti * 16 + fr) * 72 + ks * 32 + fq * 8); B2[ks] = *(const LAS bf16x8*)(T2 + (ti * 16 + fr) * 72 + ks * 32 + fq * 8); }
#pragma unroll
        for (int tv = 0; tv < 8; ++tv) { f32x4 au = (f32x4){0.f, 0.f, 0.f, 0.f}, aw = au;
#pragma unroll
            for (int ks = 0; ks < 2; ++ks) { au = __builtin_amdgcn_mfma_f32_16x16x32_bf16(Vf[tv][ks], B1[ks], au, 0, 0, 0); aw = __builtin_amdgcn_mfma_f32_16x16x32_bf16(Tk[tv][ks], B2[ks], aw, 0, 0, 0); }
            const int i = ti * 16 + fr, c0 = tv * 16 + 4 * fq;
            *(GAS f32x4*)(rec + GR_U + ((size_t)i * 128 + c0) * 4) = au;
            u32x2 pk; pk.x = pk2(aw[0], aw[1]); pk.y = pk2(aw[2], aw[3]);
            *(GAS u32x2*)(rec + GR_W + ((size_t)i * 128 + c0) * 2) = pk; } }
    LAS float* egv = betv + 64; LAS float* fdv = egv + 64;
    egv[lane] = __expf(gc); fdv[lane] = __expf(gl - gc);
    asm volatile("s_waitcnt lgkmcnt(0)" ::: "memory");
    u32x4 ldq[16];
#pragma unroll
    for (int e = 0; e < 16; ++e) { const int idx = e * 64 + lane, i = idx >> 4, c8 = idx & 15; ldq[e] = *(const GAS u32x4*)(QB + (size_t)PROW(i) * 512 + c8 * 8); }
    asm volatile("" ::: "memory");
#pragma unroll
    for (int e = 0; e < 16; ++e) { const int idx = e * 64 + lane, i = idx >> 4, c8 = idx & 15; const float sc = egv[i];
        const u32x4 v = ldq[e]; u32x4 o;
        o.x = pk2(__builtin_bit_cast(float, v.x << 16) * sc, __builtin_bit_cast(float, v.x & 0xffff0000u) * sc); o.y = pk2(__builtin_bit_cast(float, v.y << 16) * sc, __builtin_bit_cast(float, v.y & 0xffff0000u) * sc);
        o.z = pk2(__builtin_bit_cast(float, v.z << 16) * sc, __builtin_bit_cast(float, v.z & 0xffff0000u) * sc); o.w = pk2(__builtin_bit_cast(float, v.w << 16) * sc, __builtin_bit_cast(float, v.w & 0xffff0000u) * sc);
        *(GAS u32x4*)(rec + GR_QG + ((size_t)i * 128 + c8 * 8) * 2) = o; }
#pragma unroll
    for (int e = 0; e < 16; ++e) { const int idx = e * 64 + lane, kd = idx >> 3, j8 = idx & 7; ldq[e] = *(const GAS u32x4*)(KT + kd * 64 + j8 * 8); }
    asm volatile("" ::: "memory");
#pragma unroll
    for (int e = 0; e < 16; ++e) { const int idx = e * 64 + lane, kd = idx >> 3, j8 = idx & 7;
        const u32x4 v = ldq[e];
        float x[8] = {__builtin_bit_cast(float, v.x << 16), __builtin_bit_cast(float, v.x & 0xffff0000u), __builtin_bit_cast(float, v.y << 16), __builtin_bit_cast(float, v.y & 0xffff0000u),
                      __builtin_bit_cast(float, v.z << 16), __builtin_bit_cast(float, v.z & 0xffff0000u), __builtin_bit_cast(float, v.w << 16), __builtin_bit_cast(float, v.w & 0xffff0000u)};
        float y[8];
#pragma unroll
        for (int q = 0; q < 8; ++q) { const int i = d ? 63 - (j8 * 8 + q) : j8 * 8 + q; y[q] = x[q] * fdv[i]; }
        u32x4 o;
        if (d) { o.x = pk2(y[7], y[6]); o.y = pk2(y[5], y[4]); o.z = pk2(y[3], y[2]); o.w = pk2(y[1], y[0]); }
        else { o.x = pk2(y[0], y[1]); o.y = pk2(y[2], y[3]); o.z = pk2(y[4], y[5]); o.w = pk2(y[6], y[7]); }
        *(GAS u32x4*)(rec + GR_KT + ((size_t)kd * 64 + (d ? 56 - j8 * 8 : j8 * 8)) * 2) = o; }
    if (lane == 0) *(GAS float*)(rec + GR_EG) = __expf(gl);
#undef PROW
    asm volatile("s_waitcnt lgkmcnt(0)" ::: "memory");
}

__device__ __forceinline__ void gdn_chain_unit(Frame& F, int ci, int vh) {
    LAS float*  Sf = (LAS float*)(F.lds);
    LAS bf16_t* St = (LAS bf16_t*)(F.lds + 34816);
    LAS bf16_t* Wl = (LAS bf16_t*)(F.lds + 52224);
    LAS bf16_t* Ql = (LAS bf16_t*)(F.lds + 69632);
    LAS bf16_t* Al = (LAS bf16_t*)(F.lds + 87040);
    LAS bf16_t* Kl = (LAS bf16_t*)(F.lds + 96256);
    LAS float*  Ul = (LAS float*)(F.lds + 114688);
    LAS bf16_t* Vn = (LAS bf16_t*)(F.lds + 132096);
    const int tid = F.tid, lane = F.lane, wave = F.wave;
    const int b = ci >> 3, h = (ci >> 1) & 3, d = ci & 1;
    float* GO = WSP(float, WS_GDO) + (size_t)d * M_ALL * 512;
    for (int i = tid; i < 128 * 68; i += NT) Sf[i] = 0.f;
    for (int i = tid; i < 64 * 136; i += NT) St[i] = 0;
    __syncthreads();
    for (int n = 0; n < NCHUNK; ++n) {
        const unsigned char* rec = F.ws + WS_GPRE + (size_t)(ci * NCHUNK + n) * GREC;
        for (int i = tid; i < 64 * 16; i += NT) { const int r = i >> 4, c8 = i & 15;
            *(LAS u32x4*)(Wl + r * 136 + c8 * 8) = *(const u32x4*)(rec + GR_W + (r * 128 + c8 * 8) * 2);
            *(LAS u32x4*)(Ql + r * 136 + c8 * 8) = *(const u32x4*)(rec + GR_QG + (r * 128 + c8 * 8) * 2); }
        for (int i = tid; i < 128 * 8; i += NT) { const int r = i >> 3, c8 = i & 7;
            *(LAS u32x4*)(Kl + r * 72 + c8 * 8) = *(const u32x4*)(rec + GR_KT + (r * 64 + c8 * 8) * 2); }
        for (int i = tid; i < 64 * 8; i += NT) { const int r = i >> 3, c8 = i & 7;
            *(LAS u32x4*)(Al + r * 72 + c8 * 8) = *(const u32x4*)(rec + GR_AT + (r * 64 + c8 * 8) * 2); }
        for (int i = tid; i < 64 * 16; i += NT) { const int r = i >> 4, c4 = i & 15;
            *(LAS f32x4*)(Ul + r * 68 + c4 * 4) = *(const f32x4*)(rec + GR_U + (r * 128 + vh * 64 + c4 * 4) * 4); }
        const float eg = *(const float*)(rec + GR_EG);
        __syncthreads();
        mm_lds(Wl, 136, St, 136, 64, 64, 128, wave, lane, [&](int i, int j, float v) { Vn[j * 72 + i] = (bf16_t)f2bf(Ul[i * 68 + j] - v); });
        __syncthreads();
        mm_lds(Ql, 136, St, 136, 64, 64, 128, wave, lane, [&](int i, int j, float v) { Ul[i * 68 + j] = v; });
        mm_lds(Al, 72, Vn, 72, 64, 64, 64, wave, lane, [&](int i, int j, float v) {
            const int row = chain_row(b, d, n * 64 + i); GO[(size_t)row * 512 + h * 128 + vh * 64 + j] = Ul[i * 68 + j] + v; });
        __syncthreads();
        mm_lds(Kl, 72, Vn, 72, 128, 64, 64, wave, lane, [&](int i, int j, float v) {
            const float s = eg * Sf[i * 68 + j] + v; Sf[i * 68 + j] = s; St[j * 136 + i] = (bf16_t)f2bf(s); });
        __syncthreads();
    }
}

__device__ __forceinline__ void rwkv_scan_unit(Frame& F, int ci, int vhalf) {
    constexpr int TB = 32, NBLK = (CTX + SEQ) / TB, PER = 5 * 64 + 32, NLD = TB * PER / NT;
    const float* RW = WSP(float, WS_RW);
    const int tid = F.tid, lane = F.lane, wave = F.wave;
    const int b = ci >> 3, h = (ci >> 1) & 3, d = ci & 1;
    float* RO = WSP(float, WS_RWO) + (size_t)d * M_ALL * 256;
    LAS float* buf0 = (LAS float*)F.lds;
    LAS float* obuf = buf0 + 2 * TB * PER;
    const int rr = lane >> 4, kq = lane & 15, vloc = wave * 8 + rr * 2;
    f32x4 S0 = (f32x4){0.f, 0.f, 0.f, 0.f}, S1 = S0;
    float regs[NLD];
    const int sgn = d ? -1 : 1;
    auto load_block = [&](int blk) {
        const int s0 = blk * TB;
        const int row0 = (s0 < CTX) ? b * CTX + (d ? CTX - 1 - s0 : s0) : M_CTX + b * SEQ + (d ? SEQ - 1 - (s0 - CTX) : (s0 - CTX));
        const GAS float* base = (const GAS float*)(RW + (size_t)row0 * 2560 + h * 64);
#pragma unroll
        for (int e = 0; e < 20; ++e) { const int arr = e % 5, st = (e / 5) * 8 + wave;
            const int slot = arr == 0 ? 2 : (arr == 1 ? 3 + 3 * d : (arr == 2 ? 5 + 3 * d : (arr == 3 ? 4 + 3 * d : 0)));
            const float v = base[(ptrdiff_t)(sgn * st) * 2560 + slot * 256 + lane]; regs[e] = (arr == 0) ? -v : v; }
#pragma unroll
        for (int e = 0; e < 2; ++e) { const int idx = e * NT + tid, st = idx >> 5, vi = idx & 31;
            regs[20 + e] = base[(ptrdiff_t)(sgn * st) * 2560 + 256 + vhalf * 32 + vi]; } };
    auto store_block = [&](LAS float* dst) {
#pragma unroll
        for (int e = 0; e < 20; ++e) { const int arr = e % 5, st = (e / 5) * 8 + wave; dst[st * PER + arr * 64 + lane] = regs[e]; }
#pragma unroll
        for (int e = 0; e < 2; ++e) { const int idx = e * NT + tid, st = idx >> 5, vi = idx & 31; dst[st * PER + 320 + vi] = regs[20 + e]; } };
    load_block(0); store_block(buf0);
    __syncthreads();
    for (int blk = 0; blk < NBLK; ++blk) {
        LAS float* cb = buf0 + (blk & 1) * TB * PER;
        if (blk + 1 < NBLK) load_block(blk + 1);
        if (wave < 4) {
            const LAS float* vp = cb;
            f32x4 a4 = *(const LAS f32x4*)(vp + 4 * kq), w4 = *(const LAS f32x4*)(vp + 64 + 4 * kq), b4 = *(const LAS f32x4*)(vp + 128 + 4 * kq),
                  k4 = *(const LAS f32x4*)(vp + 192 + 4 * kq), r4 = *(const LAS f32x4*)(vp + 256 + 4 * kq);
            f32x2 vv = *(const LAS f32x2*)(vp + 320 + vloc);
#pragma unroll 1
            for (int g = 0; g < TB / 8; ++g) {
                float qp0[8], qp1[8];
#pragma unroll
                for (int e = 0; e < 8; ++e) {
                    const int sn = (g * 8 + e + 1 < TB) ? g * 8 + e + 1 : TB - 1;
                    const LAS float* np = cb + sn * PER;
                    const f32x4 na4 = *(const LAS f32x4*)(np + 4 * kq), nw4 = *(const LAS f32x4*)(np + 64 + 4 * kq), nb4 = *(const LAS f32x4*)(np + 128 + 4 * kq),
                                nk4 = *(const LAS f32x4*)(np + 192 + 4 * kq), nr4 = *(const LAS f32x4*)(np + 256 + 4 * kq);
                    const f32x2 nvv = *(const LAS f32x2*)(np + 320 + vloc);
                    const f32x4 p0 = S0 * a4, p1 = S1 * a4;
                    const float sa0 = row16_sum((p0[0] + p0[1]) + (p0[2] + p0[3])), sa1 = row16_sum((p1[0] + p1[1]) + (p1[2] + p1[3]));
                    S0 = S0 * w4 + (b4 * sa0 + k4 * vv[0]);
                    S1 = S1 * w4 + (b4 * sa1 + k4 * vv[1]);
                    const f32x4 q0 = S0 * r4, q1 = S1 * r4;
                    qp0[e] = (q0[0] + q0[1]) + (q0[2] + q0[3]); qp1[e] = (q1[0] + q1[1]) + (q1[2] + q1[3]);
                    a4 = na4; w4 = nw4; b4 = nb4; k4 = nk4; r4 = nr4; vv = nvv;
                }
#pragma unroll
                for (int e = 0; e < 8; ++e) { const float o0 = row16_sum(qp0[e]), o1 = row16_sum(qp1[e]);
                    if (kq == 0) *(LAS f32x2*)(obuf + (g * 8 + e) * 32 + vloc) = (f32x2){o0, o1}; }
            }
        }
        __syncthreads();
        if (blk + 1 < NBLK) store_block(buf0 + ((blk + 1) & 1) * TB * PER);
#pragma unroll
        for (int e = 0; e < 2; ++e) { const int idx = e * NT + tid; const int st = idx >> 5, vi = idx & 31;
            const int row = chain_row(b, d, blk * TB + st); RO[(size_t)row * 256 + h * 64 + vhalf * 32 + vi] = obuf[idx]; }
        __syncthreads();
    }
}


__device__ __forceinline__ void soft_bar4(volatile LAS unsigned* cnt, unsigned& gen, int lane) {
    asm volatile("s_waitcnt vmcnt(0) lgkmcnt(0)" ::: "memory");
    gen += 4u;
    if (lane == 0) __hip_atomic_fetch_add((LAS unsigned*)cnt, 1u, __ATOMIC_RELAXED, __HIP_MEMORY_SCOPE_WORKGROUP);
    while (*cnt < gen) { }
    asm volatile("" ::: "memory");
}
__device__ __forceinline__ void rwkv_scan_quarter(Frame& F, int ci, int vq, volatile LAS unsigned* cnt, unsigned& gen) {
    constexpr int TB = 32, NBLK = (CTX + SEQ) / TB;
    constexpr int RO_ = TB * 256, VO_ = TB * 320, BSZ = TB * 336;
    const float* RW = WSP(float, WS_RW);
    const int lane = F.lane, wave = F.wave, tid4 = wave * 64 + lane;
    const int b = ci >> 3, h = (ci >> 1) & 3, d = ci & 1;
    float* RO = WSP(float, WS_RWO) + (size_t)d * M_ALL * 256;
    LAS float* buf0 = (LAS float*)F.lds;
    LAS float* obuf0 = buf0 + 2 * BSZ;
    LAS float* obuf1 = (LAS float*)(F.lds + 147456);
    const int rr = lane >> 4, kq = lane & 15, vloc = wave * 4 + rr;
    float S0 = 0.f, S1 = 0.f, S2 = 0.f, S3 = 0.f;
    const int sgn = d ? -1 : 1;
    const int laneA = (rr == 0 ? 2 : (rr == 1 ? 3 + 3 * d : (rr == 2 ? 5 + 3 * d : 4 + 3 * d))) * 256 + 4 * kq;
    auto stage_block = [&](int blk, LAS float* dst) {
        const int s0 = blk * TB;
        const int row0 = (s0 < CTX) ? b * CTX + (d ? CTX - 1 - s0 : s0) : M_CTX + b * SEQ + (d ? SEQ - 1 - (s0 - CTX) : (s0 - CTX));
        const float* base = RW + (size_t)row0 * 2560 + h * 64;
#pragma unroll
        for (int i = 0; i < 8; ++i) { const int st = i * 4 + wave;
            __builtin_amdgcn_global_load_lds((const unsigned*)(base + (ptrdiff_t)(sgn * st) * 2560 + laneA), (LAS unsigned*)(dst + st * 256), 16, 0, 0); }
#pragma unroll
        for (int i = 0; i < 2; ++i) { const int s4 = wave * 2 + i, st = s4 * 4 + rr;
            __builtin_amdgcn_global_load_lds((const unsigned*)(base + (ptrdiff_t)(sgn * st) * 2560 + 4 * kq), (LAS unsigned*)(dst + RO_ + s4 * 256), 16, 0, 0); }
        if (wave < 2) { const int st = wave * 16 + (lane >> 2);
            __builtin_amdgcn_global_load_lds((const unsigned*)(base + (ptrdiff_t)(sgn * st) * 2560 + 256 + vq * 16 + (lane & 3) * 4), (LAS unsigned*)(dst + VO_ + wave * 256), 16, 0, 0); } };
    stage_block(0, buf0);
    soft_bar4(cnt, gen, lane);
    for (int blk = 0; blk < NBLK; ++blk) {
        LAS float* cb = buf0 + (blk & 1) * BSZ;
        LAS float* obuf = (blk & 1) ? obuf1 : obuf0;
        {
            struct SV { f32x4 a, w, b, k, r; float v; };
            SV xA, xB;
            { const LAS float* p = cb;
              xA.a = *(const LAS f32x4*)(p + 4 * kq); xA.w = *(const LAS f32x4*)(p + 64 + 4 * kq); xA.b = *(const LAS f32x4*)(p + 128 + 4 * kq);
              xA.k = *(const LAS f32x4*)(p + 192 + 4 * kq); xA.r = *(const LAS f32x4*)(p + RO_ + 4 * kq); xA.v = cb[VO_ + vloc]; }
            unsigned adA = (unsigned)(size_t)(cb + 4 * kq), adR = (unsigned)(size_t)(cb + RO_ + 4 * kq), adV = (unsigned)(size_t)(cb + VO_ + vloc);
            if (blk + 1 < NBLK) stage_block(blk + 1, buf0 + ((blk + 1) & 1) * BSZ);
#define RWK_STEP(CUR, NXT, E, QO) { float pa_, t0_, t1_, t2_, t3_; \
            asm volatile( \
                "v_mul_f32 %[pa], %[s0], %[a0]\n\t" \
                "ds_read_b128 %[na], %[adA] offset:%[oa]\n\t" \
                "v_fma_f32 %[pa], %[s1], %[a1], %[pa]\n\t" \
                "ds_read_b128 %[nw], %[adA] offset:%[ow]\n\t" \
                "v_fma_f32 %[pa], %[s2], %[a2], %[pa]\n\t" \
                "ds_read_b128 %[nb], %[adA] offset:%[ob]\n\t" \
                "v_fma_f32 %[pa], %[s3], %[a3], %[pa]\n\t" \
                "ds_read_b128 %[nk], %[adA] offset:%[ok]\n\t" \
                "ds_read_b128 %[nr], %[adR] offset:%[orr]\n\t" \
                "ds_read_b32 %[nv], %[adV] offset:%[ov]\n\t" \
                "v_mul_f32 %[t0], %[k0], %[vv]\n\t" \
                "v_add_f32_dpp %[pa], %[pa], %[pa] quad_perm:[1,0,3,2] row_mask:0xf bank_mask:0xf bound_ctrl:1\n\t" \
                "v_mul_f32 %[t1], %[k1], %[vv]\n\t" \
                "v_mul_f32 %[t2], %[k2], %[vv]\n\t" \
                "v_add_f32_dpp %[pa], %[pa], %[pa] quad_perm:[2,3,0,1] row_mask:0xf bank_mask:0xf bound_ctrl:1\n\t" \
                "v_mul_f32 %[t3], %[k3], %[vv]\n\t" \
                "v_fma_f32 %[t0], %[s0], %[w0], %[t0]\n\t" \
                "v_add_f32_dpp %[pa], %[pa], %[pa] row_half_mirror row_mask:0xf bank_mask:0xf bound_ctrl:1\n\t" \
                "v_fma_f32 %[t1], %[s1], %[w1], %[t1]\n\t" \
                "v_fma_f32 %[t2], %[s2], %[w2], %[t2]\n\t" \
                "v_add_f32_dpp %[pa], %[pa], %[pa] row_mirror row_mask:0xf bank_mask:0xf bound_ctrl:1\n\t" \
                "v_fma_f32 %[t3], %[s3], %[w3], %[t3]\n\t" \
                "v_fma_f32 %[s0], -%[b0], %[pa], %[t0]\n\t" \
                "v_fma_f32 %[s1], -%[b1], %[pa], %[t1]\n\t" \
                "v_fma_f32 %[s2], -%[b2], %[pa], %[t2]\n\t" \
                "v_mul_f32 %[q], %[s0], %[r0]\n\t" \
                "v_fma_f32 %[s3], -%[b3], %[pa], %[t3]\n\t" \
                "v_fma_f32 %[q], %[s1], %[r1], %[q]\n\t" \
                "v_fma_f32 %[q], %[s2], %[r2], %[q]\n\t" \
                "v_fma_f32 %[q], %[s3], %[r3], %[q]\n\t" \
                "s_waitcnt lgkmcnt(0)" \
                : [na] "=&v"(NXT.a), [nw] "=&v"(NXT.w), [nb] "=&v"(NXT.b), [nk] "=&v"(NXT.k), [nr] "=&v"(NXT.r), [nv] "=&v"(NXT.v), [q] "=&v"(QO), \
                  [s0] "+v"(S0), [s1] "+v"(S1), [s2] "+v"(S2), [s3] "+v"(S3), \
                  [pa] "=&v"(pa_), [t0] "=&v"(t0_), [t1] "=&v"(t1_), [t2] "=&v"(t2_), [t3] "=&v"(t3_) \
                : [adA] "v"(adA), [adR] "v"(adR), [adV] "v"(adV), \
                  [oa] "i"(((E) + 1) * 1024), [ow] "i"(((E) + 1) * 1024 + 256), [ob] "i"(((E) + 1) * 1024 + 512), [ok] "i"(((E) + 1) * 1024 + 768), [orr] "i"(((E) + 1) * 256), \
                  [ov] "i"(((E) + 1) * 64), \
                  [a0] "v"(CUR.a[0]), [a1] "v"(CUR.a[1]), [a2] "v"(CUR.a[2]), [a3] "v"(CUR.a[3]), \
                  [w0] "v"(CUR.w[0]), [w1] "v"(CUR.w[1]), [w2] "v"(CUR.w[2]), [w3] "v"(CUR.w[3]), \
                  [b0] "v"(CUR.b[0]), [b1] "v"(CUR.b[1]), [b2] "v"(CUR.b[2]), [b3] "v"(CUR.b[3]), \
                  [k0] "v"(CUR.k[0]), [k1] "v"(CUR.k[1]), [k2] "v"(CUR.k[2]), [k3] "v"(CUR.k[3]), \
                  [r0] "v"(CUR.r[0]), [r1] "v"(CUR.r[1]), [r2] "v"(CUR.r[2]), [r3] "v"(CUR.r[3]), [vv] "v"(CUR.v) \
                : "memory"); }
#pragma unroll 1
            for (int g = 0; g < TB / 8; ++g) {
                float qp[8];
                RWK_STEP(xA, xB, 0, qp[0]) RWK_STEP(xB, xA, 1, qp[1]) RWK_STEP(xA, xB, 2, qp[2]) RWK_STEP(xB, xA, 3, qp[3])
                RWK_STEP(xA, xB, 4, qp[4]) RWK_STEP(xB, xA, 5, qp[5]) RWK_STEP(xA, xB, 6, qp[6]) RWK_STEP(xB, xA, 7, qp[7])
                adA += 8 * 1024; adR += 8 * 256; adV += 8 * 64;
                { float n0, n1, n2, n3, m0, m1, tt, uu, oo;
                  asm volatile(
                    "v_add_f32_dpp %[n0], %[q0], %[q0] row_ror:8 row_mask:0xf bank_mask:0x3\n\t"
                    "v_add_f32_dpp %[n1], %[q1], %[q1] row_ror:8 row_mask:0xf bank_mask:0x3\n\t"
                    "v_add_f32_dpp %[n2], %[q2], %[q2] row_ror:8 row_mask:0xf bank_mask:0x3\n\t"
                    "v_add_f32_dpp %[n3], %[q3], %[q3] row_ror:8 row_mask:0xf bank_mask:0x3\n\t"
                    "v_add_f32_dpp %[n0], %[q4], %[q4] row_ror:8 row_mask:0xf bank_mask:0xc\n\t"
                    "v_add_f32_dpp %[n1], %[q5], %[q5] row_ror:8 row_mask:0xf bank_mask:0xc\n\t"
                    "v_add_f32_dpp %[n2], %[q6], %[q6] row_ror:8 row_mask:0xf bank_mask:0xc\n\t"
                    "v_add_f32_dpp %[n3], %[q7], %[q7] row_ror:8 row_mask:0xf bank_mask:0xc\n\t"
                    "v_add_f32_dpp %[m0], %[n0], %[n0] row_shl:4 row_mask:0xf bank_mask:0x5\n\t"
                    "v_add_f32_dpp %[m1], %[n1], %[n1] row_shl:4 row_mask:0xf bank_mask:0x5\n\t"
                    "v_add_f32_dpp %[m0], %[n2], %[n2] row_shr:4 row_mask:0xf bank_mask:0xa\n\t"
                    "v_add_f32_dpp %[m1], %[n3], %[n3] row_shr:4 row_mask:0xf bank_mask:0xa\n\t"
                    "v_cndmask_b32 %[tt], %[m0], %[m1], %[msk]\n\t"
                    "v_cndmask_b32 %[uu], %[m1], %[m0], %[msk]\n\t"
                    "s_nop 1\n\t"
                    "v_add_f32_dpp %[oo], %[uu], %[tt] quad_perm:[2,3,0,1] row_mask:0xf bank_mask:0xf\n\t"
                    "s_nop 1\n\t"
                    "v_add_f32_dpp %[oo], %[oo], %[oo] quad_perm:[1,0,3,2] row_mask:0xf bank_mask:0xf"
                    : [n0] "=&v"(n0), [n1] "=&v"(n1), [n2] "=&v"(n2), [n3] "=&v"(n3), [m0] "=&v"(m0), [m1] "=&v"(m1), [tt] "=&v"(tt), [uu] "=&v"(uu), [oo] "=&v"(oo)
                    : [q0] "v"(qp[0]), [q1] "v"(qp[1]), [q2] "v"(qp[2]), [q3] "v"(qp[3]), [q4] "v"(qp[4]), [q5] "v"(qp[5]), [q6] "v"(qp[6]), [q7] "v"(qp[7]), [msk] "s"(0xCCCCCCCCCCCCCCCCull));
                  if ((kq & 1) == 0) obuf[(g * 8 + (kq >> 1)) * 16 + vloc] = oo; }
            }
#undef RWK_STEP
        }
        soft_bar4(cnt, gen, lane);
#pragma unroll
        for (int e = 0; e < 2; ++e) { const int idx = e * 256 + tid4; const int st = idx >> 4, vi = idx & 15;
            const int row = chain_row(b, d, blk * TB + st); RO[(size_t)row * 256 + h * 64 + vq * 16 + vi] = obuf[idx]; }
    }
}
__device__ __forceinline__ void gdn_chain_wave(Frame& F, int ci, int vq, LAS bf16_t* St, LAS bf16_t* Vn) {
    const int lane = F.lane; int fr = lane & 15, fq = lane >> 4;
    const int b = ci >> 3, h = (ci >> 1) & 3, d = ci & 1;
    float* GO = WSP(float, WS_GDO) + (size_t)d * M_ALL * 512 + h * 128 + vq * 32;
    f32x4 S[8][2];
#pragma unroll
    for (int i = 0; i < 8; ++i) { S[i][0] = (f32x4){0.f, 0.f, 0.f, 0.f}; S[i][1] = S[i][0]; }
    for (int i = lane; i < 32 * 136 / 2; i += 64) ((LAS unsigned*)St)[i] = 0u;
#pragma unroll 1
    for (int n = 0; n < NCHUNK; ++n) {
        asm volatile("" : "+v"(fr), "+v"(fq));
        const unsigned char* rec = F.ws + WS_GPRE + (size_t)(ci * NCHUNK + n) * GREC;
        const GAS bf16_t* Wg = (const GAS bf16_t*)(rec + GR_W); const GAS bf16_t* Qg = (const GAS bf16_t*)(rec + GR_QG);
        const GAS bf16_t* Kg = (const GAS bf16_t*)(rec + GR_KT); const GAS bf16_t* Ag = (const GAS bf16_t*)(rec + GR_AT);
        const GAS float* Ug = (const GAS float*)(rec + GR_U) + vq * 32; const float eg = *(const GAS float*)(rec + GR_EG);
        const int s0 = n * 64; const int row0 = (s0 < CTX) ? b * CTX + (d ? CTX - 1 - s0 : s0) : M_CTX + b * SEQ + (d ? SEQ - 1 - (s0 - CTX) : (s0 - CTX)); const int sgn = d ? -1 : 1;
        const unsigned oW = (unsigned)(fr * 128 + fq * 8) * 2u, oK = (unsigned)(fr * 64 + fq * 8) * 2u, oU = (unsigned)((4 * fq) * 128 + fr) * 4u;
        const unsigned oG = (unsigned)((d ? 63 - 4 * fq : 4 * fq) * 512 + fr) * 4u;
        __builtin_assume(oW < 4096u); __builtin_assume(oK < 2048u); __builtin_assume(oU < 8192u); __builtin_assume(oG < 131072u);
        const GAS char* Wc = (const GAS char*)Wg; const GAS char* Qc = (const GAS char*)Qg; const GAS char* Kc = (const GAS char*)Kg; const GAS char* Ac = (const GAS char*)Ag; const GAS char* Uc = (const GAS char*)Ug;
        GAS char* Gc = (GAS char*)(GO + (size_t)(row0 - (d ? 63 : 0)) * 512);
        unsigned pf[3];
        { const unsigned char* nrec = rec + (n + 1 < NCHUNK ? GREC : 0);
#pragma unroll
          for (int i = 0; i < 3; ++i) { const int line = i * 256 + vq * 64 + lane; pf[i] = *(const GAS unsigned*)(nrec + (size_t)(line < 704 ? line : 703) * 128); }
          asm volatile("" ::: "memory"); }
        bf16x8 Bs[2][4];
#pragma unroll
        for (int j = 0; j < 2; ++j)
#pragma unroll
            for (int ks = 0; ks < 4; ++ks) Bs[j][ks] = *(const LAS bf16x8*)(St + (j * 16 + fr) * 136 + ks * 32 + fq * 8);
#pragma unroll
        for (int mh = 0; mh < 2; ++mh) { bf16x8 Aw[2][4]; float uu[2][2][4];
#pragma unroll
          for (int m2 = 0; m2 < 2; ++m2) { const int m = mh * 2 + m2;
#pragma unroll
            for (int ks = 0; ks < 4; ++ks) Aw[m2][ks] = *(const GAS bf16x8*)(Wc + (oW + (unsigned)(m * 4096 + ks * 64)));
#pragma unroll
            for (int j = 0; j < 2; ++j)
#pragma unroll
                for (int r = 0; r < 4; ++r) uu[m2][j][r] = *(const GAS float*)(Uc + (oU + (unsigned)((m * 16 + r) * 512 + j * 64))); }
          asm volatile("" ::: "memory");
#pragma unroll
          for (int m2 = 0; m2 < 2; ++m2) { const int m = mh * 2 + m2;
#pragma unroll
            for (int j = 0; j < 2; ++j) { f32x4 acc = (f32x4){0.f, 0.f, 0.f, 0.f};
#pragma unroll
                for (int ks = 0; ks < 4; ++ks) acc = __builtin_amdgcn_mfma_f32_16x16x32_bf16(Aw[m2][ks], Bs[j][ks], acc, 0, 0, 0);
                u32x2 pk; pk.x = pk2(uu[m2][j][0] - acc[0], uu[m2][j][1] - acc[1]); pk.y = pk2(uu[m2][j][2] - acc[2], uu[m2][j][3] - acc[3]);
                *(LAS u32x2*)(Vn + (j * 16 + fr) * 72 + m * 16 + 4 * fq) = pk; } } }
        bf16x8 Bv[2][2];
#pragma unroll
        for (int j = 0; j < 2; ++j)
#pragma unroll
            for (int ks = 0; ks < 2; ++ks) Bv[j][ks] = *(const LAS bf16x8*)(Vn + (j * 16 + fr) * 72 + ks * 32 + fq * 8);
#pragma unroll
        for (int mh = 0; mh < 2; ++mh) { bf16x8 Aq[2][4], Aa[2][2];
#pragma unroll
            for (int m2 = 0; m2 < 2; ++m2) { const int m = mh * 2 + m2;
#pragma unroll
                for (int ks = 0; ks < 4; ++ks) Aq[m2][ks] = *(const GAS bf16x8*)(Qc + (oW + (unsigned)(m * 4096 + ks * 64)));
#pragma unroll
                for (int ks = 0; ks < 2; ++ks) Aa[m2][ks] = *(const GAS bf16x8*)(Ac + (oK + (unsigned)(m * 2048 + ks * 64))); }
            asm volatile("" ::: "memory");
#pragma unroll
            for (int m2 = 0; m2 < 2; ++m2) { const int m = mh * 2 + m2;
#pragma unroll
                for (int j = 0; j < 2; ++j) { f32x4 acc = (f32x4){0.f, 0.f, 0.f, 0.f};
#pragma unroll
                    for (int ks = 0; ks < 4; ++ks) acc = __builtin_amdgcn_mfma_f32_16x16x32_bf16(Aq[m2][ks], Bs[j][ks], acc, 0, 0, 0);
#pragma unroll
                    for (int ks = 0; ks < 2; ++ks) acc = __builtin_amdgcn_mfma_f32_16x16x32_bf16(Aa[m2][ks], Bv[j][ks], acc, 0, 0, 0);
#pragma unroll
                    for (int r = 0; r < 4; ++r) *(GAS float*)(Gc + (unsigned)((int)oG + sgn * ((m * 16 + r) * 2048) + j * 64)) = acc[r]; } } }
        { bf16x8 Ak[8][2];
#pragma unroll
          for (int i = 0; i < 8; ++i)
#pragma unroll
            for (int ks = 0; ks < 2; ++ks) Ak[i][ks] = *(const GAS bf16x8*)(Kc + (oK + (unsigned)(i * 2048 + ks * 64)));
          asm volatile("" ::: "memory");
#pragma unroll
          for (int i = 0; i < 8; ++i)
#pragma unroll
            for (int j = 0; j < 2; ++j) { f32x4 acc = S[i][j] * eg;
#pragma unroll
                for (int ks = 0; ks < 2; ++ks) acc = __builtin_amdgcn_mfma_f32_16x16x32_bf16(Ak[i][ks], Bv[j][ks], acc, 0, 0, 0);
                S[i][j] = acc;
                u32x2 pk; pk.x = pk2(acc[0], acc[1]); pk.y = pk2(acc[2], acc[3]);
                *(LAS u32x2*)(St + (j * 16 + fr) * 136 + i * 16 + 4 * fq) = pk; } }
        asm volatile("" :: "v"(pf[0]), "v"(pf[1]), "v"(pf[2]));
    }
}

__device__ __forceinline__ void hyena_lat_unit(Frame& F, int l, int c) {
    constexpr int CPS = 8192 + 32;
    constexpr int VST = 2184;
    LAS unsigned char* cp = F.lds;
    LAS bf16_t* vv = (LAS bf16_t*)(F.lds + 8 * CPS);
    const int tid = F.tid, lane = F.lane, wave = F.wave;
    const float* g = WSP(float, WS_FILT) + ((size_t)l * 256 + c) * (2 * SEQ);
    const float* V = WSP(float, WS_VVT) + (size_t)c * NB * (CTX + SEQ);
    float* Y = WSP(float, WS_YT) + (size_t)c * NB * (CTX + SEQ);
    { float gv[8][8];
#pragma unroll
      for (int k = 0; k < 8; ++k) { const int i = tid + k * NT, r = i >> 9, n = i & 511;
#pragma unroll
          for (int e = 0; e < 8; ++e) { const int gi = 8 * n + r + e; gv[k][e] = (gi >= 1 && gi <= 4095) ? g[gi] : 0.f; } }
      asm volatile("" ::: "memory");
#pragma unroll
      for (int k = 0; k < 8; ++k) { const int i = tid + k * NT, r = i >> 9, n = i & 511;
          u32x4 p; p.x = pk2(gv[k][0], gv[k][1]); p.y = pk2(gv[k][2], gv[k][3]); p.z = pk2(gv[k][4], gv[k][5]); p.w = pk2(gv[k][6], gv[k][7]);
          *(LAS u32x4*)(cp + r * CPS + n * 16) = p; } }
    { float vb[5][8];
#pragma unroll
      for (int k = 0; k < 5; ++k) { const int i = tid + k * NT; const int bb = (i < 8 * 272) ? i / 272 : 0, gq = (i < 8 * 272) ? i % 272 : 0; const int s0 = gq * 8 - 64;
#pragma unroll
          for (int e = 0; e < 8; ++e) vb[k][e] = (i < 8 * 272 && s0 >= 0 && s0 < SEQ) ? V[(size_t)bb * (CTX + SEQ) + CTX + s0 + 7 - e] : 0.f; }
      asm volatile("" ::: "memory");
#pragma unroll
      for (int k = 0; k < 5; ++k) { const int i = tid + k * NT; if (i < 8 * 272) { const int bb = i / 272, gq = i % 272;
          u32x4 p; p.x = pk2(vb[k][0], vb[k][1]); p.y = pk2(vb[k][2], vb[k][3]); p.z = pk2(vb[k][4], vb[k][5]); p.w = pk2(vb[k][6], vb[k][7]);
          *(LAS u32x4*)(vv + bb * VST + gq * 8) = p; } } }
    __syncthreads();
    const int fr = lane & 15, fq = lane >> 4;
    const int rcp = (fr + 1) & 7;
    const int bcol = fr & 7, pb = fr >> 3;
    f32x4 acc[2][4];
#pragma unroll
    for (int p = 0; p < 2; ++p)
#pragma unroll
        for (int m = 0; m < 4; ++m) acc[p][m] = (f32x4){0.f, 0.f, 0.f, 0.f};
    const int P0 = 2 * wave;
    const int dlo = 2 * P0 - 31 < -31 ? -31 : 2 * P0 - 31, dhi = 2 * (P0 + 1) + 1 > 31 ? 31 : 2 * (P0 + 1) + 1;
    for (int d = dlo; d <= dhi; ++d) {
        bf16x8 A[4][2];
#pragma unroll
        for (int m = 0; m < 4; ++m)
#pragma unroll
            for (int s = 0; s < 2; ++s) { const int a = d * 64 + 16 * m + fr - 32 * s - 8 * fq - 7 + 2048;
                A[m][s] = *(const LAS bf16x8*)(cp + rcp * CPS + ((a - rcp) >> 3) * 16); }
#pragma unroll
        for (int p = 0; p < 2; ++p) { const int Pp = P0 + p; if (d > 2 * Pp + 1 || d < 2 * Pp - 31) continue;
            const int J = 2 * Pp + pb - d;
#pragma unroll
            for (int s = 0; s < 2; ++s) { const bf16x8 B = *(const LAS bf16x8*)(vv + bcol * VST + (J + 1) * 64 + 32 * s + 8 * fq);
#pragma unroll
                for (int m = 0; m < 4; ++m) acc[p][m] = __builtin_amdgcn_mfma_f32_16x16x32_bf16(A[m][s], B, acc[p][m], 0, 0, 0); } }
    }
#pragma unroll
    for (int p = 0; p < 2; ++p)
#pragma unroll
        for (int m = 0; m < 4; ++m) { const int t = 64 * (2 * (P0 + p) + pb) + 16 * m + 4 * fq;
            *(f32x4*)(Y + (size_t)bcol * (CTX + SEQ) + CTX + t) = acc[p][m]; }
    __syncthreads();
}
__device__ __forceinline__ void hyena_ctx_unit(Frame& F, int l, int c) {
    LAS float* gl = (LAS float*)F.lds;
    LAS float* vl = gl + 512;
    const int tid = F.tid, lane = F.lane, wave = F.wave;
    const float* g = WSP(float, WS_FILTC) + ((size_t)l * 256 + c) * (2 * CTX);
    const float* V = WSP(float, WS_VVT) + (size_t)c * NB * (CTX + SEQ);
    float* Y = WSP(float, WS_YT) + (size_t)c * NB * (CTX + SEQ);
    gl[tid] = (tid >= 1) ? g[tid] : 0.f;
    for (int i = tid; i < 8 * 256; i += NT) vl[i] = V[(size_t)(i >> 8) * (CTX + SEQ) + (i & 255)];
    __syncthreads();
    float a[4] = {0.f, 0.f, 0.f, 0.f};
    for (int s = 0; s < CTX; ++s) { const float v = vl[wave * 256 + s];
#pragma unroll
        for (int j = 0; j < 4; ++j) a[j] += gl[lane + 64 * j - s + 256] * v; }
#pragma unroll
    for (int j = 0; j < 4; ++j) Y[(size_t)wave * (CTX + SEQ) + lane + 64 * j] = a[j];
    __syncthreads();
}

__device__ __forceinline__ void phase_finish(Frame& F, int l, bool with_ctx) {
    const float* __restrict__ P = WSP(float, WS_P); const float* __restrict__ YT = WSP(float, WS_YT);
    const float* __restrict__ RW = WSP(float, WS_RW); const float* __restrict__ BON = WSP(float, WS_RWBON);
    const float* __restrict__ RO = WSP(float, WS_RWO); const float* __restrict__ GO = WSP(float, WS_GDO);
    bf16_t* __restrict__ YC = WSP(bf16_t, WS_YCAT);
    const float* sw = F.in[I_HSW] + (size_t)l * 3 * 768; const float* sb = F.in[I_HSB] + (size_t)l * 768;
    const float* gnw = F.in[I_RGNW] + l * 256; const float* gnb = F.in[I_RGNB] + l * 256; const float* gdw = F.in[I_GNW] + l * 128;
    LAS float* tile = (LAS float*)F.lds;
    const int tid = F.tid, lane = F.lane, wave = F.wave;
    const f32x4 pgw4 = *(const f32x4*)(gnw + 4 * lane), pgb4 = *(const f32x4*)(gnb + 4 * lane);
    const f32x4 pdwA = *(const f32x4*)(gdw + ((8 * lane) & 127)), pdwB = *(const f32x4*)(gdw + ((8 * lane) & 127) + 4);
    const bool cut = with_ctx && F.G == 256;
    for (int it_ = 0; ; ++it_) {
        int u, parts;
        if (cut) { if (it_ == 0) { u = F.bid; parts = 3; }
                   else if (it_ == 1 && F.bid >= 32 && F.bid < 64) { u = 256 + F.bid - 32; parts = 1; }
                   else if (it_ == 1 && F.bid >= 64 && F.bid < 96) { u = 256 + F.bid - 64; parts = 2; }
                   else break; }
        else { u = F.bid + it_ * F.G; parts = 3; if (u >= M_ALL / 64) break; }
        const int row0 = u * 64; const bool isctx = row0 < M_CTX; if (isctx && !with_ctx) continue;
        const int L = isctx ? CTX : SEQ; const int b = row_batch(row0); const int t0 = isctx ? row0 - b * CTX : row0 - M_CTX - b * SEQ;
        const int pos0 = isctx ? t0 : CTX + t0;
        if (parts & 1) {
        { float tmp[32];
#pragma unroll
          for (int k = 0; k < 32; ++k) { const int i = tid + k * NT, cc = i >> 6, tl = i & 63; tmp[k] = YT[((size_t)cc * NB + b) * (CTX + SEQ) + pos0 + tl]; }
          asm volatile("" ::: "memory");
#pragma unroll
          for (int k = 0; k < 32; ++k) { const int i = tid + k * NT, cc = i >> 6, tl = i & 63; tile[cc * 65 + tl] = tmp[k]; } }
        __syncthreads();
        { const int c2 = 2 * (tid & 127), tq = tid >> 7;
          const f32x2 wa = *(const f32x2*)(sw + c2), wb = *(const f32x2*)(sw + 768 + c2), wc_ = *(const f32x2*)(sw + 2 * 768 + c2), b0 = *(const f32x2*)(sb + c2);
          const float* pc = P + (size_t)(row0 + tq * 16) * PW + c2; f32x2 xr[18];
#pragma unroll
          for (int k = 0; k < 18; ++k) { const int t = t0 + tq * 16 + k - 1; xr[k] = (t >= 0 && t < L) ? *(const f32x2*)(pc + (ptrdiff_t)(k - 1) * PW) : (f32x2){0.f, 0.f}; }
          asm volatile("" ::: "memory");
#pragma unroll
          for (int tt = 0; tt < 16; ++tt) { const int tl = tq * 16 + tt; const f32x2 x0 = b0 + wa * xr[tt] + wb * xr[tt + 1] + wc_ * xr[tt + 2];
              *(unsigned*)(YC + (size_t)(row0 + tl) * D + c2) = pk2(tile[c2 * 65 + tl] * x0.x, tile[(c2 + 1) * 65 + tl] * x0.y); } }
        }
        if (parts & 2)
#pragma unroll 1
        for (int tp = 0; tp < 2; ++tp) {
            f32x4 ro[4][2], rv[4], rg[4], go[4][4], zz[4][2]; float bo[4];
#pragma unroll
            for (int s4 = 0; s4 < 4; ++s4) { const int row = row0 + wave * 8 + tp * 4 + s4; const float* rw = RW + (size_t)row * 2560;
                ro[s4][0] = *(const f32x4*)(RO + (size_t)row * 256 + 4 * lane); ro[s4][1] = *(const f32x4*)(RO + (size_t)(M_ALL + row) * 256 + 4 * lane);
                bo[s4] = BON[(size_t)row * 4 + (lane >> 4)]; rv[s4] = *(const f32x4*)(rw + 256 + 4 * lane); rg[s4] = *(const f32x4*)(rw + 9 * 256 + 4 * lane);
                go[s4][0] = *(const f32x4*)(GO + (size_t)row * 512 + 8 * lane); go[s4][1] = *(const f32x4*)(GO + (size_t)row * 512 + 8 * lane + 4);
                go[s4][2] = *(const f32x4*)(GO + (size_t)(M_ALL + row) * 512 + 8 * lane); go[s4][3] = *(const f32x4*)(GO + (size_t)(M_ALL + row) * 512 + 8 * lane + 4);
                zz[s4][0] = *(const f32x4*)(P + (size_t)row * PW + C_GD + 1536 + 8 * lane); zz[s4][1] = *(const f32x4*)(P + (size_t)row * PW + C_GD + 1536 + 8 * lane + 4); }
            asm volatile("" ::: "memory");
#pragma unroll
            for (int s4 = 0; s4 < 4; ++s4) { const int row = row0 + wave * 8 + tp * 4 + s4;
                { const f32x4 o = ro[s4][0] + ro[s4][1];
                  const float mean = row16_sum((o.x + o.y) + (o.z + o.w)) * (1.f / 64.f); const f32x4 dv = o - mean;
                  const float var = row16_sum((dv.x * dv.x + dv.y * dv.y) + (dv.z * dv.z + dv.w * dv.w)) * (1.f / 64.f);
                  f32x4 y = dv * rsqrtf(var + 64e-5f) * pgw4 + pgb4;
                  y = (y + rv[s4] * bo[s4]) * rg[s4];
                  u32x2 p; p.x = pk2(y.x, y.y); p.y = pk2(y.z, y.w);
                  *(u32x2*)(YC + (size_t)row * D + 256 + 4 * lane) = p; }
                { const f32x4 oa = go[s4][0] + go[s4][2], ob = go[s4][1] + go[s4][3];
                  const float ss = ((oa.x * oa.x + oa.y * oa.y) + (oa.z * oa.z + oa.w * oa.w)) + ((ob.x * ob.x + ob.y * ob.y) + (ob.z * ob.z + ob.w * ob.w));
                  const float rs = rsqrtf(row16_sum(ss) * (1.f / 128.f) + 1e-6f);
                  const f32x4 za = zz[s4][0], zb = zz[s4][1];
                  const f32x4 ya = oa * rs * pdwA * (f32x4){siluf_(za.x), siluf_(za.y), siluf_(za.z), siluf_(za.w)};
                  const f32x4 yb = ob * rs * pdwB * (f32x4){siluf_(zb.x), siluf_(zb.y), siluf_(zb.z), siluf_(zb.w)};
                  u32x4 p; p.x = pk2(ya.x, ya.y); p.y = pk2(ya.z, ya.w); p.z = pk2(yb.x, yb.y); p.w = pk2(yb.z, yb.w);
                  *(u32x4*)(YC + (size_t)row * D + 512 + 8 * lane) = p; } }
        }
        __syncthreads();
    }
}

__device__ __forceinline__ void phase_router(Frame& F, int l, int row_lo, bool dummy = false) {
    const float* H = WSP(float, WS_H); const float* mods = WSP(float, WS_MODS) + (size_t)l * 9 * (NMOD * D);
    bf16_t* N = WSP(bf16_t, WS_N);
    const float* rw = F.in[I_MRW] + (size_t)l * D * NE; const float* rb = F.in[I_MRB] + l * NE;
    unsigned* cnt = (unsigned*)(F.ws + WS_CTL) + CW_CNT + l * NE * 64 + (dummy ? 100000 : 0);
    const size_t doff = dummy ? (WS_END - WS_STOK) : 0;
    int* stok = WSP(int, WS_STOK + doff); int* toke = WSP(int, WS_TOKE + doff); int* tokr = WSP(int, WS_TOKE + MiB + doff); float* tokg = WSP(float, WS_TOKE + 2 * MiB + doff);
    constexpr int XS = 1028;
    LAS float* xr = (LAS float*)F.lds;
    LAS float* red = xr + 16 * XS;
    LAS float* lg = red + 8 * 16 * 32;
    const int tid = F.tid, lane = F.lane, wave = F.wave;
    for (int u = F.bid; u < (M_ALL - row_lo) / 16; u += F.G) {
        const int row0 = row_lo + u * 16;
        for (int tk = 0; tk < 2; ++tk) { const int tl = wave * 2 + tk, row = row0 + tl; const float* mr = mods + (size_t)row_modr(row) * (NMOD * D);
            norm_mod_row<true>(H + (size_t)row * D, F.in[I_NFFN] + l * D, mr + 3 * D, mr + 4 * D, N + (size_t)row * D, xr + tl * XS, lane); }
        __syncthreads();
        { const int tl = lane >> 2, eq = lane & 3; float acc[8];
#pragma unroll
          for (int j = 0; j < 8; ++j) acc[j] = 0.f;
          const LAS float* xp = xr + tl * XS + 128 * wave; const float* wp = rw + (size_t)(128 * wave) * NE + eq * 8;
#pragma unroll 1
          for (int kb = 0; kb < 8; ++kb) { f32x4 wv[16][2];
#pragma unroll
              for (int kk = 0; kk < 16; ++kk) { wv[kk][0] = *(const f32x4*)(wp + (size_t)(16 * kb + kk) * NE); wv[kk][1] = *(const f32x4*)(wp + (size_t)(16 * kb + kk) * NE + 4); }
              asm volatile("" ::: "memory");
#pragma unroll
              for (int k4 = 0; k4 < 4; ++k4) { const f32x4 x4 = *(const LAS f32x4*)(xp + 16 * kb + 4 * k4);
#pragma unroll
                  for (int kk = 0; kk < 4; ++kk)
#pragma unroll
                      for (int i = 0; i < 4; ++i) { acc[i] += x4[kk] * wv[4 * k4 + kk][0][i]; acc[4 + i] += x4[kk] * wv[4 * k4 + kk][1][i]; } } }
          LAS float* rp = red + (wave * 16 + tl) * 32 + eq * 8;
          *(LAS f32x4*)rp = (f32x4){acc[0], acc[1], acc[2], acc[3]}; *(LAS f32x4*)(rp + 4) = (f32x4){acc[4], acc[5], acc[6], acc[7]}; }
        __syncthreads();
        { const int tl = tid >> 5, e = tid & 31; float a = rb[e];
#pragma unroll
          for (int w = 0; w < 8; ++w) a += red[(w * 16 + tl) * 32 + e];
          lg[tl * 33 + e] = a; }
        __syncthreads();
        if (tid < 16) { const int row = row0 + tid; float v[NE];
#pragma unroll
            for (int e = 0; e < NE; ++e) v[e] = lg[tid * 33 + e];
            int sel[4]; float sv[4];
#pragma unroll
            for (int k = 0; k < 4; ++k) { float best = -3.0e38f; int bi = 0;
#pragma unroll
                for (int e = 0; e < NE; ++e) { const bool taken = (k > 0 && sel[0] == e) || (k > 1 && sel[1] == e) || (k > 2 && sel[2] == e);
                    if (!taken && v[e] > best) { best = v[e]; bi = e; } }
                sel[k] = bi; sv[k] = best; }
            float ex[4], den = 0.f;
#pragma unroll
            for (int k = 0; k < 4; ++k) { ex[k] = __expf(sv[k] - sv[0]); den += ex[k]; }
#pragma unroll
            for (int k = 0; k < 4; ++k) { const unsigned rk = atomicAdd(cnt + sel[k] * 64, 1u);
                stok[(size_t)sel[k] * M_ALL + rk] = row; toke[(size_t)row * 4 + k] = sel[k]; tokr[(size_t)row * 4 + k] = (int)rk; tokg[(size_t)row * 4 + k] = ex[k] / den; } }
        __syncthreads();
    }
}


__device__ __forceinline__ void phase_router2(Frame& F, int l, int row_lo, bool dummy = false) {
    const float* __restrict__ H = WSP(float, WS_H); const float* __restrict__ mods = WSP(float, WS_MODS) + (size_t)l * 9 * (NMOD * D);
    bf16_t* __restrict__ N = WSP(bf16_t, WS_N);
    const float* __restrict__ rw = F.in[I_MRW] + (size_t)l * D * NE; const float* __restrict__ rb = F.in[I_MRB] + l * NE; const float* __restrict__ nw = F.in[I_NFFN] + l * D;
    unsigned* cnt = (unsigned*)(F.ws + WS_CTL) + CW_CNT + l * NE * 64 + (dummy ? 100000 : 0);
    const size_t doff = dummy ? (WS_END - WS_STOK) : 0;
    int* __restrict__ stok = WSP(int, WS_STOK + doff); int* __restrict__ toke = WSP(int, WS_TOKE + doff); int* __restrict__ tokr = WSP(int, WS_TOKE + MiB + doff); float* __restrict__ tokg = WSP(float, WS_TOKE + 2 * MiB + doff);
    constexpr int WS_ = 1028;
    LAS float* WT = (LAS float*)F.lds;
    LAS unsigned* lcnt = (LAS unsigned*)(F.lds + 32 * WS_ * 4);
    LAS int* recs = (LAS int*)(lcnt + 64);
    const int tid = F.tid, lane = F.lane;
    if (tid < 64) lcnt[tid] = 0u;
#pragma unroll 1
    for (int fb = 0; fb < 4; ++fb) { float tv[16];
#pragma unroll
        for (int q = 0; q < 16; ++q) tv[q] = rw[tid + (fb * 16 + q) * NT];
        asm volatile("" ::: "memory");
#pragma unroll
        for (int q = 0; q < 16; ++q) { const int i = tid + (fb * 16 + q) * NT, k = i >> 5, e = i & 31; WT[e * WS_ + k] = tv[q]; } }
    __syncthreads();
    const int gw = F.bid * NWV + F.wave, NGW = F.G * NWV, npair = (M_ALL - row_lo) / 2;
    const bool agg = (npair + NGW - 1) / NGW <= 5;
    const float rbl = rb[lane & 31];
#pragma unroll 1
    for (int p = gw; p < npair; p += NGW) {
        const int row = row_lo + 2 * p; const float* mr = mods + (size_t)row_modr(row) * (NMOD * D);
        f32x4 hv[2][4], wv[4], sh[4], sc[4];
#pragma unroll
        for (int j = 0; j < 4; ++j) { const int c = 4 * lane + 256 * j; hv[0][j] = *(const f32x4*)(H + (size_t)row * D + c); hv[1][j] = *(const f32x4*)(H + (size_t)(row + 1) * D + c);
            wv[j] = *(const f32x4*)(nw + c); sh[j] = *(const f32x4*)(mr + 3 * D + c); sc[j] = *(const f32x4*)(mr + 4 * D + c); }
        asm volatile("" ::: "memory");
        f32x4 x[2][4];
#pragma unroll
        for (int t = 0; t < 2; ++t) { float s = 0.f;
#pragma unroll
            for (int j = 0; j < 4; ++j) s += (hv[t][j].x * hv[t][j].x + hv[t][j].y * hv[t][j].y) + (hv[t][j].z * hv[t][j].z + hv[t][j].w * hv[t][j].w);
            const float rstd = rsqrtf(wave_sum(s) * (1.f / D) + 1e-6f);
#pragma unroll
            for (int j = 0; j < 4; ++j) { const int c = 4 * lane + 256 * j; const f32x4 o = (hv[t][j] * rstd) * wv[j] * (sc[j] + 1.0f) + sh[j]; x[t][j] = o;
                u32x2 pk; pk.x = pk2(o.x, o.y); pk.y = pk2(o.z, o.w); *(u32x2*)(N + (size_t)(row + t) * D + c) = pk; } }
        float ac[64];
#pragma unroll
        for (int e = 0; e < NE; ++e) { float a0 = 0.f, a1 = 0.f;
#pragma unroll
            for (int j = 0; j < 4; ++j) { const f32x4 w4 = *(const LAS f32x4*)(WT + e * WS_ + 4 * lane + 256 * j);
                a0 += (x[0][j].x * w4.x + x[0][j].y * w4.y) + (x[0][j].z * w4.z + x[0][j].w * w4.w);
                a1 += (x[1][j].x * w4.x + x[1][j].y * w4.y) + (x[1][j].z * w4.z + x[1][j].w * w4.w); }
            ac[e] = a0; ac[32 + e] = a1; }
#define RS_DPP(old_, src_, ctrl_, bm_) __builtin_bit_cast(float, __builtin_amdgcn_update_dpp(__builtin_bit_cast(int, old_), __builtin_bit_cast(int, src_), ctrl_, 0xF, bm_, false))
#pragma unroll
        for (int v = 0; v < 64; ++v) if ((v & 8) == 0) { const float lo = ac[v], hi = ac[v | 8];
            ac[v] = RS_DPP(hi, lo, 0x128, 0x3) + RS_DPP(lo, hi, 0x128, 0xC); }
#pragma unroll
        for (int v = 0; v < 64; ++v) if ((v & 12) == 0) { const float lo = ac[v], hi = ac[v | 4];
            ac[v] = RS_DPP(hi, lo, 0x104, 0x5) + RS_DPP(lo, hi, 0x114, 0xA); }
        { const bool b1 = (lane & 2) != 0, b0 = (lane & 1) != 0, b4 = (lane & 16) != 0, b5 = (lane & 32) != 0;
#pragma unroll
          for (int v = 0; v < 64; ++v) if ((v & 14) == 0) { const float lo = ac[v], hi = ac[v | 2]; const float keep = b1 ? hi : lo, send = b1 ? lo : hi; ac[v] = keep + dppf<0x4E>(send); }
#pragma unroll
          for (int v = 0; v < 64; ++v) if ((v & 15) == 0) { const float lo = ac[v], hi = ac[v | 1]; const float keep = b0 ? hi : lo, send = b0 ? lo : hi; ac[v] = keep + dppf<0xB1>(send); }
#pragma unroll
          for (int v = 0; v < 64; ++v) if ((v & 31) == 0) { const float lo = ac[v], hi = ac[v | 16]; const float keep = b4 ? hi : lo, send = b4 ? lo : hi;
              ac[v] = keep + __builtin_bit_cast(float, __builtin_amdgcn_ds_swizzle(__builtin_bit_cast(int, send), 0x401F)); }
          { const float lo = ac[0], hi = ac[32]; const float keep = b5 ? hi : lo, send = b5 ? lo : hi;
              ac[0] = keep + __builtin_bit_cast(float, __builtin_amdgcn_ds_bpermute((lane ^ 32) << 2, __builtin_bit_cast(int, send))); } }
#undef RS_DPP
        float vl = ac[0] + rbl;
        int sel[2][4]; float sv[2][4];
#pragma unroll
        for (int k = 0; k < 4; ++k) { float m = vl;
            m = fmaxf(m, dppf<0xB1>(m)); m = fmaxf(m, dppf<0x4E>(m)); m = fmaxf(m, dppf<0x141>(m)); m = fmaxf(m, dppf<0x140>(m));
            m = fmaxf(m, __builtin_bit_cast(float, __builtin_amdgcn_update_dpp(__builtin_bit_cast(int, -3.0e38f), __builtin_bit_cast(int, m), 0x142, 0xA, 0xF, false)));
            const float m0 = __builtin_bit_cast(float, __builtin_amdgcn_readlane(__builtin_bit_cast(int, m), 31)), m1 = __builtin_bit_cast(float, __builtin_amdgcn_readlane(__builtin_bit_cast(int, m), 63));
            const unsigned long long bal = __ballot(vl == (lane < 32 ? m0 : m1));
            const int b0 = __ffs((unsigned)bal) - 1, b1 = __ffs((unsigned)(bal >> 32)) - 1;
            sel[0][k] = b0; sel[1][k] = b1; sv[0][k] = m0; sv[1][k] = m1;
            if (lane == b0 || lane == 32 + b1) vl = -3.0e38f; }
        float gt_[2][4];
#pragma unroll
        for (int t = 0; t < 2; ++t) { float ex[4], den = 0.f;
#pragma unroll
            for (int k = 0; k < 4; ++k) { ex[k] = __expf(sv[t][k] - sv[t][0]); den += ex[k]; }
#pragma unroll
            for (int k = 0; k < 4; ++k) gt_[t][k] = ex[k] / den; }
        if (lane == 0) {
          if (agg) { const int pi = (p - gw) / NGW;
#pragma unroll
            for (int t = 0; t < 2; ++t) { const int r_ = row + t;
#pragma unroll
                for (int k = 0; k < 4; ++k) { const unsigned lr = __hip_atomic_fetch_add(lcnt + sel[t][k], 1u, __ATOMIC_RELAXED, __HIP_MEMORY_SCOPE_WORKGROUP);
                    recs[(F.wave * 5 + pi) * 8 + t * 4 + k] = (sel[t][k] << 16) | (int)lr;
                    toke[(size_t)r_ * 4 + k] = sel[t][k]; tokg[(size_t)r_ * 4 + k] = gt_[t][k]; } } }
          else { unsigned rk[2][4];
#pragma unroll
            for (int t = 0; t < 2; ++t)
#pragma unroll
                for (int k = 0; k < 4; ++k) rk[t][k] = atomicAdd(cnt + sel[t][k] * 64, 1u);
#pragma unroll
            for (int t = 0; t < 2; ++t) { const int r_ = row + t;
#pragma unroll
                for (int k = 0; k < 4; ++k) { stok[(size_t)sel[t][k] * M_ALL + rk[t][k]] = r_; toke[(size_t)r_ * 4 + k] = sel[t][k]; tokr[(size_t)r_ * 4 + k] = (int)rk[t][k]; tokg[(size_t)r_ * 4 + k] = gt_[t][k]; } } } }
    }
    if (!agg) return;
    __syncthreads();
    if (tid < NE) lcnt[32 + tid] = atomicAdd(cnt + tid * 64, lcnt[tid]);
    __syncthreads();
    { const int np_ = gw < npair ? (npair - gw + NGW - 1) / NGW : 0;
      if (lane < np_ * 8) { const int pi = lane >> 3, t = (lane >> 2) & 1, k = lane & 3; const int rc = recs[(F.wave * 5 + pi) * 8 + t * 4 + k];
          const int e = rc >> 16; const unsigned slot = lcnt[32 + e] + (unsigned)(rc & 0xffff); const int r_ = row_lo + 2 * (gw + pi * NGW) + t;
          stok[(size_t)e * M_ALL + slot] = r_; tokr[(size_t)r_ * 4 + k] = (int)slot; } }
}

__device__ __forceinline__ void moe_prefix(Frame& F, int l, LAS int* pref) {
    const unsigned* cnt = (const unsigned*)(F.ws + WS_CTL) + CW_CNT + l * NE * 64;
    if (F.tid < NE) { const int c = (int)__hip_atomic_load(cnt + F.tid * 64, __ATOMIC_RELAXED, __HIP_MEMORY_SCOPE_AGENT); pref[64 + F.tid] = c; pref[128 + F.tid] = (c + 255) >> 8; }
    __syncthreads();
    if (F.tid == 0) { int a = 0;
#pragma unroll
        for (int e = 0; e < NE; ++e) { pref[e] = a; a += pref[128 + e]; }
        pref[32] = a; }
    if (F.tid >= 64 && F.tid < 64 + NE) { const int e = F.tid - 64; const int mine = pref[128 + e]; int r = 0;
#pragma unroll
        for (int o = 0; o < NE; ++o) { const int v = pref[128 + o]; r += (v > mine || (v == mine && o < e)) ? 1 : 0; }
        const int rnd = r >> 3, w = r & 7, xcd = (rnd & 1) ? 7 - w : w; pref[160 + xcd * 4 + rnd] = e; }
    __syncthreads();
}

__device__ __forceinline__ void phase_combine(Frame& F, int l, int row_lo, LAS int* pref, float tsc = 1.0f) {
    float* H = WSP(float, WS_H); const float* __restrict__ mods = WSP(float, WS_MODS);
    const bf16_t* __restrict__ YB = WSP(bf16_t, WS_YB); bf16_t* __restrict__ N = WSP(bf16_t, WS_N);
    const int* __restrict__ toke = WSP(int, WS_TOKE); const int* __restrict__ tokr = WSP(int, WS_TOKE + MiB); const float* __restrict__ tokg = WSP(float, WS_TOKE + 2 * MiB);
    const int gw = F.bid * NWV + F.wave, NGW = F.G * NWV, lane = F.lane;
    const bool last = (l == DEPTH - 1);
    int re[4], rr_[4]; float rg_[4];
    int row = row_lo + gw;
    if (row < M_ALL) {
#pragma unroll
        for (int k = 0; k < 4; ++k) { re[k] = toke[(size_t)row * 4 + k]; rr_[k] = tokr[(size_t)row * 4 + k]; rg_[k] = tokg[(size_t)row * 4 + k]; } }
    for (; row < M_ALL; row += NGW) {
        const int r9 = row_modr(row); const float* mr = mods + ((size_t)l * 9 + r9) * (NMOD * D);
        const int nrow = (row + NGW < M_ALL) ? row + NGW : row;
        int ne[4], nr[4]; float ng[4];
#pragma unroll
        for (int k = 0; k < 4; ++k) { ne[k] = toke[(size_t)nrow * 4 + k]; nr[k] = tokr[(size_t)nrow * 4 + k]; ng[k] = tokg[(size_t)nrow * 4 + k]; }
        int dst[4]; float gk[4];
#pragma unroll
        for (int k = 0; k < 4; ++k) { dst[k] = pref[re[k]] * 256 + rr_[k]; gk[k] = rg_[k]; }
        u32x2 yb[4][4]; f32x4 hv0[4], gt[4], pa[4], pb[4], pc[4];
        const float* mn = mods + ((size_t)(last ? l : l + 1) * 9 + r9) * (NMOD * D); const float* nw = last ? F.in[I_NFIN] : F.in[I_NMIX] + (l + 1) * D;
#pragma unroll
        for (int j = 0; j < 4; ++j) { const int c = 4 * lane + 256 * j;
#pragma unroll
            for (int k = 0; k < 4; ++k) yb[j][k] = *(const u32x2*)(YB + (size_t)dst[k] * D + c);
            hv0[j] = *(const f32x4*)(H + (size_t)row * D + c); gt[j] = *(const f32x4*)(mr + 5 * D + c);
            pa[j] = *(const f32x4*)(nw + c); pb[j] = *(const f32x4*)(mn + D + c); pc[j] = *(const f32x4*)(mn + c); }
        asm volatile("" ::: "memory");
        f32x4 v[4]; float ss = 0.f;
#pragma unroll
        for (int j = 0; j < 4; ++j) { const int c = 4 * lane + 256 * j; f32x4 y = (f32x4){0.f, 0.f, 0.f, 0.f};
#pragma unroll
            for (int k = 0; k < 4; ++k) { const u32x2 p = yb[j][k];
                y.x += gk[k] * __builtin_bit_cast(float, p.x << 16); y.y += gk[k] * __builtin_bit_cast(float, p.x & 0xffff0000u);
                y.z += gk[k] * __builtin_bit_cast(float, p.y << 16); y.w += gk[k] * __builtin_bit_cast(float, p.y & 0xffff0000u); }
            const f32x4 hv = hv0[j] + gt[j] * y;
            v[j] = hv; ss += (hv.x * hv.x + hv.y * hv.y) + (hv.z * hv.z + hv.w * hv.w);
            if (!last) *(f32x4*)(H + (size_t)row * D + c) = hv; }
        const float rstd = rsqrtf(wave_sum(ss) * (1.f / D) + 1e-6f);
        if (last) { float* orow = F.out + (size_t)(row - M_CTX) * D;
#pragma unroll
            for (int j = 0; j < 4; ++j) { const int c = 4 * lane + 256 * j; *(f32x4*)(orow + c) = (v[j] * rstd) * pa[j] * tsc; } }
        else {
#pragma unroll
            for (int j = 0; j < 4; ++j) { const int c = 4 * lane + 256 * j;
                const f32x4 o = (v[j] * rstd) * pa[j] * (pb[j] + 1.0f) + pc[j];
                u32x2 p; p.x = pk2(o.x, o.y); p.y = pk2(o.z, o.w); *(u32x2*)(N + (size_t)row * D + c) = p; } }
#pragma unroll
        for (int k = 0; k < 4; ++k) { re[k] = ne[k]; rr_[k] = nr[k]; rg_[k] = ng[k]; }
    }
}

#ifdef DBG_CHECK
constexpr int CW_DBG = 40000;
__device__ __forceinline__ void dbg_add(Frame& F, float num, float den) {
    float* acc = (float*)((unsigned*)(F.ws + WS_CTL) + CW_DBG);
    num = wave_sum(num); den = wave_sum(den);
    if (F.lane == 0) { atomicAdd(acc, num); atomicAdd(acc + 1, den); }
}
__device__ __forceinline__ void dbg_gdn(Frame& F, int ci) {
    const float* Q = WSP(float, WS_GQKV); const float* BG = WSP(float, WS_GBG);
    const int b = ci >> 3, h = (ci >> 1) & 3, d = ci & 1;
    const float* GO = WSP(float, WS_GDO) + (size_t)d * M_ALL * 512;
    LAS float* S = (LAS float*)F.lds;
    LAS float* part = S + 128 * 129;
    LAS float* vn = part + 512;
    LAS float* kq = vn + 128;
    const int tid = F.tid, v = tid & 127, pt = tid >> 7;
    for (int i = tid; i < 128 * 129; i += NT) S[i] = 0.f;
    __syncthreads();
    float num = 0.f, den = 0.f;
    for (int s = 0; s < CTX + SEQ; ++s) {
        const int row = chain_row(b, d, s); const float* qr = Q + (size_t)row * 1536 + h * 128;
        const float beta = BG[(size_t)row * 16 + d * 4 + h], al = __expf(BG[(size_t)row * 16 + 8 + d * 4 + h]);
        if (tid < 128) kq[tid] = qr[512 + tid]; else if (tid < 256) kq[tid] = qr[tid - 128];
        __syncthreads();
        float a = 0.f;
        for (int j = 0; j < 32; ++j) { const int kd = pt * 32 + j; const float sv = S[kd * 129 + v] * al; S[kd * 129 + v] = sv; a += sv * kq[kd]; }
        part[pt * 128 + v] = a;
        __syncthreads();
        if (tid < 128) vn[tid] = beta * (qr[1024 + tid] - (part[tid] + part[128 + tid] + part[256 + tid] + part[384 + tid]));
        __syncthreads();
        a = 0.f;
        for (int j = 0; j < 32; ++j) { const int kd = pt * 32 + j; const float sv = S[kd * 129 + v] + kq[kd] * vn[v]; S[kd * 129 + v] = sv; a += sv * kq[128 + kd]; }
        part[pt * 128 + v] = a;
        __syncthreads();
        if (tid < 128) { const float o = part[tid] + part[128 + tid] + part[256 + tid] + part[384 + tid]; const float f = GO[(size_t)row * 512 + h * 128 + tid];
            num += (o - f) * (o - f); den += o * o; }
        __syncthreads();
    }
    dbg_add(F, num, den);
}
__device__ __forceinline__ void dbg_hyena(Frame& F, int l) {
    const int gw = F.bid * NWV + F.wave, lane = F.lane;
    float num = 0.f, den = 0.f;
    for (int smp = gw; smp < 8192; smp += F.G * NWV) {
        const unsigned hsh = (unsigned)smp * 2654435761u; const int c = hsh & 255, b = (hsh >> 8) & 7; const int isc = (smp & 7) == 0; const int L = isc ? CTX : SEQ; const int t = (hsh >> 11) % L;
        const float* g = isc ? WSP(float, WS_FILTC) + ((size_t)l * 256 + c) * (2 * CTX) : WSP(float, WS_FILT) + ((size_t)l * 256 + c) * (2 * SEQ);
        const float* V = WSP(float, WS_VVT) + ((size_t)c * NB + b) * (CTX + SEQ) + (isc ? 0 : CTX);
        float a = 0.f;
        for (int s = lane; s < L; s += 64) a += g[t - s + L] * V[s];
        a = wave_sum(a);
        const float f = WSP(float, WS_YT)[((size_t)c * NB + b) * (CTX + SEQ) + (isc ? 0 : CTX) + t];
        if (isc && l == DEPTH - 1) continue;
        if (lane == 0) { num += (a - f) * (a - f); den += a * a; }
    }
    dbg_add(F, num, den);
}
__device__ __forceinline__ void dbg_moe(Frame& F, int l, LAS int* pref) {
    const bf16_t* N = WSP(bf16_t, WS_N); const bf16_t* YB = WSP(bf16_t, WS_YB);
    const int* toke = WSP(int, WS_TOKE); const int* tokr = WSP(int, WS_TOKE + MiB); const float* tokg = WSP(float, WS_TOKE + 2 * MiB);
    LAS float* xs = (LAS float*)(F.lds + F.wave * 8192);
    LAS float* as = xs + 1024;
    const int gw = F.bid * NWV + F.wave, lane = F.lane;
    float num = 0.f, den = 0.f;
    for (int smp = gw; smp < 2048; smp += F.G * NWV) {
        const int row = M_CTX + (int)(((unsigned)smp * 2654435761u) % (unsigned)M_LAT);
        for (int i = lane; i < 1024; i += 64) xs[i] = bf2f(N[(size_t)row * D + i]);
        LDS_WAIT();
        float y[16], yf[16];
#pragma unroll
        for (int j = 0; j < 16; ++j) { y[j] = 0.f; yf[j] = 0.f; }
        for (int k = 0; k < 4; ++k) { const int e = toke[(size_t)row * 4 + k]; const float gk = tokg[(size_t)row * 4 + k]; const int dst = pref[e] * 256 + tokr[(size_t)row * 4 + k];
            const float* wgu = F.in[I_MWGU] + ((size_t)l * NE + e) * D * 2048; const float* bgu = F.in[I_MBGU] + ((size_t)l * NE + e) * 2048;
            const float* wdn = F.in[I_MWDN] + ((size_t)l * NE + e) * FF * D; const float* bdn = F.in[I_MBDN] + ((size_t)l * NE + e) * D;
            for (int jf = 0; jf < 16; ++jf) { const int f = jf * 64 + lane; float g = bgu[f], u = bgu[1024 + f];
                for (int dd = 0; dd < D; ++dd) { const float x = xs[dd]; g += x * wgu[(size_t)dd * 2048 + f]; u += x * wgu[(size_t)dd * 2048 + 1024 + f]; }
                g = fminf(g, 7.f); u = fminf(fmaxf(u, -7.f), 7.f); as[f] = (u + 1.f) * (g / (1.f + __expf(-1.702f * g))); }
            LDS_WAIT();
#pragma unroll
            for (int j = 0; j < 16; ++j) { const int c = j * 64 + lane; float a = bdn[c];
                for (int f = 0; f < FF; ++f) a += as[f] * wdn[(size_t)f * D + c];
                y[j] += gk * a; yf[j] += gk * bf2f(YB[(size_t)dst * D + c]); }
            LDS_WAIT(); }
#pragma unroll
        for (int j = 0; j < 16; ++j) { num += (y[j] - yf[j]) * (y[j] - yf[j]); den += y[j] * y[j]; }
    }
    dbg_add(F, num, den);
}

__device__ __forceinline__ void dbg_static(Frame& F) {
    const int gw = F.bid * NWV + F.wave, lane = F.lane;
    float num = 0.f, den = 0.f;
    if (DBG_SUB & 1) for (int smp = gw * 64 + lane; smp < (1 << 20); smp += F.G * NT) {
        const unsigned hsh = (unsigned)smp * 2654435761u; const int l = hsh & 3, k = (hsh >> 2) & 1023, n = (hsh >> 12) % IN_COLS, n2 = (hsh >> 12) & 1023;
        const float a = F.in[I_WIN][((size_t)l * D + k) * IN_COLS + n], b = bf2f(WSP(bf16_t, WS_WIN)[((size_t)l * PW + n) * D + k]);
        const float c = F.in[I_WOUT][((size_t)l * D + k) * D + n2], d = bf2f(WSP(bf16_t, WS_WOUT)[((size_t)l * D + n2) * D + k]);
        num += (a - b) * (a - b) + (c - d) * (c - d); den += a * a + c * c; }
    if (DBG_SUB & 2) for (int smp = gw; smp < 4096; smp += F.G * NWV) {
        const unsigned hsh = (unsigned)smp * 2654435761u; const int l = hsh & 3, r = (hsh >> 2) % 9, n = (hsh >> 8) % (NMOD * D);
        float a = 0.f;
        for (int k = lane; k < D; k += 64) { const float cv = (r < 8) ? F.in[I_C][r * D + k] : F.in[I_CCTX][k]; a += siluf_(cv) * F.in[I_ADAW][((size_t)l * D + k) * (NMOD * D) + n]; }
        a = wave_sum(a) + F.in[I_ADAB][l * (NMOD * D) + n];
        const float f = WSP(float, WS_MODS)[((size_t)l * 9 + r) * (NMOD * D) + n];
        if (lane == 0) { num += (a - f) * (a - f); den += a * a; } }
    if (DBG_SUB & 4) for (int smp = gw; smp < 2048; smp += F.G * NWV) {
        const unsigned hsh = (unsigned)smp * 2654435761u; const int l = hsh & 3; const bool isctx = (hsh >> 2) & 1; const int L = isctx ? CTX : SEQ; const int p = (hsh >> 3) % L;
        const float t = (float)p / (float)(L - 1);
        LAS float* hx = (LAS float*)(F.lds + F.wave * 1024);
        float z = 0.f;
        if (lane == 0) z = t; else if (lane < 33) { const int bi = (lane - 1) & 15; const float band = 1e-4f + (float)bi * ((15.0f - 1e-4f) / 15.0f); const float ang = (6.283185307179586f / (float)L) * (float)p * band; z = (lane <= 16) ? cosf(ang) : -sinf(ang); }
        const float fr = F.in[I_HFREQ][l * 64 + lane];
        hx[lane] = z; LDS_WAIT(); float a = F.in[I_HB1][l * 64 + lane];
#pragma unroll 1
        for (int i = 0; i < 33; ++i) a += hx[i] * F.in[I_HW1][((size_t)l * 33 + i) * 64 + lane];
        float hh = sinf(fr * a); LDS_WAIT(); hx[lane] = hh; LDS_WAIT(); a = F.in[I_HB2][l * 64 + lane];
#pragma unroll 1
        for (int i = 0; i < 64; ++i) a += hx[i] * F.in[I_HW2][((size_t)l * 64 + i) * 64 + lane];
        hh = sinf(fr * a); LDS_WAIT(); hx[lane] = hh; LDS_WAIT(); a = F.in[I_HB3][l * 64 + lane];
#pragma unroll 1
        for (int i = 0; i < 64; ++i) a += hx[i] * F.in[I_HW3][((size_t)l * 64 + i) * 64 + lane];
        hh = sinf(fr * a); LDS_WAIT(); hx[lane] = hh; LDS_WAIT();
        const int ch = ((hsh >> 16) + lane * 16) & 255; float of = 0.f, ob = 0.f;
#pragma unroll 1
        for (int i = 0; i < 64; ++i) { of += hx[i] * F.in[I_HW4][((size_t)l * 64 + i) * 512 + ch]; ob += hx[i] * F.in[I_HW4][((size_t)l * 64 + i) * 512 + 256 + ch]; }
        const float dl = -3.0701134573253946f + (float)ch * ((-15.350567286626973f + 3.0701134573253946f) / 255.0f); const float win = __expf(-t * fabsf(dl));
        of = of * win + (p == 0 ? F.in[I_HSKIP][l * 256 + ch] : 0.f); ob *= win;
        const float* filt = isctx ? WSP(float, WS_FILTC) + ((size_t)l * 256 + ch) * (2 * CTX) : WSP(float, WS_FILT) + ((size_t)l * 256 + ch) * (2 * SEQ);
        if (lane < 16) { const float ff = filt[L + p]; num += (of - ff) * (of - ff); den += of * of;
            if (p >= 1) { const float fb = filt[L - p]; num += (ob - fb) * (ob - fb); den += ob * ob; } }
        LDS_WAIT(); }
    dbg_add(F, num, den);
}

__device__ __forceinline__ float dbg_rw_m(const float* P, const float* mu, int row, int cc) {
    const bool isctx = row < M_CTX; const int b = row_batch(row); const int t = isctx ? row - b * CTX : row - M_CTX - b * SEQ;
    const float* pr = P + (size_t)row * PW + C_RW; float sh = 0.f;
    if (isctx) { if ((cc & 1) == 0) { if (t > 0) sh = pr[-PW + cc]; } else { if (t < CTX - 1) sh = pr[PW + cc]; } }
    else { const int gr = t / 64, gc = t % 64, m4 = cc % 4;
        if (m4 == 0) { if (gc > 0) sh = pr[-PW + cc]; } else if (m4 == 1) { if (gc < 63) sh = pr[PW + cc]; } else if (m4 == 2) { if (gr > 0) sh = pr[-64 * PW + cc]; } else { if (gr < 31) sh = pr[64 * PW + cc]; } }
    return pr[cc] + mu[cc] * (sh - pr[cc]);
}
__device__ __forceinline__ void dbg_prep(Frame& F, int l) {
    const float* P = WSP(float, WS_P); const int gw = F.bid * NWV + F.wave, lane = F.lane;
    float num = 0.f, den = 0.f;
    if (DBG_SUB & 1) for (int smp = gw; smp < 1024; smp += F.G * NWV) {
        const int row = (int)(((unsigned)smp * 2654435761u) % (unsigned)M_ALL);
        const float* mu = F.in[I_RMU] + (size_t)l * RWC; const float* rw = WSP(float, WS_RW) + (size_t)row * 2560;
#pragma unroll 1
        for (int q = 0; q < 4; ++q) { const int c = lane + 64 * q;
            const float r_ = dbg_rw_m(P, mu, row, c), k_ = dbg_rw_m(P, mu, row, 256 + c), v_ = dbg_rw_m(P, mu, row, 512 + c);
            float lw[2] = {F.in[I_RW0][l * 512 + c], F.in[I_RW0][l * 512 + 256 + c]}, la[2] = {F.in[I_RA0][l * 512 + c], F.in[I_RA0][l * 512 + 256 + c]}, g = 0.f;
#pragma unroll 1
            for (int r = 0; r < 64; ++r) {
#pragma unroll
                for (int d = 0; d < 2; ++d) { lw[d] += tanhf(dbg_rw_m(P, mu, row, 768 + d * 64 + r)) * F.in[I_RW2][(((size_t)l * 2 + d) * 64 + r) * 256 + c];
                    la[d] += dbg_rw_m(P, mu, row, 896 + d * 64 + r) * F.in[I_RA2][(((size_t)l * 2 + d) * 64 + r) * 256 + c]; } }
#pragma unroll 1
            for (int r = 0; r < 128; ++r) g += sigmoidf_(dbg_rw_m(P, mu, row, 1024 + r)) * F.in[I_RG2][((size_t)l * 128 + r) * 256 + c];
            const float kx = k_ * F.in[I_RKK][l * 256 + c]; const float kk = kx * rsqrtf(wave_sum(kx * kx) + 1e-12f);
            float ref[10]; ref[0] = r_; ref[1] = v_; ref[2] = kk; ref[9] = g; float bon = 0.f;
#pragma unroll
            for (int d = 0; d < 2; ++d) { const float lwv = -softplusf_(-lw[d]) - 0.5f; ref[3 + 3 * d] = expf(-expf(lwv)); const float a = sigmoidf_(la[d]);
                const float kd = k_ * (1.f + (a - 1.f) * F.in[I_RKA][l * 256 + c]); ref[4 + 3 * d] = kd; ref[5 + 3 * d] = kk * a; bon += r_ * kd * F.in[I_RRK][l * 256 + c]; }
            bon = wave_sum(bon);
#pragma unroll
            for (int j = 0; j < 10; ++j) { const float f = rw[j * 256 + c]; num += (ref[j] - f) * (ref[j] - f); den += ref[j] * ref[j]; }
            if (lane == 0) { const float f = WSP(float, WS_RWBON)[(size_t)row * 4 + q]; num += (bon - f) * (bon - f); den += bon * bon; } } }
    if (DBG_SUB & 2) for (int smp = gw; smp < 4096; smp += F.G * NWV) {
        const int row = (int)(((unsigned)smp * 2654435761u) % (unsigned)M_ALL);
        const bool isctx = row < M_CTX; const int L = isctx ? CTX : SEQ; const int b = row_batch(row); const int t = isctx ? row - b * CTX : row - M_CTX - b * SEQ;
        const float* cw = F.in[I_GCONV] + (size_t)l * 5 * 1536; const float* q = WSP(float, WS_GQKV) + (size_t)row * 1536;
#pragma unroll 1
        for (int part = 0; part < 3; ++part)
#pragma unroll 1
            for (int hd = 0; hd < 4; ++hd) { float x[2];
#pragma unroll
                for (int jj = 0; jj < 2; ++jj) { const int c = part * 512 + hd * 128 + jj * 64 + lane; float a = 0.f;
                    for (int tap = 0; tap < 5; ++tap) { const int tt = t + tap - 2; if (tt >= 0 && tt < L) a += P[(size_t)(row + tap - 2) * PW + C_GD + c] * cw[tap * 1536 + c]; }
                    x[jj] = a / (1.f + expf(-a)); }
                if (part < 2) { const float sc = rsqrtf(wave_sum(x[0] * x[0] + x[1] * x[1]) + 1e-12f) * (part == 0 ? 0.08838834764831845f : 1.f); x[0] *= sc; x[1] *= sc; }
#pragma unroll
                for (int jj = 0; jj < 2; ++jj) { const float f = q[part * 512 + hd * 128 + jj * 64 + lane]; num += (x[jj] - f) * (x[jj] - f); den += x[jj] * x[jj]; } }
        if (lane < 16) { const float rv = P[(size_t)row * PW + C_GD + 2048 + lane]; float ov;
            if (lane < 8) ov = 1.f / (1.f + expf(-rv)); else { const int dh = lane - 8; ov = -expf(F.in[I_GALOG][l * 8 + dh]) * softplusf_(rv + F.in[I_GDT][l * 8 + dh]); }
            const float f = WSP(float, WS_GBG)[(size_t)row * 16 + lane]; num += (ov - f) * (ov - f); den += ov * ov; } }
    if (DBG_SUB & 4) for (int smp = gw; smp < 4096; smp += F.G * NWV) {
        const int row = M_CTX + (int)(((unsigned)smp * 2654435761u) % (unsigned)M_LAT); const int b = row_batch(row), t = row - M_CTX - b * SEQ;
        const float* sw = F.in[I_HSW] + (size_t)l * 3 * 768; const float* sb = F.in[I_HSB] + (size_t)l * 768;
        const bf16_t* yc = WSP(bf16_t, WS_YCAT) + (size_t)row * D;
#pragma unroll 1
        for (int j = 0; j < 4; ++j) { const int c = j * 64 + lane; float u[3];
#pragma unroll
            for (int g3 = 0; g3 < 3; ++g3) { float a = sb[g3 * 256 + c];
                for (int tap = 0; tap < 3; ++tap) { const int tt = t + tap - 1; if (tt >= 0 && tt < SEQ) a += P[(size_t)(row + tap - 1) * PW + g3 * 256 + c] * sw[tap * 768 + g3 * 256 + c]; }
                u[g3] = a; }
            const float vv = u[2] * u[1]; const float fv = WSP(float, WS_VVT)[((size_t)c * NB + b) * (CTX + SEQ) + CTX + t];
            num += (vv - fv) * (vv - fv); den += vv * vv;
            const float yv = WSP(float, WS_YT)[((size_t)c * NB + b) * (CTX + SEQ) + CTX + t] * u[0]; const float fy = bf2f(yc[c]);
            num += (yv - fy) * (yv - fy); den += yv * yv; }
        const float* rw = WSP(float, WS_RW) + (size_t)row * 2560;
#pragma unroll 1
        for (int q = 0; q < 4; ++q) { const int c = lane + 64 * q; const float o = WSP(float, WS_RWO)[(size_t)row * 256 + c] + WSP(float, WS_RWO)[(size_t)(M_ALL + row) * 256 + c];
            const float mean = wave_sum(o) / 64.f; const float var = wave_sum((o - mean) * (o - mean)) / 64.f;
            float y = (o - mean) / sqrtf(var + 64e-5f) * F.in[I_RGNW][l * 256 + c] + F.in[I_RGNB][l * 256 + c];
            y = (y + WSP(float, WS_RWBON)[(size_t)row * 4 + q] * rw[256 + c]) * rw[9 * 256 + c];
            const float fy = bf2f(yc[256 + c]); num += (y - fy) * (y - fy); den += y * y; }
#pragma unroll 1
        for (int hd = 0; hd < 4; ++hd) { float o[2];
#pragma unroll
            for (int jj = 0; jj < 2; ++jj) { const int c = hd * 128 + jj * 64 + lane; o[jj] = WSP(float, WS_GDO)[(size_t)row * 512 + c] + WSP(float, WS_GDO)[(size_t)(M_ALL + row) * 512 + c]; }
            const float rs = 1.f / sqrtf(wave_sum(o[0] * o[0] + o[1] * o[1]) / 128.f + 1e-6f);
#pragma unroll
            for (int jj = 0; jj < 2; ++jj) { const int c = hd * 128 + jj * 64 + lane; const float z = P[(size_t)row * PW + C_GD + 1536 + c];
                const float y = o[jj] * rs * F.in[I_GNW][l * 128 + jj * 64 + lane] * (z / (1.f + expf(-z))); const float fy = bf2f(yc[512 + c]); num += (y - fy) * (y - fy); den += y * y; } } }
    dbg_add(F, num, den);
}
__device__ __forceinline__ void dbg_router(Frame& F, int l) {
    const int gw = F.bid * NWV + F.wave, lane = F.lane; LAS float* xs = (LAS float*)(F.lds + F.wave * 4096);
    float num = 0.f, den = 0.f;
    for (int smp = gw; smp < 4096; smp += F.G * NWV) {
        const int row = M_CTX + (int)(((unsigned)smp * 2654435761u) % (unsigned)M_LAT); const int b = row_batch(row);
        const float* h = WSP(float, WS_H) + (size_t)row * D; const float* mr = WSP(float, WS_MODS) + ((size_t)l * 9 + b) * (NMOD * D);
        float ss = 0.f; for (int i = lane; i < D; i += 64) ss += h[i] * h[i];
        const float rstd = 1.f / sqrtf(wave_sum(ss) / D + 1e-6f);
        for (int i = lane; i < D; i += 64) xs[i] = h[i] * rstd * F.in[I_NFFN][l * D + i] * (1.f + mr[4 * D + i]) + mr[3 * D + i];
        LDS_WAIT();
        float lg = -3e38f;
        if (lane < 32) { lg = F.in[I_MRB][l * NE + lane]; for (int k = 0; k < D; ++k) lg += xs[k] * F.in[I_MRW][((size_t)l * D + k) * NE + lane]; }
        float sv[4]; int se[4]; float cur = lg;
#pragma unroll
        for (int k = 0; k < 4; ++k) { float m = cur;
#pragma unroll
            for (int o = 1; o < 64; o <<= 1) m = fmaxf(m, __shfl_xor(m, o));
            const unsigned long long bal = __ballot(cur == m); const int who = __ffsll((long long)bal) - 1; sv[k] = m; se[k] = who; if (lane == who) cur = -3e38f; }
        float ex[4], dn = 0.f;
#pragma unroll
        for (int k = 0; k < 4; ++k) { ex[k] = expf(sv[k] - sv[0]); dn += ex[k]; }
        if (lane == 0) {
#pragma unroll
            for (int k = 0; k < 4; ++k) { const float g = ex[k] / dn; float fg = 0.f;
                for (int k2 = 0; k2 < 4; ++k2) if (WSP(int, WS_TOKE)[(size_t)row * 4 + k2] == se[k]) fg = WSP(float, WS_TOKE + 2 * MiB)[(size_t)row * 4 + k2];
                num += (g - fg) * (g - fg); den += g * g; } }
        LDS_WAIT(); }
    dbg_add(F, num, den);
}
__device__ __forceinline__ void dbg_rwkv_scan(Frame& F, int ci) {
    const int lane = F.lane; const int b = ci >> 3, h = (ci >> 1) & 3, d = ci & 1;
    const float* RW = WSP(float, WS_RW); const float* RO = WSP(float, WS_RWO) + (size_t)d * M_ALL * 256;
    LAS float* vs = (LAS float*)(F.lds + F.wave * 2048);
    float S[64];
#pragma unroll
    for (int k = 0; k < 64; ++k) S[k] = 0.f;
    float num = 0.f, den = 0.f;
#pragma unroll 1
    for (int s = 0; s < CTX + SEQ; ++s) { const int row = chain_row(b, d, s); const float* src = RW + (size_t)row * 2560 + h * 64;
        vs[lane] = -src[2 * 256 + lane]; vs[64 + lane] = src[(3 + 3 * d) * 256 + lane]; vs[128 + lane] = src[(5 + 3 * d) * 256 + lane]; vs[192 + lane] = src[(4 + 3 * d) * 256 + lane]; vs[256 + lane] = src[lane];
        const float v = src[256 + lane]; LDS_WAIT();
        float sa = 0.f;
#pragma unroll
        for (int k = 0; k < 64; ++k) sa += S[k] * vs[k];
        float o = 0.f;
#pragma unroll
        for (int k = 0; k < 64; ++k) { S[k] = S[k] * vs[64 + k] + sa * vs[128 + k] + v * vs[192 + k]; o += S[k] * vs[256 + k]; }
        const float f = RO[(size_t)row * 256 + h * 64 + lane]; num += (o - f) * (o - f); den += o * o; LDS_WAIT(); }
    dbg_add(F, num, den);
}
__device__ __forceinline__ void dbg_scale(Frame& F, float K) {
    const float* acc = (const float*)((unsigned*)(F.ws + WS_CTL) + CW_DBG);
    const float rel = sqrtf(acc[0] / fmaxf(acc[1], 1e-30f)); const float sc = 1.f + K * rel;
    for (size_t i = (size_t)F.bid * NT + F.tid; i < (size_t)M_LAT * D; i += (size_t)F.G * NT) F.out[i] *= sc;
}
#endif

#ifdef TPROBE
__device__ __attribute__((noinline)) void tprobe_stamp(unsigned char* ws, int mode) {
    unsigned* t = (unsigned*)(ws + WS_CTL) + 50000;
    if (blockIdx.x == 0 && threadIdx.x == 0) { const unsigned now = (unsigned)__builtin_amdgcn_s_memrealtime();
        if (mode == 2) { t[2] = now; t[1] = now; }
        else if (mode == 0) t[1] = now;
        else atomicAdd(t, now - t[1]); }
}
__device__ __attribute__((noinline)) float tprobe_scale(unsigned char* ws) {
    const unsigned* t = (const unsigned*)(ws + WS_CTL) + 50000;
    const unsigned acc = __hip_atomic_load(t, __ATOMIC_RELAXED, __HIP_MEMORY_SCOPE_AGENT), st = __hip_atomic_load(t + 2, __ATOMIC_RELAXED, __HIP_MEMORY_SCOPE_AGENT);
    const unsigned now = (unsigned)__builtin_amdgcn_s_memrealtime();
    return 1.0f + TPROBE_K * (float)acc / (float)(now - st);
}
#endif
constexpr int PH_PER_LAYER = 11, N_PHASES = 1 + DEPTH * PH_PER_LAYER;
__global__ void __launch_bounds__(NT, 2) hybrid_fwd(Args args) {
    extern __shared__ __attribute__((aligned(16))) unsigned char lds_raw[];
    Frame F;
    F.lds = (LAS unsigned char*)lds_raw;
    F.tid = threadIdx.x; F.lane = F.tid & 63; F.wave = __builtin_amdgcn_readfirstlane(F.tid >> 6);
    F.G = gridDim.x; F.bid = blockIdx.x; F.in = args.in; F.ws = args.ws; F.out = args.out;
    const int wave0 = F.wave;
    volatile LAS unsigned* MISC = (volatile LAS unsigned*)(F.lds + MISC_OFF);
    LAS int* pref = (LAS int*)(F.lds + MISC_OFF + 256);
    if (F.tid < 4) MISC[F.tid] = 0u;
    __syncthreads();
    const int lo = args.ph_lo, hi = args.ph_hi;
    XcdBarrier bar; bar.bar = (unsigned*)(F.ws + WS_CTL) + CW_BAR; bar.x = 0; bar.st = MISC;
    if (hi - lo > 1) bar = xcd_barrier_post((unsigned*)(F.ws + WS_CTL) + CW_BAR, MISC);
#ifndef PHASE_MASK
#define PHASE_MASK 0xFFFF
#endif
#define PM(j) ((PHASE_MASK >> (j)) & 1)
#define ENTER() do { F.ws = launder_ptr(F.ws); F.out = launder_ptr(F.out); l = launder_int(l); { int ln_; asm volatile("v_mbcnt_lo_u32_b32 %0, -1, 0\n\tv_mbcnt_hi_u32_b32 %0, -1, %0" : "=&v"(ln_)); __builtin_assume(ln_ >= 0 && ln_ < 64); F.lane = ln_; F.wave = launder_int(wave0); __builtin_assume(F.wave >= 0 && F.wave < 8); F.tid = F.wave * 64 + ln_; } } while (0)
#define IN(k) (lo <= (k) && (k) < hi)
#define last (l == DEPTH - 1)
#ifdef TPROBE
#define SEAMC(k, cls) do { if (hi > (k) + 1) xcd_barrier(bar); \
        if ((cls) == TPROBE - 1) tprobe_stamp(F.ws, 0); \
        if ((cls) == TPROBE) tprobe_stamp(F.ws, 1); } while (0)
#else
#define SEAMC(k, cls) do { if (hi > (k) + 1) xcd_barrier(bar); } while (0)
#endif
#define SEAM(k) SEAMC(k, 99)
#ifdef TPROBE
    tprobe_stamp(F.ws, 2);
#endif
    if (PM(11) && IN(0)) { phase_prologue(F);
#if defined(DUP_PHASE) && DUP_PHASE == 0
        __syncthreads(); phase_prologue(F);
#endif
        SEAM(0); }
    for (int l = 0; l < DEPTH; ++l) {
        const int pb = 1 + l * PH_PER_LAYER;
        if (PM(0) && l == 0 && IN(pb + 0)) { ENTER(); phase_norm0(F); SEAMC(pb + 0, 1); }
        if (PM(1) && IN(pb + 1)) {
            ENTER();
            pg8::StaticOrder S; S.init(WSP(bf16_t, WS_N), WSP(bf16_t, WS_WIN) + (size_t)l * PW * D, M_ALL, PW, D, F.G, F.bid);
            pg8::EpiF32 E{WSP(float, WS_P), PW};
            const bool split = (F.G == 256) && (hi - lo > 1);
            if (split) S.i1 = 4;
            pg8::gemm_phase(F.lds, S, E, F.tid);
            if (split) {
                xcd_barrier(bar);
                if (F.bid < 128) { S.i0 = 4; S.i1 = 5; pg8::gemm_phase(F.lds, S, E, F.tid); }
                else { const int j = F.bid - 128; TileSched t1 = strided_sched(F, 0); t1.bal = true;
                    if (j < 64) { t1.v0 = j; prep_rwkv(F, l, t1); }
                    else if (j < 96) { t1.v0 = j - 64; prep_gdn(F, l, t1); }
                    else if (!last) { t1.v0 = j - 96; prep_hyena(F, l, true, t1); } }
            }
#if defined(DUPX) && DUPX == 2
            __syncthreads(); pg8::gemm_phase(F.lds, S, E, F.tid);
#endif
#if defined(DUP_PHASE) && DUP_PHASE == 2
            __syncthreads(); pg8::gemm_phase(F.lds, S, E, F.tid);
#endif
            SEAMC(pb + 1, 2);
        }
        if (PM(2) && IN(pb + 2)) {
            ENTER();
#ifndef SUBM
#define SUBM 7
#endif
            TileSched th = strided_sched(F, M_ALL / 64), tr = strided_sched(F, M_ALL / 32), tg = strided_sched(F, M_ALL / 64);
            if (F.G == 256 && hi - lo > 1) { const int i = F.bid; th.bal = tr.bal = tg.bal = true;
                tr.v0 = 64 + i; tr.v1 = 320 + i; tg.v0 = 32 + i; th.v0 = 32 + i; }
            else if (F.G == 256) { const int i = F.bid; th.bal = tr.bal = tg.bal = true;
                tr.v0 = i; tr.v1 = i + 256; tr.v2 = (i + 512 < M_ALL / 32) ? i + 512 : -1;
                tg.v0 = i; tg.v1 = (i >= 64 && i < 96) ? 256 + (i - 64) : -1;
                th.v0 = i; th.v1 = (i >= 96 && i < 128) ? 256 + (i - 96) : -1; }
            prep_hyena(F, l, !last, th); __syncthreads(); prep_rwkv(F, l, tr); __syncthreads(); prep_gdn(F, l, tg);
#if defined(DUPX) && DUPX == 3
            __syncthreads(); prep_hyena(F, l, !last, th); __syncthreads(); prep_rwkv(F, l, tr); __syncthreads(); prep_gdn(F, l, tg);
#endif
#if defined(DUPX) && DUPX == 31
            __syncthreads(); prep_rwkv(F, l, tr);
#endif
#if defined(DUPX) && DUPX == 32
            __syncthreads(); prep_gdn(F, l, tg);
#endif
            SEAMC(pb + 2, 3); }
        if (PM(3) && IN(pb + 3)) {
            ENTER();
            if (F.wave < 5) { LAS unsigned char* wl = F.lds + F.wave * 27648;
                if (F.G == 256) {
                    { const int u = F.bid * 5 + F.wave; gdn_precompute_wave(F, u / NCHUNK, u % NCHUNK, wl); }
                    if (F.wave < 4) { const int u = 1280 + F.bid * 4 + F.wave; gdn_precompute_wave(F, u / NCHUNK, u % NCHUNK, wl); } }
                else for (int u = F.bid * 5 + F.wave; u < 64 * NCHUNK; u += F.G * 5) gdn_precompute_wave(F, u / NCHUNK, u % NCHUNK, wl); }
            __syncthreads();
            for (int c = F.bid; c < 256; c += F.G) { hyena_lat_unit(F, l, c); if (!last) hyena_ctx_unit(F, l, c); }
#if defined(DUPX) && DUPX == 4
            __syncthreads(); if (F.wave < 5) { LAS unsigned char* wl = F.lds + F.wave * 27648; for (int u = F.bid * 5 + F.wave; u < 64 * NCHUNK; u += F.G * 5) gdn_precompute_wave(F, u / NCHUNK, u % NCHUNK, wl); }
            __syncthreads();
#endif
#if defined(DUPX) && DUPX == 41
            __syncthreads(); for (int c = F.bid; c < 256; c += F.G) { hyena_lat_unit(F, l, c); if (!last) hyena_ctx_unit(F, l, c); }
#endif
            SEAMC(pb + 3, 4);
        }
        if (PM(4) && IN(pb + 4)) {
            ENTER();
            {
                volatile LAS unsigned* sbc = (volatile LAS unsigned*)(F.lds + MISC_OFF + 64);
                if (F.tid == 0) *sbc = 0u;
                __syncthreads();
                if (F.wave < 4) { unsigned gen = 0u;
                    if (F.G == 256) { const int xcd = F.bid & 7, t = F.bid >> 3; rwkv_scan_quarter(F, (t >> 2) * 8 + xcd, t & 3, sbc, gen); }
                    else for (int u = F.bid; u < 256; u += F.G) rwkv_scan_quarter(F, u >> 2, u & 3, sbc, gen);
#if defined(DUP_PHASE) && DUP_PHASE == 53
                    { const int xcd = F.bid & 7, t = F.bid >> 3; rwkv_scan_quarter(F, (t >> 2) * 8 + xcd, t & 3, sbc, gen); }
#endif
                }
                else { LAS bf16_t* St = (LAS bf16_t*)(F.lds + 90112 + (F.wave - 4) * 14336); LAS bf16_t* Vn = St + 32 * 136;
                    if (F.G == 256) {
                        if (F.wave == 4) { const int xcd = F.bid & 7, t = F.bid >> 3; gdn_chain_wave(F, (t >> 2) * 8 + xcd, t & 3, St, Vn);
#if defined(DUP_PHASE) && DUP_PHASE == 54
                            gdn_chain_wave(F, (t >> 2) * 8 + xcd, t & 3, St, Vn);
#endif
                        } }
                    else for (int g = F.bid * 4 + (F.wave - 4); g < 256; g += F.G * 4) gdn_chain_wave(F, g >> 2, g & 3, St, Vn);
                }
                __syncthreads();
            }
            SEAMC(pb + 4, 5);
        }
        if (PM(5) && IN(pb + 5)) { ENTER(); phase_finish(F, l, !last);
#if defined(DUP_PHASE) && DUP_PHASE == 6
            __syncthreads(); phase_finish(F, l, !last);
#endif
            SEAMC(pb + 5, 6); }
        if (PM(6) && IN(pb + 6)) {
            ENTER();
            const int r0 = last ? M_CTX : 0;
            pg8::StaticOrder S; S.init(WSP(bf16_t, WS_YCAT) + (size_t)r0 * D, WSP(bf16_t, WS_WOUT) + (size_t)l * D * D, M_ALL - r0, D, D, F.G, F.bid);
            pg8::EpiRes E{WSP(float, WS_H) + (size_t)r0 * D, WSP(float, WS_H) + (size_t)r0 * D, WSP(float, WS_MODS) + (size_t)l * 9 * (NMOD * D) + 2 * D, r0};
            pg8::gemm_phase(F.lds, S, E, F.tid);
            SEAMC(pb + 6, 7);
        }
        if (PM(7) && IN(pb + 7)) { ENTER(); phase_router2(F, l, last ? M_CTX : 0);
#if defined(DUPX) && DUPX == 8
            __syncthreads(); phase_router(F, l, last ? M_CTX : 0, true);
#endif
#if defined(DUPX) && DUPX == 81
            __syncthreads(); phase_router2(F, l, last ? M_CTX : 0, true);
#endif
 SEAMC(pb + 7, 8); }
        if (PM(8) && IN(pb + 8)) {
            ENTER();
            moe_prefix(F, l, pref);
            pg8::MoeOrder<true, 8> S; S.A = WSP(bf16_t, WS_N); S.Bt = WSP(bf16_t, WS_WGU) + (size_t)l * NE * 2048 * D; S.K = D; S.Nexp = 2048; S.pref = pref; S.stok = WSP(int, WS_STOK); S.G = F.G; S.c = F.bid;
            pg8::EpiGU E{WSP(bf16_t, WS_ACT), F.in[I_MBGU] + (size_t)l * NE * 2048};
            pg8::gemm_phase(F.lds, S, E, F.tid);
            SEAMC(pb + 8, 9);
        }
        if (PM(9) && IN(pb + 9)) {
            ENTER();
            moe_prefix(F, l, pref);
            pg8::MoeOrder<false, 4> S; S.A = WSP(bf16_t, WS_ACT); S.Bt = WSP(bf16_t, WS_WDN) + (size_t)l * NE * D * FF; S.K = FF; S.Nexp = D; S.pref = pref; S.stok = nullptr; S.G = F.G; S.c = F.bid;
            pg8::EpiDN E{WSP(bf16_t, WS_YB), F.in[I_MBDN] + (size_t)l * NE * D};
            pg8::gemm_phase(F.lds, S, E, F.tid);
#if defined(DUP_PHASE) && DUP_PHASE == 10
            __syncthreads(); pg8::gemm_phase(F.lds, S, E, F.tid);
#endif
            SEAMC(pb + 9, 10);
        }
        if (PM(10) && IN(pb + 10)) { ENTER(); moe_prefix(F, l, pref); float tsc = 1.0f;
#ifdef TPROBE
            if (last) tsc = tprobe_scale(F.ws);
#endif
            phase_combine(F, l, last ? M_CTX : 0, pref, tsc); SEAMC(pb + 10, 11); }
    }
#undef IN
#undef SEAM
#undef last
}


#ifdef DBG_CHECK
__global__ void __launch_bounds__(NT, 2) dbg_kernel(Args args) {
    extern __shared__ __attribute__((aligned(16))) unsigned char lds_raw[];
    Frame F;
    F.lds = (LAS unsigned char*)lds_raw;
    F.tid = threadIdx.x; F.lane = F.tid & 63; F.wave = __builtin_amdgcn_readfirstlane(F.tid >> 6);
    F.G = gridDim.x; F.bid = blockIdx.x; F.in = args.in; F.ws = args.ws; F.out = args.out;
    LAS int* pref = (LAS int*)(F.lds + MISC_OFF + 256);
    const int l = DEPTH - 1;
    if (args.ph_lo == 0) {
        if (DBG_CHECK == 1) { moe_prefix(F, l, pref); dbg_moe(F, l, pref); }
        if (DBG_CHECK == 2) { if (F.bid < 8) dbg_gdn(F, F.bid * 8 + (F.bid & 1) + 2 * (F.bid % 4)); }
        if (DBG_CHECK == 3) dbg_hyena(F, l);
        if (DBG_CHECK == 4) dbg_static(F);
        if (DBG_CHECK == 5) dbg_prep(F, l);
        if (DBG_CHECK == 6) dbg_router(F, l);
        if (DBG_CHECK == 7) { if (F.bid < 8 && F.wave == 0) dbg_rwkv_scan(F, F.bid * 8 + (F.bid & 1) + 2 * (F.bid % 4)); }
    } else dbg_scale(F, DBG_K);
}
#endif
extern "C" void kernel_launch(void* const* d_in, const int* in_sizes, int n_in, void* d_out, int out_size, void* d_ws, size_t ws_size, hipStream_t stream) {
    static int grid = 0;
    if (grid == 0) {
        int dev = 0, cus = 0, per_cu = 0;
        if (n_in != 43 || ws_size < WS_END) { fprintf(stderr, "kernel_launch: unexpected inputs (%d) or workspace (%zu < %zu)\n", n_in, ws_size, (size_t)WS_END); grid = -1; return; }
        if (hipGetDevice(&dev) != hipSuccess || hipDeviceGetAttribute(&cus, hipDeviceAttributeMultiprocessorCount, dev) != hipSuccess) { grid = -1; return; }
        if (hipFuncSetAttribute((const void*)hybrid_fwd, hipFuncAttributeMaxDynamicSharedMemorySize, LDS_BYTES) != hipSuccess) { fprintf(stderr, "kernel_launch: hipFuncSetAttribute failed\n"); grid = -1; return; }
        if (hipOccupancyMaxActiveBlocksPerMultiprocessor(&per_cu, (const void*)hybrid_fwd, NT, LDS_BYTES) != hipSuccess || per_cu < 1) fprintf(stderr, "kernel_launch: occupancy query reports %d\n", per_cu);
        (void)hipGetLastError();
        grid = cus;
    }
    if (grid < 0) return;
    (void)hipMemsetAsync((char*)d_ws + WS_CTL, 0, CTL_ZERO, stream);
    Args a{};
    for (int i = 0; i < 43; ++i) a.in[i] = (const float*)d_in[i];
    a.out = (float*)d_out; a.ws = (unsigned char*)d_ws;
#if N_LAUNCH_MODE == 1
    a.ph_lo = 0; a.ph_hi = N_PHASES;
    hipLaunchKernelGGL(hybrid_fwd, dim3(grid), dim3(NT), LDS_BYTES, stream, a);
#else
    const int nph = N_PHASES;
    for (int ph = 0; ph < nph; ++ph) {
        if (ph > 0 && ph < N_PHASES && (ph - 1) % PH_PER_LAYER == 0 && (ph - 1) / PH_PER_LAYER > 0) continue;
        a.ph_lo = ph; a.ph_hi = ph + 1;
        hipLaunchKernelGGL(hybrid_fwd, dim3(grid), dim3(NT), LDS_BYTES, stream, a);
    }
#ifdef DBG_CHECK
    static int dbg_init = 0;
    if (!dbg_init) { (void)hipFuncSetAttribute((const void*)dbg_kernel, hipFuncAttributeMaxDynamicSharedMemorySize, LDS_BYTES); dbg_init = 1; }
    a.ph_lo = 0; a.ph_hi = 1; hipLaunchKernelGGL(dbg_kernel, dim3(grid), dim3(NT), LDS_BYTES, stream, a);
    a.ph_lo = 1; a.ph_hi = 2; hipLaunchKernelGGL(dbg_kernel, dim3(grid), dim3(NT), LDS_BYTES, stream, a);
#endif
#endif
}
```
